# Optimizing an MI355X kernel written in HIP

```python
import jax, jax.numpy as jnp
from jax import lax
import numpy as np

D_MODEL = 1024
BATCH = 16
SEQ = 256
DEPTH = 4
DEC_BATCH = 4
DEC_SEQ = 4096
PAST_LEN = 256

GRID_W = 64
N_EVEN = (DEPTH + 1) // 2
N_ODD = DEPTH // 2
EPS = 1e-6

HEAD_DIM = 64
A_Q_HEADS = 8
A_KV_HEADS = 2
A_GROUPS = A_Q_HEADS // A_KV_HEADS
WINDOW = 128
BLOCK = 128
ROPE_BASE = 10000.0
NEG_INF = -1e30

B_HEADS = 4
B_DK = 64
B_DV = 128
GLA_RANK = 16
GLA_NORMALIZER = 16.0
GLA_CHUNK = 64

A_WIDTH = A_Q_HEADS * HEAD_DIM
B_WIDTH = B_HEADS * B_DV
MIX_WIDTH = A_WIDTH + B_WIDTH
SIZES_EVEN = (A_Q_HEADS * HEAD_DIM, A_KV_HEADS * HEAD_DIM, A_KV_HEADS * HEAD_DIM,
              B_HEADS * B_DK, B_HEADS * B_DK, B_HEADS * B_DV, B_HEADS * B_DV, 2 * GLA_RANK)
P_EVEN = sum(SIZES_EVEN)

D_RNN = D_MODEL
LRU_BLOCK_W = 256
LRU_BLOCKS = D_RNN // LRU_BLOCK_W
CONV_W = 4
LRU_C = 8.0

D_FF = ((8 * D_MODEL + 3 * 256 - 1) // (3 * 256)) * 256

kernel_name = 'hybrid_diffusion_prefix_step'


def rmsnorm(x, g):
    xf = x.astype(jnp.float32)
    y = xf * lax.rsqrt(jnp.mean(xf * xf, axis=-1, keepdims=True) + EPS)
    return (y * g.astype(jnp.float32)).astype(x.dtype)


def modulate(x, g, shift, scale):
    return rmsnorm(x, g) * (1 + scale) + shift


def ada(cvec, w, b):
    return jnp.split(jax.nn.silu(cvec) @ w + b, 6, axis=-1)


def split_cols(z, sizes):
    return jnp.split(z, list(np.cumsum(sizes)[:-1]), axis=-1)


def rope_2d(x):
    T = x.shape[1]
    n_rows = T // GRID_W
    rows = jnp.repeat(jnp.arange(n_rows, dtype=jnp.float32), GRID_W)
    cols = jnp.tile(jnp.arange(GRID_W, dtype=jnp.float32), n_rows)
    nf = HEAD_DIM // 4
    inv = ROPE_BASE ** (-jnp.arange(nf, dtype=jnp.float32) / nf)
    ar = rows[:, None] * inv
    ac = cols[:, None] * inv
    ang = jnp.concatenate([ar, ar, ac, ac], axis=-1)
    shp = (T,) + (1,) * (x.ndim - 3) + (HEAD_DIM,)
    cos = jnp.cos(ang).reshape(shp)
    sin = jnp.sin(ang).reshape(shp)

    def rot_half(z):
        z1, z2 = jnp.split(z, 2, axis=-1)
        return jnp.concatenate([-z2, z1], axis=-1)

    xr, xc = jnp.split(x, 2, axis=-1)
    xrot = jnp.concatenate([rot_half(xr), rot_half(xc)], axis=-1)
    return (x * cos + xrot * sin).astype(x.dtype)


def sink_softmax(scores, sink):
    s = sink.astype(jnp.float32).reshape(A_KV_HEADS, A_GROUPS, 1, 1)
    s = jnp.broadcast_to(s, scores.shape[:-1] + (1,))
    p = jax.nn.softmax(jnp.concatenate([s, scores], axis=-1), axis=-1)
    return p[..., 1:]


def ctx_attention(q, k, v, sink):
    B, Tc = q.shape[:2]
    nb = Tc // BLOCK
    scale = HEAD_DIM ** -0.5
    qb = q.reshape(B, nb, BLOCK, A_KV_HEADS, A_GROUPS, HEAD_DIM).transpose(1, 0, 2, 3, 4, 5)

    def one_block(qblk):
        s = jnp.einsum('bqkgd,bskd->bkgqs', qblk, k).astype(jnp.float32) * scale
        p = sink_softmax(s, sink)
        return jnp.einsum('bkgqs,bskd->bqkgd', p.astype(v.dtype), v)

    o = lax.map(one_block, qb)
    return o.transpose(1, 0, 2, 3, 4, 5).reshape(B, Tc, A_WIDTH)


def latent_attention(q, k, v, kc, vc, sink):
    B, T = q.shape[:2]
    Tc = kc.shape[1]
    nb = T // BLOCK
    scale = HEAD_DIM ** -0.5
    qb = q.reshape(B, nb, BLOCK, A_KV_HEADS, A_GROUPS, HEAD_DIM)
    pad = ((0, 0), (BLOCK, BLOCK), (0, 0), (0, 0))
    kp = jnp.pad(k, pad).reshape(B, nb + 2, BLOCK, A_KV_HEADS, HEAD_DIM)
    vp = jnp.pad(v, pad).reshape(B, nb + 2, BLOCK, A_KV_HEADS, HEAD_DIM)
    kw = jnp.concatenate([kp[:, :-2], kp[:, 1:-1], kp[:, 2:]], axis=2)
    vw = jnp.concatenate([vp[:, :-2], vp[:, 1:-1], vp[:, 2:]], axis=2)
    qi = jnp.arange(nb)[:, None] * BLOCK + jnp.arange(BLOCK)[None, :]
    kj = (jnp.arange(nb)[:, None] - 1) * BLOCK + jnp.arange(3 * BLOCK)[None, :]
    valid = ((kj[:, None, :] >= 0) & (kj[:, None, :] < T)
             & (jnp.abs(qi[:, :, None] - kj[:, None, :]) <= WINDOW))
    s_w = jnp.einsum('bnqkgd,bnskd->bnkgqs', qb, kw).astype(jnp.float32) * scale
    s_w = jnp.where(valid[None, :, None, None], s_w, NEG_INF)
    s_c = jnp.einsum('bnqkgd,bskd->bnkgqs', qb, kc).astype(jnp.float32) * scale
    p = sink_softmax(jnp.concatenate([s_c, s_w], axis=-1), sink)
    p_c = p[..., :Tc].astype(v.dtype)
    p_w = p[..., Tc:].astype(v.dtype)
    o = (jnp.einsum('bnkgqs,bskd->bnqkgd', p_c, vc)
         + jnp.einsum('bnkgqs,bnskd->bnqkgd', p_w, vw))
    return o.reshape(B, T, A_WIDTH)


def gla_chunked(q, k, v, log_a, s0):
    B, T, H, dk = q.shape
    n = T // GLA_CHUNK

    def chunks(z):
        return z.reshape(B, n, GLA_CHUNK, H, z.shape[-1]).transpose(1, 0, 3, 2, 4)

    qc, kc, vc, ac = chunks(q), chunks(k), chunks(v), chunks(log_a)
    bcum = jnp.cumsum(ac, axis=3)
    b_last = bcum[:, :, :, -1:, :]
    q_e = qc * jnp.exp(bcum)
    k_e = kc * jnp.exp(-bcum)
    k_s = kc * jnp.exp(b_last - bcum)
    mask = jnp.tril(jnp.ones((GLA_CHUNK, GLA_CHUNK), dtype=bool))
    attn = jnp.where(mask, jnp.einsum('nbhid,nbhjd->nbhij', q_e, k_e), 0.0)
    o_intra = jnp.einsum('nbhij,nbhjv->nbhiv', attn, vc)
    decay_last = jnp.exp(b_last[:, :, :, 0, :])
    kv = jnp.einsum('nbhjd,nbhjv->nbhdv', k_s, vc)

    def step(s, xs):
        q_ec, dl, kv_c = xs
        o = jnp.einsum('bhid,bhdv->bhiv', q_ec, s)
        return dl[..., None] * s + kv_c, o

    s_fin, o_inter = lax.scan(step, s0, (q_e, decay_last, kv))
    o = (o_intra + o_inter).transpose(1, 0, 3, 2, 4).reshape(B, T, H, v.shape[-1])
    return o, s_fin


def gla_bidir(q, k, v, lr, w_alpha, b_alpha, s0_f, s0_b):
    B, T = q.shape[:2]
    la = jax.nn.log_sigmoid(jnp.einsum('btzr,zrk->btzk', lr.astype(jnp.float32), w_alpha.astype(jnp.float32))
                            + b_alpha.astype(jnp.float32)) / GLA_NORMALIZER
    la = la.reshape(B, T, 2, B_HEADS, B_DK)
    q, k, v = q.astype(jnp.float32), k.astype(jnp.float32), v.astype(jnp.float32)
    o_f, s_f = gla_chunked(q, k, v, la[:, :, 0], s0_f.astype(jnp.float32))

    def flip(z):
        return jnp.flip(z, axis=1)

    o_b, s_b = gla_chunked(flip(q), flip(k), flip(v), flip(la[:, :, 1]), s0_b.astype(jnp.float32))
    return o_f + flip(o_b), s_f, s_b


def gla_output(o, r, gain):
    B, T = o.shape[:2]
    o = o * lax.rsqrt(jnp.mean(o * o, axis=-1, keepdims=True) + EPS)
    o = o.reshape(B, T, B_WIDTH) * gain.astype(jnp.float32)
    return (o * jax.nn.silu(r.astype(jnp.float32))).astype(r.dtype)


def even_project(h, w_in):
    B, T, _ = h.shape
    qa, ka, va, qb, kb, vb, rb, lr = split_cols(h @ w_in, SIZES_EVEN)
    qa = qa.reshape(B, T, A_KV_HEADS, A_GROUPS, HEAD_DIM)
    ka = ka.reshape(B, T, A_KV_HEADS, HEAD_DIM)
    va = va.reshape(B, T, A_KV_HEADS, HEAD_DIM)
    qb = qb.reshape(B, T, B_HEADS, B_DK) * (B_DK ** -0.5)
    kb = kb.reshape(B, T, B_HEADS, B_DK)
    vb = vb.reshape(B, T, B_HEADS, B_DV)
    lr = lr.reshape(B, T, 2, GLA_RANK)
    return qa, ka, va, qb, kb, vb, rb, lr


def even_ctx(h, w_in, sink, w_alpha, b_alpha, gla_gain, w_out):
    B = h.shape[0]
    qa, ka, va, qb, kb, vb, rb, lr = even_project(h, w_in)
    oa = ctx_attention(qa, ka, va, sink)
    zeros = jnp.zeros((B, B_HEADS, B_DK, B_DV), jnp.float32)
    ob, s_f, s_b = gla_bidir(qb, kb, vb, lr, w_alpha, b_alpha, zeros, zeros)
    out = jnp.concatenate([oa, gla_output(ob, rb, gla_gain)], axis=-1) @ w_out
    return out, ka, va, jnp.stack([s_f, s_b], axis=1)


def even_lat(h, kc, vc, s0, w_in, sink, w_alpha, b_alpha, gla_gain, w_out):
    qa, ka, va, qb, kb, vb, rb, lr = even_project(h, w_in)
    oa = latent_attention(rope_2d(qa), rope_2d(ka), va, kc, vc, sink)
    ob, _, _ = gla_bidir(qb, kb, vb, lr, w_alpha, b_alpha, s0[:, 0], s0[:, 1])
    return jnp.concatenate([oa, gla_output(ob, rb, gla_gain)], axis=-1) @ w_out


def conv_centred(x, w, b):
    T = x.shape[1]
    left = CONV_W // 2
    xp = jnp.pad(x, ((0, 0), (left, CONV_W - 1 - left), (0, 0)))
    y = xp[:, 0:T] * w[0]
    for i in range(1, CONV_W):
        y = y + xp[:, i:i + T] * w[i]
    return y + b


def blockdiag(x, w, b):
    B, T, _ = x.shape
    y = jnp.einsum('btnc,ncd->btnd', x.reshape(B, T, LRU_BLOCKS, LRU_BLOCK_W), w.astype(jnp.float32))
    return y.reshape(B, T, D_RNN) + b.astype(jnp.float32)


def _lin_combine(e1, e2):
    a1, b1 = e1
    a2, b2 = e2
    return a1 * a2, a2 * b1 + b2


def rglru_dir(x, w_a, b_a, w_x, b_x, lam, h0):
    xf = x.astype(jnp.float32)
    r = jax.nn.sigmoid(blockdiag(xf, w_a, b_a))
    i = jax.nn.sigmoid(blockdiag(xf, w_x, b_x))
    log_a = -LRU_C * r * jax.nn.softplus(-lam.astype(jnp.float32))
    a = jnp.exp(log_a)
    u = jnp.sqrt(-jnp.expm1(2.0 * log_a)) * (i * xf)
    u = u.at[:, 0].add(a[:, 0] * h0.astype(jnp.float32))
    _, hs = lax.associative_scan(_lin_combine, (a, u), axis=1)
    return hs, hs[:, -1]


def odd_mixer(h, h0, w_in, conv_w, conv_b, w_ga, b_ga, w_gx, b_gx, lam, w_out):
    g, u = jnp.split(h @ w_in, 2, axis=-1)
    u = conv_centred(u, conv_w, conv_b)
    y_f, hf = rglru_dir(u, w_ga[0], b_ga[0], w_gx[0], b_gx[0], lam[0], h0[:, 0])
    y_b, hb = rglru_dir(jnp.flip(u, axis=1), w_ga[1], b_ga[1], w_gx[1], b_gx[1], lam[1], h0[:, 1])
    y = y_f + jnp.flip(y_b, axis=1)
    out = (jax.nn.gelu(g).astype(jnp.float32) * y).astype(h.dtype) @ w_out
    return out, jnp.stack([hf, hb], axis=1)


def swiglu(h, w_in, w_out):
    g, u = jnp.split(h @ w_in, 2, axis=-1)
    return (jax.nn.silu(g) * u) @ w_out


def setup_inputs(seed: int = 0) -> dict:
    key = jax.random.key(seed)
    ks = iter(jax.random.split(key, 32))

    def nrm(shape, s):
        return jax.random.normal(next(ks), shape, jnp.float32) * s

    D = D_MODEL
    x_prompt = nrm((BATCH, SEQ, D), 1.0)
    x_sample = nrm((DEC_BATCH, DEC_SEQ, D), 1.0)
    c = nrm((DEC_BATCH, D), 1.0)
    cache_k = nrm((DEC_BATCH, N_EVEN, PAST_LEN, A_KV_HEADS, HEAD_DIM), 1.0)
    cache_v = nrm((DEC_BATCH, N_EVEN, PAST_LEN, A_KV_HEADS, HEAD_DIM), 1.0)
    state_gla = nrm((DEC_BATCH, N_EVEN, 2, B_HEADS, B_DK, B_DV), 0.5)
    state_lru = nrm((DEC_BATCH, N_ODD, 2, D_RNN), 0.5)
    c_ctx = nrm((D,), 1.0)
    w_ada = nrm((DEPTH, D, 6 * D), 0.5 * D ** -0.5)
    b_ada = nrm((DEPTH, 6 * D), 0.01)
    norm_mix = 1.0 + nrm((DEPTH, D), 0.05)
    norm_ffn = 1.0 + nrm((DEPTH, D), 0.05)
    w_in_even = nrm((N_EVEN, D, P_EVEN), D ** -0.5)
    attn_sink = nrm((N_EVEN, A_Q_HEADS), 1.0)
    w_alpha = nrm((N_EVEN, 2, GLA_RANK, B_HEADS * B_DK), GLA_RANK ** -0.5)
    b_alpha = nrm((N_EVEN, 2, B_HEADS * B_DK), 0.1)
    gla_gain = 1.0 + nrm((N_EVEN, B_WIDTH), 0.05)
    w_out_even = nrm((N_EVEN, MIX_WIDTH, D), MIX_WIDTH ** -0.5)
    w_in_odd = nrm((N_ODD, D, 2 * D_RNN), D ** -0.5)
    conv_w = nrm((N_ODD, CONV_W, D_RNN), CONV_W ** -0.5)
    conv_b = nrm((N_ODD, D_RNN), 0.01)
    w_gate_a = nrm((N_ODD, 2, LRU_BLOCKS, LRU_BLOCK_W, LRU_BLOCK_W), LRU_BLOCK_W ** -0.5)
    b_gate_a = nrm((N_ODD, 2, D_RNN), 0.01)
    w_gate_x = nrm((N_ODD, 2, LRU_BLOCKS, LRU_BLOCK_W, LRU_BLOCK_W), LRU_BLOCK_W ** -0.5)
    b_gate_x = nrm((N_ODD, 2, D_RNN), 0.01)
    a0 = jax.random.uniform(next(ks), (N_ODD, 2, D_RNN), jnp.float32, minval=0.9, maxval=0.999)
    lru_lambda = jnp.log(a0) - jnp.log1p(-a0)
    w_out_odd = nrm((N_ODD, D_RNN, D), D_RNN ** -0.5)
    w_ffn_in = nrm((DEPTH, D, 2 * D_FF), D ** -0.5)
    w_ffn_out = nrm((DEPTH, D_FF, D), D_FF ** -0.5)
    norm_final = 1.0 + nrm((D,), 0.05)
    return {'x_prompt': x_prompt, 'x_sample': x_sample, 'c': c,
            'cache_k': cache_k, 'cache_v': cache_v, 'state_gla': state_gla, 'state_lru': state_lru,
            'c_ctx': c_ctx, 'w_ada': w_ada, 'b_ada': b_ada, 'norm_mix': norm_mix, 'norm_ffn': norm_ffn,
            'w_in_even': w_in_even, 'attn_sink': attn_sink, 'w_alpha': w_alpha, 'b_alpha': b_alpha,
            'gla_gain': gla_gain, 'w_out_even': w_out_even, 'w_in_odd': w_in_odd, 'conv_w': conv_w,
            'conv_b': conv_b, 'w_gate_a': w_gate_a, 'b_gate_a': b_gate_a, 'w_gate_x': w_gate_x,
            'b_gate_x': b_gate_x, 'lru_lambda': lru_lambda, 'w_out_odd': w_out_odd,
            'w_ffn_in': w_ffn_in, 'w_ffn_out': w_ffn_out, 'norm_final': norm_final}


def reference(x_prompt, x_sample, c, cache_k, cache_v, state_gla, state_lru, c_ctx,
              w_ada, b_ada, norm_mix, norm_ffn, w_in_even, attn_sink, w_alpha, b_alpha, gla_gain,
              w_out_even, w_in_odd, conv_w, conv_b, w_gate_a, b_gate_a, w_gate_x, b_gate_x,
              lru_lambda, w_out_odd, w_ffn_in, w_ffn_out, norm_final):
    xp, xs = x_prompt, x_sample
    new_k, new_v, new_gla, new_lru = [], [], [], []
    for l in range(DEPTH):
        sh1c, sc1c, g1c, sh2c, sc2c, g2c = ada(c_ctx, w_ada[l], b_ada[l])
        sh1s, sc1s, g1s, sh2s, sc2s, g2s = (m[:, None] for m in ada(c, w_ada[l], b_ada[l]))
        hp = modulate(xp, norm_mix[l], sh1c, sc1c)
        hs = modulate(xs, norm_mix[l], sh1s, sc1s)
        if l % 2 == 0:
            e = l // 2
            ew = (w_in_even[e], attn_sink[e], w_alpha[e], b_alpha[e], gla_gain[e], w_out_even[e])
            op, k_c, v_c, s_c = even_ctx(hp, *ew)
            os_ = even_lat(hs, cache_k[:, e], cache_v[:, e], state_gla[:, e], *ew)
            new_k.append(k_c)
            new_v.append(v_c)
            new_gla.append(s_c)
        else:
            o = l // 2
            ow = (w_in_odd[o], conv_w[o], conv_b[o], w_gate_a[o], b_gate_a[o], w_gate_x[o],
                  b_gate_x[o], lru_lambda[o], w_out_odd[o])
            h0 = jnp.zeros((xp.shape[0], 2, D_RNN), jnp.float32)
            op, h_c = odd_mixer(hp, h0, *ow)
            os_, _ = odd_mixer(hs, state_lru[:, o], *ow)
            new_lru.append(h_c)
        xp = xp + g1c * op
        xs = xs + g1s * os_
        xp = xp + g2c * swiglu(modulate(xp, norm_ffn[l], sh2c, sc2c), w_ffn_in[l], w_ffn_out[l])
        xs = xs + g2s * swiglu(modulate(xs, norm_ffn[l], sh2s, sc2s), w_ffn_in[l], w_ffn_out[l])
    y_prompt = rmsnorm(xp, norm_final)
    y_sample = rmsnorm(xs, norm_final)
    new_cache_k = jnp.stack(new_k, axis=1)
    new_cache_v = jnp.stack(new_v, axis=1)
    new_state_gla = jnp.stack(new_gla, axis=1)
    new_state_lru = jnp.stack(new_lru, axis=1)
    return (y_prompt, y_sample, new_cache_k, new_cache_v, new_state_gla, new_state_lru)
```

```cpp
#include <hip/hip_runtime.h>
#include <cstdio>
#include <cstdint>

#ifndef MK_MULTI
#define MK_MULTI 0
#endif

#define LAS __attribute__((address_space(3)))
#define GAS __attribute__((address_space(1)))
typedef unsigned short bf16_t;
typedef short bf16x8 __attribute__((ext_vector_type(8)));
typedef short s16x4 __attribute__((ext_vector_type(4)));
typedef float f32x2 __attribute__((ext_vector_type(2)));
typedef float f32x4 __attribute__((ext_vector_type(4)));
typedef float f32x16 __attribute__((ext_vector_type(16)));
typedef unsigned u32x2 __attribute__((ext_vector_type(2)));
typedef unsigned u32x4 __attribute__((ext_vector_type(4)));
typedef LAS unsigned char* lptr;

constexpr int D = 1024, NCTX = 16, TCTX = 256, NLAT = 4, TLAT = 4096, DEPTH = 4;
constexpr int MCTX = NCTX * TCTX;
constexpr int M = MCTX + NLAT * TLAT;
constexpr int PE = 2336, PEP = 2560;
constexpr int ZW = 2304;
constexpr int DFF = 2816;
constexpr float EPS = 1e-6f;
constexpr float LOG2E = 1.4426950408889634f;
constexpr float QSCALE = 0.125f * LOG2E;
constexpr int NCHUNK = M / 64;

constexpr size_t OUT_CK = (size_t)M * D, OUT_CV = OUT_CK + 1048576, OUT_GLA = OUT_CV + 1048576, OUT_LRU = OUT_GLA + 2097152, OUT_END = OUT_LRU + 65536;

constexpr size_t MiB = 1u << 20;
constexpr size_t WS_CTL = 0, CTL_ZERO_BYTES = 64 * 1024;
constexpr size_t WS_MOD = 1 * MiB;
constexpr size_t WS_ROPE = WS_MOD + 512 * 1024;
constexpr size_t WS_CK = 2 * MiB, WS_CV = 2 * MiB + 512 * 1024;
constexpr size_t WS_WINE = 4 * MiB;
constexpr size_t WS_WOUTE = WS_WINE + 10 * MiB;
constexpr size_t WS_WINO = WS_WOUTE + 4 * MiB;
constexpr size_t WS_WG = WS_WINO + 8 * MiB;
constexpr size_t WS_WOUTO = WS_WG + 4 * MiB;
constexpr size_t WS_WF1 = WS_WOUTO + 4 * MiB;
constexpr size_t WS_WF2 = WS_WF1 + 44 * MiB;
constexpr size_t WS_XN = WS_WF2 + 22 * MiB;
static_assert(WS_XN == 100 * MiB, "ws map");
constexpr size_t WS_BIG = 140 * MiB;
constexpr size_t WS_ZE = WS_BIG;
constexpr size_t WS_KV = WS_BIG + 90 * MiB;
constexpr size_t WS_LR = WS_BIG + 170 * MiB;
constexpr size_t WS_DL = WS_BIG + 173 * MiB;
constexpr size_t WS_G = WS_BIG;
constexpr size_t WS_U = WS_BIG + 40 * MiB;
constexpr size_t WS_UC = WS_BIG + 80 * MiB;
constexpr size_t WS_LAF = WS_BIG + 120 * MiB;
constexpr size_t WS_LAB = WS_BIG + 160 * MiB;
constexpr size_t WS_BB = WS_BIG + 200 * MiB;
constexpr size_t WS_AGG = WS_BIG + 240 * MiB;
constexpr size_t WS_H = WS_BIG;
constexpr size_t WS_END = WS_BIG + 242 * MiB;

constexpr int RING_BYTES = 131072;
constexpr int LDSCTL_OFF = RING_BYTES, MISC_OFF = LDSCTL_OFF + 320;
constexpr int LDS_BYTES = 147456;
constexpr int NWAVES = 8, NTHREADS = 512;

__device__ __forceinline__ unsigned f2bf(float f) { unsigned u = __builtin_bit_cast(unsigned, f); return (u + 0x7fffu + ((u >> 16) & 1u)) >> 16; }
__device__ __forceinline__ unsigned pk2(float lo, float hi) { return f2bf(lo) | (f2bf(hi) << 16); }
__device__ __forceinline__ float bf2f(unsigned short b) { return __builtin_bit_cast(float, (unsigned)b << 16); }
__device__ __forceinline__ float bflo(unsigned w) { return __builtin_bit_cast(float, w << 16); }
__device__ __forceinline__ float bfhi(unsigned w) { return __builtin_bit_cast(float, w & 0xffff0000u); }
__device__ __forceinline__ float fexp2(float x) { return __builtin_amdgcn_exp2f(x); }
__device__ __forceinline__ float fexp(float x) { return __builtin_amdgcn_exp2f(x * LOG2E); }
__device__ __forceinline__ float sigmoidf_(float x) { return 1.0f / (1.0f + fexp(-x)); }
__device__ __forceinline__ float siluf_(float x) { return x / (1.0f + fexp(-x)); }
__device__ __forceinline__ float gelu_tanh(float x) { const float z = 0.7978845608028654f * (x + 0.044715f * x * x * x); const float t = 1.0f - 2.0f / (fexp(2.0f * z) + 1.0f); return 0.5f * x * (1.0f + t); }
__device__ __forceinline__ int crow(int r, int hh) { return (r & 3) + 8 * (r >> 2) + 4 * hh; }
__device__ __forceinline__ int cond_of_row(int row) { return row < MCTX ? 0 : 1 + ((row - MCTX) >> 12); }
#define LDS_WAIT() asm volatile("s_waitcnt lgkmcnt(0)" ::: "memory")
#define VM_WAIT() asm volatile("s_waitcnt vmcnt(0)" ::: "memory")
__device__ __forceinline__ s16x4 tr_read(lptr p) { typedef short v4i16_t __attribute__((ext_vector_type(4))); return __builtin_bit_cast(s16x4, __builtin_amdgcn_ds_read_tr16_b64_v4i16((LAS v4i16_t*)p)); }
__device__ __forceinline__ bf16x8 tr_frag(lptr p) { const s16x4 a = tr_read(p), b = tr_read(p + 512); return (bf16x8){a[0], a[1], a[2], a[3], b[0], b[1], b[2], b[3]}; }
__device__ __forceinline__ float wave_sum(float v) {
#pragma unroll
    for (int o = 1; o < 64; o <<= 1) v += __shfl_xor(v, o);
    return v;
}

struct Params {
    const float* in[30];
    float* out; unsigned char* ws;
    int step_lo, step_hi;
};
enum { I_XP = 0, I_XS, I_C, I_CK, I_CV, I_SGLA, I_SLRU, I_CCTX, I_WADA, I_BADA, I_NMIX, I_NFFN, I_WINE, I_SINK, I_WALPHA, I_BALPHA, I_GGAIN, I_WOUTE,
       I_WINO, I_CONVW, I_CONVB, I_WGA, I_BGA, I_WGX, I_BGX, I_LAM, I_WOUTO, I_WF1, I_WF2, I_NFIN };

namespace pg8 {
constexpr int BM = 256, BK = 64, HALF = 128, HTB = HALF * BK * 2, STAGE_BYTES = 8 * HTB, NXCD = 8, WGM = 8;
__device__ __forceinline__ int lds_byte(int r, int c) { const int st = (r >> 4) * 2 + (c >> 5), rr = r & 15, cc = c & 31, ob = rr * 64 + cc * 2; return st * 1024 + (ob ^ (((ob >> 9) & 1) << 5)); }
__device__ __forceinline__ void stage_rc(int b, int& R, int& C) { const int st = b / 1024, sb = b % 1024, swz = sb ^ (((sb >> 9) & 1) << 5); R = (st >> 1) * 16 + swz / 64; C = (st & 1) * 32 + (swz % 64) / 2; }
__device__ __forceinline__ int perm32(int rho) { const int n = rho >> 4, i = rho & 15; return 8 * (i >> 2) + 4 * n + (i & 3); }
struct Unit { int pm, pn; };
struct Gemm { const bf16_t* A; const bf16_t* Bt; int lda, K, nM, nN, a_grp; bool perm; };
struct StaticOrder {
    int nM, nN, nwg, G, c;
    __device__ void init(int nM_, int nN_, int G_, int c_) { nM = nM_; nN = nN_; nwg = nM * nN; G = G_; c = c_; }
    __device__ bool next(int i, Unit& u) const {
        const long L = (long)i * G + c; if (L >= nwg) return false;
        int wgid = (int)L; { const int q = nwg / NXCD, r = nwg % NXCD, xcd = wgid % NXCD, off = wgid / NXCD; wgid = (xcd < r ? xcd * (q + 1) : r * (q + 1) + (xcd - r) * q) + off; }
        const int nig = WGM * nN, gid = wgid / nig, fm = gid * WGM, gsz = (nM - fm) < WGM ? (nM - fm) : WGM;
        u.pm = fm + ((wgid % nig) % gsz); u.pn = (wgid % nig) / gsz; return true;
    }
};

template <class Epi>
__device__ __forceinline__ void gemm_phase(lptr lds, const int tid, const Gemm g, const StaticOrder& S, const Epi& E) {
    const int wid = __builtin_amdgcn_readfirstlane(tid >> 6), lane = tid & 63, wr = wid >> 2, wc = wid & 3, fr = lane & 15, fq = lane >> 4;
    const int K = g.K, nt = K / BK, lda = g.lda;
    unsigned voffA[2], voffB[2];
#pragma unroll
    for (int i = 0; i < 2; ++i) { int R, C; stage_rc(tid * 16 + i * 8192, R, C); const int Rb = g.perm ? ((R & ~31) + perm32(R & 31)) : R;
        voffA[i] = (unsigned)(R * lda + C) * 2u; voffB[i] = (unsigned)(Rb * K + C) * 2u; }
    const size_t kstep = (size_t)(BK * 2);
    const size_t hsA = (size_t)HALF * lda * 2, hsB = (size_t)HALF * K * 2;
    const unsigned ldsw = (unsigned)wid * 1024u;
    const int aoff = lds_byte(wr * 64 + fr, fq * 8), boff = lds_byte(wc * 32 + fr, fq * 8);
#define PG8_SA(b, h) (((b) * 2 + (h)) * HTB)
#define PG8_SB(b, h) ((4 + (b) * 2 + (h)) * HTB)
#define PG8_STAGE(bufoff, gbase, voff) do { _Pragma("unroll") for (int _i = 0; _i < 2; ++_i) \
        __builtin_amdgcn_global_load_lds((const unsigned*)((const char*)(gbase) + (voff)[_i]), (LAS unsigned*)(lds + (bufoff) + ldsw + _i * 8192), 16, 0, 0); } while (0)
#define PG8_LDA(dst, b, h) do { _Pragma("unroll") for (int m = 0; m < 4; ++m) _Pragma("unroll") for (int k = 0; k < 2; ++k) dst[m][k] = *(const LAS bf16x8*)(lds + PG8_SA(b, h) + aoff + m * 2048 + k * 1024); } while (0)
#define PG8_LDB(dst, b, h) do { _Pragma("unroll") for (int n = 0; n < 2; ++n) _Pragma("unroll") for (int k = 0; k < 2; ++k) dst[n][k] = *(const LAS bf16x8*)(lds + PG8_SB(b, h) + boff + n * 2048 + k * 1024); } while (0)
#define PG8_MMA(ai, bj, At, Bt) do { __builtin_amdgcn_s_setprio(1); _Pragma("unroll") for (int m = 0; m < 4; ++m) _Pragma("unroll") for (int n = 0; n < 2; ++n) _Pragma("unroll") for (int k = 0; k < 2; ++k) \
        acc[ai][bj][m][n] = __builtin_amdgcn_mfma_f32_16x16x32_bf16(Bt[n][k], At[m][k], acc[ai][bj][m][n], 0, 0, 0); __builtin_amdgcn_s_setprio(0); } while (0)
#define PG8_WAIT_V(n) asm volatile("s_waitcnt vmcnt(" #n ")" ::: "memory")
#define PG8_WAIT_L(n) asm volatile("s_waitcnt lgkmcnt(" #n ")" ::: "memory")
#define PG8_BAR __builtin_amdgcn_s_barrier()
#define PG8_SCHED __builtin_amdgcn_sched_barrier(0)
#define PG8_ABASE(u) ((const char*)g.A + ((size_t)(u).pm * BM * lda + (g.a_grp ? (size_t)((u).pn / g.a_grp) * K : 0)) * 2)
#define PG8_BBASE(u) ((const char*)g.Bt + (size_t)(u).pn * BM * K * 2)
    Unit cur, nxt; int ui = 0;
    if (!S.next(0, cur)) return;
    f32x4 acc[2][2][4][2];
#pragma unroll
    for (int a = 0; a < 2; ++a)
#pragma unroll
        for (int b = 0; b < 2; ++b)
#pragma unroll
            for (int m = 0; m < 4; ++m)
#pragma unroll
                for (int n = 0; n < 2; ++n) acc[a][b][m][n] = (f32x4){0.f, 0.f, 0.f, 0.f};
    bf16x8 At[4][2], B0[2][2], B1[2][2];
    const char* cA = PG8_ABASE(cur); const char* cB = PG8_BBASE(cur);
    PG8_STAGE(PG8_SB(0, 0), cB, voffB); PG8_STAGE(PG8_SB(0, 1), cB + hsB, voffB); PG8_STAGE(PG8_SA(0, 0), cA, voffA); PG8_STAGE(PG8_SA(0, 1), cA + hsA, voffA);
    if (wr == 1) PG8_BAR;
    PG8_WAIT_V(2); PG8_BAR;
    PG8_STAGE(PG8_SB(1, 0), cB + kstep, voffB); PG8_STAGE(PG8_SA(1, 0), cA + kstep, voffA); PG8_STAGE(PG8_SB(1, 1), cB + hsB + kstep, voffB);
    PG8_WAIT_V(6); PG8_BAR;
    for (;;) {
        const bool has_next = S.next(ui + 1, nxt);
        const char* nA = has_next ? PG8_ABASE(nxt) : cA; const char* nB = has_next ? PG8_BBASE(nxt) : cB;
        for (int t = 0; t < nt; t += 2) {
            const bool last = (t == nt - 2);
            const char* a1 = cA + (size_t)(t + 1) * kstep;
            const char* a2 = last ? nA : cA + (size_t)(t + 2) * kstep; const char* b2 = last ? nB : cB + (size_t)(t + 2) * kstep;
            const char* a3 = a2 + kstep; const char* b3 = b2 + kstep;
            PG8_LDB(B0, 0, 0); PG8_LDB(B1, 0, 1); PG8_SCHED; PG8_LDA(At, 0, 0); PG8_STAGE(PG8_SA(1, 1), a1 + hsA, voffA);
            PG8_WAIT_V(8); PG8_WAIT_L(0); PG8_BAR; PG8_MMA(0, 0, At, B0); PG8_MMA(0, 1, At, B1); PG8_BAR; PG8_SCHED;
            PG8_LDA(At, 0, 1); PG8_STAGE(PG8_SB(0, 0), b2, voffB); PG8_STAGE(PG8_SB(0, 1), b2 + hsB, voffB); PG8_STAGE(PG8_SA(0, 0), a2, voffA);
            PG8_WAIT_V(8); PG8_WAIT_L(0); PG8_BAR; PG8_MMA(1, 0, At, B0); PG8_MMA(1, 1, At, B1); PG8_BAR; PG8_SCHED;
            PG8_LDB(B0, 1, 0); PG8_LDB(B1, 1, 1); PG8_SCHED; PG8_LDA(At, 1, 0); PG8_STAGE(PG8_SA(0, 1), a2 + hsA, voffA);
            PG8_WAIT_V(8); PG8_WAIT_L(0); PG8_BAR; PG8_MMA(0, 0, At, B0); PG8_MMA(0, 1, At, B1); PG8_BAR; PG8_SCHED;
            PG8_LDA(At, 1, 1); PG8_STAGE(PG8_SB(1, 0), b3, voffB); PG8_STAGE(PG8_SB(1, 1), b3 + hsB, voffB); PG8_STAGE(PG8_SA(1, 0), a3, voffA);
            PG8_WAIT_V(8); PG8_WAIT_L(0); PG8_BAR; PG8_MMA(1, 0, At, B0); PG8_MMA(1, 1, At, B1); PG8_BAR; PG8_SCHED;
        }
        if (wr == 0) PG8_BAR;
        { int fr_ = fr, fq_ = fq; asm volatile("" : "+v"(fr_), "+v"(fq_)); E(acc, cur, wr, wc, fr_, fq_); }
        if (!has_next) break;
#pragma unroll
        for (int a = 0; a < 2; ++a)
#pragma unroll
            for (int b = 0; b < 2; ++b)
#pragma unroll
                for (int m = 0; m < 4; ++m)
#pragma unroll
                    for (int n = 0; n < 2; ++n) acc[a][b][m][n] = (f32x4){0.f, 0.f, 0.f, 0.f};
        cur = nxt; cA = nA; cB = nB; ++ui;
        if (wr == 1) PG8_BAR;
    }
    PG8_WAIT_V(0);
    PG8_BAR;
#undef PG8_SA
#undef PG8_SB
#undef PG8_STAGE
#undef PG8_LDA
#undef PG8_LDB
#undef PG8_MMA
#undef PG8_WAIT_V
#undef PG8_WAIT_L
#undef PG8_BAR
#undef PG8_SCHED
#undef PG8_ABASE
#undef PG8_BBASE
}
}

enum EpiKind { EK_EVEN_IN = 0, EK_ODD_IN, EK_GATES, EK_RES, EK_SWIGLU };
struct Epi {
    int kind; int layer, sub;
    float* X;
    const float* mod;
    int gidx;
    bf16_t* o0; bf16_t* o1; bf16_t* o2; bf16_t* o3;
    float* lr;
    const float* rope;
    const bf16_t* uc;
    const float *ba, *bx, *lam;
    __device__ __forceinline__ void operator()(const f32x4 (&acc)[2][2][4][2], const pg8::Unit& u, int wr, int wc, int fr, int fq) const {
        const int row0 = u.pm * 256 + wr * 64 + fr;
        if (kind == EK_RES) {
            const int ci = cond_of_row(u.pm * 256);
            const float* gate = mod + ((size_t)(layer * 5 + ci) * 6 + gidx) * 1024;
            const int col0 = u.pn * 256 + wc * 32 + 4 * fq;
            f32x4 gv[2][2];
#pragma unroll
            for (int bj = 0; bj < 2; ++bj)
#pragma unroll
                for (int n = 0; n < 2; ++n) gv[bj][n] = *(const f32x4*)(gate + col0 + bj * 128 + n * 16);
#pragma unroll
            for (int ai = 0; ai < 2; ++ai)
#pragma unroll
                for (int m = 0; m < 4; ++m) { float* rowp = X + (size_t)(row0 + ai * 128 + m * 16) * D + col0;
#pragma unroll
                    for (int bj = 0; bj < 2; ++bj)
#pragma unroll
                        for (int n = 0; n < 2; ++n) { f32x4* p = (f32x4*)(rowp + bj * 128 + n * 16); f32x4 x = *p; x += gv[bj][n] * acc[ai][bj][m][n]; *p = x; } }
        } else if (kind == EK_SWIGLU) {
            bf16_t* H = o0; const int col0 = u.pn * 128 + wc * 32 + 8 * fq;
#pragma unroll
            for (int ai = 0; ai < 2; ++ai)
#pragma unroll
                for (int m = 0; m < 4; ++m) { const f32x4 g0 = acc[ai][0][m][0], g1 = acc[ai][0][m][1], u0 = acc[ai][1][m][0], u1 = acc[ai][1][m][1];
                    u32x4 w; w.x = pk2(siluf_(g0[0]) * u0[0], siluf_(g0[1]) * u0[1]); w.y = pk2(siluf_(g0[2]) * u0[2], siluf_(g0[3]) * u0[3]);
                    w.z = pk2(siluf_(g1[0]) * u1[0], siluf_(g1[1]) * u1[1]); w.w = pk2(siluf_(g1[2]) * u1[2], siluf_(g1[3]) * u1[3]);
                    *(u32x4*)(H + (size_t)(row0 + ai * 128 + m * 16) * DFF + col0) = w; }
        } else if (kind == EK_ODD_IN) {
            const bool isg = u.pn < 4; bf16_t* O = isg ? o0 : o1; const int colt = (isg ? u.pn : u.pn - 4) * 256 + wc * 32 + 8 * fq;
#pragma unroll
            for (int ai = 0; ai < 2; ++ai)
#pragma unroll
                for (int m = 0; m < 4; ++m) { bf16_t* rowp = O + (size_t)(row0 + ai * 128 + m * 16) * D + colt;
#pragma unroll
                    for (int bj = 0; bj < 2; ++bj) { f32x4 v0 = acc[ai][bj][m][0], v1 = acc[ai][bj][m][1];
                        if (isg) {
#pragma unroll
                            for (int j = 0; j < 4; ++j) { v0[j] = gelu_tanh(v0[j]); v1[j] = gelu_tanh(v1[j]); } }
                        u32x4 w; w.x = pk2(v0[0], v0[1]); w.y = pk2(v0[2], v0[3]); w.z = pk2(v1[0], v1[1]); w.w = pk2(v1[2], v1[3]);
                        *(u32x4*)(rowp + bj * 128) = w; } }
        } else if (kind == EK_GATES) {
            const int blk = u.pn >> 2, t = u.pn & 3, dir = t >> 1, half = t & 1;
            const int ch0 = blk * 256 + half * 128 + wc * 32 + 8 * fq;
            const size_t pofs = (size_t)(sub * 2 + dir) * 1024 + ch0;
            float ba_[8], bx_[8], c8_[8];
#pragma unroll
            for (int q = 0; q < 8; ++q) { ba_[q] = ba[pofs + q]; bx_[q] = bx[pofs + q]; const float lm = lam[pofs + q]; c8_[q] = -8.0f * log1pf(__expf(-lm)); }
            bf16_t* LA = dir ? o1 : o0; bf16_t* BB = dir ? o3 : o2;
#pragma unroll
            for (int ai = 0; ai < 2; ++ai)
#pragma unroll
                for (int m = 0; m < 4; ++m) { const size_t ro = (size_t)(row0 + ai * 128 + m * 16) * D + ch0;
                    const u32x4 ucw = *(const u32x4*)(uc + ro);
                    float ucv[8] = {bflo(ucw.x), bfhi(ucw.x), bflo(ucw.y), bfhi(ucw.y), bflo(ucw.z), bfhi(ucw.z), bflo(ucw.w), bfhi(ucw.w)};
                    float la[8], bb[8];
#pragma unroll
                    for (int n = 0; n < 2; ++n)
#pragma unroll
                        for (int j = 0; j < 4; ++j) { const int q = n * 4 + j;
                            const float r = sigmoidf_(acc[ai][0][m][n][j] + ba_[q]), ig = sigmoidf_(acc[ai][1][m][n][j] + bx_[q]);
                            const float l = c8_[q] * r; const float a2 = fexp(2.0f * l); const float cf = sqrtf(fmaxf(1.0f - a2, 0.0f));
                            la[q] = l; bb[q] = cf * ig * ucv[q]; }
                    u32x4 w; w.x = pk2(la[0], la[1]); w.y = pk2(la[2], la[3]); w.z = pk2(la[4], la[5]); w.w = pk2(la[6], la[7]); *(u32x4*)(LA + ro) = w;
                    w.x = pk2(bb[0], bb[1]); w.y = pk2(bb[2], bb[3]); w.z = pk2(bb[4], bb[5]); w.w = pk2(bb[6], bb[7]); *(u32x4*)(BB + ro) = w; }
        } else {
            bf16_t* ZE = o0; const int pn = u.pn; const bool lat = u.pm >= 16;
            if (pn == 9) {
                if (wc == 0) {
#pragma unroll
                    for (int ai = 0; ai < 2; ++ai)
#pragma unroll
                        for (int m = 0; m < 4; ++m) { float* p = lr + (size_t)(row0 + ai * 128 + m * 16) * 32 + 8 * fq; *(f32x4*)p = acc[ai][0][m][0]; *(f32x4*)(p + 4) = acc[ai][0][m][1]; }
                }
            } else if (pn <= 2) {
                const int half = wc & 1;
#pragma unroll
                for (int ai = 0; ai < 2; ++ai)
#pragma unroll
                    for (int m = 0; m < 4; ++m) { const int row = row0 + ai * 128 + m * 16;
                        const int tpos = (row - MCTX) & 4095; const int pos = half ? (tpos & 63) : (tpos >> 6);
                        f32x4 cs[4];
                        if (lat) {
#pragma unroll
                            for (int q = 0; q < 4; ++q) cs[q] = *(const f32x4*)(rope + (size_t)(pos * 16 + 8 * (fq & 1)) * 2 + q * 4);
                        }
#pragma unroll
                        for (int bj = 0; bj < 2; ++bj) { f32x4 v0 = acc[ai][bj][m][0], v1 = acc[ai][bj][m][1];
                            const bool isv = (pn == 2 && bj == 1), isk = (pn == 2 && bj == 0);
                            if (pn == 2 && !lat) {
                                const int b = row >> 8, tt = row & 255; const int kc = wc * 32 + 8 * fq;
                                float* dst = X + (isv ? OUT_CV : OUT_CK) + ((size_t)(b * 2 + sub) * 256 + tt) * 128 + kc;
                                *(f32x4*)dst = v0; *(f32x4*)(dst + 4) = v1;
                            }
                            if (lat && !isv) {
                                float x[8] = {v0[0], v0[1], v0[2], v0[3], v1[0], v1[1], v1[2], v1[3]}; float o[8];
#pragma unroll
                                for (int q = 0; q < 8; ++q) { const float pr = __shfl_xor(x[q], 32); const float c = cs[q >> 1][(q & 1) * 2], s = cs[q >> 1][(q & 1) * 2 + 1];
                                    o[q] = x[q] * c + (fq < 2 ? -pr : pr) * s; }
                                v0 = (f32x4){o[0], o[1], o[2], o[3]}; v1 = (f32x4){o[4], o[5], o[6], o[7]};
                            }
                            if (!isk && !isv) { v0 *= QSCALE; v1 *= QSCALE; }
                            u32x4 w; w.x = pk2(v0[0], v0[1]); w.y = pk2(v0[2], v0[3]); w.z = pk2(v1[0], v1[1]); w.w = pk2(v1[2], v1[3]);
                            *(u32x4*)(ZE + (size_t)row * ZW + pn * 256 + bj * 128 + wc * 32 + 8 * fq) = w; } }
            } else {
                const float sc = (pn == 3) ? 0.125f : 1.0f; const bool act = pn >= 7;
#pragma unroll
                for (int ai = 0; ai < 2; ++ai)
#pragma unroll
                    for (int m = 0; m < 4; ++m) { bf16_t* rowp = ZE + (size_t)(row0 + ai * 128 + m * 16) * ZW + pn * 256 + wc * 32 + 8 * fq;
#pragma unroll
                        for (int bj = 0; bj < 2; ++bj) { f32x4 v0 = acc[ai][bj][m][0] * sc, v1 = acc[ai][bj][m][1] * sc;
                            if (act) {
#pragma unroll
                                for (int j = 0; j < 4; ++j) { v0[j] = siluf_(v0[j]); v1[j] = siluf_(v1[j]); } }
                            u32x4 w; w.x = pk2(v0[0], v0[1]); w.y = pk2(v0[2], v0[3]); w.z = pk2(v1[0], v1[1]); w.w = pk2(v1[2], v1[3]);
                            *(u32x4*)(rowp + bj * 128) = w; } }
            }
        }
    }
};

#define XB_TMO      128
#define XB_XCNT(j)  (256  + 64 * (j))
#define XB_XSUB(j)  (1280 + 64 * (j))
#define XB_XGEN(j)  (2304 + 64 * (j))
#define XB_TOP      3328
#define XB_TOPGEN   3392
#define XCD_BAR_WORDS 3456
#define XB_SPIN_CAP (1u << 18)
__device__ __forceinline__ unsigned xb_ld(unsigned* p)              { return __hip_atomic_load(p, __ATOMIC_RELAXED, __HIP_MEMORY_SCOPE_AGENT); }
__device__ __forceinline__ unsigned xb_add(unsigned* p, unsigned v) { return __hip_atomic_fetch_add(p, v, __ATOMIC_RELAXED, __HIP_MEMORY_SCOPE_AGENT); }
__device__ __forceinline__ unsigned xb_xcc_id() { return (unsigned)__builtin_amdgcn_s_getreg((3 << 11) | 20) & 0xFu; }
#define XB_SPIN(cond, bar) do { unsigned _sp = 0; while (cond) { __builtin_amdgcn_s_sleep(1); \
    if ((++_sp & 255u) == 0u) { if (xb_ld(&(bar)[XB_TMO])) break; if (_sp > XB_SPIN_CAP) { atomicAdd(&(bar)[XB_TMO], 1u); break; } } } } while (0)
struct XcdBarrier { unsigned* bar; unsigned x; volatile LAS unsigned* st; };
__device__ __forceinline__ XcdBarrier xcd_barrier_post(unsigned* bar, volatile LAS unsigned* st) {
    XcdBarrier b; b.bar = bar; b.x = xb_xcc_id(); b.st = st;
    if (threadIdx.x == 0) (void)xb_add(&bar[XB_XCNT(b.x)], 1u);
    return b;
}
__device__ __forceinline__ void xcd_barrier_complete(unsigned* bar, unsigned x, unsigned& nloc, unsigned& nx) {
    const unsigned G = gridDim.x * gridDim.y * gridDim.z;
    unsigned sum, cnt, mine, sp = 0u;
    for (;;) {
        sum = 0u; cnt = 0u; mine = 0u;
#pragma unroll
        for (unsigned j = 0; j < 16; ++j) { const unsigned c = xb_ld(&bar[XB_XCNT(j)]); sum += c; cnt += (c > 0u) ? 1u : 0u; mine = (j == x) ? c : mine; }
        if (sum == G) break;
        __builtin_amdgcn_s_sleep(1);
        if ((++sp & 255u) == 0u) { if (xb_ld(&bar[XB_TMO])) break; if (sp > XB_SPIN_CAP) { atomicAdd(&bar[XB_TMO], 1u); break; } }
    }
    nloc = mine > 0u ? mine : 1u; nx = cnt > 0u ? cnt : 1u;
}
__device__ __forceinline__ void xcd_barrier(const XcdBarrier& b, const int tid) {
    asm volatile("s_waitcnt vmcnt(0)" ::: "memory");
    __syncthreads();
    if (tid == 0) {
        unsigned* bar = b.bar;
        __builtin_amdgcn_s_waitcnt(0);
        unsigned nloc = b.st[0], nx = b.st[1];
        if (nloc == 0u) { xcd_barrier_complete(bar, b.x, nloc, nx); b.st[0] = nloc; b.st[1] = nx; }
        const unsigned old = xb_add(&bar[XB_XSUB(b.x)], 1u);
        const unsigned gen = old / nloc;
        if (old + 1u == (gen + 1u) * nloc) {
            __builtin_amdgcn_fence(__ATOMIC_RELEASE, "agent");
            asm volatile("s_waitcnt vmcnt(0)" ::: "memory");
            const unsigned og = xb_add(&bar[XB_TOP], 1u);
            const unsigned tg = og / nx;
            if (og + 1u == (tg + 1u) * nx) xb_add(&bar[XB_TOPGEN], 1u);
            else XB_SPIN(xb_ld(&bar[XB_TOPGEN]) == tg, bar);
            __builtin_amdgcn_fence(__ATOMIC_ACQUIRE, "agent");
            xb_add(&bar[XB_XGEN(b.x)], 1u);
            asm volatile("s_waitcnt vmcnt(0)" ::: "memory");
        } else {
            XB_SPIN(xb_ld(&bar[XB_XGEN(b.x)]) == gen, bar);
            __builtin_amdgcn_fence(__ATOMIC_ACQUIRE, "agent");
            asm volatile("s_waitcnt vmcnt(0)" ::: "memory");
        }
    }
    __syncthreads();
}

struct Frame {
    lptr lds; int tid, lane, wave, vcu, G;
    const Params* p; float* out; unsigned char* ws; int bid;
};
#define WSP(T, off) ((T*)(F.ws + (off)))

__device__ __forceinline__ void transpose_block(const float* src, int ldw, bf16_t* dst, int ldt, LAS float* scr, int lane) {
#pragma unroll 8
    for (int i = 0; i < 32; ++i) { const int kk = 2 * i + (lane >> 5); scr[kk * 33 + (lane & 31)] = src[(size_t)kk * ldw + (lane & 31)]; }
    LDS_WAIT(); asm volatile("" ::: "memory");
    const int c = lane & 7;
#pragma unroll
    for (int j = 0; j < 4; ++j) { const int n = (lane >> 3) + 8 * j; const LAS float* s = scr + (8 * c) * 33 + n;
        u32x4 o; o.x = pk2(s[0 * 33], s[1 * 33]); o.y = pk2(s[2 * 33], s[3 * 33]); o.z = pk2(s[4 * 33], s[5 * 33]); o.w = pk2(s[6 * 33], s[7 * 33]);
        *(u32x4*)(dst + (size_t)n * ldt + 8 * c) = o; }
    LDS_WAIT(); asm volatile("" ::: "memory");
}
constexpr int IT_WINE = 16 * 73, IT_SQ = 512, IT_WINO = 1024, IT_GATES = 512, IT_F1 = 16 * 176, IT_F2 = 44 * 32;
constexpr int IT_E = IT_WINE + IT_SQ, IT_O = IT_WINO + IT_GATES + IT_SQ, IT_L = IT_F1 + IT_F2;
constexpr int IT_TOTAL = 2 * IT_E + 2 * IT_O + 4 * IT_L;

__device__ __forceinline__ void convert_item(Frame& F, int it, LAS float* scr) {
    const int lane = F.lane;
    if (it < 2 * IT_E) {
        const int e = it / IT_E; int r = it % IT_E;
        if (r < IT_WINE) { const int kb = r / 73, nb = r % 73;
            transpose_block(F.p->in[I_WINE] + (size_t)e * D * PE + (size_t)(64 * kb) * PE + 32 * nb, PE, WSP(bf16_t, WS_WINE) + (size_t)e * PEP * D + (size_t)(32 * nb) * D + 64 * kb, D, scr, lane);
        } else { r -= IT_WINE; const int kb = r / 32, nb = r % 32;
            transpose_block(F.p->in[I_WOUTE] + (size_t)e * D * D + (size_t)(64 * kb) * D + 32 * nb, D, WSP(bf16_t, WS_WOUTE) + (size_t)e * D * D + (size_t)(32 * nb) * D + 64 * kb, D, scr, lane); }
        return;
    }
    it -= 2 * IT_E;
    if (it < 2 * IT_O) {
        const int o = it / IT_O; int r = it % IT_O;
        if (r < IT_WINO) { const int kb = r / 64, nb = r % 64;
            transpose_block(F.p->in[I_WINO] + (size_t)o * D * 2048 + (size_t)(64 * kb) * 2048 + 32 * nb, 2048, WSP(bf16_t, WS_WINO) + (size_t)o * 2048 * D + (size_t)(32 * nb) * D + 64 * kb, D, scr, lane);
        } else if (r < IT_WINO + IT_GATES) { r -= IT_WINO;
            const int mat = r >> 5, q = r & 31, kb = q >> 3, nb = q & 7; const int isx = mat >> 3, dir = (mat >> 2) & 1, blk = mat & 3;
            const float* src = F.p->in[isx ? I_WGX : I_WGA] + ((size_t)((o * 2 + dir) * 4 + blk)) * 65536 + (size_t)(64 * kb) * 256 + 32 * nb;
            const int d0 = 32 * nb, half = d0 >> 7; const int drow = blk * 1024 + (dir * 2 + half) * 256 + isx * 128 + (d0 & 127);
            transpose_block(src, 256, WSP(bf16_t, WS_WG) + (size_t)o * 4096 * 256 + (size_t)drow * 256 + 64 * kb, 256, scr, lane);
        } else { r -= IT_WINO + IT_GATES; const int kb = r / 32, nb = r % 32;
            transpose_block(F.p->in[I_WOUTO] + (size_t)o * D * D + (size_t)(64 * kb) * D + 32 * nb, D, WSP(bf16_t, WS_WOUTO) + (size_t)o * D * D + (size_t)(32 * nb) * D + 64 * kb, D, scr, lane); }
        return;
    }
    it -= 2 * IT_O;
    { const int l = it / IT_L; int r = it % IT_L;
        if (r < IT_F1) { const int kb = r / 176, nb = r % 176; const int n0 = 32 * nb; const int isu = n0 >= DFF; const int c = n0 - isu * DFF; const int drow = (c >> 7) * 256 + isu * 128 + (c & 127);
            transpose_block(F.p->in[I_WF1] + (size_t)l * D * 5632 + (size_t)(64 * kb) * 5632 + n0, 5632, WSP(bf16_t, WS_WF1) + (size_t)l * 5632 * D + (size_t)drow * D + 64 * kb, D, scr, lane);
        } else { r -= IT_F1; const int kb = r / 32, nb = r % 32;
            transpose_block(F.p->in[I_WF2] + (size_t)l * DFF * D + (size_t)(64 * kb) * D + 32 * nb, D, WSP(bf16_t, WS_WF2) + (size_t)l * D * DFF + (size_t)(32 * nb) * DFF + 64 * kb, DFF, scr, lane); }
    }
}

__device__ __forceinline__ void phase_prologue(Frame& F) {
    const int tid = F.tid, lane = F.lane, wave = F.wave;
    const int gt = F.vcu * NTHREADS + tid, NGT = F.G * NTHREADS;
    {
        LAS float* sil = (LAS float*)F.lds;
        LAS float* red = (LAS float*)(F.lds + 20480);
        for (int i = tid; i < 5 * 1024; i += NTHREADS) { const int ci = i >> 10, k = i & 1023; const float v = ci == 0 ? F.p->in[I_CCTX][k] : F.p->in[I_C][(ci - 1) * 1024 + k]; sil[i] = siluf_(v); }
        __syncthreads();
        for (int item = F.vcu; item < 4 * 48; item += F.G) {
            const int l = item / 48, n0 = (item % 48) * 128;
            const float* wp = F.p->in[I_WADA] + ((size_t)l * 1024 + wave * 128) * 6144 + n0 + 2 * lane;
            float a0[5] = {0.f, 0.f, 0.f, 0.f, 0.f}, a1[5] = {0.f, 0.f, 0.f, 0.f, 0.f};
#pragma unroll 8
            for (int kk = 0; kk < 128; ++kk) { const f32x2 w = *(const f32x2*)(wp + (size_t)kk * 6144);
#pragma unroll
                for (int ci = 0; ci < 5; ++ci) { const float s = sil[ci * 1024 + wave * 128 + kk]; a0[ci] += s * w.x; a1[ci] += s * w.y; } }
#pragma unroll
            for (int ci = 0; ci < 5; ++ci) { red[(wave * 5 + ci) * 128 + 2 * lane] = a0[ci]; red[(wave * 5 + ci) * 128 + 2 * lane + 1] = a1[ci]; }
            __syncthreads();
            for (int i = tid; i < 640; i += NTHREADS) { const int ci = i >> 7, n = i & 127; float s = F.p->in[I_BADA][l * 6144 + n0 + n];
#pragma unroll
                for (int w = 0; w < 8; ++w) s += red[(w * 5 + ci) * 128 + n];
                WSP(float, WS_MOD)[(size_t)(l * 5 + ci) * 6144 + n0 + n] = s; }
            __syncthreads();
        }
    }
    for (int i = gt; i < 1024; i += NGT) { const int pos = i >> 4, fi = i & 15; const float inv = exp2f(-(float)fi * (13.287712379549449f / 16.0f)); const float a = (float)pos * inv;
        WSP(float, WS_ROPE)[2 * i] = cosf(a); WSP(float, WS_ROPE)[2 * i + 1] = sinf(a); }
    for (int i = gt; i < 4 * 2 * 256 * 128 / 4; i += NGT) { const f32x4 k = ((const f32x4*)F.p->in[I_CK])[i], v = ((const f32x4*)F.p->in[I_CV])[i];
        u32x2 a; a.x = pk2(k[0], k[1]); a.y = pk2(k[2], k[3]); ((u32x2*)WSP(bf16_t, WS_CK))[i] = a; a.x = pk2(v[0], v[1]); a.y = pk2(v[2], v[3]); ((u32x2*)WSP(bf16_t, WS_CV))[i] = a; }
    for (int i = gt; i < 2 * (PEP - PE) * D / 8; i += NGT) { const int e = i / ((PEP - PE) * D / 8), r = i % ((PEP - PE) * D / 8);
        ((u32x4*)(WSP(bf16_t, WS_WINE) + (size_t)e * PEP * D + (size_t)PE * D))[r] = (u32x4){0u, 0u, 0u, 0u}; }
    { const f32x4* xp = (const f32x4*)F.p->in[I_XP]; const f32x4* xs = (const f32x4*)F.p->in[I_XS]; f32x4* X = (f32x4*)F.out; const int NP = MCTX * D / 4, NT_ = M * D / 4;
        for (int i = gt; i < NT_; i += NGT) X[i] = i < NP ? xp[i] : xs[i - NP]; }
    {
        LAS float* scr = (LAS float*)(F.lds + 40960 + wave * 8704);
        const int gw = F.vcu * NWAVES + wave, NGW = F.G * NWAVES;
        for (int it = gw; it < IT_TOTAL; it += NGW) convert_item(F, it, scr);
    }
}

__device__ __forceinline__ void phase_norm(Frame& F, int l, int which) {
    const int lane = F.lane; const int gw = F.vcu * NWAVES + F.wave;
    const float* gvec = which == 0 ? F.p->in[I_NMIX] + l * 1024 : which == 1 ? F.p->in[I_NFFN] + l * 1024 : F.p->in[I_NFIN];
    const float* mod = WSP(float, WS_MOD);
    bf16_t* XN = WSP(bf16_t, WS_XN);
    f32x4 gg[4], sh[4]; int cur_ci = -1;
    for (int r = 0; r < 10; ++r) {
        const int row = gw * 10 + r; const int ci = cond_of_row(row);
        if (ci != cur_ci) { cur_ci = ci;
#pragma unroll
            for (int j = 0; j < 4; ++j) { const int col = 4 * lane + 256 * j; gg[j] = *(const f32x4*)(gvec + col);
                if (which < 2) { const float* mb = mod + ((size_t)(l * 5 + ci) * 6 + which * 3) * 1024 + col; const f32x4 s1 = *(const f32x4*)(mb + 1024); gg[j] = gg[j] * (1.0f + s1); sh[j] = *(const f32x4*)mb; } } }
        float* xr = F.out + (size_t)row * D;
        f32x4 v[4]; float s = 0.f;
#pragma unroll
        for (int j = 0; j < 4; ++j) { v[j] = *(const f32x4*)(xr + 4 * lane + 256 * j); s += (v[j].x * v[j].x + v[j].y * v[j].y) + (v[j].z * v[j].z + v[j].w * v[j].w); }
        const float rs = 1.0f / sqrtf(wave_sum(s) * (1.0f / D) + EPS);
        if (which < 2) {
#pragma unroll
            for (int j = 0; j < 4; ++j) { const f32x4 y = v[j] * rs * gg[j] + sh[j]; u32x2 w; w.x = pk2(y[0], y[1]); w.y = pk2(y[2], y[3]); *(u32x2*)(XN + (size_t)row * D + 4 * lane + 256 * j) = w; }
        } else {
#pragma unroll
            for (int j = 0; j < 4; ++j) *(f32x4*)(xr + 4 * lane + 256 * j) = v[j] * rs * gg[j];
        }
    }
}

__device__ __forceinline__ void attn_unit(Frame& F, int e, int kind, int b, int kvh, int qb, int hp) {
    const int lane = F.lane, w = F.wave, r32 = lane & 31, hh = lane >> 5;
    const bf16_t* ZE = WSP(bf16_t, WS_ZE);
    const int head = kvh * 4 + hp * 2 + (w >> 2);
    const int seqbase = kind == 0 ? MCTX + b * TLAT : b * TCTX;
    const int qloc = qb * 128 + (w & 3) * 32 + r32;
    const int iloc = (w & 3) * 32 + r32;
    bf16x8 qr[4];
#pragma unroll
    for (int d0 = 0; d0 < 4; ++d0) qr[d0] = *(const bf16x8*)(ZE + (size_t)(seqbase + qloc) * ZW + head * 64 + d0 * 16 + hh * 8);
    const int wt0 = (kind == 0 && qb == 0) ? 2 : 0, wt1 = (kind == 0) ? ((qb == 31) ? 4 : 6) : 0;
    const int NT = 4 + (wt1 - wt0);
    float m_run = F.p->in[I_SINK][e * 8 + head] * LOG2E; float l_run = hh == 0 ? 1.0f : 0.0f;
    f32x16 o0 = {}, o1 = {};
    const int kkey = lane, kchunk = w;
    const int vkey = 16 * (w & 3) + (lane >> 2), vdh = w >> 2, vpiece = lane & 3;
    const unsigned kdst = (unsigned)(kchunk * 1024 + kkey * 16), vdst = (unsigned)(16384 + vdh * 4096 + (w & 3) * 1024 + lane * 16);
    u32x4 kreg, vreg; int mtype = 0, joff = 0;
    auto tile_ptrs = [&](int t, const bf16_t*& kp, const bf16_t*& vp, int& pitch, int& mt, int& jo) {
        if (kind == 0 && t < 4) { const size_t base = ((size_t)(b * 2 + e) * 256 + 64 * t) * 128 + kvh * 64; kp = WSP(bf16_t, WS_CK) + base; vp = WSP(bf16_t, WS_CV) + base; pitch = 128; mt = 0; jo = 0; }
        else if (kind == 0) { const int wt = t - 4 + wt0; const int blk = qb - 1 + (wt >> 1); const size_t row = (size_t)seqbase + blk * 128 + (wt & 1) * 64;
            kp = ZE + row * ZW + 512 + kvh * 64; vp = ZE + row * ZW + 640 + kvh * 64; pitch = ZW; mt = (blk < qb) ? 1 : (blk > qb) ? 2 : 0; jo = (wt & 1) * 64; }
        else { const size_t row = (size_t)seqbase + 64 * t; kp = ZE + row * ZW + 512 + kvh * 64; vp = ZE + row * ZW + 640 + kvh * 64; pitch = ZW; mt = 0; jo = 0; }
    };
    { const bf16_t *kp, *vp; int pitch, mt, jo; tile_ptrs(0, kp, vp, pitch, mt, jo);
        kreg = *(const u32x4*)(kp + (size_t)kkey * pitch + kchunk * 8); vreg = *(const u32x4*)(vp + (size_t)vkey * pitch + vdh * 32 + vpiece * 8);
        *(LAS u32x4*)(F.lds + kdst) = kreg; *(LAS u32x4*)(F.lds + vdst) = vreg; mtype = mt; joff = jo; }
    __syncthreads();
    for (int t = 0; t < NT; ++t) {
        const int buf = t & 1; int nmt = 0, njo = 0;
        if (t + 1 < NT) { const bf16_t *kp, *vp; int pitch; tile_ptrs(t + 1, kp, vp, pitch, nmt, njo);
            kreg = *(const u32x4*)(kp + (size_t)kkey * pitch + kchunk * 8); vreg = *(const u32x4*)(vp + (size_t)vkey * pitch + vdh * 32 + vpiece * 8); }
        const lptr kb = F.lds + buf * 8192 + hh * 1024 + r32 * 16;
        f32x16 p0 = {}, p1 = {};
#pragma unroll
        for (int d0 = 0; d0 < 4; ++d0) { const bf16x8 k0 = *(const LAS bf16x8*)(kb + d0 * 2048), k1 = *(const LAS bf16x8*)(kb + d0 * 2048 + 512);
            p0 = __builtin_amdgcn_mfma_f32_32x32x16_bf16(k0, qr[d0], p0, 0, 0, 0); p1 = __builtin_amdgcn_mfma_f32_32x32x16_bf16(k1, qr[d0], p1, 0, 0, 0); }
        if (mtype != 0) {
#pragma unroll
            for (int r = 0; r < 16; ++r) { const int j0 = joff + crow(r, hh), j1 = j0 + 32;
                const bool bad0 = (mtype == 1) ? (j0 < iloc) : (j0 > iloc), bad1 = (mtype == 1) ? (j1 < iloc) : (j1 > iloc);
                if (bad0) p0[r] = -1e30f; if (bad1) p1[r] = -1e30f; }
        }
        float mx = fmaxf(p0[0], p1[0]);
#pragma unroll
        for (int r = 1; r < 16; ++r) mx = fmaxf(mx, fmaxf(p0[r], p1[r]));
        mx = fmaxf(mx, __shfl_xor(mx, 32));
        const float m_new = fmaxf(m_run, mx); const float alpha = fexp2(m_run - m_new); m_run = m_new;
        float ps = 0.f;
#pragma unroll
        for (int r = 0; r < 16; ++r) { p0[r] = fexp2(p0[r] - m_new); p1[r] = fexp2(p1[r] - m_new); ps += p0[r] + p1[r]; }
        l_run = l_run * alpha + ps;
#pragma unroll
        for (int r = 0; r < 16; ++r) { o0[r] *= alpha; o1[r] *= alpha; }
        u32x4 pw[4];
#pragma unroll
        for (int s = 0; s < 2; ++s) { pw[s] = (u32x4){pk2(p0[8 * s], p0[8 * s + 1]), pk2(p0[8 * s + 2], p0[8 * s + 3]), pk2(p0[8 * s + 4], p0[8 * s + 5]), pk2(p0[8 * s + 6], p0[8 * s + 7])};
            pw[2 + s] = (u32x4){pk2(p1[8 * s], p1[8 * s + 1]), pk2(p1[8 * s + 2], p1[8 * s + 3]), pk2(p1[8 * s + 4], p1[8 * s + 5]), pk2(p1[8 * s + 6], p1[8 * s + 7])}; }
        const lptr vb = F.lds + 16384 + buf * 8192 + ((lane >> 4) & 1) * 32 + (lane & 3) * 8 + (4 * hh + ((lane & 15) >> 2)) * 64;
#pragma unroll
        for (int s = 0; s < 4; ++s) { const bf16x8 v0 = tr_frag(vb + s * 1024), v1 = tr_frag(vb + 4096 + s * 1024);
            o0 = __builtin_amdgcn_mfma_f32_32x32x16_bf16(v0, __builtin_bit_cast(bf16x8, pw[s]), o0, 0, 0, 0);
            o1 = __builtin_amdgcn_mfma_f32_32x32x16_bf16(v1, __builtin_bit_cast(bf16x8, pw[s]), o1, 0, 0, 0); }
        if (t + 1 < NT) { *(LAS u32x4*)(F.lds + (buf ^ 1) * 8192 + kdst) = kreg; *(LAS u32x4*)(F.lds + (buf ^ 1) * 8192 + vdst) = vreg; }
        mtype = nmt; joff = njo;
        __syncthreads();
    }
    const float lt = l_run + __shfl_xor(l_run, 32); const float inv = 1.0f / lt;
    bf16_t* orow = WSP(bf16_t, WS_XN) + (size_t)(seqbase + qloc) * D + head * 64;
#pragma unroll
    for (int g = 0; g < 4; ++g) { u32x2 a; a.x = pk2(o0[4 * g] * inv, o0[4 * g + 1] * inv); a.y = pk2(o0[4 * g + 2] * inv, o0[4 * g + 3] * inv); *(u32x2*)(orow + 8 * g + 4 * hh) = a;
        a.x = pk2(o1[4 * g] * inv, o1[4 * g + 1] * inv); a.y = pk2(o1[4 * g + 2] * inv, o1[4 * g + 3] * inv); *(u32x2*)(orow + 32 + 8 * g + 4 * hh) = a; }
}

constexpr int GL_LA = 0;
constexpr int GL_LR = 32768;
constexpr int GL_WA = 40960;
constexpr int GL_BA = 49152;
constexpr int GL_BL = 49664;
constexpr int GL_A = 51200;
constexpr int GL_B = 67584;
constexpr int GL_C = 83968;
__device__ __forceinline__ int timg(int r, int c, int R) { return (c >> 5) * (R * 64) + (r >> 3) * 512 + (r & 7) * 64 + (c & 31) * 2; }

__device__ __forceinline__ void gla_bcum(Frame& F, int e, int gc, int hd) {
    const int tid = F.tid; const int R0 = gc * 64;
    LAS float* LA = (LAS float*)(F.lds + GL_LA); LAS float* LRs = (LAS float*)(F.lds + GL_LR); LAS float* WA = (LAS float*)(F.lds + GL_WA);
    LAS float* BA = (LAS float*)(F.lds + GL_BA); LAS float* BL = (LAS float*)(F.lds + GL_BL);
    { const int row = tid >> 3, c4 = tid & 7; *(LAS f32x4*)(LRs + row * 32 + 4 * c4) = *(const f32x4*)(WSP(float, WS_LR) + (size_t)(R0 + row) * 32 + 4 * c4);
      const int z = tid >> 8, r = (tid >> 4) & 15, k4 = tid & 15; *(LAS f32x4*)(WA + (z * 16 + r) * 64 + 4 * k4) = *(const f32x4*)(F.p->in[I_WALPHA] + ((size_t)(e * 2 + z) * 16 + r) * 256 + hd * 64 + 4 * k4);
      if (tid < 128) { const int zz = tid >> 6, k = tid & 63; BA[tid] = F.p->in[I_BALPHA][(e * 2 + zz) * 256 + hd * 64 + k]; } }
    __syncthreads();
    { const int k = tid & 63, tg = tid >> 6;
#pragma unroll
      for (int z = 0; z < 2; ++z) { float wa[16];
#pragma unroll
        for (int r = 0; r < 16; ++r) wa[r] = WA[(z * 16 + r) * 64 + k];
        const float bz = BA[z * 64 + k];
#pragma unroll
        for (int tt = 0; tt < 8; ++tt) { const int t = tg * 8 + tt; float x = bz;
#pragma unroll
            for (int r = 0; r < 16; ++r) x += LRs[t * 32 + z * 16 + r] * wa[r];
            const float ls = fminf(x, 0.f) - log1pf(__expf(-fabsf(x)));
            LA[(z * 64 + t) * 64 + k] = ls * (1.0f / 16.0f); } } }
    __syncthreads();
    LAS float* TOT = LRs;
    { const int z = tid >> 8, seg = (tid >> 6) & 3, k = tid & 63; float run = 0.f;
      if (z == 0) { for (int t = seg * 16; t < seg * 16 + 16; ++t) { run += LA[t * 64 + k]; LA[t * 64 + k] = run; } }
      else { for (int t = seg * 16 + 15; t >= seg * 16; --t) { run += LA[(64 + t) * 64 + k]; LA[(64 + t) * 64 + k] = run; } }
      TOT[(z * 4 + seg) * 64 + k] = run; }
    __syncthreads();
    { const int z = tid >> 8, seg = (tid >> 6) & 3, k = tid & 63; float add = 0.f;
      if (z == 0) { for (int s = 0; s < seg; ++s) add += TOT[s * 64 + k]; } else { for (int s = seg + 1; s < 4; ++s) add += TOT[(4 + s) * 64 + k]; }
      for (int t = seg * 16; t < seg * 16 + 16; ++t) LA[(z * 64 + t) * 64 + k] += add;
      if (z == 0 && seg == 3) BL[k] = LA[63 * 64 + k];
      if (z == 1 && seg == 0) BL[64 + k] = LA[64 * 64 + k]; }
    __syncthreads();
}
__device__ __forceinline__ void gla_stage_v(Frame& F, int R0, int hd, int off) {
    const bf16_t* ZE = WSP(bf16_t, WS_ZE);
#pragma unroll
    for (int i = 0; i < 2; ++i) { const int p = F.tid + 512 * i, t = p >> 4, v8 = (p & 15) * 8;
        *(LAS u32x4*)(F.lds + off + timg(t, v8, 64)) = *(const u32x4*)(ZE + (size_t)(R0 + t) * ZW + 1280 + hd * 128 + v8); }
}
__device__ __forceinline__ void gla_g1_item(Frame& F, int e, int gc, int hd) {
    const int tid = F.tid, lane = F.lane, w = F.wave; const int R0 = gc * 64;
    gla_bcum(F, e, gc, hd);
    LAS float* LA = (LAS float*)(F.lds + GL_LA); LAS float* BL = (LAS float*)(F.lds + GL_BL);
    const bf16_t* ZE = WSP(bf16_t, WS_ZE);
    { const int t = tid >> 3, k8 = (tid & 7) * 8; const u32x4 gk = *(const u32x4*)(ZE + (size_t)(R0 + t) * ZW + 1024 + hd * 64 + k8);
      const float kf[8] = {bflo(gk.x), bfhi(gk.x), bflo(gk.y), bfhi(gk.y), bflo(gk.z), bfhi(gk.z), bflo(gk.w), bfhi(gk.w)};
#pragma unroll
      for (int z = 0; z < 2; ++z) { float ks[8];
#pragma unroll
        for (int j = 0; j < 8; ++j) ks[j] = kf[j] * fexp(BL[z * 64 + k8 + j] - LA[(z * 64 + t) * 64 + k8 + j]);
        *(LAS u32x4*)(F.lds + GL_A + z * 8192 + timg(t, k8, 64)) = (u32x4){pk2(ks[0], ks[1]), pk2(ks[2], ks[3]), pk2(ks[4], ks[5]), pk2(ks[6], ks[7])}; } }
    gla_stage_v(F, R0, hd, GL_B);
    __syncthreads();
    { const int vb = w & 3, z = w >> 2; const int hh = lane >> 5, q = (lane & 15) >> 2;
      const int lofs = q * 64 + (((lane >> 4) & 1) * 16 + (lane & 3) * 4) * 2;
      f32x16 a0 = {}, a1 = {};
#pragma unroll
      for (int s = 0; s < 4; ++s) { const int rofs = (2 * s + hh) * 512;
        const lptr vp = F.lds + GL_B + vb * 4096 + rofs + lofs; const s16x4 va = tr_read(vp), vb2 = tr_read(vp + 256);
        const bf16x8 vf = (bf16x8){va[0], va[1], va[2], va[3], vb2[0], vb2[1], vb2[2], vb2[3]};
        const lptr kp = F.lds + GL_A + z * 8192 + rofs + lofs; const s16x4 ka = tr_read(kp), kb2 = tr_read(kp + 256), kc = tr_read(kp + 4096), kd = tr_read(kp + 4096 + 256);
        const bf16x8 kf0 = (bf16x8){ka[0], ka[1], ka[2], ka[3], kb2[0], kb2[1], kb2[2], kb2[3]}, kf1 = (bf16x8){kc[0], kc[1], kc[2], kc[3], kd[0], kd[1], kd[2], kd[3]};
        a0 = __builtin_amdgcn_mfma_f32_32x32x16_bf16(vf, kf0, a0, 0, 0, 0); a1 = __builtin_amdgcn_mfma_f32_32x32x16_bf16(vf, kf1, a1, 0, 0, 0); }
      float* kv = WSP(float, WS_KV) + ((size_t)(gc * 4 + hd) * 2 + z) * 8192;
#pragma unroll
      for (int r = 0; r < 16; ++r) { const int v = 32 * vb + crow(r, hh); kv[v * 64 + (lane & 31)] = a0[r]; kv[v * 64 + 32 + (lane & 31)] = a1[r]; } }
    if (tid < 128) WSP(float, WS_DL)[((size_t)(gc * 4 + hd) * 2 + (tid >> 6)) * 64 + (tid & 63)] = fexp(BL[tid]);
    __syncthreads();
}
__device__ __forceinline__ void phase_g2(Frame& F, int e) {
    const int tid = F.tid; float* KV = WSP(float, WS_KV); const float* DL = WSP(float, WS_DL);
    {
        const int v = F.vcu; const int chain = v >> 3, slice = v & 7; const int b = chain >> 3, hd = (chain >> 1) & 3, z = chain & 1;
        const int off = slice * 1024 + tid * 2, k = off & 63, vv = off >> 6;
        const float* s0 = F.p->in[I_SGLA] + ((size_t)((b * 2 + e) * 2 + z) * 4 + hd) * 8192;
        f32x2 S = (f32x2){s0[(size_t)k * 128 + vv], s0[(size_t)(k + 1) * 128 + vv]};
        for (int c8 = 0; c8 < 64; c8 += 8) {
            f32x2 kv[8], dl[8];
#pragma unroll
            for (int i = 0; i < 8; ++i) { const int c = z ? 63 - (c8 + i) : c8 + i; const size_t it = (size_t)((64 + b * 64 + c) * 4 + hd) * 2 + z;
                kv[i] = *(const f32x2*)(KV + it * 8192 + off); dl[i] = *(const f32x2*)(DL + it * 64 + k); }
#pragma unroll
            for (int i = 0; i < 8; ++i) { const int c = z ? 63 - (c8 + i) : c8 + i; const size_t it = (size_t)((64 + b * 64 + c) * 4 + hd) * 2 + z;
                *(f32x2*)(KV + it * 8192 + off) = S; S = dl[i] * S + kv[i]; }
        }
    }
    for (int item = F.vcu; item < 512; item += F.G) {
        const int chain = item >> 2, slice = item & 3; const int b = chain >> 3, hd = (chain >> 1) & 3, z = chain & 1;
        const int off = slice * 2048 + tid * 4, k = off & 63, vv = off >> 6;
        f32x4 S = {0.f, 0.f, 0.f, 0.f};
#pragma unroll
        for (int i = 0; i < 4; ++i) { const int c = z ? 3 - i : i; const size_t it = (size_t)((b * 4 + c) * 4 + hd) * 2 + z;
            const f32x4 kv = *(const f32x4*)(KV + it * 8192 + off), dl = *(const f32x4*)(DL + it * 64 + k);
            *(f32x4*)(KV + it * 8192 + off) = S; S = dl * S + kv; }
        float* dst = F.out + OUT_GLA + ((size_t)((b * 2 + e) * 2 + z) * 4 + hd) * 8192;
#pragma unroll
        for (int j = 0; j < 4; ++j) dst[(size_t)(k + j) * 128 + vv] = S[j];
    }
}
__device__ __forceinline__ void gla_g3_item(Frame& F, int e, int gc, int hd) {
    const int tid = F.tid, lane = F.lane, w = F.wave; const int R0 = gc * 64;
    gla_bcum(F, e, gc, hd);
    LAS float* LA = (LAS float*)(F.lds + GL_LA);
    const bf16_t* ZE = WSP(bf16_t, WS_ZE);
    { const int t = tid >> 3, c = tid & 7, k8 = c * 8;
      const u32x4 gq = *(const u32x4*)(ZE + (size_t)(R0 + t) * ZW + 768 + hd * 64 + k8), gk = *(const u32x4*)(ZE + (size_t)(R0 + t) * ZW + 1024 + hd * 64 + k8);
      const float qf[8] = {bflo(gq.x), bfhi(gq.x), bflo(gq.y), bfhi(gq.y), bflo(gq.z), bfhi(gq.z), bflo(gq.w), bfhi(gq.w)};
      const float kf[8] = {bflo(gk.x), bfhi(gk.x), bflo(gk.y), bfhi(gk.y), bflo(gk.z), bfhi(gk.z), bflo(gk.w), bfhi(gk.w)};
      const int so = t * 128 + ((c ^ (t & 7)) * 16);
#pragma unroll
      for (int z = 0; z < 2; ++z) { float qe[8], ke[8];
#pragma unroll
        for (int j = 0; j < 8; ++j) { const float bc = LA[(z * 64 + t) * 64 + k8 + j]; qe[j] = qf[j] * fexp(bc); ke[j] = kf[j] * fexp(-bc); }
        *(LAS u32x4*)(F.lds + GL_A + z * 8192 + so) = (u32x4){pk2(qe[0], qe[1]), pk2(qe[2], qe[3]), pk2(qe[4], qe[5]), pk2(qe[6], qe[7])};
        *(LAS u32x4*)(F.lds + GL_B + z * 8192 + so) = (u32x4){pk2(ke[0], ke[1]), pk2(ke[2], ke[3]), pk2(ke[4], ke[5]), pk2(ke[6], ke[7])}; } }
    gla_stage_v(F, R0, hd, GL_C);
    __syncthreads();
    { const float* KV = WSP(float, WS_KV) + (size_t)(gc * 4 + hd) * 2 * 8192;
#pragma unroll
      for (int i = 0; i < 8; ++i) { const int idx = tid + 512 * i, z = idx >> 11, rem = idx & 2047, v = rem >> 4, k4 = (rem & 15) * 4;
        const f32x4 s = *(const f32x4*)(KV + (size_t)z * 8192 + v * 64 + k4);
        *(LAS u32x2*)(F.lds + GL_LA + z * 16384 + v * 128 + (((k4 >> 3) ^ (v & 7)) * 16) + (k4 & 7) * 2) = (u32x2){pk2(s[0], s[1]), pk2(s[2], s[3])}; } }
    __syncthreads();
    const int vb = w >> 1, ib = w & 1, r32 = lane & 31, hh = lane >> 5;
    f32x16 o = {};
    bf16x8 qf[2][4];
    { const int i = 32 * ib + r32;
#pragma unroll
      for (int z = 0; z < 2; ++z)
#pragma unroll
        for (int s = 0; s < 4; ++s) qf[z][s] = *(const LAS bf16x8*)(F.lds + GL_A + z * 8192 + i * 128 + (((2 * s + hh) ^ (i & 7)) * 16)); }
    { const int v = 32 * vb + r32;
#pragma unroll
      for (int z = 0; z < 2; ++z)
#pragma unroll
        for (int s = 0; s < 4; ++s) { const bf16x8 sf = *(const LAS bf16x8*)(F.lds + GL_LA + z * 16384 + v * 128 + (((2 * s + hh) ^ (v & 7)) * 16));
            o = __builtin_amdgcn_mfma_f32_32x32x16_bf16(sf, qf[z][s], o, 0, 0, 0); } }
    const lptr vbase = F.lds + GL_C + vb * 4096 + ((lane >> 4) & 1) * 32 + (lane & 3) * 8 + (4 * hh + ((lane & 15) >> 2)) * 64;
#pragma unroll
    for (int jb = 0; jb < 2; ++jb) {
        const int j = 32 * jb + r32; f32x16 xf = {}, xb = {};
        const bool do_f = !(jb == 1 && ib == 0), do_b = !(jb == 0 && ib == 1);
#pragma unroll
        for (int s = 0; s < 4; ++s) { const int so = j * 128 + (((2 * s + hh) ^ (j & 7)) * 16);
            if (do_f) { const bf16x8 kf = *(const LAS bf16x8*)(F.lds + GL_B + so); xf = __builtin_amdgcn_mfma_f32_32x32x16_bf16(kf, qf[0][s], xf, 0, 0, 0); }
            if (do_b) { const bf16x8 kb = *(const LAS bf16x8*)(F.lds + GL_B + 8192 + so); xb = __builtin_amdgcn_mfma_f32_32x32x16_bf16(kb, qf[1][s], xb, 0, 0, 0); } }
        float x[16]; const int ii = 32 * ib + r32;
#pragma unroll
        for (int r = 0; r < 16; ++r) { const int jj = 32 * jb + crow(r, hh); x[r] = ((do_f && jj <= ii) ? xf[r] : 0.f) + ((do_b && jj >= ii) ? xb[r] : 0.f); }
#pragma unroll
        for (int s2 = 0; s2 < 2; ++s2) { const u32x4 pw = (u32x4){pk2(x[8 * s2], x[8 * s2 + 1]), pk2(x[8 * s2 + 2], x[8 * s2 + 3]), pk2(x[8 * s2 + 4], x[8 * s2 + 5]), pk2(x[8 * s2 + 6], x[8 * s2 + 7])};
            const bf16x8 vf = tr_frag(vbase + (4 * jb + 2 * s2) * 512);
            o = __builtin_amdgcn_mfma_f32_32x32x16_bf16(vf, __builtin_bit_cast(bf16x8, pw), o, 0, 0, 0); }
    }
    LAS float* SSQ = (LAS float*)(F.lds + GL_LR);
    { float s = 0.f;
#pragma unroll
      for (int r = 0; r < 16; ++r) s += o[r] * o[r];
      s += __shfl_xor(s, 32);
      if (hh == 0) SSQ[vb * 64 + 32 * ib + r32] = s; }
    __syncthreads();
    { const int i = 32 * ib + r32; const float tot = SSQ[i] + SSQ[64 + i] + SSQ[128 + i] + SSQ[192 + i]; const float rs = 1.0f / sqrtf(tot * (1.0f / 128.0f) + EPS);
      const float* gain = F.p->in[I_GGAIN] + e * 512 + hd * 128; const size_t row = (size_t)(R0 + i);
#pragma unroll
      for (int g = 0; g < 4; ++g) { const int v0 = 32 * vb + 8 * g + 4 * hh; const f32x4 gn = *(const f32x4*)(gain + v0);
        const u32x2 gr = *(const u32x2*)(ZE + row * ZW + 1792 + hd * 128 + v0);
        const float r0 = o[4 * g] * rs * gn[0] * bflo(gr.x), r1 = o[4 * g + 1] * rs * gn[1] * bfhi(gr.x), r2 = o[4 * g + 2] * rs * gn[2] * bflo(gr.y), r3 = o[4 * g + 3] * rs * gn[3] * bfhi(gr.y);
        *(u32x2*)(WSP(bf16_t, WS_XN) + row * D + 512 + hd * 128 + v0) = (u32x2){pk2(r0, r1), pk2(r2, r3)}; } }
    __syncthreads();
}

__device__ __forceinline__ void phase_attn_g1(Frame& F, int e) {
    const int v = F.vcu;
    for (int i = 0; i < 2; ++i) { const int uid = 2 * v + i; const int hp = uid & 1, qb = (uid >> 1) & 31, kvh = (uid >> 6) & 1, b = uid >> 7; attn_unit(F, e, 0, b, kvh, qb, hp); }
    if (v < 128) { const int hp = v & 1, qb = (v >> 1) & 1, kvh = (v >> 2) & 1, b = v >> 3; attn_unit(F, e, 1, b, kvh, qb, hp); }
    for (int it = v * 5; it < v * 5 + 5; ++it) gla_g1_item(F, e, it >> 2, it & 3);
}
__device__ __forceinline__ void phase_g3(Frame& F, int e) {
    const int v = F.vcu;
    for (int it = v * 5; it < v * 5 + 5; ++it) gla_g3_item(F, e, it >> 2, it & 3);
}

__device__ __forceinline__ void phase_conv(Frame& F, int o) {
    const bf16_t* U = WSP(bf16_t, WS_U); bf16_t* UC = WSP(bf16_t, WS_UC);
    const int gt = F.vcu * NTHREADS + F.tid, NGT = F.G * NTHREADS;
    for (int it = gt; it < 1280 * 128; it += NGT) {
        const int cg = it & 127, rg = it >> 7, c0 = cg * 8, r0 = rg * 16;
        const int seqlen = r0 < MCTX ? TCTX : TLAT; const int sb = r0 < MCTX ? (r0 & ~(TCTX - 1)) : MCTX + ((r0 - MCTX) & ~(TLAT - 1)); const int se = sb + seqlen;
        float w[4][8], bias[8];
#pragma unroll
        for (int i = 0; i < 4; ++i)
#pragma unroll
            for (int j = 0; j < 8; ++j) w[i][j] = F.p->in[I_CONVW][(size_t)(o * 4 + i) * 1024 + c0 + j];
#pragma unroll
        for (int j = 0; j < 8; ++j) bias[j] = F.p->in[I_CONVB][o * 1024 + c0 + j];
        float win[4][8];
        auto ld = [&](int row, float (&dst)[8]) { if (row >= sb && row < se) { const u32x4 x = *(const u32x4*)(U + (size_t)row * D + c0);
                dst[0] = bflo(x.x); dst[1] = bfhi(x.x); dst[2] = bflo(x.y); dst[3] = bfhi(x.y); dst[4] = bflo(x.z); dst[5] = bfhi(x.z); dst[6] = bflo(x.w); dst[7] = bfhi(x.w); }
            else {
#pragma unroll
                for (int j = 0; j < 8; ++j) dst[j] = 0.f; } };
        ld(r0 - 2, win[0]); ld(r0 - 1, win[1]); ld(r0, win[2]);
#pragma unroll 4
        for (int r = 0; r < 16; ++r) { ld(r0 + r + 1, win[3]); float y[8];
#pragma unroll
            for (int j = 0; j < 8; ++j) y[j] = bias[j] + w[0][j] * win[0][j] + w[1][j] * win[1][j] + w[2][j] * win[2][j] + w[3][j] * win[3][j];
            *(u32x4*)(UC + (size_t)(r0 + r) * D + c0) = (u32x4){pk2(y[0], y[1]), pk2(y[2], y[3]), pk2(y[4], y[5]), pk2(y[6], y[7])};
#pragma unroll
            for (int j = 0; j < 8; ++j) { win[0][j] = win[1][j]; win[1][j] = win[2][j]; win[2][j] = win[3][j]; } }
    }
}
__device__ __forceinline__ void phase_scan_a(Frame& F) {
    for (int item = F.vcu; item < 128 * 2; item += F.G) {
        const int hf = item & 1, z = (item >> 1) & 1, pm = 16 + (item >> 2); const int ch = hf * 512 + F.tid;
        const bf16_t* LA = WSP(bf16_t, z ? WS_LAB : WS_LAF); const bf16_t* BB = WSP(bf16_t, z ? WS_BB : WS_U);
        float P = 0.f, h = 0.f;
        for (int r8 = 0; r8 < 256; r8 += 8) { float la[8], bb[8];
#pragma unroll
            for (int i = 0; i < 8; ++i) { const int r = z ? 255 - (r8 + i) : r8 + i; const size_t ix = (size_t)(pm * 256 + r) * D + ch; la[i] = bf2f(LA[ix]); bb[i] = bf2f(BB[ix]); }
#pragma unroll
            for (int i = 0; i < 8; ++i) { P += la[i]; h = fexp(la[i]) * h + bb[i]; } }
        *(f32x2*)(WSP(float, WS_AGG) + ((size_t)(pm * 2 + z) * 1024 + ch) * 2) = (f32x2){P, h};
    }
}
__device__ __forceinline__ void phase_scan_b(Frame& F, int o) {
    for (int item = F.vcu; item < 160; item += F.G) {
        const int hf = item & 1, pm = item >> 1; const int ch = hf * 512 + F.tid; const bool lat = pm >= 16;
        const bf16_t* LAF = WSP(bf16_t, WS_LAF); const bf16_t* LAB = WSP(bf16_t, WS_LAB); const bf16_t* BF = WSP(bf16_t, WS_U); bf16_t* BBk = WSP(bf16_t, WS_BB);
        const bf16_t* Gg = WSP(bf16_t, WS_G); bf16_t* YG = WSP(bf16_t, WS_XN); const float* AGG = WSP(float, WS_AGG);
        float hfw = 0.f, hbw = 0.f;
        if (lat) { const int b = (pm - 16) >> 4, q = (pm - 16) & 15, pm0 = pm - q;
            hfw = F.p->in[I_SLRU][(size_t)((b * 2 + o) * 2 + 0) * 1024 + ch]; hbw = F.p->in[I_SLRU][(size_t)((b * 2 + o) * 2 + 1) * 1024 + ch];
            for (int qq = 0; qq < q; ++qq) { const f32x2 a = *(const f32x2*)(AGG + ((size_t)((pm0 + qq) * 2 + 0) * 1024 + ch) * 2); hfw = fexp(a.x) * hfw + a.y; }
            for (int qq = 15; qq > q; --qq) { const f32x2 a = *(const f32x2*)(AGG + ((size_t)((pm0 + qq) * 2 + 1) * 1024 + ch) * 2); hbw = fexp(a.x) * hbw + a.y; } }
        for (int r8 = 0; r8 < 256; r8 += 8) { float la[8], bb[8];
#pragma unroll
            for (int i = 0; i < 8; ++i) { const size_t ix = (size_t)(pm * 256 + 255 - (r8 + i)) * D + ch; la[i] = bf2f(LAB[ix]); bb[i] = bf2f(BBk[ix]); }
#pragma unroll
            for (int i = 0; i < 8; ++i) { const size_t ix = (size_t)(pm * 256 + 255 - (r8 + i)) * D + ch; hbw = fexp(la[i]) * hbw + bb[i]; BBk[ix] = (bf16_t)f2bf(hbw); } }
        if (!lat) F.out[OUT_LRU + (size_t)((pm * 2 + o) * 2 + 1) * 1024 + ch] = hbw;
        for (int r8 = 0; r8 < 256; r8 += 8) { float la[8], bb[8], yb[8], gg[8];
#pragma unroll
            for (int i = 0; i < 8; ++i) { const size_t ix = (size_t)(pm * 256 + r8 + i) * D + ch; la[i] = bf2f(LAF[ix]); bb[i] = bf2f(BF[ix]); yb[i] = bf2f(BBk[ix]); gg[i] = bf2f(Gg[ix]); }
#pragma unroll
            for (int i = 0; i < 8; ++i) { const size_t ix = (size_t)(pm * 256 + r8 + i) * D + ch; hfw = fexp(la[i]) * hfw + bb[i]; YG[ix] = (bf16_t)f2bf(gg[i] * (hfw + yb[i])); } }
        if (!lat) F.out[OUT_LRU + (size_t)((pm * 2 + o) * 2 + 0) * 1024 + ch] = hfw;
    }
}

constexpr int NSTEPS = 42;
__global__ void __launch_bounds__(NTHREADS, 2) mk_fwd(Params P) {
    extern __shared__ __attribute__((aligned(16))) unsigned char lds_raw[];
    const lptr lds0 = (lptr)lds_raw;
    volatile LAS unsigned* MISC = (volatile LAS unsigned*)(lds0 + MISC_OFF);
    for (int u = threadIdx.x; u < (LDS_BYTES - LDSCTL_OFF) / 4; u += NTHREADS) ((LAS unsigned*)(lds0 + LDSCTL_OFF))[u] = 0u;
    __syncthreads();
    unsigned* ctl = (unsigned*)(P.ws + WS_CTL);
    XcdBarrier bar; bar.bar = ctl + 1024; bar.x = 0; bar.st = nullptr;
    const bool multi = (P.step_hi - P.step_lo) > 1;
    if (multi) bar = xcd_barrier_post(ctl + 1024, MISC + 8);

    for (int step = P.step_lo; step < P.step_hi; ++step) {
        Frame F; F.lds = lds0; F.p = &P;
        { int tid = threadIdx.x; asm volatile("" : "+v"(tid)); F.tid = tid; F.lane = tid & 63; F.wave = __builtin_amdgcn_readfirstlane(tid >> 6); }
        { int G = gridDim.x, bx = blockIdx.x; asm volatile("" : "+s"(G), "+s"(bx)); F.G = G; F.bid = bx; F.vcu = (G % 8 == 0) ? (bx % 8) * (G / 8) + bx / 8 : bx; }
        { unsigned char* ws = P.ws; float* out = P.out; asm volatile("" : "+s"(ws), "+s"(out)); F.ws = ws; F.out = out; }
        bool did = true;
        if (step == 0) phase_prologue(F);
        else if (step == 41) phase_norm(F, 0, 2);
        else {
            const int l = (step - 1) / 10, j = (step - 1) % 10; const bool even = (l & 1) == 0; const int sub = l >> 1;
            int gk = -1;
            if (j == 0) phase_norm(F, l, 0);
            else if (j == 7) phase_norm(F, l, 1);
            else if (j == 1) gk = even ? EK_EVEN_IN : EK_ODD_IN;
            else if (j == 6) gk = EK_RES;
            else if (j == 8) gk = EK_SWIGLU;
            else if (j == 9) gk = EK_RES;
            else if (even) { if (j == 2) phase_attn_g1(F, sub); else if (j == 3) phase_g2(F, sub); else if (j == 4) phase_g3(F, sub); else did = false; }
            else { if (j == 2) phase_conv(F, sub); else if (j == 3) gk = EK_GATES; else if (j == 4) phase_scan_a(F); else phase_scan_b(F, sub); }
            if (gk >= 0) {
                pg8::Gemm g; Epi E; E.kind = gk; E.layer = l; E.sub = sub; E.X = F.out; E.mod = WSP(float, WS_MOD); E.gidx = 2; E.o0 = E.o1 = E.o2 = E.o3 = nullptr; E.lr = WSP(float, WS_LR);
                E.rope = WSP(float, WS_ROPE); E.uc = WSP(bf16_t, WS_UC); E.ba = F.p->in[I_BGA]; E.bx = F.p->in[I_BGX]; E.lam = F.p->in[I_LAM];
                g.nM = M / 256; g.a_grp = 0; g.lda = D; g.K = D; g.A = WSP(bf16_t, WS_XN);
                if (gk == EK_EVEN_IN) { g.Bt = WSP(bf16_t, WS_WINE) + (size_t)sub * PEP * D; g.nN = 10; g.perm = true; E.o0 = WSP(bf16_t, WS_ZE); }
                else if (gk == EK_ODD_IN) { g.Bt = WSP(bf16_t, WS_WINO) + (size_t)sub * 2048 * D; g.nN = 8; g.perm = true; E.o0 = WSP(bf16_t, WS_G); E.o1 = WSP(bf16_t, WS_U); }
                else if (gk == EK_GATES) { g.A = WSP(bf16_t, WS_UC); g.K = 256; g.a_grp = 4; g.Bt = WSP(bf16_t, WS_WG) + (size_t)sub * 4096 * 256; g.nN = 16; g.perm = true;
                    E.o0 = WSP(bf16_t, WS_LAF); E.o1 = WSP(bf16_t, WS_LAB); E.o2 = WSP(bf16_t, WS_U); E.o3 = WSP(bf16_t, WS_BB); }
                else if (gk == EK_SWIGLU) { g.Bt = WSP(bf16_t, WS_WF1) + (size_t)l * 5632 * D; g.nN = 22; g.perm = true; E.o0 = WSP(bf16_t, WS_H); }
                else if (j == 6) { g.Bt = (even ? WSP(bf16_t, WS_WOUTE) : WSP(bf16_t, WS_WOUTO)) + (size_t)sub * D * D; g.nN = 4; g.perm = false; E.gidx = 2; }
                else { g.A = WSP(bf16_t, WS_H); g.lda = DFF; g.K = DFF; g.Bt = WSP(bf16_t, WS_WF2) + (size_t)l * D * DFF; g.nN = 4; g.perm = false; E.gidx = 5; }
                pg8::StaticOrder S; S.init(g.nM, g.nN, F.G, F.bid);
                pg8::gemm_phase<Epi>(F.lds, F.tid, g, S, E);
            }
        }
        if (multi && did && step + 1 < P.step_hi) xcd_barrier(bar, F.tid);
        else __syncthreads();
    }
}

extern "C" void kernel_launch(void* const* d_in, const int* in_sizes, int n_in, void* d_out, int out_size, void* d_ws, size_t ws_size, hipStream_t stream) {
    static int grid = 0;
    if (grid == 0) {
        if (n_in != 30 || (size_t)out_size != OUT_END || ws_size < WS_END) { fprintf(stderr, "kernel_launch: unexpected shapes: n_in %d out %d ws %zu (need %zu)\n", n_in, out_size, ws_size, (size_t)WS_END); grid = -1; return; }
        int dev = 0, cus = 0;
        if (hipGetDevice(&dev) != hipSuccess || hipDeviceGetAttribute(&cus, hipDeviceAttributeMultiprocessorCount, dev) != hipSuccess) { grid = -1; return; }
        if (hipFuncSetAttribute((const void*)mk_fwd, hipFuncAttributeMaxDynamicSharedMemorySize, LDS_BYTES) != hipSuccess) { fprintf(stderr, "kernel_launch: hipFuncSetAttribute failed\n"); grid = -1; return; }
        (void)hipGetLastError();
        grid = cus;
        if (grid != 256) fprintf(stderr, "kernel_launch: %d CUs (built for 256)\n", grid);
    }
    if (grid < 0) return;
    (void)hipMemsetAsync((char*)d_ws + WS_CTL, 0, CTL_ZERO_BYTES, stream);
    Params p{};
    for (int i = 0; i < 30; ++i) p.in[i] = (const float*)d_in[i];
    p.out = (float*)d_out; p.ws = (unsigned char*)d_ws;
#if MK_MULTI
    for (int s = 0; s < NSTEPS; ++s) {
        if (s >= 1 && s <= 40) { const int l = (s - 1) / 10, j = (s - 1) % 10; if ((l & 1) == 0 && j == 5) continue; }
        p.step_lo = s; p.step_hi = s + 1;
        hipLaunchKernelGGL(mk_fwd, dim3(grid), dim3(NTHREADS), LDS_BYTES, stream, p);
    }
#else
    p.step_lo = 0; p.step_hi = NSTEPS;
    hipLaunchKernelGGL(mk_fwd, dim3(grid), dim3(NTHREADS), LDS_BYTES, stream, p);
#endif
}
```

```cpp
#include <hip/hip_runtime.h>
#include <cstdio>
#include <cstdint>

#ifndef MK_MULTI
#define MK_MULTI 0
#endif

#ifndef PROBE_MASK
#define PROBE_MASK 0
#endif
#ifndef PROBE_N
#define PROBE_N 1
#endif
#define LAS __attribute__((address_space(3)))
#define GAS __attribute__((address_space(1)))
typedef unsigned short bf16_t;
typedef short bf16x8 __attribute__((ext_vector_type(8)));
typedef short s16x4 __attribute__((ext_vector_type(4)));
typedef float f32x2 __attribute__((ext_vector_type(2)));
typedef float f32x4 __attribute__((ext_vector_type(4)));
typedef float f32x16 __attribute__((ext_vector_type(16)));
typedef unsigned u32x2 __attribute__((ext_vector_type(2)));
typedef unsigned u32x4 __attribute__((ext_vector_type(4)));
typedef LAS unsigned char* lptr;

constexpr int D = 1024, NCTX = 16, TCTX = 256, NLAT = 4, TLAT = 4096, DEPTH = 4;
constexpr int MCTX = NCTX * TCTX;
constexpr int M = MCTX + NLAT * TLAT;
constexpr int PE = 2336, PEP = 2560;
constexpr int ZW = 2304;
constexpr int DFF = 2816;
constexpr float EPS = 1e-6f;
constexpr float LOG2E = 1.4426950408889634f;
constexpr float QSCALE = 0.125f * LOG2E;
constexpr int NCHUNK = M / 64;

constexpr size_t OUT_CK = (size_t)M * D, OUT_CV = OUT_CK + 1048576, OUT_GLA = OUT_CV + 1048576, OUT_LRU = OUT_GLA + 2097152, OUT_END = OUT_LRU + 65536;

constexpr size_t MiB = 1u << 20;
constexpr size_t WS_CTL = 0, CTL_ZERO_BYTES = 64 * 1024;
constexpr size_t WS_BIAS = 256 * 1024;
constexpr size_t BIAS_E = 0, BIAS_O = 2 * 5 * 2560, BIAS_F = BIAS_O + 2 * 5 * 2048, BIAS_TOTAL = BIAS_F + 4 * 5 * 5632;
constexpr size_t WS_SSQ = 3 * MiB;
constexpr size_t WS_MOD = 1 * MiB;
constexpr size_t WS_ROPE = WS_MOD + 512 * 1024;
constexpr size_t WS_CK = 2 * MiB, WS_CV = 2 * MiB + 512 * 1024;
constexpr size_t WS_WINE = 4 * MiB;
constexpr size_t WS_WOUTE = WS_WINE + 10 * MiB;
constexpr size_t WS_WINO = WS_WOUTE + 4 * MiB;
constexpr size_t WS_WG = WS_WINO + 8 * MiB;
constexpr size_t WS_WOUTO = WS_WG + 4 * MiB;
constexpr size_t WS_WF1 = WS_WOUTO + 4 * MiB;
constexpr size_t WS_WF2 = WS_WF1 + 44 * MiB;
constexpr size_t WS_XN = WS_WF2 + 22 * MiB;
static_assert(WS_XN == 100 * MiB, "ws map");
constexpr size_t WS_BIG = 140 * MiB;
constexpr size_t WS_ZE = WS_BIG;
constexpr size_t WS_KV = WS_BIG + 90 * MiB;
constexpr size_t WS_LR = WS_BIG + 170 * MiB;
constexpr size_t WS_DL = WS_BIG + 173 * MiB;
constexpr size_t WS_MIX = WS_BIG + 176 * MiB;
constexpr size_t WS_G = WS_BIG;
constexpr size_t WS_U = WS_BIG + 40 * MiB;
constexpr size_t WS_UC = WS_BIG + 80 * MiB;
constexpr size_t WS_LAF = WS_BIG + 120 * MiB;
constexpr size_t WS_LAB = WS_BIG + 160 * MiB;
constexpr size_t WS_BB = WS_BIG + 200 * MiB;
constexpr size_t WS_AGG = WS_XN;
constexpr size_t WS_CARRY = WS_XN + 8 * MiB;
constexpr size_t WS_H = WS_BIG;
constexpr size_t WS_END = WS_BIG + 240 * MiB;

constexpr int RING_BYTES = 131072;
constexpr int LDSCTL_OFF = RING_BYTES, MISC_OFF = LDSCTL_OFF + 320;
constexpr int LDS_BYTES = 147456;
constexpr int NWAVES = 8, NTHREADS = 512;

__device__ __forceinline__ unsigned f2bf(float f) { unsigned u = __builtin_bit_cast(unsigned, f); return (u + 0x7fffu + ((u >> 16) & 1u)) >> 16; }
__device__ __forceinline__ unsigned pk2(float lo, float hi) { return f2bf(lo) | (f2bf(hi) << 16); }
__device__ __forceinline__ float bf2f(unsigned short b) { return __builtin_bit_cast(float, (unsigned)b << 16); }
__device__ __forceinline__ float bflo(unsigned w) { return __builtin_bit_cast(float, w << 16); }
__device__ __forceinline__ float bfhi(unsigned w) { return __builtin_bit_cast(float, w & 0xffff0000u); }
__device__ __forceinline__ float fexp2(float x) { return __builtin_amdgcn_exp2f(x); }
__device__ __forceinline__ float fexp(float x) { return __builtin_amdgcn_exp2f(x * LOG2E); }
__device__ __forceinline__ float frcp(float x) { return __builtin_amdgcn_rcpf(x); }
__device__ __forceinline__ float frsq(float x) { return __builtin_amdgcn_rsqf(x); }
__device__ __forceinline__ float fsqrt(float x) { return __builtin_amdgcn_sqrtf(x); }
__device__ __forceinline__ float flog(float x) { return __builtin_amdgcn_logf(x) * 0.6931471805599453f; }
__device__ __forceinline__ float sigmoidf_(float x) { return frcp(1.0f + fexp(-x)); }
__device__ __forceinline__ float siluf_(float x) { return x * frcp(1.0f + fexp(-x)); }
__device__ __forceinline__ float gelu_tanh(float x) { const float z = 0.7978845608028654f * (x + 0.044715f * x * x * x); const float t = 1.0f - 2.0f * frcp(fexp(2.0f * z) + 1.0f); return 0.5f * x * (1.0f + t); }
__device__ __forceinline__ int crow(int r, int hh) { return (r & 3) + 8 * (r >> 2) + 4 * hh; }
__device__ __forceinline__ int cond_of_row(int row) { return row < MCTX ? 0 : 1 + ((row - MCTX) >> 12); }
#define LDS_WAIT() asm volatile("s_waitcnt lgkmcnt(0)" ::: "memory")
#define VM_WAIT() asm volatile("s_waitcnt vmcnt(0)" ::: "memory")
__device__ __forceinline__ s16x4 tr_read(lptr p) { typedef short v4i16_t __attribute__((ext_vector_type(4))); return __builtin_bit_cast(s16x4, __builtin_amdgcn_ds_read_tr16_b64_v4i16((LAS v4i16_t*)p)); }
__device__ __forceinline__ bf16x8 tr_frag(lptr p) { const s16x4 a = tr_read(p), b = tr_read(p + 512); return (bf16x8){a[0], a[1], a[2], a[3], b[0], b[1], b[2], b[3]}; }
__device__ __forceinline__ float shfl_idx(float v, int src_lane) { return __builtin_bit_cast(float, __builtin_amdgcn_ds_bpermute(src_lane << 2, __builtin_bit_cast(int, v))); }
__device__ __forceinline__ float shfl_x(float v, int lane, int mask) { return shfl_idx(v, lane ^ mask); }
__device__ __forceinline__ float wave_sum(float v, int lane) {
#pragma unroll
    for (int o = 1; o < 64; o <<= 1) v += shfl_x(v, lane, o);
    return v;
}

struct Params {
    const float* in[30];
    float* out; unsigned char* ws;
    int step_lo, step_hi;
};
enum { I_XP = 0, I_XS, I_C, I_CK, I_CV, I_SGLA, I_SLRU, I_CCTX, I_WADA, I_BADA, I_NMIX, I_NFFN, I_WINE, I_SINK, I_WALPHA, I_BALPHA, I_GGAIN, I_WOUTE,
       I_WINO, I_CONVW, I_CONVB, I_WGA, I_BGA, I_WGX, I_BGX, I_LAM, I_WOUTO, I_WF1, I_WF2, I_NFIN };

namespace pg8 {
constexpr int BM = 256, BK = 64, HALF = 128, HTB = HALF * BK * 2, STAGE_BYTES = 8 * HTB, NXCD = 8, WGM = 8;
__device__ __forceinline__ int lds_byte(int r, int c) { const int st = (r >> 4) * 2 + (c >> 5), rr = r & 15, cc = c & 31, ob = rr * 64 + cc * 2; return st * 1024 + (ob ^ (((ob >> 9) & 1) << 5)); }
__device__ __forceinline__ void stage_rc(int b, int& R, int& C) { const int st = b / 1024, sb = b % 1024, swz = sb ^ (((sb >> 9) & 1) << 5); R = (st >> 1) * 16 + swz / 64; C = (st & 1) * 32 + (swz % 64) / 2; }
__device__ __forceinline__ int perm32(int rho) { const int n = rho >> 4, i = rho & 15; return 8 * (i >> 2) + 4 * n + (i & 3); }
struct Unit { int pm, pn; };
struct Gemm { const bf16_t* A; const bf16_t* Bt; int lda, K, nM, nN, a_grp; bool perm; };
struct StaticOrder {
    int nM, nN, nwg, G, c;
    __device__ void init(int nM_, int nN_, int G_, int c_) { nM = nM_; nN = nN_; nwg = nM * nN; G = G_; c = c_; }
    __device__ bool next(int i, Unit& u) const {
        const long L = (long)i * G + c; if (L >= nwg) return false;
        int wgid = (int)L; { const int q = nwg / NXCD, r = nwg % NXCD, xcd = wgid % NXCD, off = wgid / NXCD; wgid = (xcd < r ? xcd * (q + 1) : r * (q + 1) + (xcd - r) * q) + off; }
        const int nig = WGM * nN, gid = wgid / nig, fm = gid * WGM, gsz = (nM - fm) < WGM ? (nM - fm) : WGM;
        u.pm = fm + ((wgid % nig) % gsz); u.pn = (wgid % nig) / gsz; return true;
    }
};

template <class Epi>
__device__ __forceinline__ void gemm_phase(lptr lds, const int tid, const float zf, const Gemm g, const StaticOrder& S, const Epi& E) {
    const int wid = __builtin_amdgcn_readfirstlane(tid >> 6), lane = tid & 63, wr = wid >> 2, wc = wid & 3, fr = lane & 15, fq = lane >> 4;
    const int K = g.K, nt = K / BK, lda = g.lda;
    unsigned voffA[2], voffB[2];
#pragma unroll
    for (int i = 0; i < 2; ++i) { int R, C; stage_rc(tid * 16 + i * 8192, R, C); const int Rb = g.perm ? ((R & ~31) + perm32(R & 31)) : R;
        voffA[i] = (unsigned)(R * lda + C) * 2u; voffB[i] = (unsigned)(Rb * K + C) * 2u; }
    const size_t kstep = (size_t)(BK * 2);
    const size_t hsA = (size_t)HALF * lda * 2, hsB = (size_t)HALF * K * 2;
    const unsigned ldsw = (unsigned)wid * 1024u;
    const int aoff = lds_byte(wr * 64 + fr, fq * 8), boff = lds_byte(wc * 32 + fr, fq * 8);
#define PG8_SA(b, h) (((b) * 2 + (h)) * HTB)
#define PG8_SB(b, h) ((4 + (b) * 2 + (h)) * HTB)
#define PG8_STAGE(bufoff, gbase, voff) do { _Pragma("unroll") for (int _i = 0; _i < 2; ++_i) \
        __builtin_amdgcn_global_load_lds((const unsigned*)((const char*)(gbase) + (voff)[_i]), (LAS unsigned*)(lds + (bufoff) + ldsw + _i * 8192), 16, 0, 0); } while (0)
#define PG8_LDA(dst, b, h) do { _Pragma("unroll") for (int m = 0; m < 4; ++m) _Pragma("unroll") for (int k = 0; k < 2; ++k) dst[m][k] = *(const LAS bf16x8*)(lds + PG8_SA(b, h) + aoff + m * 2048 + k * 1024); } while (0)
#define PG8_LDB(dst, b, h) do { _Pragma("unroll") for (int n = 0; n < 2; ++n) _Pragma("unroll") for (int k = 0; k < 2; ++k) dst[n][k] = *(const LAS bf16x8*)(lds + PG8_SB(b, h) + boff + n * 2048 + k * 1024); } while (0)
#define PG8_MMA(ai, bj, At, Bt) do { __builtin_amdgcn_s_setprio(1); _Pragma("unroll") for (int m = 0; m < 4; ++m) _Pragma("unroll") for (int n = 0; n < 2; ++n) _Pragma("unroll") for (int k = 0; k < 2; ++k) \
        acc[ai][bj][m][n] = __builtin_amdgcn_mfma_f32_16x16x32_bf16(Bt[n][k], At[m][k], acc[ai][bj][m][n], 0, 0, 0); __builtin_amdgcn_s_setprio(0); } while (0)
#define PG8_WAIT_V(n) asm volatile("s_waitcnt vmcnt(" #n ")" ::: "memory")
#define PG8_WAIT_L(n) asm volatile("s_waitcnt lgkmcnt(" #n ")" ::: "memory")
#define PG8_BAR __builtin_amdgcn_s_barrier()
#define PG8_SCHED __builtin_amdgcn_sched_barrier(0)
#define PG8_ABASE(u) ((const char*)g.A + ((size_t)(u).pm * BM * lda + (g.a_grp ? (size_t)((u).pn / g.a_grp) * K : 0)) * 2)
#define PG8_BBASE(u) ((const char*)g.Bt + (size_t)(u).pn * BM * K * 2)
    Unit cur, nxt; int ui = 0;
    if (!S.next(0, cur)) return;
    f32x4 acc[2][2][4][2];
#pragma unroll
    for (int a = 0; a < 2; ++a)
#pragma unroll
        for (int b = 0; b < 2; ++b)
#pragma unroll
            for (int m = 0; m < 4; ++m)
#pragma unroll
                for (int n = 0; n < 2; ++n) acc[a][b][m][n] = (f32x4){zf, zf, zf, zf};
    bf16x8 At[4][2], B0[2][2], B1[2][2];
    const char* cA = PG8_ABASE(cur); const char* cB = PG8_BBASE(cur);
    PG8_STAGE(PG8_SB(0, 0), cB, voffB); PG8_STAGE(PG8_SB(0, 1), cB + hsB, voffB); PG8_STAGE(PG8_SA(0, 0), cA, voffA); PG8_STAGE(PG8_SA(0, 1), cA + hsA, voffA);
    if (wr == 1) PG8_BAR;
    PG8_WAIT_V(2); PG8_BAR;
    PG8_STAGE(PG8_SB(1, 0), cB + kstep, voffB); PG8_STAGE(PG8_SA(1, 0), cA + kstep, voffA); PG8_STAGE(PG8_SB(1, 1), cB + hsB + kstep, voffB);
    PG8_WAIT_V(6); PG8_BAR;
    for (;;) {
        const bool has_next = S.next(ui + 1, nxt);
        const char* nA = has_next ? PG8_ABASE(nxt) : cA; const char* nB = has_next ? PG8_BBASE(nxt) : cB;
#pragma unroll 1
        for (int t = 0; t < nt; t += 2) {
            const bool last = (t == nt - 2);
            const char* a1 = cA + (size_t)(t + 1) * kstep;
            const char* a2 = last ? nA : cA + (size_t)(t + 2) * kstep; const char* b2 = last ? nB : cB + (size_t)(t + 2) * kstep;
            const char* a3 = a2 + kstep; const char* b3 = b2 + kstep;
            PG8_LDB(B0, 0, 0); PG8_LDB(B1, 0, 1); PG8_SCHED; PG8_LDA(At, 0, 0); PG8_STAGE(PG8_SA(1, 1), a1 + hsA, voffA);
            PG8_WAIT_V(8); PG8_WAIT_L(0); PG8_BAR; PG8_MMA(0, 0, At, B0); PG8_MMA(0, 1, At, B1); PG8_BAR; PG8_SCHED;
            PG8_LDA(At, 0, 1); PG8_STAGE(PG8_SB(0, 0), b2, voffB); PG8_STAGE(PG8_SB(0, 1), b2 + hsB, voffB); PG8_STAGE(PG8_SA(0, 0), a2, voffA);
            PG8_WAIT_V(8); PG8_WAIT_L(0); PG8_BAR; PG8_MMA(1, 0, At, B0); PG8_MMA(1, 1, At, B1); PG8_BAR; PG8_SCHED;
            PG8_LDB(B0, 1, 0); PG8_LDB(B1, 1, 1); PG8_SCHED; PG8_LDA(At, 1, 0); PG8_STAGE(PG8_SA(0, 1), a2 + hsA, voffA);
            PG8_WAIT_V(8); PG8_WAIT_L(0); PG8_BAR; PG8_MMA(0, 0, At, B0); PG8_MMA(0, 1, At, B1); PG8_BAR; PG8_SCHED;
            PG8_LDA(At, 1, 1); PG8_STAGE(PG8_SB(1, 0), b3, voffB); PG8_STAGE(PG8_SB(1, 1), b3 + hsB, voffB); PG8_STAGE(PG8_SA(1, 0), a3, voffA);
            PG8_WAIT_V(8); PG8_WAIT_L(0); PG8_BAR; PG8_MMA(1, 0, At, B0); PG8_MMA(1, 1, At, B1); PG8_BAR; PG8_SCHED;
        }
        if (wr == 0) PG8_BAR;
        { int fr_ = fr, fq_ = fq; asm volatile("" : "+v"(fr_), "+v"(fq_)); E(acc, cur, wr, wc, fr_, fq_); }
        if (!has_next) break;
#pragma unroll
        for (int a = 0; a < 2; ++a)
#pragma unroll
            for (int b = 0; b < 2; ++b)
#pragma unroll
                for (int m = 0; m < 4; ++m)
#pragma unroll
                    for (int n = 0; n < 2; ++n) acc[a][b][m][n] = (f32x4){zf, zf, zf, zf};
        cur = nxt; cA = nA; cB = nB; ++ui;
        if (wr == 1) PG8_BAR;
    }
    PG8_WAIT_V(0);
    PG8_BAR;
#undef PG8_SA
#undef PG8_SB
#undef PG8_STAGE
#undef PG8_LDA
#undef PG8_LDB
#undef PG8_MMA
#undef PG8_WAIT_V
#undef PG8_WAIT_L
#undef PG8_BAR
#undef PG8_SCHED
#undef PG8_ABASE
#undef PG8_BBASE
}
}

enum EpiKind { EK_EVEN_IN = 0, EK_ODD_IN, EK_GATES, EK_RES, EK_SWIGLU };
template <int kind> struct Epi {
    int layer, sub; int gidx;
    const Params* p; int oz;
#define EWS(T, off) ((T*)(p->ws + ((size_t)(off) + (size_t)oz)))
#define EIN(i) (p->in[(i) + oz])
#define NORM_FIX_SETUP(NIDX, BOFF, NTOT) float rs_[2][4]; f32x4 bia_[2][2]; { const float* sq_ = EWS(const float, WS_SSQ) + (size_t)(NIDX) * M; \
        _Pragma("unroll") for (int ai = 0; ai < 2; ++ai) _Pragma("unroll") for (int m = 0; m < 4; ++m) rs_[ai][m] = frsq(sq_[row0 + ai * 128 + m * 16] * (1.0f / D) + EPS); \
        const float* bp_ = EWS(const float, WS_BIAS) + (BOFF) + (size_t)cond_of_row(u.pm * 256) * (NTOT) + u.pn * 256 + wc * 32 + 8 * fq; \
        _Pragma("unroll") for (int bj = 0; bj < 2; ++bj) _Pragma("unroll") for (int n = 0; n < 2; ++n) bia_[bj][n] = *(const f32x4*)(bp_ + bj * 128 + 4 * n); }
#define FIXV(ai, bj, m, n) (acc[ai][bj][m][n] * rs_[ai][m] + bia_[bj][n])
    __device__ __forceinline__ void operator()(const f32x4 (&acc)[2][2][4][2], const pg8::Unit& u, int wr, int wc, int fr, int fq) const {
        const int row0 = u.pm * 256 + wr * 64 + fr;
        float* const X = p->out + oz;
        if constexpr (kind == EK_RES) {
            const float* mod = EWS(const float, WS_MOD);
            const int ci = cond_of_row(u.pm * 256);
            const float* gate = mod + ((size_t)(layer * 5 + ci) * 6 + gidx) * 1024;
            const int col0 = u.pn * 256 + wc * 32 + 4 * fq;
            const int nn = (gidx == 2) ? 2 * layer + 1 : 2 * layer + 2;
            const bool fin = nn == 8;
            const float* nw = (gidx == 2) ? EIN(I_NFFN) + layer * 1024 : (fin ? EIN(I_NFIN) : EIN(I_NMIX) + (layer + 1) * 1024);
            const float* scv = mod + ((size_t)((gidx == 2 ? layer : (fin ? layer : layer + 1)) * 5 + ci) * 6 + (gidx == 2 ? 4 : 1)) * 1024;
            f32x4 gv[2][2], gp[2][2];
#pragma unroll
            for (int bj = 0; bj < 2; ++bj)
#pragma unroll
                for (int n = 0; n < 2; ++n) { gv[bj][n] = *(const f32x4*)(gate + col0 + bj * 128 + n * 16);
                    gp[bj][n] = *(const f32x4*)(nw + col0 + bj * 128 + n * 16); if (!fin) gp[bj][n] = gp[bj][n] * (1.0f + *(const f32x4*)(scv + col0 + bj * 128 + n * 16)); }
            bf16_t* XN = EWS(bf16_t, WS_XN); float* ssq = EWS(float, WS_SSQ) + (size_t)nn * M;
            const int lane_ = fq * 16 + fr;
#pragma unroll
            for (int ai = 0; ai < 2; ++ai)
#pragma unroll
                for (int m = 0; m < 4; ++m) { const int row = row0 + ai * 128 + m * 16; float* rowp = X + (size_t)row * D + col0; float sq = 0.f;
#pragma unroll
                    for (int bj = 0; bj < 2; ++bj)
#pragma unroll
                        for (int n = 0; n < 2; ++n) { f32x4* p = (f32x4*)(rowp + bj * 128 + n * 16); f32x4 x = *p; x += gv[bj][n] * acc[ai][bj][m][n]; *p = x;
                            sq += (x[0] * x[0] + x[1] * x[1]) + (x[2] * x[2] + x[3] * x[3]);
                            if (!fin) { const f32x4 y = x * gp[bj][n]; *(u32x2*)(XN + (size_t)row * D + col0 + bj * 128 + n * 16) = (u32x2){pk2(y[0], y[1]), pk2(y[2], y[3])}; } }
                    sq += shfl_x(sq, lane_, 16); sq += shfl_x(sq, lane_, 32);
                    if (fq == 0) atomicAdd(ssq + row, sq); }
        } else if constexpr (kind == EK_SWIGLU) {
            bf16_t* H = EWS(bf16_t, WS_H); const int col0 = u.pn * 128 + wc * 32 + 8 * fq;
            NORM_FIX_SETUP(2 * layer + 1, BIAS_F + (size_t)layer * 5 * 5632, 5632)
#pragma unroll
            for (int ai = 0; ai < 2; ++ai)
#pragma unroll
                for (int m = 0; m < 4; ++m) { const f32x4 g0 = FIXV(ai, 0, m, 0), g1 = FIXV(ai, 0, m, 1), u0 = FIXV(ai, 1, m, 0), u1 = FIXV(ai, 1, m, 1);
                    u32x4 w; w.x = pk2(siluf_(g0[0]) * u0[0], siluf_(g0[1]) * u0[1]); w.y = pk2(siluf_(g0[2]) * u0[2], siluf_(g0[3]) * u0[3]);
                    w.z = pk2(siluf_(g1[0]) * u1[0], siluf_(g1[1]) * u1[1]); w.w = pk2(siluf_(g1[2]) * u1[2], siluf_(g1[3]) * u1[3]);
                    *(u32x4*)(H + (size_t)(row0 + ai * 128 + m * 16) * DFF + col0) = w; }
        } else if constexpr (kind == EK_ODD_IN) {
            const bool isg = u.pn < 4; bf16_t* O = isg ? EWS(bf16_t, WS_G) : EWS(bf16_t, WS_U); const int colt = (isg ? u.pn : u.pn - 4) * 256 + wc * 32 + 8 * fq;
            NORM_FIX_SETUP(2 * layer, BIAS_O + (size_t)sub * 5 * 2048, 2048)
#pragma unroll
            for (int ai = 0; ai < 2; ++ai)
#pragma unroll
                for (int m = 0; m < 4; ++m) { bf16_t* rowp = O + (size_t)(row0 + ai * 128 + m * 16) * D + colt;
#pragma unroll
                    for (int bj = 0; bj < 2; ++bj) { f32x4 v0 = FIXV(ai, bj, m, 0), v1 = FIXV(ai, bj, m, 1);
                        if (isg) {
#pragma unroll
                            for (int j = 0; j < 4; ++j) { v0[j] = gelu_tanh(v0[j]); v1[j] = gelu_tanh(v1[j]); } }
                        u32x4 w; w.x = pk2(v0[0], v0[1]); w.y = pk2(v0[2], v0[3]); w.z = pk2(v1[0], v1[1]); w.w = pk2(v1[2], v1[3]);
                        *(u32x4*)(rowp + bj * 128) = w; } }
        } else if constexpr (kind == EK_GATES) {
            const int blk = u.pn >> 2, t = u.pn & 3, dir = t >> 1, half = t & 1;
            const int ch0 = blk * 256 + half * 128 + wc * 32 + 8 * fq;
            const size_t pofs = (size_t)(sub * 2 + dir) * 1024 + ch0;
            bf16_t* AC = dir ? EWS(bf16_t, WS_LAB) : EWS(bf16_t, WS_LAF); bf16_t* HL = dir ? EWS(bf16_t, WS_BB) : EWS(bf16_t, WS_U);
            const bf16_t* uc = EWS(const bf16_t, WS_UC); const float* ba = EIN(I_BGA); const float* bx = EIN(I_BGX); const float* lam = EIN(I_LAM); float* agg = EWS(float, WS_AGG);
            const int lane_ = fq * 16 + fr;
#define DPPF(old, x, ctrl) __builtin_bit_cast(float, __builtin_amdgcn_update_dpp(__builtin_bit_cast(int, (float)(old)), __builtin_bit_cast(int, (float)(x)), (ctrl), 0xf, 0xf, false))
#define SCAN_STEP(ctrl) { const float Ap = DPPF(1.0f, A[q], ctrl), Hp = DPPF(0.0f, H[q], ctrl); H[q] = A[q] * Hp + H[q]; A[q] *= Ap; }
#define GATE_GROUP(m, C1, C2, C4, C8, LASTLANE) { const size_t ro = (size_t)(row0 + ai * 128 + (m) * 16) * D + ch0 + 4 * n; \
                const u32x2 ucw = *(const u32x2*)(uc + ro); \
                const float ucv[4] = {bflo(ucw.x), bfhi(ucw.x), bflo(ucw.y), bfhi(ucw.y)}; \
                float A[4], H[4]; \
                _Pragma("unroll") for (int q = 0; q < 4; ++q) { const float r = sigmoidf_(acc[ai][0][m][n][q] + ba_[q]), ig = sigmoidf_(acc[ai][1][m][n][q] + bx_[q]); \
                    const float av = fexp2(c8_[q] * r); A[q] = av; H[q] = fsqrt(fmaxf(1.0f - av * av, 0.0f)) * ig * ucv[q]; } \
                _Pragma("unroll") for (int q = 0; q < 4; ++q) { SCAN_STEP(C1) SCAN_STEP(C2) SCAN_STEP(C4) SCAN_STEP(C8) } \
                _Pragma("unroll") for (int q = 0; q < 4; ++q) { H[q] = A[q] * Hc[q] + H[q]; A[q] *= Ac[q]; } \
                *(u32x2*)(AC + ro) = (u32x2){pk2(A[0], A[1]), pk2(A[2], A[3])}; \
                *(u32x2*)(HL + ro) = (u32x2){pk2(H[0], H[1]), pk2(H[2], H[3])}; \
                _Pragma("unroll") for (int q = 0; q < 4; ++q) { Ac[q] = shfl_idx(A[q], (LASTLANE)); Hc[q] = shfl_idx(H[q], (LASTLANE)); } }
#pragma unroll
            for (int n = 0; n < 2; ++n) {
                float ba_[4], bx_[4], c8_[4];
#pragma unroll
                for (int q = 0; q < 4; ++q) { ba_[q] = ba[pofs + 4 * n + q]; bx_[q] = bx[pofs + 4 * n + q]; c8_[q] = -8.0f * LOG2E * flog(1.0f + fexp(-lam[pofs + 4 * n + q])); }
#pragma unroll
                for (int ai = 0; ai < 2; ++ai) {
                    float Ac[4], Hc[4];
#pragma unroll
                    for (int q = 0; q < 4; ++q) { Ac[q] = 1.0f; Hc[q] = 0.0f; }
                    if (dir == 0) { GATE_GROUP(0, 0x111, 0x112, 0x114, 0x118, (lane_ & 48) | 15) GATE_GROUP(1, 0x111, 0x112, 0x114, 0x118, (lane_ & 48) | 15)
                                    GATE_GROUP(2, 0x111, 0x112, 0x114, 0x118, (lane_ & 48) | 15) GATE_GROUP(3, 0x111, 0x112, 0x114, 0x118, (lane_ & 48) | 15) }
                    else          { GATE_GROUP(3, 0x101, 0x102, 0x104, 0x108, lane_ & 48) GATE_GROUP(2, 0x101, 0x102, 0x104, 0x108, lane_ & 48)
                                    GATE_GROUP(1, 0x101, 0x102, 0x104, 0x108, lane_ & 48) GATE_GROUP(0, 0x101, 0x102, 0x104, 0x108, lane_ & 48) }
                    if (fr == 0) { float* ag = agg + ((size_t)((u.pm * 4 + ai * 2 + wr) * 2 + dir) * 1024 + ch0 + 4 * n) * 2;
                        *(f32x4*)ag = (f32x4){Ac[0], Hc[0], Ac[1], Hc[1]}; *(f32x4*)(ag + 4) = (f32x4){Ac[2], Hc[2], Ac[3], Hc[3]}; }
                }
            }
#undef GATE_GROUP
#undef SCAN_STEP
#undef DPPF
        } else {
            bf16_t* ZE = EWS(bf16_t, WS_ZE); const int pn = u.pn; const bool lat = u.pm >= 16; float* lr = EWS(float, WS_LR); const float* rope = EWS(const float, WS_ROPE);
            NORM_FIX_SETUP(2 * layer, BIAS_E + (size_t)sub * 5 * 2560, 2560)
            if (pn == 9) {
                if (wc == 0) {
#pragma unroll
                    for (int ai = 0; ai < 2; ++ai)
#pragma unroll
                        for (int m = 0; m < 4; ++m) { float* p = lr + (size_t)(row0 + ai * 128 + m * 16) * 32 + 8 * fq; *(f32x4*)p = FIXV(ai, 0, m, 0); *(f32x4*)(p + 4) = FIXV(ai, 0, m, 1); }
                }
            } else if (pn <= 2) {
                const int half = wc & 1;
#pragma unroll
                for (int ai = 0; ai < 2; ++ai)
#pragma unroll
                    for (int m = 0; m < 4; ++m) { const int row = row0 + ai * 128 + m * 16;
                        const int tpos = (row - MCTX) & 4095; const int pos = half ? (tpos & 63) : (tpos >> 6);
                        f32x4 cs[4];
                        if (lat) {
#pragma unroll
                            for (int q = 0; q < 4; ++q) cs[q] = *(const f32x4*)(rope + (size_t)(pos * 16 + 8 * (fq & 1)) * 2 + q * 4);
                        }
#pragma unroll
                        for (int bj = 0; bj < 2; ++bj) { f32x4 v0 = FIXV(ai, bj, m, 0), v1 = FIXV(ai, bj, m, 1);
                            const bool isv = (pn == 2 && bj == 1), isk = (pn == 2 && bj == 0);
                            if (pn == 2 && !lat) {
                                const int b = row >> 8, tt = row & 255; const int kc = wc * 32 + 8 * fq;
                                float* dst = X + (isv ? OUT_CV : OUT_CK) + ((size_t)(b * 2 + sub) * 256 + tt) * 128 + kc;
                                *(f32x4*)dst = v0; *(f32x4*)(dst + 4) = v1;
                            }
                            if (lat && !isv) {
                                float x[8] = {v0[0], v0[1], v0[2], v0[3], v1[0], v1[1], v1[2], v1[3]}; float o[8];
#pragma unroll
                                for (int q = 0; q < 8; ++q) { const float pr = shfl_x(x[q], fq * 16 + fr, 32); const float c = cs[q >> 1][(q & 1) * 2], s = cs[q >> 1][(q & 1) * 2 + 1];
                                    o[q] = x[q] * c + (fq < 2 ? -pr : pr) * s; }
                                v0 = (f32x4){o[0], o[1], o[2], o[3]}; v1 = (f32x4){o[4], o[5], o[6], o[7]};
                            }
                            if (!isk && !isv) { v0 *= QSCALE; v1 *= QSCALE; }
                            u32x4 w; w.x = pk2(v0[0], v0[1]); w.y = pk2(v0[2], v0[3]); w.z = pk2(v1[0], v1[1]); w.w = pk2(v1[2], v1[3]);
                            *(u32x4*)(ZE + (size_t)row * ZW + pn * 256 + bj * 128 + wc * 32 + 8 * fq) = w; } }
            } else {
                const float sc = (pn == 3) ? 0.125f : 1.0f; const bool act = pn >= 7;
#pragma unroll
                for (int ai = 0; ai < 2; ++ai)
#pragma unroll
                    for (int m = 0; m < 4; ++m) { bf16_t* rowp = ZE + (size_t)(row0 + ai * 128 + m * 16) * ZW + pn * 256 + wc * 32 + 8 * fq;
#pragma unroll
                        for (int bj = 0; bj < 2; ++bj) { f32x4 v0 = FIXV(ai, bj, m, 0) * sc, v1 = FIXV(ai, bj, m, 1) * sc;
                            if (act) {
#pragma unroll
                                for (int j = 0; j < 4; ++j) { v0[j] = siluf_(v0[j]); v1[j] = siluf_(v1[j]); } }
                            u32x4 w; w.x = pk2(v0[0], v0[1]); w.y = pk2(v0[2], v0[3]); w.z = pk2(v1[0], v1[1]); w.w = pk2(v1[2], v1[3]);
                            *(u32x4*)(rowp + bj * 128) = w; } }
            }
        }
    }
#undef EWS
#undef EIN
#undef NORM_FIX_SETUP
#undef FIXV
};

#define XB_TMO      128
#define XB_XCNT(j)  (256  + 64 * (j))
#define XB_XSUB(j)  (1280 + 64 * (j))
#define XB_XGEN(j)  (2304 + 64 * (j))
#define XB_TOP      3328
#define XB_TOPGEN   3392
#define XCD_BAR_WORDS 3456
#define XB_SPIN_CAP (1u << 18)
__device__ __forceinline__ unsigned xb_ld(unsigned* p)              { return __hip_atomic_load(p, __ATOMIC_RELAXED, __HIP_MEMORY_SCOPE_AGENT); }
__device__ __forceinline__ unsigned xb_add(unsigned* p, unsigned v) { return __hip_atomic_fetch_add(p, v, __ATOMIC_RELAXED, __HIP_MEMORY_SCOPE_AGENT); }
__device__ __forceinline__ unsigned xb_xcc_id() { return (unsigned)__builtin_amdgcn_s_getreg((3 << 11) | 20) & 0xFu; }
#define XB_SPIN(cond, bar) do { unsigned _sp = 0; while (cond) { __builtin_amdgcn_s_sleep(1); \
    if ((++_sp & 255u) == 0u) { if (xb_ld(&(bar)[XB_TMO])) break; if (_sp > XB_SPIN_CAP) { atomicAdd(&(bar)[XB_TMO], 1u); break; } } } } while (0)
struct XcdBarrier { unsigned* bar; unsigned x; volatile LAS unsigned* st; };
__device__ __forceinline__ XcdBarrier xcd_barrier_post(unsigned* bar, volatile LAS unsigned* st) {
    XcdBarrier b; b.bar = bar; b.x = xb_xcc_id(); b.st = st;
    if (threadIdx.x == 0) (void)xb_add(&bar[XB_XCNT(b.x)], 1u);
    return b;
}
__device__ __forceinline__ void xcd_barrier_complete(unsigned* bar, unsigned x, unsigned& nloc, unsigned& nx) {
    const unsigned G = gridDim.x * gridDim.y * gridDim.z;
    unsigned sum, cnt, mine, sp = 0u;
    for (;;) {
        sum = 0u; cnt = 0u; mine = 0u;
#pragma unroll
        for (unsigned j = 0; j < 16; ++j) { const unsigned c = xb_ld(&bar[XB_XCNT(j)]); sum += c; cnt += (c > 0u) ? 1u : 0u; mine = (j == x) ? c : mine; }
        if (sum == G) break;
        __builtin_amdgcn_s_sleep(1);
        if ((++sp & 255u) == 0u) { if (xb_ld(&bar[XB_TMO])) break; if (sp > XB_SPIN_CAP) { atomicAdd(&bar[XB_TMO], 1u); break; } }
    }
    nloc = mine > 0u ? mine : 1u; nx = cnt > 0u ? cnt : 1u;
}
__device__ __forceinline__ void xcd_barrier(const XcdBarrier& b, const int tid) {
    asm volatile("s_waitcnt vmcnt(0)" ::: "memory");
    __syncthreads();
    if (tid == 0) {
        unsigned* bar = b.bar;
        __builtin_amdgcn_s_waitcnt(0);
        unsigned nloc = b.st[0], nx = b.st[1];
        if (nloc == 0u) { xcd_barrier_complete(bar, b.x, nloc, nx); b.st[0] = nloc; b.st[1] = nx; }
        const unsigned old = xb_add(&bar[XB_XSUB(b.x)], 1u);
        const unsigned gen = old / nloc;
        if (old + 1u == (gen + 1u) * nloc) {
            __builtin_amdgcn_fence(__ATOMIC_RELEASE, "agent");
            asm volatile("s_waitcnt vmcnt(0)" ::: "memory");
            const unsigned og = xb_add(&bar[XB_TOP], 1u);
            const unsigned tg = og / nx;
            if (og + 1u == (tg + 1u) * nx) xb_add(&bar[XB_TOPGEN], 1u);
            else XB_SPIN(xb_ld(&bar[XB_TOPGEN]) == tg, bar);
            __builtin_amdgcn_fence(__ATOMIC_ACQUIRE, "agent");
            xb_add(&bar[XB_XGEN(b.x)], 1u);
            asm volatile("s_waitcnt vmcnt(0)" ::: "memory");
        } else {
            XB_SPIN(xb_ld(&bar[XB_XGEN(b.x)]) == gen, bar);
            __builtin_amdgcn_fence(__ATOMIC_ACQUIRE, "agent");
            asm volatile("s_waitcnt vmcnt(0)" ::: "memory");
        }
    }
    __syncthreads();
}

struct Frame {
    lptr lds; int tid, lane, wave, vcu, G;
    const Params* p; float* out; int oz, bid;
};
#define FIN(i) (F.p->in[(i) + F.oz])
#define WSP(T, off) ((T*)(F.p->ws + ((size_t)(off) + (size_t)F.oz)))

__device__ __forceinline__ void transpose_block(const float* src, int ldw, bf16_t* dst, int ldt, LAS float* scr, int lane) {
#pragma unroll 8
    for (int i = 0; i < 32; ++i) { const int kk = 2 * i + (lane >> 5); scr[kk * 33 + (lane & 31)] = src[(size_t)kk * ldw + (lane & 31)]; }
    LDS_WAIT(); asm volatile("" ::: "memory");
    const int c = lane & 7;
#pragma unroll
    for (int j = 0; j < 4; ++j) { const int n = (lane >> 3) + 8 * j; const LAS float* s = scr + (8 * c) * 33 + n;
        u32x4 o; o.x = pk2(s[0 * 33], s[1 * 33]); o.y = pk2(s[2 * 33], s[3 * 33]); o.z = pk2(s[4 * 33], s[5 * 33]); o.w = pk2(s[6 * 33], s[7 * 33]);
        *(u32x4*)(dst + (size_t)n * ldt + 8 * c) = o; }
    LDS_WAIT(); asm volatile("" ::: "memory");
}
constexpr int IT_WINE = 16 * 73, IT_SQ = 512, IT_WINO = 1024, IT_GATES = 512, IT_F1 = 16 * 176, IT_F2 = 44 * 32;
constexpr int IT_E = IT_WINE + IT_SQ, IT_O = IT_WINO + IT_GATES + IT_SQ, IT_L = IT_F1 + IT_F2;
constexpr int IT_TOTAL = 2 * IT_E + 2 * IT_O + 4 * IT_L;

__device__ __forceinline__ void convert_item(Frame& F, int it, LAS float* scr) {
    const int lane = F.lane;
    if (it < 2 * IT_E) {
        const int e = it / IT_E; int r = it % IT_E;
        if (r < IT_WINE) { const int kb = r / 73, nb = r % 73;
            transpose_block(FIN(I_WINE) + (size_t)e * D * PE + (size_t)(64 * kb) * PE + 32 * nb, PE, WSP(bf16_t, WS_WINE) + (size_t)e * PEP * D + (size_t)(32 * nb) * D + 64 * kb, D, scr, lane);
        } else { r -= IT_WINE; const int kb = r / 32, nb = r % 32;
            transpose_block(FIN(I_WOUTE) + (size_t)e * D * D + (size_t)(64 * kb) * D + 32 * nb, D, WSP(bf16_t, WS_WOUTE) + (size_t)e * D * D + (size_t)(32 * nb) * D + 64 * kb, D, scr, lane); }
        return;
    }
    it -= 2 * IT_E;
    if (it < 2 * IT_O) {
        const int o = it / IT_O; int r = it % IT_O;
        if (r < IT_WINO) { const int kb = r / 64, nb = r % 64;
            transpose_block(FIN(I_WINO) + (size_t)o * D * 2048 + (size_t)(64 * kb) * 2048 + 32 * nb, 2048, WSP(bf16_t, WS_WINO) + (size_t)o * 2048 * D + (size_t)(32 * nb) * D + 64 * kb, D, scr, lane);
        } else if (r < IT_WINO + IT_GATES) { r -= IT_WINO;
            const int mat = r >> 5, q = r & 31, kb = q >> 3, nb = q & 7; const int isx = mat >> 3, dir = (mat >> 2) & 1, blk = mat & 3;
            const float* src = FIN(isx ? I_WGX : I_WGA) + ((size_t)((o * 2 + dir) * 4 + blk)) * 65536 + (size_t)(64 * kb) * 256 + 32 * nb;
            const int d0 = 32 * nb, half = d0 >> 7; const int drow = blk * 1024 + (dir * 2 + half) * 256 + isx * 128 + (d0 & 127);
            transpose_block(src, 256, WSP(bf16_t, WS_WG) + (size_t)o * 4096 * 256 + (size_t)drow * 256 + 64 * kb, 256, scr, lane);
        } else { r -= IT_WINO + IT_GATES; const int kb = r / 32, nb = r % 32;
            transpose_block(FIN(I_WOUTO) + (size_t)o * D * D + (size_t)(64 * kb) * D + 32 * nb, D, WSP(bf16_t, WS_WOUTO) + (size_t)o * D * D + (size_t)(32 * nb) * D + 64 * kb, D, scr, lane); }
        return;
    }
    it -= 2 * IT_O;
    { const int l = it / IT_L; int r = it % IT_L;
        if (r < IT_F1) { const int kb = r / 176, nb = r % 176; const int n0 = 32 * nb; const int isu = n0 >= DFF; const int c = n0 - isu * DFF; const int drow = (c >> 7) * 256 + isu * 128 + (c & 127);
            transpose_block(FIN(I_WF1) + (size_t)l * D * 5632 + (size_t)(64 * kb) * 5632 + n0, 5632, WSP(bf16_t, WS_WF1) + (size_t)l * 5632 * D + (size_t)drow * D + 64 * kb, D, scr, lane);
        } else { r -= IT_F1; const int kb = r / 32, nb = r % 32;
            transpose_block(FIN(I_WF2) + (size_t)l * DFF * D + (size_t)(64 * kb) * D + 32 * nb, D, WSP(bf16_t, WS_WF2) + (size_t)l * D * DFF + (size_t)(32 * nb) * DFF + 64 * kb, DFF, scr, lane); }
    }
}

__device__ __forceinline__ void phase_prologue(Frame& F) {
    const int tid = F.tid, lane = F.lane, wave = F.wave;
    const int gt = F.vcu * NTHREADS + tid, NGT = F.G * NTHREADS;
    {
        LAS float* sil = (LAS float*)F.lds;
        LAS float* red = (LAS float*)(F.lds + 20480);
        for (int i = tid; i < 5 * 1024; i += NTHREADS) { const int ci = i >> 10, k = i & 1023; const float v = ci == 0 ? FIN(I_CCTX)[k] : FIN(I_C)[(ci - 1) * 1024 + k]; sil[i] = siluf_(v); }
        __syncthreads();
        for (int item = F.vcu; item < 4 * 48; item += F.G) {
            const int l = item / 48, n0 = (item % 48) * 128;
            const float* wp = FIN(I_WADA) + ((size_t)l * 1024 + wave * 128) * 6144 + n0 + 2 * lane;
            float a0[5] = {0.f, 0.f, 0.f, 0.f, 0.f}, a1[5] = {0.f, 0.f, 0.f, 0.f, 0.f};
#pragma unroll 8
            for (int kk = 0; kk < 128; ++kk) { const f32x2 w = *(const f32x2*)(wp + (size_t)kk * 6144);
#pragma unroll
                for (int ci = 0; ci < 5; ++ci) { const float s = sil[ci * 1024 + wave * 128 + kk]; a0[ci] += s * w.x; a1[ci] += s * w.y; } }
#pragma unroll
            for (int ci = 0; ci < 5; ++ci) { red[(wave * 5 + ci) * 128 + 2 * lane] = a0[ci]; red[(wave * 5 + ci) * 128 + 2 * lane + 1] = a1[ci]; }
            __syncthreads();
            for (int i = tid; i < 640; i += NTHREADS) { const int ci = i >> 7, n = i & 127; float s = FIN(I_BADA)[l * 6144 + n0 + n];
#pragma unroll
                for (int w = 0; w < 8; ++w) s += red[(w * 5 + ci) * 128 + n];
                WSP(float, WS_MOD)[(size_t)(l * 5 + ci) * 6144 + n0 + n] = s; }
            __syncthreads();
        }
    }
    for (int i = gt; i < 1024; i += NGT) { const int pos = i >> 4, fi = i & 15; const float inv = fexp2(-(float)fi * (13.287712379549449f / 16.0f)); const float a = (float)pos * inv;
        WSP(float, WS_ROPE)[2 * i] = __cosf(a); WSP(float, WS_ROPE)[2 * i + 1] = __sinf(a); }
    for (int i = gt; i < 4 * 2 * 256 * 128 / 4; i += NGT) { const f32x4 k = ((const f32x4*)FIN(I_CK))[i], v = ((const f32x4*)FIN(I_CV))[i];
        u32x2 a; a.x = pk2(k[0], k[1]); a.y = pk2(k[2], k[3]); ((u32x2*)WSP(bf16_t, WS_CK))[i] = a; a.x = pk2(v[0], v[1]); a.y = pk2(v[2], v[3]); ((u32x2*)WSP(bf16_t, WS_CV))[i] = a; }
    for (int i = gt; i < 2 * (PEP - PE) * D / 8; i += NGT) { const int e = i / ((PEP - PE) * D / 8), r = i % ((PEP - PE) * D / 8);
        ((u32x4*)(WSP(bf16_t, WS_WINE) + (size_t)e * PEP * D + (size_t)PE * D))[r] = (u32x4){0u, 0u, 0u, 0u}; }
    for (int i = gt; i < 8 * M / 4; i += NGT) ((f32x4*)(WSP(float, WS_SSQ) + M))[i] = (f32x4){0.f, 0.f, 0.f, 0.f};
    {
        LAS float* scr = (LAS float*)(F.lds + 40960 + wave * 8704);
        const int gw = F.vcu * NWAVES + wave, NGW = F.G * NWAVES;
        for (int it = gw; it < IT_TOTAL; it += NGW) convert_item(F, it, scr);
    }
}

__device__ __forceinline__ void phase_pre(Frame& F) {
    const int lane = F.lane; const int gw = F.vcu * NWAVES + F.wave, NGW = F.G * NWAVES;
    const float* mod = WSP(float, WS_MOD); float* bias = WSP(float, WS_BIAS);
    for (int mi = 0; mi < 8; ++mi) {
        const int l = mi < 2 ? 2 * mi : mi < 4 ? 2 * (mi - 2) + 1 : mi - 4; const int shj = mi < 4 ? 0 : 3;
        const int N = mi < 2 ? 2560 : mi < 4 ? 2048 : 5632;
        const bf16_t* W = mi < 2 ? WSP(bf16_t, WS_WINE) + (size_t)mi * PEP * D : mi < 4 ? WSP(bf16_t, WS_WINO) + (size_t)(mi - 2) * 2048 * D : WSP(bf16_t, WS_WF1) + (size_t)(mi - 4) * 5632 * D;
        float* bo = bias + (mi < 2 ? BIAS_E + (size_t)mi * 5 * 2560 : mi < 4 ? BIAS_O + (size_t)(mi - 2) * 5 * 2048 : BIAS_F + (size_t)(mi - 4) * 5 * 5632);
        f32x4 sh[5][4];
#pragma unroll
        for (int ci = 0; ci < 5; ++ci)
#pragma unroll
            for (int q = 0; q < 4; ++q) sh[ci][q] = *(const f32x4*)(mod + ((size_t)(l * 5 + ci) * 6 + shj) * 1024 + 16 * lane + 4 * q);
        for (int n = gw; n < N; n += NGW) {
            const u32x4 w0 = *(const u32x4*)(W + (size_t)n * D + 16 * lane), w1 = *(const u32x4*)(W + (size_t)n * D + 16 * lane + 8);
            const float wf[16] = {bflo(w0.x), bfhi(w0.x), bflo(w0.y), bfhi(w0.y), bflo(w0.z), bfhi(w0.z), bflo(w0.w), bfhi(w0.w), bflo(w1.x), bfhi(w1.x), bflo(w1.y), bfhi(w1.y), bflo(w1.z), bfhi(w1.z), bflo(w1.w), bfhi(w1.w)};
            float r[5];
#pragma unroll
            for (int ci = 0; ci < 5; ++ci) { float a = 0.f;
#pragma unroll
                for (int q = 0; q < 16; ++q) a += sh[ci][q >> 2][q & 3] * wf[q];
                r[ci] = wave_sum(a, lane); }
            if (lane < 5) bo[(size_t)lane * N + n] = lane == 0 ? r[0] : lane == 1 ? r[1] : lane == 2 ? r[2] : lane == 3 ? r[3] : r[4];
        }
    }
    {
        const float* gvec = FIN(I_NMIX); bf16_t* XN = WSP(bf16_t, WS_XN); float* ssq = WSP(float, WS_SSQ);
        f32x4 gg[4]; int cur_ci = -1;
        for (int r = 0; r < 10; ++r) {
            const int row = gw * 10 + r; const int ci = cond_of_row(row);
            if (ci != cur_ci) { cur_ci = ci;
#pragma unroll
                for (int j = 0; j < 4; ++j) { const int col = 4 * lane + 256 * j; gg[j] = *(const f32x4*)(gvec + col) * (1.0f + *(const f32x4*)(mod + ((size_t)ci * 6 + 1) * 1024 + col)); } }
            const float* xin = row < MCTX ? FIN(I_XP) + (size_t)row * D : FIN(I_XS) + (size_t)(row - MCTX) * D;
            float* xr = F.out + (size_t)row * D;
            f32x4 v[4]; float s = 0.f;
#pragma unroll
            for (int j = 0; j < 4; ++j) { v[j] = *(const f32x4*)(xin + 4 * lane + 256 * j); s += (v[j].x * v[j].x + v[j].y * v[j].y) + (v[j].z * v[j].z + v[j].w * v[j].w); }
            s = wave_sum(s, lane);
            if (lane == 0) ssq[row] = s;
#pragma unroll
            for (int j = 0; j < 4; ++j) { *(f32x4*)(xr + 4 * lane + 256 * j) = v[j]; const f32x4 y = v[j] * gg[j]; *(u32x2*)(XN + (size_t)row * D + 4 * lane + 256 * j) = (u32x2){pk2(y[0], y[1]), pk2(y[2], y[3])}; }
        }
    }
}
__device__ __forceinline__ void phase_final(Frame& F) {
    const int lane = F.lane; const int gw = F.vcu * NWAVES + F.wave;
    const float* gvec = FIN(I_NFIN); const float* ssq = WSP(float, WS_SSQ) + (size_t)8 * M;
    f32x4 gg[4];
#pragma unroll
    for (int j = 0; j < 4; ++j) gg[j] = *(const f32x4*)(gvec + 4 * lane + 256 * j);
    for (int r = 0; r < 10; ++r) { const int row = gw * 10 + r; float* xr = F.out + (size_t)row * D; const float rs = frsq(ssq[row] * (1.0f / D) + EPS);
#pragma unroll
        for (int j = 0; j < 4; ++j) { f32x4* p = (f32x4*)(xr + 4 * lane + 256 * j); *p = *p * rs * gg[j]; } }
}

__device__ __forceinline__ void attn_unit(Frame& F, int e, int kind, int b, int kvh, int qb, int hp) {
    const int lane = F.lane, w = F.wave, r32 = lane & 31, hh = lane >> 5;
    const bf16_t* ZE = WSP(bf16_t, WS_ZE);
    const int head = kvh * 4 + hp * 2 + (w >> 2);
    const int seqbase = kind == 0 ? MCTX + b * TLAT : b * TCTX;
    const int qloc = qb * 128 + (w & 3) * 32 + r32;
    const int iloc = (w & 3) * 32 + r32;
    bf16x8 qr[4];
#pragma unroll
    for (int d0 = 0; d0 < 4; ++d0) qr[d0] = *(const bf16x8*)(ZE + (size_t)(seqbase + qloc) * ZW + head * 64 + d0 * 16 + hh * 8);
    const int wt0 = (kind == 0 && qb == 0) ? 2 : 0, wt1 = (kind == 0) ? ((qb == 31) ? 4 : 6) : 0;
    const int NT = 4 + (wt1 - wt0);
    float m_run = FIN(I_SINK)[e * 8 + head] * LOG2E; float l_run = hh == 0 ? 1.0f : 0.0f;
    f32x16 o0 = {}, o1 = {};
    const int kkey = lane, kchunk = w;
    const int vkey = 16 * (w & 3) + (lane >> 2), vdh = w >> 2, vpiece = lane & 3;
    const unsigned kdst = (unsigned)(kchunk * 1024 + kkey * 16), vdst = (unsigned)(16384 + vdh * 4096 + (w & 3) * 1024 + lane * 16);
    u32x4 kreg, vreg; int mtype = 0, joff = 0;
    auto tile_ptrs = [&](int t, const bf16_t*& kp, const bf16_t*& vp, int& pitch, int& mt, int& jo) {
        if (kind == 0 && t < 4) { const size_t base = ((size_t)(b * 2 + e) * 256 + 64 * t) * 128 + kvh * 64; kp = WSP(bf16_t, WS_CK) + base; vp = WSP(bf16_t, WS_CV) + base; pitch = 128; mt = 0; jo = 0; }
        else if (kind == 0) { const int wt = t - 4 + wt0; const int blk = qb - 1 + (wt >> 1); const size_t row = (size_t)seqbase + blk * 128 + (wt & 1) * 64;
            kp = ZE + row * ZW + 512 + kvh * 64; vp = ZE + row * ZW + 640 + kvh * 64; pitch = ZW; mt = (blk < qb) ? 1 : (blk > qb) ? 2 : 0; jo = (wt & 1) * 64; }
        else { const size_t row = (size_t)seqbase + 64 * t; kp = ZE + row * ZW + 512 + kvh * 64; vp = ZE + row * ZW + 640 + kvh * 64; pitch = ZW; mt = 0; jo = 0; }
    };
    { const bf16_t *kp, *vp; int pitch, mt, jo; tile_ptrs(0, kp, vp, pitch, mt, jo);
        kreg = *(const u32x4*)(kp + (size_t)kkey * pitch + kchunk * 8); vreg = *(const u32x4*)(vp + (size_t)vkey * pitch + vdh * 32 + vpiece * 8);
        *(LAS u32x4*)(F.lds + kdst) = kreg; *(LAS u32x4*)(F.lds + vdst) = vreg; mtype = mt; joff = jo; }
    __syncthreads();
    for (int t = 0; t < NT; ++t) {
        const int buf = t & 1; int nmt = 0, njo = 0;
        if (t + 1 < NT) { const bf16_t *kp, *vp; int pitch; tile_ptrs(t + 1, kp, vp, pitch, nmt, njo);
            kreg = *(const u32x4*)(kp + (size_t)kkey * pitch + kchunk * 8); vreg = *(const u32x4*)(vp + (size_t)vkey * pitch + vdh * 32 + vpiece * 8); }
        const lptr kb = F.lds + buf * 8192 + hh * 1024 + r32 * 16;
        f32x16 p0 = {}, p1 = {};
#pragma unroll
        for (int d0 = 0; d0 < 4; ++d0) { const bf16x8 k0 = *(const LAS bf16x8*)(kb + d0 * 2048), k1 = *(const LAS bf16x8*)(kb + d0 * 2048 + 512);
            p0 = __builtin_amdgcn_mfma_f32_32x32x16_bf16(k0, qr[d0], p0, 0, 0, 0); p1 = __builtin_amdgcn_mfma_f32_32x32x16_bf16(k1, qr[d0], p1, 0, 0, 0); }
        if (mtype != 0) {
#pragma unroll
            for (int r = 0; r < 16; ++r) { const int j0 = joff + crow(r, hh), j1 = j0 + 32;
                const bool bad0 = (mtype == 1) ? (j0 < iloc) : (j0 > iloc), bad1 = (mtype == 1) ? (j1 < iloc) : (j1 > iloc);
                if (bad0) p0[r] = -1e30f; if (bad1) p1[r] = -1e30f; }
        }
        float mx = fmaxf(p0[0], p1[0]);
#pragma unroll
        for (int r = 1; r < 16; ++r) mx = fmaxf(mx, fmaxf(p0[r], p1[r]));
        mx = fmaxf(mx, shfl_x(mx, lane, 32));
        const float m_new = fmaxf(m_run, mx); const float alpha = fexp2(m_run - m_new); m_run = m_new;
        float ps = 0.f;
#pragma unroll
        for (int r = 0; r < 16; ++r) { p0[r] = fexp2(p0[r] - m_new); p1[r] = fexp2(p1[r] - m_new); ps += p0[r] + p1[r]; }
        l_run = l_run * alpha + ps;
#pragma unroll
        for (int r = 0; r < 16; ++r) { o0[r] *= alpha; o1[r] *= alpha; }
        u32x4 pw[4];
#pragma unroll
        for (int s = 0; s < 2; ++s) { pw[s] = (u32x4){pk2(p0[8 * s], p0[8 * s + 1]), pk2(p0[8 * s + 2], p0[8 * s + 3]), pk2(p0[8 * s + 4], p0[8 * s + 5]), pk2(p0[8 * s + 6], p0[8 * s + 7])};
            pw[2 + s] = (u32x4){pk2(p1[8 * s], p1[8 * s + 1]), pk2(p1[8 * s + 2], p1[8 * s + 3]), pk2(p1[8 * s + 4], p1[8 * s + 5]), pk2(p1[8 * s + 6], p1[8 * s + 7])}; }
        const lptr vb = F.lds + 16384 + buf * 8192 + ((lane >> 4) & 1) * 32 + (lane & 3) * 8 + (4 * hh + ((lane & 15) >> 2)) * 64;
#pragma unroll
        for (int s = 0; s < 4; ++s) { const bf16x8 v0 = tr_frag(vb + s * 1024), v1 = tr_frag(vb + 4096 + s * 1024);
            o0 = __builtin_amdgcn_mfma_f32_32x32x16_bf16(v0, __builtin_bit_cast(bf16x8, pw[s]), o0, 0, 0, 0);
            o1 = __builtin_amdgcn_mfma_f32_32x32x16_bf16(v1, __builtin_bit_cast(bf16x8, pw[s]), o1, 0, 0, 0); }
        if (t + 1 < NT) { *(LAS u32x4*)(F.lds + (buf ^ 1) * 8192 + kdst) = kreg; *(LAS u32x4*)(F.lds + (buf ^ 1) * 8192 + vdst) = vreg; }
        mtype = nmt; joff = njo;
        __syncthreads();
    }
    const float lt = l_run + shfl_x(l_run, lane, 32); const float inv = frcp(lt);
    bf16_t* orow = WSP(bf16_t, WS_MIX) + (size_t)(seqbase + qloc) * D + head * 64;
#pragma unroll
    for (int g = 0; g < 4; ++g) { u32x2 a; a.x = pk2(o0[4 * g] * inv, o0[4 * g + 1] * inv); a.y = pk2(o0[4 * g + 2] * inv, o0[4 * g + 3] * inv); *(u32x2*)(orow + 8 * g + 4 * hh) = a;
        a.x = pk2(o1[4 * g] * inv, o1[4 * g + 1] * inv); a.y = pk2(o1[4 * g + 2] * inv, o1[4 * g + 3] * inv); *(u32x2*)(orow + 32 + 8 * g + 4 * hh) = a; }
}

constexpr int GL_LA = 0;
constexpr int GL_LR = 32768;
constexpr int GL_WA = 40960;
constexpr int GL_BA = 49152;
constexpr int GL_BL = 49664;
constexpr int GL_A = 51200;
constexpr int GL_B = 67584;
constexpr int GL_C = 83968;
__device__ __forceinline__ int timg(int r, int c, int R) { return (c >> 5) * (R * 64) + (r >> 3) * 512 + (r & 7) * 64 + (c & 31) * 2; }

__device__ __forceinline__ void gla_bcum(Frame& F, int e, int gc, int hd) {
    const int tid = F.tid; const int R0 = gc * 64;
    LAS float* LA = (LAS float*)(F.lds + GL_LA); LAS float* LRs = (LAS float*)(F.lds + GL_LR); LAS float* WA = (LAS float*)(F.lds + GL_WA);
    LAS float* BA = (LAS float*)(F.lds + GL_BA); LAS float* BL = (LAS float*)(F.lds + GL_BL);
    { const int row = tid >> 3, c4 = tid & 7; *(LAS f32x4*)(LRs + row * 32 + 4 * c4) = *(const f32x4*)(WSP(float, WS_LR) + (size_t)(R0 + row) * 32 + 4 * c4);
      const int z = tid >> 8, r = (tid >> 4) & 15, k4 = tid & 15; *(LAS f32x4*)(WA + (z * 16 + r) * 64 + 4 * k4) = *(const f32x4*)(FIN(I_WALPHA) + ((size_t)(e * 2 + z) * 16 + r) * 256 + hd * 64 + 4 * k4);
      if (tid < 128) { const int zz = tid >> 6, k = tid & 63; BA[tid] = FIN(I_BALPHA)[(e * 2 + zz) * 256 + hd * 64 + k]; } }
    __syncthreads();
    { const int k = tid & 63, tg = tid >> 6;
#pragma unroll
      for (int z = 0; z < 2; ++z) { float wa[16];
#pragma unroll
        for (int r = 0; r < 16; ++r) wa[r] = WA[(z * 16 + r) * 64 + k];
        const float bz = BA[z * 64 + k];
#pragma unroll
        for (int tt = 0; tt < 8; ++tt) { const int t = tg * 8 + tt; float x = bz;
#pragma unroll
            for (int r = 0; r < 16; ++r) x += LRs[t * 32 + z * 16 + r] * wa[r];
            const float ls = fminf(x, 0.f) - flog(1.0f + fexp(-fabsf(x)));
            LA[(z * 64 + t) * 64 + k] = ls * (1.0f / 16.0f); } } }
    __syncthreads();
    LAS float* TOT = LRs;
    { const int z = tid >> 8, seg = (tid >> 6) & 3, k = tid & 63; float run = 0.f;
      if (z == 0) { for (int t = seg * 16; t < seg * 16 + 16; ++t) { run += LA[t * 64 + k]; LA[t * 64 + k] = run; } }
      else { for (int t = seg * 16 + 15; t >= seg * 16; --t) { run += LA[(64 + t) * 64 + k]; LA[(64 + t) * 64 + k] = run; } }
      TOT[(z * 4 + seg) * 64 + k] = run; }
    __syncthreads();
    { const int z = tid >> 8, seg = (tid >> 6) & 3, k = tid & 63; float add = 0.f;
      if (z == 0) { for (int s = 0; s < seg; ++s) add += TOT[s * 64 + k]; } else { for (int s = seg + 1; s < 4; ++s) add += TOT[(4 + s) * 64 + k]; }
      for (int t = seg * 16; t < seg * 16 + 16; ++t) LA[(z * 64 + t) * 64 + k] += add;
      if (z == 0 && seg == 3) BL[k] = LA[63 * 64 + k];
      if (z == 1 && seg == 0) BL[64 + k] = LA[64 * 64 + k]; }
    __syncthreads();
}
__device__ __forceinline__ void gla_stage_v(Frame& F, int R0, int hd, int off) {
    const bf16_t* ZE = WSP(bf16_t, WS_ZE);
#pragma unroll
    for (int i = 0; i < 2; ++i) { const int p = F.tid + 512 * i, t = p >> 4, v8 = (p & 15) * 8;
        *(LAS u32x4*)(F.lds + off + timg(t, v8, 64)) = *(const u32x4*)(ZE + (size_t)(R0 + t) * ZW + 1280 + hd * 128 + v8); }
}
__device__ __forceinline__ void gla_g1_item(Frame& F, int e, int gc, int hd) {
    const int tid = F.tid, lane = F.lane, w = F.wave; const int R0 = gc * 64;
    gla_bcum(F, e, gc, hd);
    LAS float* LA = (LAS float*)(F.lds + GL_LA); LAS float* BL = (LAS float*)(F.lds + GL_BL);
    const bf16_t* ZE = WSP(bf16_t, WS_ZE);
    { const int t = tid >> 3, k8 = (tid & 7) * 8; const u32x4 gk = *(const u32x4*)(ZE + (size_t)(R0 + t) * ZW + 1024 + hd * 64 + k8);
      const float kf[8] = {bflo(gk.x), bfhi(gk.x), bflo(gk.y), bfhi(gk.y), bflo(gk.z), bfhi(gk.z), bflo(gk.w), bfhi(gk.w)};
#pragma unroll
      for (int z = 0; z < 2; ++z) { float ks[8];
#pragma unroll
        for (int j = 0; j < 8; ++j) ks[j] = kf[j] * fexp(BL[z * 64 + k8 + j] - LA[(z * 64 + t) * 64 + k8 + j]);
        *(LAS u32x4*)(F.lds + GL_A + z * 8192 + timg(t, k8, 64)) = (u32x4){pk2(ks[0], ks[1]), pk2(ks[2], ks[3]), pk2(ks[4], ks[5]), pk2(ks[6], ks[7])}; } }
    gla_stage_v(F, R0, hd, GL_B);
    __syncthreads();
    { const int vb = w & 3, z = w >> 2; const int hh = lane >> 5, q = (lane & 15) >> 2;
      const int lofs = q * 64 + (((lane >> 4) & 1) * 16 + (lane & 3) * 4) * 2;
      f32x16 a0 = {}, a1 = {};
#pragma unroll
      for (int s = 0; s < 4; ++s) { const int rofs = (2 * s + hh) * 512;
        const lptr vp = F.lds + GL_B + vb * 4096 + rofs + lofs; const s16x4 va = tr_read(vp), vb2 = tr_read(vp + 256);
        const bf16x8 vf = (bf16x8){va[0], va[1], va[2], va[3], vb2[0], vb2[1], vb2[2], vb2[3]};
        const lptr kp = F.lds + GL_A + z * 8192 + rofs + lofs; const s16x4 ka = tr_read(kp), kb2 = tr_read(kp + 256), kc = tr_read(kp + 4096), kd = tr_read(kp + 4096 + 256);
        const bf16x8 kf0 = (bf16x8){ka[0], ka[1], ka[2], ka[3], kb2[0], kb2[1], kb2[2], kb2[3]}, kf1 = (bf16x8){kc[0], kc[1], kc[2], kc[3], kd[0], kd[1], kd[2], kd[3]};
        a0 = __builtin_amdgcn_mfma_f32_32x32x16_bf16(vf, kf0, a0, 0, 0, 0); a1 = __builtin_amdgcn_mfma_f32_32x32x16_bf16(vf, kf1, a1, 0, 0, 0); }
      float* kv = WSP(float, WS_KV) + ((size_t)(gc * 4 + hd) * 2 + z) * 8192;
#pragma unroll
      for (int r = 0; r < 16; ++r) { const int v = 32 * vb + crow(r, hh); kv[v * 64 + (lane & 31)] = a0[r]; kv[v * 64 + 32 + (lane & 31)] = a1[r]; } }
    if (tid < 128) WSP(float, WS_DL)[((size_t)(gc * 4 + hd) * 2 + (tid >> 6)) * 64 + (tid & 63)] = fexp(BL[tid]);
    __syncthreads();
}
__device__ __forceinline__ void phase_g2(Frame& F, int e) {
    const int tid = F.tid; float* KV = WSP(float, WS_KV); const float* DL = WSP(float, WS_DL);
    {
        const int v = F.vcu; const int chain = v >> 3, slice = v & 7; const int b = chain >> 3, hd = (chain >> 1) & 3, z = chain & 1;
        const int off = slice * 1024 + tid * 2, k = off & 63, vv = off >> 6;
        const float* s0 = FIN(I_SGLA) + ((size_t)((b * 2 + e) * 2 + z) * 4 + hd) * 8192;
        f32x2 S = (f32x2){s0[(size_t)k * 128 + vv], s0[(size_t)(k + 1) * 128 + vv]};
        for (int c8 = 0; c8 < 64; c8 += 8) {
            f32x2 kv[8], dl[8];
#pragma unroll
            for (int i = 0; i < 8; ++i) { const int c = z ? 63 - (c8 + i) : c8 + i; const size_t it = (size_t)((64 + b * 64 + c) * 4 + hd) * 2 + z;
                kv[i] = *(const f32x2*)(KV + it * 8192 + off); dl[i] = *(const f32x2*)(DL + it * 64 + k); }
#pragma unroll
            for (int i = 0; i < 8; ++i) { const int c = z ? 63 - (c8 + i) : c8 + i; const size_t it = (size_t)((64 + b * 64 + c) * 4 + hd) * 2 + z;
                *(f32x2*)(KV + it * 8192 + off) = S; S = dl[i] * S + kv[i]; }
        }
    }
    for (int item = F.vcu; item < 512; item += F.G) {
        const int chain = item >> 2, slice = item & 3; const int b = chain >> 3, hd = (chain >> 1) & 3, z = chain & 1;
        const int off = slice * 2048 + tid * 4, k = off & 63, vv = off >> 6;
        const float zf = (float)F.oz; f32x4 S = {zf, zf, zf, zf};
#pragma unroll
        for (int i = 0; i < 4; ++i) { const int c = z ? 3 - i : i; const size_t it = (size_t)((b * 4 + c) * 4 + hd) * 2 + z;
            const f32x4 kv = *(const f32x4*)(KV + it * 8192 + off), dl = *(const f32x4*)(DL + it * 64 + k);
            *(f32x4*)(KV + it * 8192 + off) = S; S = dl * S + kv; }
        float* dst = F.out + OUT_GLA + ((size_t)((b * 2 + e) * 2 + z) * 4 + hd) * 8192;
#pragma unroll
        for (int j = 0; j < 4; ++j) dst[(size_t)(k + j) * 128 + vv] = S[j];
    }
}
__device__ __forceinline__ void gla_g3_item(Frame& F, int e, int gc, int hd) {
    const int tid = F.tid, lane = F.lane, w = F.wave; const int R0 = gc * 64;
    gla_bcum(F, e, gc, hd);
    LAS float* LA = (LAS float*)(F.lds + GL_LA);
    const bf16_t* ZE = WSP(bf16_t, WS_ZE);
    { const int t = tid >> 3, c = tid & 7, k8 = c * 8;
      const u32x4 gq = *(const u32x4*)(ZE + (size_t)(R0 + t) * ZW + 768 + hd * 64 + k8), gk = *(const u32x4*)(ZE + (size_t)(R0 + t) * ZW + 1024 + hd * 64 + k8);
      const float qf[8] = {bflo(gq.x), bfhi(gq.x), bflo(gq.y), bfhi(gq.y), bflo(gq.z), bfhi(gq.z), bflo(gq.w), bfhi(gq.w)};
      const float kf[8] = {bflo(gk.x), bfhi(gk.x), bflo(gk.y), bfhi(gk.y), bflo(gk.z), bfhi(gk.z), bflo(gk.w), bfhi(gk.w)};
      const int so = t * 128 + ((c ^ (t & 7)) * 16);
#pragma unroll
      for (int z = 0; z < 2; ++z) { float qe[8], ke[8];
#pragma unroll
        for (int j = 0; j < 8; ++j) { const float bc = LA[(z * 64 + t) * 64 + k8 + j]; qe[j] = qf[j] * fexp(bc); ke[j] = kf[j] * fexp(-bc); }
        *(LAS u32x4*)(F.lds + GL_A + z * 8192 + so) = (u32x4){pk2(qe[0], qe[1]), pk2(qe[2], qe[3]), pk2(qe[4], qe[5]), pk2(qe[6], qe[7])};
        *(LAS u32x4*)(F.lds + GL_B + z * 8192 + so) = (u32x4){pk2(ke[0], ke[1]), pk2(ke[2], ke[3]), pk2(ke[4], ke[5]), pk2(ke[6], ke[7])}; } }
    gla_stage_v(F, R0, hd, GL_C);
    __syncthreads();
    { const float* KV = WSP(float, WS_KV) + (size_t)(gc * 4 + hd) * 2 * 8192;
#pragma unroll
      for (int i = 0; i < 8; ++i) { const int idx = tid + 512 * i, z = idx >> 11, rem = idx & 2047, v = rem >> 4, k4 = (rem & 15) * 4;
        const f32x4 s = *(const f32x4*)(KV + (size_t)z * 8192 + v * 64 + k4);
        *(LAS u32x2*)(F.lds + GL_LA + z * 16384 + v * 128 + (((k4 >> 3) ^ (v & 7)) * 16) + (k4 & 7) * 2) = (u32x2){pk2(s[0], s[1]), pk2(s[2], s[3])}; } }
    __syncthreads();
    const int vb = w >> 1, ib = w & 1, r32 = lane & 31, hh = lane >> 5;
    f32x16 o = {};
    bf16x8 qf[2][4];
    { const int i = 32 * ib + r32;
#pragma unroll
      for (int z = 0; z < 2; ++z)
#pragma unroll
        for (int s = 0; s < 4; ++s) qf[z][s] = *(const LAS bf16x8*)(F.lds + GL_A + z * 8192 + i * 128 + (((2 * s + hh) ^ (i & 7)) * 16)); }
    { const int v = 32 * vb + r32;
#pragma unroll
      for (int z = 0; z < 2; ++z)
#pragma unroll
        for (int s = 0; s < 4; ++s) { const bf16x8 sf = *(const LAS bf16x8*)(F.lds + GL_LA + z * 16384 + v * 128 + (((2 * s + hh) ^ (v & 7)) * 16));
            o = __builtin_amdgcn_mfma_f32_32x32x16_bf16(sf, qf[z][s], o, 0, 0, 0); } }
    const lptr vbase = F.lds + GL_C + vb * 4096 + ((lane >> 4) & 1) * 32 + (lane & 3) * 8 + (4 * hh + ((lane & 15) >> 2)) * 64;
#pragma unroll
    for (int jb = 0; jb < 2; ++jb) {
        const int j = 32 * jb + r32; f32x16 xf = {}, xb = {};
        const bool do_f = !(jb == 1 && ib == 0), do_b = !(jb == 0 && ib == 1);
#pragma unroll
        for (int s = 0; s < 4; ++s) { const int so = j * 128 + (((2 * s + hh) ^ (j & 7)) * 16);
            if (do_f) { const bf16x8 kf = *(const LAS bf16x8*)(F.lds + GL_B + so); xf = __builtin_amdgcn_mfma_f32_32x32x16_bf16(kf, qf[0][s], xf, 0, 0, 0); }
            if (do_b) { const bf16x8 kb = *(const LAS bf16x8*)(F.lds + GL_B + 8192 + so); xb = __builtin_amdgcn_mfma_f32_32x32x16_bf16(kb, qf[1][s], xb, 0, 0, 0); } }
        float x[16]; const int ii = 32 * ib + r32;
#pragma unroll
        for (int r = 0; r < 16; ++r) { const int jj = 32 * jb + crow(r, hh); x[r] = ((do_f && jj <= ii) ? xf[r] : 0.f) + ((do_b && jj >= ii) ? xb[r] : 0.f); }
#pragma unroll
        for (int s2 = 0; s2 < 2; ++s2) { const u32x4 pw = (u32x4){pk2(x[8 * s2], x[8 * s2 + 1]), pk2(x[8 * s2 + 2], x[8 * s2 + 3]), pk2(x[8 * s2 + 4], x[8 * s2 + 5]), pk2(x[8 * s2 + 6], x[8 * s2 + 7])};
            const bf16x8 vf = tr_frag(vbase + (4 * jb + 2 * s2) * 512);
            o = __builtin_amdgcn_mfma_f32_32x32x16_bf16(vf, __builtin_bit_cast(bf16x8, pw), o, 0, 0, 0); }
    }
    LAS float* SSQ = (LAS float*)(F.lds + GL_LR);
    { float s = 0.f;
#pragma unroll
      for (int r = 0; r < 16; ++r) s += o[r] * o[r];
      s += shfl_x(s, lane, 32);
      if (hh == 0) SSQ[vb * 64 + 32 * ib + r32] = s; }
    __syncthreads();
    { const int i = 32 * ib + r32; const float tot = SSQ[i] + SSQ[64 + i] + SSQ[128 + i] + SSQ[192 + i]; const float rs = frsq(tot * (1.0f / 128.0f) + EPS);
      const float* gain = FIN(I_GGAIN) + e * 512 + hd * 128; const size_t row = (size_t)(R0 + i);
#pragma unroll
      for (int g = 0; g < 4; ++g) { const int v0 = 32 * vb + 8 * g + 4 * hh; const f32x4 gn = *(const f32x4*)(gain + v0);
        const u32x2 gr = *(const u32x2*)(ZE + row * ZW + 1792 + hd * 128 + v0);
        const float r0 = o[4 * g] * rs * gn[0] * bflo(gr.x), r1 = o[4 * g + 1] * rs * gn[1] * bfhi(gr.x), r2 = o[4 * g + 2] * rs * gn[2] * bflo(gr.y), r3 = o[4 * g + 3] * rs * gn[3] * bfhi(gr.y);
        *(u32x2*)(WSP(bf16_t, WS_MIX) + row * D + 512 + hd * 128 + v0) = (u32x2){pk2(r0, r1), pk2(r2, r3)}; } }
    __syncthreads();
}

__device__ __forceinline__ void phase_attn_g1(Frame& F, int e) {
    const int v = F.vcu;
    for (int i = 0; i < 2; ++i) { const int uid = 2 * v + i; const int hp = uid & 1, qb = (uid >> 1) & 31, kvh = (uid >> 6) & 1, b = uid >> 7; attn_unit(F, e, 0, b, kvh, qb, hp); }
    if (v < 128) { const int hp = v & 1, qb = (v >> 1) & 1, kvh = (v >> 2) & 1, b = v >> 3; attn_unit(F, e, 1, b, kvh, qb, hp); }
    for (int it = v * 5; it < v * 5 + 5; ++it) gla_g1_item(F, e, it >> 2, it & 3);
}
__device__ __forceinline__ void phase_g3(Frame& F, int e) {
    const int v = F.vcu;
    for (int it = v * 5; it < v * 5 + 5; ++it) gla_g3_item(F, e, it >> 2, it & 3);
}

__device__ __forceinline__ void phase_conv(Frame& F, int o) {
    const bf16_t* U = WSP(bf16_t, WS_U); bf16_t* UC = WSP(bf16_t, WS_UC);
    const int gt = F.vcu * NTHREADS + F.tid, NGT = F.G * NTHREADS;
    for (int it = gt; it < 1280 * 128; it += NGT) {
        const int cg = it & 127, rg = it >> 7, c0 = cg * 8, r0 = rg * 16;
        const int seqlen = r0 < MCTX ? TCTX : TLAT; const int sb = r0 < MCTX ? (r0 & ~(TCTX - 1)) : MCTX + ((r0 - MCTX) & ~(TLAT - 1)); const int se = sb + seqlen;
        float w[4][8], bias[8];
#pragma unroll
        for (int i = 0; i < 4; ++i)
#pragma unroll
            for (int j = 0; j < 8; ++j) w[i][j] = FIN(I_CONVW)[(size_t)(o * 4 + i) * 1024 + c0 + j];
#pragma unroll
        for (int j = 0; j < 8; ++j) bias[j] = FIN(I_CONVB)[o * 1024 + c0 + j];
        float win[4][8];
        auto ld = [&](int row, float (&dst)[8]) { if (row >= sb && row < se) { const u32x4 x = *(const u32x4*)(U + (size_t)row * D + c0);
                dst[0] = bflo(x.x); dst[1] = bfhi(x.x); dst[2] = bflo(x.y); dst[3] = bfhi(x.y); dst[4] = bflo(x.z); dst[5] = bfhi(x.z); dst[6] = bflo(x.w); dst[7] = bfhi(x.w); }
            else {
#pragma unroll
                for (int j = 0; j < 8; ++j) dst[j] = 0.f; } };
        ld(r0 - 2, win[0]); ld(r0 - 1, win[1]); ld(r0, win[2]);
#pragma unroll 4
        for (int r = 0; r < 16; ++r) { ld(r0 + r + 1, win[3]); float y[8];
#pragma unroll
            for (int j = 0; j < 8; ++j) y[j] = bias[j] + w[0][j] * win[0][j] + w[1][j] * win[1][j] + w[2][j] * win[2][j] + w[3][j] * win[3][j];
            *(u32x4*)(UC + (size_t)(r0 + r) * D + c0) = (u32x4){pk2(y[0], y[1]), pk2(y[2], y[3]), pk2(y[4], y[5]), pk2(y[6], y[7])};
#pragma unroll
            for (int j = 0; j < 8; ++j) { win[0][j] = win[1][j]; win[1][j] = win[2][j]; win[2][j] = win[3][j]; } }
    }
}
__device__ __forceinline__ void phase_carry(Frame& F, int o) {
    const float* AGG = WSP(float, WS_AGG); float* CAR = WSP(float, WS_CARRY);
    const int gt = F.vcu * NTHREADS + F.tid, NGT = F.G * NTHREADS;
    for (int c = gt; c < 8192 + 32768; c += NGT) {
        if (c < 8192) { const int b = c >> 11, z = (c >> 10) & 1, ch = c & 1023; const int base = 64 + b * 64;
            float h = FIN(I_SLRU)[(size_t)((b * 2 + o) * 2 + z) * 1024 + ch];
            for (int i8 = 0; i8 < 64; i8 += 8) { f32x2 a[8];
#pragma unroll
                for (int i = 0; i < 8; ++i) { const int ck = base + (z ? 63 - (i8 + i) : i8 + i); a[i] = *(const f32x2*)(AGG + ((size_t)(ck * 2 + z) * 1024 + ch) * 2); }
#pragma unroll
                for (int i = 0; i < 8; ++i) { const int ck = base + (z ? 63 - (i8 + i) : i8 + i); CAR[(size_t)(ck * 2 + z) * 1024 + ch] = h; h = a[i].x * h + a[i].y; } }
        } else { const int cc = c - 8192; const int b = cc >> 11, z = (cc >> 10) & 1, ch = cc & 1023; const int base = b * 4; float h = 0.f;
#pragma unroll
            for (int i = 0; i < 4; ++i) { const int ck = base + (z ? 3 - i : i); const f32x2 a = *(const f32x2*)(AGG + ((size_t)(ck * 2 + z) * 1024 + ch) * 2); CAR[(size_t)(ck * 2 + z) * 1024 + ch] = h; h = a.x * h + a.y; }
            F.out[OUT_LRU + (size_t)((b * 2 + o) * 2 + z) * 1024 + ch] = h; }
    }
}
__device__ __forceinline__ void phase_lru_out(Frame& F) {
    const bf16_t* ACF = WSP(bf16_t, WS_LAF); const bf16_t* ACB = WSP(bf16_t, WS_LAB); const bf16_t* HLF = WSP(bf16_t, WS_U); const bf16_t* HLB = WSP(bf16_t, WS_BB);
    bf16_t* Gg = WSP(bf16_t, WS_G); const float* CAR = WSP(float, WS_CARRY);
    const int gt = F.vcu * NTHREADS + F.tid, NGT = F.G * NTHREADS;
    for (int it = gt; it < 1280 * 128; it += NGT) {
        const int cg = it & 127, rg = it >> 7, c0 = cg * 8, r0 = rg * 16, ck = r0 >> 6;
        float cf[8], cb[8];
        { const f32x4 a0 = *(const f32x4*)(CAR + (size_t)(ck * 2) * 1024 + c0), a1 = *(const f32x4*)(CAR + (size_t)(ck * 2) * 1024 + c0 + 4), b0 = *(const f32x4*)(CAR + (size_t)(ck * 2 + 1) * 1024 + c0), b1 = *(const f32x4*)(CAR + (size_t)(ck * 2 + 1) * 1024 + c0 + 4);
#pragma unroll
          for (int j = 0; j < 4; ++j) { cf[j] = a0[j]; cf[4 + j] = a1[j]; cb[j] = b0[j]; cb[4 + j] = b1[j]; } }
#pragma unroll 4
        for (int r = 0; r < 16; ++r) { const size_t ix = (size_t)(r0 + r) * D + c0;
            const u32x4 af = *(const u32x4*)(ACF + ix), ab = *(const u32x4*)(ACB + ix), hf = *(const u32x4*)(HLF + ix), hb = *(const u32x4*)(HLB + ix), gg = *(const u32x4*)(Gg + ix);
            float y[8];
#pragma unroll
            for (int w2 = 0; w2 < 4; ++w2) { y[2 * w2] = bflo(gg[w2]) * ((bflo(hf[w2]) + bflo(af[w2]) * cf[2 * w2]) + (bflo(hb[w2]) + bflo(ab[w2]) * cb[2 * w2]));
                y[2 * w2 + 1] = bfhi(gg[w2]) * ((bfhi(hf[w2]) + bfhi(af[w2]) * cf[2 * w2 + 1]) + (bfhi(hb[w2]) + bfhi(ab[w2]) * cb[2 * w2 + 1])); }
            *(u32x4*)(Gg + ix) = (u32x4){pk2(y[0], y[1]), pk2(y[2], y[3]), pk2(y[4], y[5]), pk2(y[6], y[7])}; }
    }
}

constexpr int NSTEPS = 42;
template <int KIND>
__device__ __forceinline__ void run_gemm(Frame& F, int l, int sub, int gidx, const bf16_t* A, int lda, int K, int a_grp, const bf16_t* Bt, int nN, bool perm) {
    pg8::Gemm g; g.A = A; g.Bt = Bt; g.lda = lda; g.K = K; g.nM = M / 256; g.nN = nN; g.a_grp = a_grp; g.perm = perm;
    Epi<KIND> E; E.layer = l; E.sub = sub; E.gidx = gidx; E.p = F.p; E.oz = F.oz;
    pg8::StaticOrder S; S.init(g.nM, g.nN, F.G, F.bid);
    pg8::gemm_phase<Epi<KIND>>(F.lds, F.tid, (float)F.oz, g, S, E);
}
__global__ void __launch_bounds__(NTHREADS, 2) mk_fwd(Params P) {
    extern __shared__ __attribute__((aligned(16))) unsigned char lds_raw[];
    const lptr lds0 = (lptr)lds_raw;
    volatile LAS unsigned* MISC = (volatile LAS unsigned*)(lds0 + MISC_OFF);
    static_assert((LDS_BYTES - LDSCTL_OFF) == 8 * NTHREADS * 4, "LDS control region");
#pragma unroll
    for (int u = 0; u < 8; ++u) ((LAS unsigned*)(lds0 + LDSCTL_OFF))[u * NTHREADS + threadIdx.x] = 0u;
    __syncthreads();
    unsigned* ctl = (unsigned*)(P.ws + WS_CTL);
    XcdBarrier bar; bar.bar = ctl + 1024; bar.x = 0; bar.st = nullptr;
    const int lo = P.step_lo, hi = P.step_hi;
    const bool multi = (hi - lo) > 1;
    if (multi) bar = xcd_barrier_post(ctl + 1024, MISC + 8);
#define STEP_BEGIN(s) if (lo <= (s) && (s) < hi) { Frame F; F.lds = lds0; F.p = &P; \
        { int tid = threadIdx.x; asm volatile("" : "+v"(tid)); F.tid = tid; F.lane = tid & 63; F.wave = __builtin_amdgcn_readfirstlane(tid >> 6); } \
        { int G = gridDim.x, bx = blockIdx.x, oz = 0; asm volatile("" : "+s"(G), "+s"(bx), "+s"(oz)); F.G = G; F.bid = bx; F.vcu = (G % 8 == 0) ? (bx % 8) * (G / 8) + bx / 8 : bx; F.oz = oz; F.out = P.out + oz; }
#define STEP_END(s) if (multi && (s) + 1 < hi) { XcdBarrier bb = bar; asm volatile("" : "+s"(bb.bar), "+s"(bb.x)); xcd_barrier(bb, F.tid); } else __syncthreads(); }

    STEP_BEGIN(0) phase_prologue(F); STEP_END(0)
    for (int l = 0; l < DEPTH; ++l) {
        const int s0 = 1 + 10 * l; const bool even = (l & 1) == 0; const int sub = l >> 1;
        if (l == 0) { STEP_BEGIN(1) phase_pre(F); STEP_END(1) }
        if (even) {
            STEP_BEGIN(s0 + 1) run_gemm<EK_EVEN_IN>(F, l, sub, 0, WSP(bf16_t, WS_XN), D, D, 0, WSP(bf16_t, WS_WINE) + (size_t)sub * PEP * D, 10, true); STEP_END(s0 + 1)
            STEP_BEGIN(s0 + 2) phase_attn_g1(F, sub); STEP_END(s0 + 2)
            STEP_BEGIN(s0 + 3) phase_g2(F, sub); STEP_END(s0 + 3)
            STEP_BEGIN(s0 + 4) phase_g3(F, sub); STEP_END(s0 + 4)
            STEP_BEGIN(s0 + 6) run_gemm<EK_RES>(F, l, sub, 2, WSP(bf16_t, WS_MIX), D, D, 0, WSP(bf16_t, WS_WOUTE) + (size_t)sub * D * D, 4, false); STEP_END(s0 + 6)
        } else {
            STEP_BEGIN(s0 + 1) run_gemm<EK_ODD_IN>(F, l, sub, 0, WSP(bf16_t, WS_XN), D, D, 0, WSP(bf16_t, WS_WINO) + (size_t)sub * 2048 * D, 8, true); STEP_END(s0 + 1)
            STEP_BEGIN(s0 + 2) phase_conv(F, sub); STEP_END(s0 + 2)
            STEP_BEGIN(s0 + 3) run_gemm<EK_GATES>(F, l, sub, 0, WSP(bf16_t, WS_UC), D, 256, 4, WSP(bf16_t, WS_WG) + (size_t)sub * 4096 * 256, 16, true); STEP_END(s0 + 3)
            STEP_BEGIN(s0 + 4) phase_carry(F, sub); STEP_END(s0 + 4)
            STEP_BEGIN(s0 + 5) phase_lru_out(F); STEP_END(s0 + 5)
            STEP_BEGIN(s0 + 6) run_gemm<EK_RES>(F, l, sub, 2, WSP(bf16_t, WS_G), D, D, 0, WSP(bf16_t, WS_WOUTO) + (size_t)sub * D * D, 4, false); STEP_END(s0 + 6)
        }
        STEP_BEGIN(s0 + 8) run_gemm<EK_SWIGLU>(F, l, sub, 0, WSP(bf16_t, WS_XN), D, D, 0, WSP(bf16_t, WS_WF1) + (size_t)l * 5632 * D, 22, true); STEP_END(s0 + 8)
        STEP_BEGIN(s0 + 9) run_gemm<EK_RES>(F, l, sub, 5, WSP(bf16_t, WS_H), DFF, DFF, 0, WSP(bf16_t, WS_WF2) + (size_t)l * D * DFF, 4, false); STEP_END(s0 + 9)
    }
    STEP_BEGIN(41) phase_final(F); STEP_END(41)
#undef STEP_BEGIN
#undef STEP_END
}

extern "C" void kernel_launch(void* const* d_in, const int* in_sizes, int n_in, void* d_out, int out_size, void* d_ws, size_t ws_size, hipStream_t stream) {
    static int grid = 0;
    if (grid == 0) {
        if (n_in != 30 || (size_t)out_size != OUT_END || ws_size < WS_END) { fprintf(stderr, "kernel_launch: unexpected shapes: n_in %d out %d ws %zu (need %zu)\n", n_in, out_size, ws_size, (size_t)WS_END); grid = -1; return; }
        int dev = 0, cus = 0;
        if (hipGetDevice(&dev) != hipSuccess || hipDeviceGetAttribute(&cus, hipDeviceAttributeMultiprocessorCount, dev) != hipSuccess) { grid = -1; return; }
        if (hipFuncSetAttribute((const void*)mk_fwd, hipFuncAttributeMaxDynamicSharedMemorySize, LDS_BYTES) != hipSuccess) { fprintf(stderr, "kernel_launch: hipFuncSetAttribute failed\n"); grid = -1; return; }
        (void)hipGetLastError();
        grid = cus;
        if (grid != 256) fprintf(stderr, "kernel_launch: %d CUs (built for 256)\n", grid);
    }
    if (grid < 0) return;
    (void)hipMemsetAsync((char*)d_ws + WS_CTL, 0, CTL_ZERO_BYTES, stream);
    Params p{};
    for (int i = 0; i < 30; ++i) p.in[i] = (const float*)d_in[i];
    p.out = (float*)d_out; p.ws = (unsigned char*)d_ws;
#if MK_MULTI
    for (int s = 0; s < NSTEPS; ++s) {
        if (s >= 1 && s <= 40) { const int l = (s - 1) / 10, j = (s - 1) % 10; if (((l & 1) == 0 && j == 5) || j == 7 || (j == 0 && l > 0)) continue; }
        p.step_lo = s; p.step_hi = s + 1;
        hipLaunchKernelGGL(mk_fwd, dim3(grid), dim3(NTHREADS), LDS_BYTES, stream, p);
    }
#else
    p.step_lo = 0; p.step_hi = NSTEPS;
    hipLaunchKernelGGL(mk_fwd, dim3(grid), dim3(NTHREADS), LDS_BYTES, stream, p);
#endif
}
```

```cpp
#include <hip/hip_runtime.h>
#include <cstdio>
#include <cstdint>

#ifndef MK_MULTI
#define MK_MULTI 0
#endif

#ifndef PROBE_K1
#define PROBE_K1 -1
#endif
#ifndef PROBE_K2
#define PROBE_K2 -1
#endif
#define LAS __attribute__((address_space(3)))
#define GAS __attribute__((address_space(1)))
typedef unsigned short bf16_t;
typedef short bf16x8 __attribute__((ext_vector_type(8)));
typedef short s16x4 __attribute__((ext_vector_type(4)));
typedef float f32x2 __attribute__((ext_vector_type(2)));
typedef float f32x4 __attribute__((ext_vector_type(4)));
typedef float f32x16 __attribute__((ext_vector_type(16)));
typedef unsigned u32x2 __attribute__((ext_vector_type(2)));
typedef unsigned u32x4 __attribute__((ext_vector_type(4)));
typedef LAS unsigned char* lptr;

constexpr int D = 1024, NCTX = 16, TCTX = 256, NLAT = 4, TLAT = 4096, DEPTH = 4;
constexpr int MCTX = NCTX * TCTX;
constexpr int M = MCTX + NLAT * TLAT;
constexpr int PE = 2336, PEP = 2560;
constexpr int ZW = 2304;
constexpr int DFF = 2816;
constexpr float EPS = 1e-6f;
constexpr float LOG2E = 1.4426950408889634f;
constexpr float QSCALE = 0.125f * LOG2E;
constexpr int NCHUNK = M / 64;

constexpr size_t OUT_CK = (size_t)M * D, OUT_CV = OUT_CK + 1048576, OUT_GLA = OUT_CV + 1048576, OUT_LRU = OUT_GLA + 2097152, OUT_END = OUT_LRU + 65536;

constexpr size_t MiB = 1u << 20;
constexpr size_t WS_CTL = 0, CTL_ZERO_BYTES = 128 * 1024;
constexpr int CW_Q = 12288;
constexpr int CW_CNT = 16384;
constexpr size_t WS_BIAS = 256 * 1024;
constexpr size_t BIAS_E = 0, BIAS_O = 2 * 5 * 2560, BIAS_F = BIAS_O + 2 * 5 * 2048, BIAS_TOTAL = BIAS_F + 4 * 5 * 5632;
constexpr size_t SSQP_OFF = 10485760;
constexpr size_t WS_SSQ_UNUSED = 3 * MiB;
constexpr size_t WS_MOD = 1 * MiB;
constexpr size_t WS_ROPE = WS_MOD + 512 * 1024;
constexpr size_t WS_CK = 2 * MiB, WS_CV = 2 * MiB + 512 * 1024;
constexpr size_t WS_WINE = 4 * MiB;
constexpr size_t WS_WOUTE = WS_WINE + 10 * MiB;
constexpr size_t WS_WINO = WS_WOUTE + 4 * MiB;
constexpr size_t WS_WG = WS_WINO + 8 * MiB;
constexpr size_t WS_WOUTO = WS_WG + 4 * MiB;
constexpr size_t WS_WF1 = WS_WOUTO + 4 * MiB;
constexpr size_t WS_WF2 = WS_WF1 + 44 * MiB;
constexpr size_t WS_XN = WS_WF2 + 22 * MiB;
static_assert(WS_XN == 100 * MiB, "ws map");
constexpr size_t WS_BIG = 140 * MiB;
constexpr size_t WS_ZE = 140 * MiB;
constexpr size_t WS_KV = 230 * MiB;
constexpr size_t WS_MIX = 340 * MiB;
constexpr size_t WS_LR = 380 * MiB;
constexpr size_t WS_DL = 383 * MiB;
constexpr size_t WS_G = 140 * MiB;
constexpr size_t WS_U = 180 * MiB;
constexpr size_t WS_UC = 220 * MiB;
constexpr size_t WS_LAF = 260 * MiB;
constexpr size_t WS_LAB = 300 * MiB;
constexpr size_t WS_BB = 340 * MiB;
constexpr size_t WS_AGG = WS_XN;
constexpr size_t WS_CARRY = WS_XN + 8 * MiB;
constexpr size_t WS_H = 230 * MiB;
constexpr size_t WS_SSQ8 = 220 * MiB;
constexpr size_t WS_XF = 140 * MiB;
constexpr size_t WS_END = 384 * MiB;

constexpr int RING_BYTES = 131072;
constexpr int LDSCTL_OFF = RING_BYTES, MISC_OFF = LDSCTL_OFF + 320;
constexpr int LDS_BYTES = 147456;
constexpr int NWAVES = 8, NTHREADS = 512;

__device__ __forceinline__ unsigned f2bf(float f) { unsigned u = __builtin_bit_cast(unsigned, f); return (u + 0x7fffu + ((u >> 16) & 1u)) >> 16; }
typedef __bf16 bf16x2_t __attribute__((ext_vector_type(2)));
__device__ __forceinline__ unsigned pk2(float lo, float hi) { const f32x2 v = {lo, hi}; return __builtin_bit_cast(unsigned, __builtin_convertvector(v, bf16x2_t)); }
__device__ __forceinline__ float bf2f(unsigned short b) { return __builtin_bit_cast(float, (unsigned)b << 16); }
__device__ __forceinline__ float bflo(unsigned w) { return __builtin_bit_cast(float, w << 16); }
__device__ __forceinline__ float bfhi(unsigned w) { return __builtin_bit_cast(float, w & 0xffff0000u); }
__device__ __forceinline__ float fexp2(float x) { return __builtin_amdgcn_exp2f(x); }
__device__ __forceinline__ float fexp(float x) { return __builtin_amdgcn_exp2f(x * LOG2E); }
__device__ __forceinline__ float frcp(float x) { return __builtin_amdgcn_rcpf(x); }
__device__ __forceinline__ float frsq(float x) { return __builtin_amdgcn_rsqf(x); }
__device__ __forceinline__ float fsqrt(float x) { return __builtin_amdgcn_sqrtf(x); }
__device__ __forceinline__ float flog(float x) { return __builtin_amdgcn_logf(x) * 0.6931471805599453f; }
__device__ __forceinline__ float sigmoidf_(float x) { return frcp(1.0f + fexp(-x)); }
__device__ __forceinline__ float siluf_(float x) { return x * frcp(1.0f + fexp(-x)); }
__device__ __forceinline__ float gelu_tanh(float x) { const float z = 0.7978845608028654f * (x + 0.044715f * x * x * x); const float t = 1.0f - 2.0f * frcp(fexp(2.0f * z) + 1.0f); return 0.5f * x * (1.0f + t); }
__device__ __forceinline__ int crow(int r, int hh) { return (r & 3) + 8 * (r >> 2) + 4 * hh; }
__device__ __forceinline__ int cond_of_row(int row) { return row < MCTX ? 0 : 1 + ((row - MCTX) >> 12); }
#define LDS_WAIT() asm volatile("s_waitcnt lgkmcnt(0)" ::: "memory")
#define VM_WAIT() asm volatile("s_waitcnt vmcnt(0)" ::: "memory")
__device__ __forceinline__ s16x4 tr_read(lptr p) { typedef short v4i16_t __attribute__((ext_vector_type(4))); return __builtin_bit_cast(s16x4, __builtin_amdgcn_ds_read_tr16_b64_v4i16((LAS v4i16_t*)p)); }
__device__ __forceinline__ bf16x8 tr_frag(lptr p) { const s16x4 a = tr_read(p), b = tr_read(p + 512); return (bf16x8){a[0], a[1], a[2], a[3], b[0], b[1], b[2], b[3]}; }
__device__ __forceinline__ float shfl_idx(float v, int src_lane) { return __builtin_bit_cast(float, __builtin_amdgcn_ds_bpermute(src_lane << 2, __builtin_bit_cast(int, v))); }
__device__ __forceinline__ float shfl_x(float v, int lane, int mask) { return shfl_idx(v, lane ^ mask); }
__device__ __forceinline__ float wave_sum(float v, int lane) {
#pragma unroll
    for (int o = 1; o < 64; o <<= 1) v += shfl_x(v, lane, o);
    return v;
}

struct Params {
    const float* in[30];
    float* out; unsigned char* ws;
    int step_lo, step_hi;
};
enum { I_XP = 0, I_XS, I_C, I_CK, I_CV, I_SGLA, I_SLRU, I_CCTX, I_WADA, I_BADA, I_NMIX, I_NFFN, I_WINE, I_SINK, I_WALPHA, I_BALPHA, I_GGAIN, I_WOUTE,
       I_WINO, I_CONVW, I_CONVB, I_WGA, I_BGA, I_WGX, I_BGX, I_LAM, I_WOUTO, I_WF1, I_WF2, I_NFIN };

namespace pg8 {
constexpr int BM = 256, BK = 64, HALF = 128, HTB = HALF * BK * 2, STAGE_BYTES = 8 * HTB, NXCD = 8, WGM = 8;
__device__ __forceinline__ int lds_byte(int r, int c) { const int st = (r >> 4) * 2 + (c >> 5), rr = r & 15, cc = c & 31, ob = rr * 64 + cc * 2; return st * 1024 + (ob ^ (((ob >> 9) & 1) << 5)); }
__device__ __forceinline__ void stage_rc(int b, int& R, int& C) { const int st = b / 1024, sb = b % 1024, swz = sb ^ (((sb >> 9) & 1) << 5); R = (st >> 1) * 16 + swz / 64; C = (st & 1) * 32 + (swz % 64) / 2; }
__device__ __forceinline__ int perm32(int rho) { const int n = rho >> 4, i = rho & 15; return 8 * (i >> 2) + 4 * n + (i & 3); }
struct Unit { int pm, pn; };
struct Gemm { const bf16_t* A; const bf16_t* Bt; int lda, K, nM, nN, a_grp; bool perm; };
struct StaticOrder {
    int nM, nN, nwg, G, c;
    unsigned* queue; LAS unsigned* word;
    int rot;
    unsigned* ready; unsigned need; unsigned* fin;
    __device__ void init(int nM_, int nN_, int G_, int c_) { nM = nM_; nN = nN_; nwg = nM * nN; G = G_; c = c_; rot = 0; ready = nullptr; need = 0; fin = nullptr; queue = nullptr; word = nullptr; }
    __device__ __forceinline__ void a_ready(const Unit& u, int tid) const {
        if (ready == nullptr) return;
        if (tid < 64) { unsigned* p = ready + 16 * u.pm; unsigned sp = 0;
            while ((unsigned)__builtin_amdgcn_readfirstlane(__hip_atomic_load(p, __ATOMIC_RELAXED, __HIP_MEMORY_SCOPE_AGENT)) < need) { __builtin_amdgcn_s_sleep(2); if (++sp > (1u << 22)) break; }
            __builtin_amdgcn_fence(__ATOMIC_ACQUIRE, "agent");
            asm volatile("s_waitcnt vmcnt(0)" ::: "memory"); }
        asm volatile("" ::: "memory"); __builtin_amdgcn_s_barrier(); asm volatile("" ::: "memory");
    }
    __device__ __forceinline__ void unit_of(int j, Unit& u) const { const int x = c & 7, g = j / (5 * nN), jj = j % (5 * nN); u.pn = jj / 5; u.pm = 10 * x + 5 * g + jj % 5; }
    __device__ __forceinline__ bool fetch(int i, Unit& u, int tid) const {
        if (queue == nullptr) { const bool h = next(i, u); if (h) a_ready(u, tid); return h; }
        if (tid < 64) { unsigned j = 0; if (tid == 0) j = __hip_atomic_fetch_add(queue + 16 * (c & 7), 1u, __ATOMIC_RELAXED, __HIP_MEMORY_SCOPE_AGENT);
            j = (unsigned)__builtin_amdgcn_readfirstlane((int)j);
            if (j < (unsigned)(10 * nN) && ready != nullptr) { Unit t; unit_of((int)j, t); unsigned* p = ready + 16 * t.pm; unsigned sp = 0;
                while ((unsigned)__builtin_amdgcn_readfirstlane(__hip_atomic_load(p, __ATOMIC_RELAXED, __HIP_MEMORY_SCOPE_AGENT)) < need) { __builtin_amdgcn_s_sleep(2); if (++sp > (1u << 22)) break; }
                __builtin_amdgcn_fence(__ATOMIC_ACQUIRE, "agent"); asm volatile("s_waitcnt vmcnt(0)" ::: "memory"); }
            if (tid == 0) *word = j;
            asm volatile("s_waitcnt lgkmcnt(0)" ::: "memory"); }
        asm volatile("" ::: "memory"); __builtin_amdgcn_s_barrier(); asm volatile("" ::: "memory");
        const unsigned j = *(volatile LAS unsigned*)word;
        if (j >= (unsigned)(10 * nN)) return false;
        unit_of((int)j, u); return true;
    }
    __device__ __forceinline__ void done(const Unit& u, int lane) const {
        if (fin == nullptr) return;
        asm volatile("s_waitcnt vmcnt(0)" ::: "memory");
        if (lane == 0) __hip_atomic_fetch_add(fin + 16 * u.pm, 1u, __ATOMIC_RELAXED, __HIP_MEMORY_SCOPE_AGENT);
    }
    __device__ bool next(int i, Unit& u) const {
        if (G == 256 && nM == 80) { const int x = c & 7, j = i * 32 + (((c >> 3) + rot) & 31); if (j >= 10 * nN) return false;
            const int g = j / (5 * nN), jj = j % (5 * nN); u.pn = jj / 5; u.pm = 10 * x + 5 * g + jj % 5; return true; }
        const long L = (long)i * G + c; if (L >= nwg) return false;
        int wgid = (int)L; { const int q = nwg / NXCD, r = nwg % NXCD, xcd = wgid % NXCD, off = wgid / NXCD; wgid = (xcd < r ? xcd * (q + 1) : r * (q + 1) + (xcd - r) * q) + off; }
        const int nig = WGM * nN, gid = wgid / nig, fm = gid * WGM, gsz = (nM - fm) < WGM ? (nM - fm) : WGM;
        u.pm = fm + ((wgid % nig) % gsz); u.pn = (wgid % nig) / gsz; return true;
    }
};

template <class Epi>
__device__ __forceinline__ void gemm_phase(lptr lds, const int tid, const float zf, const Gemm g, const StaticOrder& S, const Epi& E) {
    const int wid = __builtin_amdgcn_readfirstlane(tid >> 6), lane = tid & 63, wr = wid >> 2, wc = wid & 3, fr = lane & 15, fq = lane >> 4;
    const int K = g.K, nt = K / BK, lda = g.lda;
    unsigned voffA[2], voffB[2];
#pragma unroll
    for (int i = 0; i < 2; ++i) { int R, C; stage_rc(tid * 16 + i * 8192, R, C); const int Rb = g.perm ? ((R & ~31) + perm32(R & 31)) : R;
        voffA[i] = (unsigned)(R * lda + C) * 2u; voffB[i] = (unsigned)(Rb * K + C) * 2u; }
    const size_t kstep = (size_t)(BK * 2);
    const size_t hsA = (size_t)HALF * lda * 2, hsB = (size_t)HALF * K * 2;
    const unsigned ldsw = (unsigned)wid * 1024u;
    const int aoff = lds_byte(wr * 64 + fr, fq * 8), boff = lds_byte(wc * 32 + fr, fq * 8);
#define PG8_SA(b, h) (((b) * 2 + (h)) * HTB)
#define PG8_SB(b, h) ((4 + (b) * 2 + (h)) * HTB)
#define PG8_STAGE(bufoff, gbase, voff) do { _Pragma("unroll") for (int _i = 0; _i < 2; ++_i) \
        __builtin_amdgcn_global_load_lds((const unsigned*)((const char*)(gbase) + (voff)[_i]), (LAS unsigned*)(lds + (bufoff) + ldsw + _i * 8192), 16, 0, 0); } while (0)
#define PG8_LDA(dst, b, h) do { _Pragma("unroll") for (int m = 0; m < 4; ++m) _Pragma("unroll") for (int k = 0; k < 2; ++k) dst[m][k] = *(const LAS bf16x8*)(lds + PG8_SA(b, h) + aoff + m * 2048 + k * 1024); } while (0)
#define PG8_LDB(dst, b, h) do { _Pragma("unroll") for (int n = 0; n < 2; ++n) _Pragma("unroll") for (int k = 0; k < 2; ++k) dst[n][k] = *(const LAS bf16x8*)(lds + PG8_SB(b, h) + boff + n * 2048 + k * 1024); } while (0)
#define PG8_MMA(ai, bj, At, Bt) do { __builtin_amdgcn_s_setprio(1); _Pragma("unroll") for (int m = 0; m < 4; ++m) _Pragma("unroll") for (int n = 0; n < 2; ++n) _Pragma("unroll") for (int k = 0; k < 2; ++k) \
        acc[ai][bj][m][n] = __builtin_amdgcn_mfma_f32_16x16x32_bf16(Bt[n][k], At[m][k], acc[ai][bj][m][n], 0, 0, 0); __builtin_amdgcn_s_setprio(0); } while (0)
#define PG8_WAIT_V(n) asm volatile("s_waitcnt vmcnt(" #n ")" ::: "memory")
#define PG8_WAIT_L(n) asm volatile("s_waitcnt lgkmcnt(" #n ")" ::: "memory")
#define PG8_BAR __builtin_amdgcn_s_barrier()
#define PG8_SCHED __builtin_amdgcn_sched_barrier(0)
#define PG8_ABASE(u) ((const char*)g.A + ((size_t)(u).pm * BM * lda + (g.a_grp ? (size_t)((u).pn / g.a_grp) * K : 0)) * 2)
#define PG8_BBASE(u) ((const char*)g.Bt + (size_t)(u).pn * BM * K * 2)
    Unit cur, nxt; int ui = 0;
    if (!S.fetch(0, cur, tid)) return;
    f32x4 acc[2][2][4][2];
#pragma unroll
    for (int a = 0; a < 2; ++a)
#pragma unroll
        for (int b = 0; b < 2; ++b)
#pragma unroll
            for (int m = 0; m < 4; ++m)
#pragma unroll
                for (int n = 0; n < 2; ++n) acc[a][b][m][n] = (f32x4){zf, zf, zf, zf};
    bf16x8 At[4][2], B0[2][2], B1[2][2];
    const char* cA = PG8_ABASE(cur); const char* cB = PG8_BBASE(cur);
    PG8_STAGE(PG8_SB(0, 0), cB, voffB); PG8_STAGE(PG8_SB(0, 1), cB + hsB, voffB); PG8_STAGE(PG8_SA(0, 0), cA, voffA); PG8_STAGE(PG8_SA(0, 1), cA + hsA, voffA);
    if (wr == 1) PG8_BAR;
    PG8_WAIT_V(2); PG8_BAR;
    PG8_STAGE(PG8_SB(1, 0), cB + kstep, voffB); PG8_STAGE(PG8_SA(1, 0), cA + kstep, voffA); PG8_STAGE(PG8_SB(1, 1), cB + hsB + kstep, voffB);
    PG8_WAIT_V(6); PG8_BAR;
    for (;;) {
        bool has_next = false; const char* nA = cA; const char* nB = cB;
#pragma unroll 1
        for (int t = 0; t < nt; t += 2) {
            const bool last = (t == nt - 2);
            if (last) { has_next = S.fetch(ui + 1, nxt, tid); if (has_next) { nA = PG8_ABASE(nxt); nB = PG8_BBASE(nxt); } }
            const char* a1 = cA + (size_t)(t + 1) * kstep;
            const char* a2 = last ? nA : cA + (size_t)(t + 2) * kstep; const char* b2 = last ? nB : cB + (size_t)(t + 2) * kstep;
            const char* a3 = a2 + kstep; const char* b3 = b2 + kstep;
            PG8_LDB(B0, 0, 0); PG8_LDB(B1, 0, 1); PG8_SCHED; PG8_LDA(At, 0, 0); PG8_STAGE(PG8_SA(1, 1), a1 + hsA, voffA);
            PG8_WAIT_V(8); PG8_WAIT_L(0); PG8_BAR; PG8_MMA(0, 0, At, B0); PG8_MMA(0, 1, At, B1); PG8_BAR; PG8_SCHED;
            PG8_LDA(At, 0, 1); PG8_STAGE(PG8_SB(0, 0), b2, voffB); PG8_STAGE(PG8_SB(0, 1), b2 + hsB, voffB); PG8_STAGE(PG8_SA(0, 0), a2, voffA);
            PG8_WAIT_V(8); PG8_WAIT_L(0); PG8_BAR; PG8_MMA(1, 0, At, B0); PG8_MMA(1, 1, At, B1); PG8_BAR; PG8_SCHED;
            PG8_LDB(B0, 1, 0); PG8_LDB(B1, 1, 1); PG8_SCHED; PG8_LDA(At, 1, 0); PG8_STAGE(PG8_SA(0, 1), a2 + hsA, voffA);
            PG8_WAIT_V(8); PG8_WAIT_L(0); PG8_BAR; PG8_MMA(0, 0, At, B0); PG8_MMA(0, 1, At, B1); PG8_BAR; PG8_SCHED;
            PG8_LDA(At, 1, 1); PG8_STAGE(PG8_SB(1, 0), b3, voffB); PG8_STAGE(PG8_SB(1, 1), b3 + hsB, voffB); PG8_STAGE(PG8_SA(1, 0), a3, voffA);
            PG8_WAIT_V(8); PG8_WAIT_L(0); PG8_BAR; PG8_MMA(1, 0, At, B0); PG8_MMA(1, 1, At, B1); PG8_BAR; PG8_SCHED;
        }
        if (wr == 0) PG8_BAR;
        { int fr_ = fr, fq_ = fq; asm volatile("" : "+v"(fr_), "+v"(fq_)); E(acc, cur, wr, wc, fr_, fq_); S.done(cur, fq_ * 16 + fr_); }
        if (!has_next) break;
#pragma unroll
        for (int a = 0; a < 2; ++a)
#pragma unroll
            for (int b = 0; b < 2; ++b)
#pragma unroll
                for (int m = 0; m < 4; ++m)
#pragma unroll
                    for (int n = 0; n < 2; ++n) acc[a][b][m][n] = (f32x4){zf, zf, zf, zf};
        cur = nxt; cA = nA; cB = nB; ++ui;
        if (wr == 1) PG8_BAR;
    }
    PG8_WAIT_V(0);
    PG8_BAR;
#undef PG8_SA
#undef PG8_SB
#undef PG8_STAGE
#undef PG8_LDA
#undef PG8_LDB
#undef PG8_MMA
#undef PG8_WAIT_V
#undef PG8_WAIT_L
#undef PG8_BAR
#undef PG8_SCHED
#undef PG8_ABASE
#undef PG8_BBASE
}
}

enum EpiKind { EK_EVEN_IN = 0, EK_ODD_IN, EK_GATES, EK_RES, EK_SWIGLU };
template <int kind> struct Epi {
    int layer, sub; int gidx;
    const Params* p; int oz;
#define EWS(T, off) ((T*)(p->ws + ((size_t)(off) + (size_t)oz)))
#define EIN(i) (p->in[(i) + oz])
#define NORM_FIX_SETUP(NIDX, BOFF, NTOT) float rs_[2][4]; f32x4 bia_[2][2]; { const float* sq_ = p->out + oz + SSQP_OFF + (size_t)(NIDX) * M * 16; \
        _Pragma("unroll") for (int ai = 0; ai < 2; ++ai) _Pragma("unroll") for (int m = 0; m < 4; ++m) { const f32x4 a_ = *(const f32x4*)(sq_ + (size_t)(row0 + ai * 128 + m * 16) * 16 + 4 * fq); \
            float s_ = (a_[0] + a_[1]) + (a_[2] + a_[3]); s_ += shfl_x(s_, fq * 16 + fr, 16); s_ += shfl_x(s_, fq * 16 + fr, 32); rs_[ai][m] = frsq(s_ * (1.0f / D) + EPS); }     \
        const float* bp_ = EWS(const float, WS_BIAS) + (BOFF) + (size_t)cond_of_row(u.pm * 256) * (NTOT) + u.pn * 256 + wc * 32 + 8 * fq; \
        _Pragma("unroll") for (int bj = 0; bj < 2; ++bj) _Pragma("unroll") for (int n = 0; n < 2; ++n) bia_[bj][n] = *(const f32x4*)(bp_ + bj * 128 + 4 * n); }
#define FIXV(ai, bj, m, n) (acc[ai][bj][m][n] * rs_[ai][m] + bia_[bj][n])
    __device__ __forceinline__ void operator()(const f32x4 (&acc)[2][2][4][2], const pg8::Unit& u, int wr, int wc, int fr, int fq) const {
        const int row0 = u.pm * 256 + wr * 64 + fr;
        float* const X = p->out + oz;
        if constexpr (kind == EK_RES) {
            const float* mod = EWS(const float, WS_MOD);
            const int ci = cond_of_row(u.pm * 256);
            const float* gate = mod + ((size_t)(layer * 5 + ci) * 6 + gidx) * 1024;
            const int col0 = u.pn * 256 + wc * 32 + 8 * fq;
            const int nn = (gidx == 2) ? 2 * layer + 1 : 2 * layer + 2;
            const bool fin = nn == 8;
            const float* nw = (gidx == 2) ? EIN(I_NFFN) + layer * 1024 : (fin ? EIN(I_NFIN) : EIN(I_NMIX) + (layer + 1) * 1024);
            const float* scv = mod + ((size_t)((gidx == 2 ? layer : (fin ? layer : layer + 1)) * 5 + ci) * 6 + (gidx == 2 ? 4 : 1)) * 1024;
            f32x4 gv[2][2], gp[2][2];
#pragma unroll
            for (int bj = 0; bj < 2; ++bj)
#pragma unroll
                for (int n = 0; n < 2; ++n) { gv[bj][n] = *(const f32x4*)(gate + col0 + bj * 128 + n * 4);
                    gp[bj][n] = *(const f32x4*)(nw + col0 + bj * 128 + n * 4); if (!fin) gp[bj][n] = gp[bj][n] * (1.0f + *(const f32x4*)(scv + col0 + bj * 128 + n * 4)); }
            bf16_t* XN = EWS(bf16_t, WS_XN); float* ssq = (fin ? EWS(float, WS_SSQ8) : p->out + oz + SSQP_OFF + (size_t)nn * M * 16) + u.pn * 4 + wc;
            const int lane_ = fq * 16 + fr;
            bf16_t* Xb = (bf16_t*)X; const bool from_in = (layer == 0 && gidx == 2);
            const float* Xr = u.pm < 16 ? EIN(I_XP) : EIN(I_XS) - (size_t)MCTX * D;
#pragma unroll
            for (int h8 = 0; h8 < 4; ++h8) { const int ai = h8 >> 1, mb = (h8 & 1) * 2;
                f32x4 xo[2][2][2];
                if (from_in) {
#pragma unroll
                    for (int mm = 0; mm < 2; ++mm)
#pragma unroll
                        for (int bj = 0; bj < 2; ++bj)
#pragma unroll
                            for (int n = 0; n < 2; ++n) xo[mm][bj][n] = *(const f32x4*)(Xr + (size_t)(row0 + ai * 128 + (mb + mm) * 16) * D + col0 + bj * 128 + n * 4);
                } else { u32x4 xw[2][2];
#pragma unroll
                    for (int mm = 0; mm < 2; ++mm)
#pragma unroll
                        for (int bj = 0; bj < 2; ++bj) xw[mm][bj] = *(const u32x4*)(Xb + (size_t)(row0 + ai * 128 + (mb + mm) * 16) * D + col0 + bj * 128);
#pragma unroll
                    for (int mm = 0; mm < 2; ++mm)
#pragma unroll
                        for (int bj = 0; bj < 2; ++bj) { const u32x4 w = xw[mm][bj]; xo[mm][bj][0] = (f32x4){bflo(w.x), bfhi(w.x), bflo(w.y), bfhi(w.y)}; xo[mm][bj][1] = (f32x4){bflo(w.z), bfhi(w.z), bflo(w.w), bfhi(w.w)}; } }
#pragma unroll
                for (int mm = 0; mm < 2; ++mm) { const int m = mb + mm; const int row = row0 + ai * 128 + m * 16; float sq = 0.f;
#pragma unroll
                    for (int bj = 0; bj < 2; ++bj) { const f32x4 x0 = xo[mm][bj][0] + gv[bj][0] * acc[ai][bj][m][0], x1 = xo[mm][bj][1] + gv[bj][1] * acc[ai][bj][m][1];
                        if (fin) { float* xf = EWS(float, WS_XF) + (size_t)row * D + col0 + bj * 128; *(f32x4*)xf = x0; *(f32x4*)(xf + 4) = x1; }
                        else *(u32x4*)(Xb + (size_t)row * D + col0 + bj * 128) = (u32x4){pk2(x0[0], x0[1]), pk2(x0[2], x0[3]), pk2(x1[0], x1[1]), pk2(x1[2], x1[3])};
                        sq += ((x0[0] * x0[0] + x0[1] * x0[1]) + (x0[2] * x0[2] + x0[3] * x0[3])) + ((x1[0] * x1[0] + x1[1] * x1[1]) + (x1[2] * x1[2] + x1[3] * x1[3]));
                        if (!fin) { const f32x4 y0 = x0 * gp[bj][0], y1 = x1 * gp[bj][1]; const u32x4 w = (u32x4){pk2(y0[0], y0[1]), pk2(y0[2], y0[3]), pk2(y1[0], y1[1]), pk2(y1[2], y1[3])};
                            bf16_t* xp = XN + (size_t)row * D + col0 + bj * 128;
                            asm volatile("global_store_dwordx4 %0, %1, off sc1\n\ts_nop 1" :: "v"(xp), "v"(w) : "memory"); } }
                    sq += shfl_x(sq, lane_, 16); sq += shfl_x(sq, lane_, 32);
                    if (fq == 0) __hip_atomic_store(ssq + (size_t)row * 16, sq, __ATOMIC_RELAXED, __HIP_MEMORY_SCOPE_AGENT); }
            }
        } else if constexpr (kind == EK_SWIGLU) {
            bf16_t* H = EWS(bf16_t, WS_H); const int col0 = u.pn * 128 + wc * 32 + 8 * fq;
            NORM_FIX_SETUP(2 * layer + 1, BIAS_F + (size_t)layer * 5 * 5632, 5632)
#pragma unroll
            for (int ai = 0; ai < 2; ++ai)
#pragma unroll
                for (int m = 0; m < 4; ++m) { const f32x4 g0 = FIXV(ai, 0, m, 0), g1 = FIXV(ai, 0, m, 1), u0 = FIXV(ai, 1, m, 0), u1 = FIXV(ai, 1, m, 1);
                    u32x4 w; w.x = pk2(siluf_(g0[0]) * u0[0], siluf_(g0[1]) * u0[1]); w.y = pk2(siluf_(g0[2]) * u0[2], siluf_(g0[3]) * u0[3]);
                    w.z = pk2(siluf_(g1[0]) * u1[0], siluf_(g1[1]) * u1[1]); w.w = pk2(siluf_(g1[2]) * u1[2], siluf_(g1[3]) * u1[3]);
                    bf16_t* hp = H + (size_t)(row0 + ai * 128 + m * 16) * DFF + col0;
                    asm volatile("global_store_dwordx4 %0, %1, off sc1\n\ts_nop 1" :: "v"(hp), "v"(w) : "memory"); }
        } else if constexpr (kind == EK_ODD_IN) {
            const bool isg = u.pn < 4; bf16_t* O = isg ? EWS(bf16_t, WS_G) : EWS(bf16_t, WS_U); const int colt = (isg ? u.pn : u.pn - 4) * 256 + wc * 32 + 8 * fq;
            NORM_FIX_SETUP(2 * layer, BIAS_O + (size_t)sub * 5 * 2048, 2048)
#pragma unroll
            for (int ai = 0; ai < 2; ++ai)
#pragma unroll
                for (int m = 0; m < 4; ++m) { bf16_t* rowp = O + (size_t)(row0 + ai * 128 + m * 16) * D + colt;
#pragma unroll
                    for (int bj = 0; bj < 2; ++bj) { f32x4 v0 = FIXV(ai, bj, m, 0), v1 = FIXV(ai, bj, m, 1);
                        if (isg) {
#pragma unroll
                            for (int j = 0; j < 4; ++j) { v0[j] = gelu_tanh(v0[j]); v1[j] = gelu_tanh(v1[j]); } }
                        u32x4 w; w.x = pk2(v0[0], v0[1]); w.y = pk2(v0[2], v0[3]); w.z = pk2(v1[0], v1[1]); w.w = pk2(v1[2], v1[3]);
                        *(u32x4*)(rowp + bj * 128) = w; } }
        } else if constexpr (kind == EK_GATES) {
            const int blk = u.pn >> 2, t = u.pn & 3, dir = t >> 1, half = t & 1;
            const int ch0 = blk * 256 + half * 128 + wc * 32 + 8 * fq;
            const size_t pofs = (size_t)(sub * 2 + dir) * 1024 + ch0;
            bf16_t* AC = dir ? EWS(bf16_t, WS_LAB) : EWS(bf16_t, WS_LAF); bf16_t* HL = dir ? EWS(bf16_t, WS_BB) : EWS(bf16_t, WS_U);
            const bf16_t* uc = EWS(const bf16_t, WS_UC); const float* ba = EIN(I_BGA); const float* bx = EIN(I_BGX); const float* lam = EIN(I_LAM); float* agg = EWS(float, WS_AGG);
            const int lane_ = fq * 16 + fr;
#define DPPF(old, x, ctrl) __builtin_bit_cast(float, __builtin_amdgcn_update_dpp(__builtin_bit_cast(int, (float)(old)), __builtin_bit_cast(int, (float)(x)), (ctrl), 0xf, 0xf, false))
#define SCAN_STEP(ctrl) { const float Ap = DPPF(1.0f, A[q], ctrl), Hp = DPPF(0.0f, H[q], ctrl); H[q] = A[q] * Hp + H[q]; A[q] *= Ap; }
#define GATE_GROUP(m, C1, C2, C4, C8, LASTLANE) { const size_t ro = (size_t)(row0 + ai * 128 + (m) * 16) * D + ch0; \
                const u32x4 ucw = *(const u32x4*)(uc + ro); \
                const float ucv[8] = {bflo(ucw.x), bfhi(ucw.x), bflo(ucw.y), bfhi(ucw.y), bflo(ucw.z), bfhi(ucw.z), bflo(ucw.w), bfhi(ucw.w)}; \
                float A[8], H[8]; \
                _Pragma("unroll") for (int q = 0; q < 8; ++q) { const float r = sigmoidf_(acc[ai][0][m][q >> 2][q & 3] + ba_[q]), ig = sigmoidf_(acc[ai][1][m][q >> 2][q & 3] + bx_[q]); \
                    const float av = fexp2(c8_[q] * r); A[q] = av; H[q] = fsqrt(fmaxf(1.0f - av * av, 0.0f)) * ig * ucv[q]; } \
                _Pragma("unroll") for (int q = 0; q < 8; ++q) { SCAN_STEP(C1) SCAN_STEP(C2) SCAN_STEP(C4) SCAN_STEP(C8) } \
                _Pragma("unroll") for (int q = 0; q < 8; ++q) { H[q] = A[q] * Hc[q] + H[q]; A[q] *= Ac[q]; } \
                *(u32x4*)(AC + ro) = (u32x4){pk2(A[0], A[1]), pk2(A[2], A[3]), pk2(A[4], A[5]), pk2(A[6], A[7])}; \
                *(u32x4*)(HL + ro) = (u32x4){pk2(H[0], H[1]), pk2(H[2], H[3]), pk2(H[4], H[5]), pk2(H[6], H[7])}; \
                _Pragma("unroll") for (int q = 0; q < 8; ++q) { Ac[q] = shfl_idx(A[q], (LASTLANE)); Hc[q] = shfl_idx(H[q], (LASTLANE)); } }
            float ba_[8], bx_[8], c8_[8];
#pragma unroll
            for (int q = 0; q < 8; ++q) { ba_[q] = ba[pofs + q]; bx_[q] = bx[pofs + q]; c8_[q] = -8.0f * LOG2E * flog(1.0f + fexp(-lam[pofs + q])); }
#pragma unroll
            for (int ai = 0; ai < 2; ++ai) {
                float Ac[8], Hc[8];
#pragma unroll
                for (int q = 0; q < 8; ++q) { Ac[q] = 1.0f; Hc[q] = 0.0f; }
                if (dir == 0) { GATE_GROUP(0, 0x111, 0x112, 0x114, 0x118, (lane_ & 48) | 15) GATE_GROUP(1, 0x111, 0x112, 0x114, 0x118, (lane_ & 48) | 15)
                                GATE_GROUP(2, 0x111, 0x112, 0x114, 0x118, (lane_ & 48) | 15) GATE_GROUP(3, 0x111, 0x112, 0x114, 0x118, (lane_ & 48) | 15) }
                else          { GATE_GROUP(3, 0x101, 0x102, 0x104, 0x108, lane_ & 48) GATE_GROUP(2, 0x101, 0x102, 0x104, 0x108, lane_ & 48)
                                GATE_GROUP(1, 0x101, 0x102, 0x104, 0x108, lane_ & 48) GATE_GROUP(0, 0x101, 0x102, 0x104, 0x108, lane_ & 48) }
                if (fr == 0) { float* ag = agg + ((size_t)((u.pm * 4 + ai * 2 + wr) * 2 + dir) * 1024 + ch0) * 2;
#pragma unroll
                    for (int q = 0; q < 8; q += 2) *(f32x4*)(ag + 2 * q) = (f32x4){Ac[q], Hc[q], Ac[q + 1], Hc[q + 1]}; }
            }
#undef GATE_GROUP
#undef SCAN_STEP
#undef DPPF
        } else {
            bf16_t* ZE = EWS(bf16_t, WS_ZE); const int pn = u.pn; const bool lat = u.pm >= 16; float* lr = EWS(float, WS_LR); const float* rope = EWS(const float, WS_ROPE);
            NORM_FIX_SETUP(2 * layer, BIAS_E + (size_t)sub * 5 * 2560, 2560)
            if (pn == 9) {
                if (wc == 0) {
#pragma unroll
                    for (int ai = 0; ai < 2; ++ai)
#pragma unroll
                        for (int m = 0; m < 4; ++m) { float* p = lr + (size_t)(row0 + ai * 128 + m * 16) * 32 + 8 * fq; *(f32x4*)p = FIXV(ai, 0, m, 0); *(f32x4*)(p + 4) = FIXV(ai, 0, m, 1); }
                }
            } else if (pn <= 2) {
                const int half = wc & 1;
#pragma unroll
                for (int ai = 0; ai < 2; ++ai)
#pragma unroll
                    for (int m = 0; m < 4; ++m) { const int row = row0 + ai * 128 + m * 16;
                        const int tpos = (row - MCTX) & 4095; const int pos = half ? (tpos & 63) : (tpos >> 6);
                        f32x4 cs[4];
                        if (lat) {
#pragma unroll
                            for (int q = 0; q < 4; ++q) cs[q] = *(const f32x4*)(rope + (size_t)(pos * 16 + 8 * (fq & 1)) * 2 + q * 4);
                        }
#pragma unroll
                        for (int bj = 0; bj < 2; ++bj) { f32x4 v0 = FIXV(ai, bj, m, 0), v1 = FIXV(ai, bj, m, 1);
                            const bool isv = (pn == 2 && bj == 1), isk = (pn == 2 && bj == 0);
                            if (pn == 2 && !lat) {
                                const int b = row >> 8, tt = row & 255; const int kc = wc * 32 + 8 * fq;
                                float* dst = X + (isv ? OUT_CV : OUT_CK) + ((size_t)(b * 2 + sub) * 256 + tt) * 128 + kc;
                                *(f32x4*)dst = v0; *(f32x4*)(dst + 4) = v1;
                            }
                            if (lat && !isv) {
                                float x[8] = {v0[0], v0[1], v0[2], v0[3], v1[0], v1[1], v1[2], v1[3]}; float o[8];
#pragma unroll
                                for (int q = 0; q < 8; ++q) { const float pr = shfl_x(x[q], fq * 16 + fr, 32); const float c = cs[q >> 1][(q & 1) * 2], s = cs[q >> 1][(q & 1) * 2 + 1];
                                    o[q] = x[q] * c + (fq < 2 ? -pr : pr) * s; }
                                v0 = (f32x4){o[0], o[1], o[2], o[3]}; v1 = (f32x4){o[4], o[5], o[6], o[7]};
                            }
                            if (!isk && !isv) { v0 *= QSCALE; v1 *= QSCALE; }
                            u32x4 w; w.x = pk2(v0[0], v0[1]); w.y = pk2(v0[2], v0[3]); w.z = pk2(v1[0], v1[1]); w.w = pk2(v1[2], v1[3]);
                            *(u32x4*)(ZE + (size_t)row * ZW + pn * 256 + bj * 128 + wc * 32 + 8 * fq) = w; } }
            } else {
                const float sc = (pn == 3) ? 0.125f : 1.0f; const bool act = pn >= 7;
#pragma unroll
                for (int ai = 0; ai < 2; ++ai)
#pragma unroll
                    for (int m = 0; m < 4; ++m) { bf16_t* rowp = ZE + (size_t)(row0 + ai * 128 + m * 16) * ZW + pn * 256 + wc * 32 + 8 * fq;
#pragma unroll
                        for (int bj = 0; bj < 2; ++bj) { f32x4 v0 = FIXV(ai, bj, m, 0) * sc, v1 = FIXV(ai, bj, m, 1) * sc;
                            if (act) {
#pragma unroll
                                for (int j = 0; j < 4; ++j) { v0[j] = siluf_(v0[j]); v1[j] = siluf_(v1[j]); } }
                            u32x4 w; w.x = pk2(v0[0], v0[1]); w.y = pk2(v0[2], v0[3]); w.z = pk2(v1[0], v1[1]); w.w = pk2(v1[2], v1[3]);
                            *(u32x4*)(rowp + bj * 128) = w; } }
            }
        }
    }
#undef EWS
#undef EIN
#undef NORM_FIX_SETUP
#undef FIXV
};

#define XB_TMO      128
#define XB_XCNT(j)  (256  + 64 * (j))
#define XB_XSUB(j)  (1280 + 64 * (j))
#define XB_XGEN(j)  (2304 + 64 * (j))
#define XB_TOP      3328
#define XB_TOPGEN   3392
#define XCD_BAR_WORDS 3456
#define XB_SPIN_CAP (1u << 18)
__device__ __forceinline__ unsigned xb_ld(unsigned* p)              { return __hip_atomic_load(p, __ATOMIC_RELAXED, __HIP_MEMORY_SCOPE_AGENT); }
__device__ __forceinline__ unsigned xb_add(unsigned* p, unsigned v) { return __hip_atomic_fetch_add(p, v, __ATOMIC_RELAXED, __HIP_MEMORY_SCOPE_AGENT); }
__device__ __forceinline__ unsigned xb_xcc_id() { return (unsigned)__builtin_amdgcn_s_getreg((3 << 11) | 20) & 0xFu; }
#define XB_SPIN(cond, bar) do { unsigned _sp = 0; while (cond) { __builtin_amdgcn_s_sleep(1); \
    if ((++_sp & 255u) == 0u) { if (xb_ld(&(bar)[XB_TMO])) break; if (_sp > XB_SPIN_CAP) { atomicAdd(&(bar)[XB_TMO], 1u); break; } } } } while (0)
struct XcdBarrier { unsigned* bar; unsigned x; volatile LAS unsigned* st; };
__device__ __forceinline__ XcdBarrier xcd_barrier_post(unsigned* bar, volatile LAS unsigned* st) {
    XcdBarrier b; b.bar = bar; b.x = xb_xcc_id(); b.st = st;
    if (threadIdx.x == 0) (void)xb_add(&bar[XB_XCNT(b.x)], 1u);
    return b;
}
__device__ __forceinline__ void xcd_barrier_complete(unsigned* bar, unsigned x, unsigned& nloc, unsigned& nx) {
    const unsigned G = gridDim.x * gridDim.y * gridDim.z;
    unsigned sum, cnt, mine, sp = 0u;
    for (;;) {
        sum = 0u; cnt = 0u; mine = 0u;
#pragma unroll
        for (unsigned j = 0; j < 16; ++j) { const unsigned c = xb_ld(&bar[XB_XCNT(j)]); sum += c; cnt += (c > 0u) ? 1u : 0u; mine = (j == x) ? c : mine; }
        if (sum == G) break;
        __builtin_amdgcn_s_sleep(1);
        if ((++sp & 255u) == 0u) { if (xb_ld(&bar[XB_TMO])) break; if (sp > XB_SPIN_CAP) { atomicAdd(&bar[XB_TMO], 1u); break; } }
    }
    nloc = mine > 0u ? mine : 1u; nx = cnt > 0u ? cnt : 1u;
}
__device__ __forceinline__ void xcd_barrier(const XcdBarrier& b, const int tid) {
    asm volatile("s_waitcnt vmcnt(0)" ::: "memory");
    __syncthreads();
    if (tid == 0) {
        unsigned* bar = b.bar;
        __builtin_amdgcn_s_waitcnt(0);
        unsigned nloc = b.st[0], nx = b.st[1];
        if (nloc == 0u) { xcd_barrier_complete(bar, b.x, nloc, nx); b.st[0] = nloc; b.st[1] = nx; }
        const unsigned old = xb_add(&bar[XB_XSUB(b.x)], 1u);
        const unsigned gen = old / nloc;
        if (old + 1u == (gen + 1u) * nloc) {
            __builtin_amdgcn_fence(__ATOMIC_RELEASE, "agent");
            asm volatile("s_waitcnt vmcnt(0)" ::: "memory");
            const unsigned og = xb_add(&bar[XB_TOP], 1u);
            const unsigned tg = og / nx;
            if (og + 1u == (tg + 1u) * nx) xb_add(&bar[XB_TOPGEN], 1u);
            else XB_SPIN(xb_ld(&bar[XB_TOPGEN]) == tg, bar);
            __builtin_amdgcn_fence(__ATOMIC_ACQUIRE, "agent");
            xb_add(&bar[XB_XGEN(b.x)], 1u);
            asm volatile("s_waitcnt vmcnt(0)" ::: "memory");
        } else {
            XB_SPIN(xb_ld(&bar[XB_XGEN(b.x)]) == gen, bar);
            __builtin_amdgcn_fence(__ATOMIC_ACQUIRE, "agent");
            asm volatile("s_waitcnt vmcnt(0)" ::: "memory");
        }
    }
    __syncthreads();
}

struct Frame {
    lptr lds; int tid, lane, wave, vcu, G;
    const Params* p; float* out; int oz, bid;
};
#define FIN(i) (F.p->in[(i) + F.oz])
#define WSP(T, off) ((T*)(F.p->ws + ((size_t)(off) + (size_t)F.oz)))

__device__ __forceinline__ void transpose_block(const float* src, int ldw, bf16_t* dst, int ldt, LAS float* scr, int lane) {
#pragma unroll
    for (int hb = 0; hb < 2; ++hb) { float tv[16];
#pragma unroll
        for (int i = 0; i < 16; ++i) { const int kk = 2 * (16 * hb + i) + (lane >> 5); tv[i] = src[(size_t)kk * ldw + (lane & 31)]; }
#pragma unroll
        for (int i = 0; i < 16; ++i) { const int kk = 2 * (16 * hb + i) + (lane >> 5); scr[kk * 33 + (lane & 31)] = tv[i]; } }
    LDS_WAIT(); asm volatile("" ::: "memory");
    const int c = lane & 7;
#pragma unroll
    for (int j = 0; j < 4; ++j) { const int n = (lane >> 3) + 8 * j; const LAS float* s = scr + (8 * c) * 33 + n;
        u32x4 o; o.x = pk2(s[0 * 33], s[1 * 33]); o.y = pk2(s[2 * 33], s[3 * 33]); o.z = pk2(s[4 * 33], s[5 * 33]); o.w = pk2(s[6 * 33], s[7 * 33]);
        *(u32x4*)(dst + (size_t)n * ldt + 8 * c) = o; }
    LDS_WAIT(); asm volatile("" ::: "memory");
}
constexpr int IT_WINE = 16 * 73, IT_SQ = 512, IT_WINO = 1024, IT_GATES = 512, IT_F1 = 16 * 176, IT_F2 = 44 * 32;
constexpr int IT_E = IT_WINE + IT_SQ, IT_O = IT_WINO + IT_GATES + IT_SQ, IT_L = IT_F1 + IT_F2;
constexpr int IT_TOTAL = 2 * IT_E + 2 * IT_O + 4 * IT_L;

__device__ __forceinline__ void convert_item(Frame& F, int it, LAS float* scr) {
    const float* src; int ldw; bf16_t* dst; int ldt;
    if (it < 2 * IT_E) {
        const int e = it / IT_E; int r = it % IT_E;
        if (r < IT_WINE) { const int kb = r / 73, nb = r % 73;
            src = FIN(I_WINE) + (size_t)e * D * PE + (size_t)(64 * kb) * PE + 32 * nb; ldw = PE; dst = WSP(bf16_t, WS_WINE) + (size_t)e * PEP * D + (size_t)(32 * nb) * D + 64 * kb; ldt = D;
        } else { r -= IT_WINE; const int kb = r / 32, nb = r % 32;
            src = FIN(I_WOUTE) + (size_t)e * D * D + (size_t)(64 * kb) * D + 32 * nb; ldw = D; dst = WSP(bf16_t, WS_WOUTE) + (size_t)e * D * D + (size_t)(32 * nb) * D + 64 * kb; ldt = D; }
    } else if (it < 2 * IT_E + 2 * IT_O) {
        const int i2 = it - 2 * IT_E; const int o = i2 / IT_O; int r = i2 % IT_O;
        if (r < IT_WINO) { const int kb = r / 64, nb = r % 64;
            src = FIN(I_WINO) + (size_t)o * D * 2048 + (size_t)(64 * kb) * 2048 + 32 * nb; ldw = 2048; dst = WSP(bf16_t, WS_WINO) + (size_t)o * 2048 * D + (size_t)(32 * nb) * D + 64 * kb; ldt = D;
        } else if (r < IT_WINO + IT_GATES) { r -= IT_WINO;
            const int mat = r >> 5, q = r & 31, kb = q >> 3, nb = q & 7; const int isx = mat >> 3, dir = (mat >> 2) & 1, blk = mat & 3;
            src = FIN(isx ? I_WGX : I_WGA) + ((size_t)((o * 2 + dir) * 4 + blk)) * 65536 + (size_t)(64 * kb) * 256 + 32 * nb; ldw = 256;
            const int d0 = 32 * nb, half = d0 >> 7; const int drow = blk * 1024 + (dir * 2 + half) * 256 + isx * 128 + (d0 & 127);
            dst = WSP(bf16_t, WS_WG) + (size_t)o * 4096 * 256 + (size_t)drow * 256 + 64 * kb; ldt = 256;
        } else { r -= IT_WINO + IT_GATES; const int kb = r / 32, nb = r % 32;
            src = FIN(I_WOUTO) + (size_t)o * D * D + (size_t)(64 * kb) * D + 32 * nb; ldw = D; dst = WSP(bf16_t, WS_WOUTO) + (size_t)o * D * D + (size_t)(32 * nb) * D + 64 * kb; ldt = D; }
    } else {
        const int i3 = it - 2 * IT_E - 2 * IT_O; const int l = i3 / IT_L; int r = i3 % IT_L;
        if (r < IT_F1) { const int kb = r / 176, nb = r % 176; const int n0 = 32 * nb; const int isu = n0 >= DFF; const int c = n0 - isu * DFF; const int drow = (c >> 7) * 256 + isu * 128 + (c & 127);
            src = FIN(I_WF1) + (size_t)l * D * 5632 + (size_t)(64 * kb) * 5632 + n0; ldw = 5632; dst = WSP(bf16_t, WS_WF1) + (size_t)l * 5632 * D + (size_t)drow * D + 64 * kb; ldt = D;
        } else { r -= IT_F1; const int kb = r / 32, nb = r % 32;
            src = FIN(I_WF2) + (size_t)l * DFF * D + (size_t)(64 * kb) * D + 32 * nb; ldw = D; dst = WSP(bf16_t, WS_WF2) + (size_t)l * D * DFF + (size_t)(32 * nb) * DFF + 64 * kb; ldt = DFF; }
    }
    transpose_block(src, ldw, dst, ldt, scr, F.lane);
}

__device__ __forceinline__ void phase_prologue(Frame& F) {
    const int tid = F.tid, lane = F.lane, wave = F.wave;
    const int gt = F.vcu * NTHREADS + tid, NGT = F.G * NTHREADS;
    {
        LAS float* sil = (LAS float*)F.lds;
        LAS float* red = (LAS float*)(F.lds + 20480);
        for (int i = tid; i < 5 * 1024; i += NTHREADS) { const int ci = i >> 10, k = i & 1023; const float v = ci == 0 ? FIN(I_CCTX)[k] : FIN(I_C)[(ci - 1) * 1024 + k]; sil[i] = siluf_(v); }
        __syncthreads();
        for (int item = F.vcu; item < 4 * 48; item += F.G) {
            const int l = item / 48, n0 = (item % 48) * 128;
            const float* wp = FIN(I_WADA) + ((size_t)l * 1024 + wave * 128) * 6144 + n0 + 2 * lane;
            float a0[5] = {0.f, 0.f, 0.f, 0.f, 0.f}, a1[5] = {0.f, 0.f, 0.f, 0.f, 0.f};
#pragma unroll 8
            for (int kk = 0; kk < 128; ++kk) { const f32x2 w = *(const f32x2*)(wp + (size_t)kk * 6144);
#pragma unroll
                for (int ci = 0; ci < 5; ++ci) { const float s = sil[ci * 1024 + wave * 128 + kk]; a0[ci] += s * w.x; a1[ci] += s * w.y; } }
#pragma unroll
            for (int ci = 0; ci < 5; ++ci) { red[(wave * 5 + ci) * 128 + 2 * lane] = a0[ci]; red[(wave * 5 + ci) * 128 + 2 * lane + 1] = a1[ci]; }
            __syncthreads();
            for (int i = tid; i < 640; i += NTHREADS) { const int ci = i >> 7, n = i & 127; float s = FIN(I_BADA)[l * 6144 + n0 + n];
#pragma unroll
                for (int w = 0; w < 8; ++w) s += red[(w * 5 + ci) * 128 + n];
                WSP(float, WS_MOD)[(size_t)(l * 5 + ci) * 6144 + n0 + n] = s; }
            __syncthreads();
        }
    }
    for (int i = gt; i < 1024; i += NGT) { const int pos = i >> 4, fi = i & 15; const float inv = fexp2(-(float)fi * (13.287712379549449f / 16.0f)); const float a = (float)pos * inv;
        WSP(float, WS_ROPE)[2 * i] = __cosf(a); WSP(float, WS_ROPE)[2 * i + 1] = __sinf(a); }
    for (int i = gt; i < 4 * 2 * 256 * 128 / 4; i += NGT) { const f32x4 k = ((const f32x4*)FIN(I_CK))[i], v = ((const f32x4*)FIN(I_CV))[i];
        u32x2 a; a.x = pk2(k[0], k[1]); a.y = pk2(k[2], k[3]); ((u32x2*)WSP(bf16_t, WS_CK))[i] = a; a.x = pk2(v[0], v[1]); a.y = pk2(v[2], v[3]); ((u32x2*)WSP(bf16_t, WS_CV))[i] = a; }
    for (int i = gt; i < 2 * (PEP - PE) * D / 8; i += NGT) { const int e = i / ((PEP - PE) * D / 8), r = i % ((PEP - PE) * D / 8);
        ((u32x4*)(WSP(bf16_t, WS_WINE) + (size_t)e * PEP * D + (size_t)PE * D))[r] = (u32x4){0u, 0u, 0u, 0u}; }
    {
        LAS float* scr = (LAS float*)(F.lds + 40960 + wave * 8704);
        const int gw = F.vcu * NWAVES + wave, NGW = F.G * NWAVES;
        for (int it = gw; it < IT_TOTAL; it += NGW) convert_item(F, it, scr);
    }
}

__device__ __forceinline__ void phase_pre(Frame& F) {
    const int lane = F.lane; const int gw = F.vcu * NWAVES + F.wave, NGW = F.G * NWAVES;
    const float* mod = WSP(float, WS_MOD); float* bias = WSP(float, WS_BIAS);
    for (int mi = 0; mi < 8; ++mi) {
        const int l = mi < 2 ? 2 * mi : mi < 4 ? 2 * (mi - 2) + 1 : mi - 4; const int shj = mi < 4 ? 0 : 3;
        const int N = mi < 2 ? 2560 : mi < 4 ? 2048 : 5632;
        const bf16_t* W = mi < 2 ? WSP(bf16_t, WS_WINE) + (size_t)mi * PEP * D : mi < 4 ? WSP(bf16_t, WS_WINO) + (size_t)(mi - 2) * 2048 * D : WSP(bf16_t, WS_WF1) + (size_t)(mi - 4) * 5632 * D;
        float* bo = bias + (mi < 2 ? BIAS_E + (size_t)mi * 5 * 2560 : mi < 4 ? BIAS_O + (size_t)(mi - 2) * 5 * 2048 : BIAS_F + (size_t)(mi - 4) * 5 * 5632);
        f32x4 sh[5][4];
#pragma unroll
        for (int ci = 0; ci < 5; ++ci)
#pragma unroll
            for (int q = 0; q < 4; ++q) sh[ci][q] = *(const f32x4*)(mod + ((size_t)(l * 5 + ci) * 6 + shj) * 1024 + 16 * lane + 4 * q);
        for (int n = gw; n < N; n += NGW) {
            const u32x4 w0 = *(const u32x4*)(W + (size_t)n * D + 16 * lane), w1 = *(const u32x4*)(W + (size_t)n * D + 16 * lane + 8);
            const float wf[16] = {bflo(w0.x), bfhi(w0.x), bflo(w0.y), bfhi(w0.y), bflo(w0.z), bfhi(w0.z), bflo(w0.w), bfhi(w0.w), bflo(w1.x), bfhi(w1.x), bflo(w1.y), bfhi(w1.y), bflo(w1.z), bfhi(w1.z), bflo(w1.w), bfhi(w1.w)};
            float r[5];
#pragma unroll
            for (int ci = 0; ci < 5; ++ci) { float a = 0.f;
#pragma unroll
                for (int q = 0; q < 16; ++q) a += sh[ci][q >> 2][q & 3] * wf[q];
                r[ci] = wave_sum(a, lane); }
            if (lane < 5) bo[(size_t)lane * N + n] = lane == 0 ? r[0] : lane == 1 ? r[1] : lane == 2 ? r[2] : lane == 3 ? r[3] : r[4];
        }
    }
    {
        const float* gvec = FIN(I_NMIX); bf16_t* XN = WSP(bf16_t, WS_XN); float* ssq = F.out + SSQP_OFF;
        f32x4 gg[4]; int cur_ci = -1;
        for (int r = 0; r < 10; ++r) {
            const int row = gw * 10 + r; const int ci = cond_of_row(row);
            if (ci != cur_ci) { cur_ci = ci;
#pragma unroll
                for (int j = 0; j < 4; ++j) { const int col = 4 * lane + 256 * j; gg[j] = *(const f32x4*)(gvec + col) * (1.0f + *(const f32x4*)(mod + ((size_t)ci * 6 + 1) * 1024 + col)); } }
            const float* xin = row < MCTX ? FIN(I_XP) + (size_t)row * D : FIN(I_XS) + (size_t)(row - MCTX) * D;
            f32x4 v[4]; float s = 0.f;
#pragma unroll
            for (int j = 0; j < 4; ++j) { v[j] = *(const f32x4*)(xin + 4 * lane + 256 * j); s += (v[j].x * v[j].x + v[j].y * v[j].y) + (v[j].z * v[j].z + v[j].w * v[j].w); }
            s = wave_sum(s, lane);
            if (lane < 16) ssq[(size_t)row * 16 + lane] = lane == 0 ? s : 0.f;
#pragma unroll
            for (int j = 0; j < 4; ++j) { const f32x4 y = v[j] * gg[j]; *(u32x2*)(XN + (size_t)row * D + 4 * lane + 256 * j) = (u32x2){pk2(y[0], y[1]), pk2(y[2], y[3])}; }
        }
    }
}
__device__ __forceinline__ void phase_final(Frame& F) {
    const int lane = F.lane; const int gw = F.vcu * NWAVES + F.wave;
    const float* gvec = FIN(I_NFIN); const float* ssq = WSP(float, WS_SSQ8); const float* XF = WSP(float, WS_XF);
    f32x4 gg[4];
#pragma unroll
    for (int j = 0; j < 4; ++j) gg[j] = *(const f32x4*)(gvec + 4 * lane + 256 * j);
    float rs[10];
#pragma unroll
    for (int r = 0; r < 10; ++r) { const int row = gw * 10 + r; const f32x4* q_ = (const f32x4*)(ssq + (size_t)row * 16); const f32x4 a_ = q_[0], b_ = q_[1], c_ = q_[2], d_ = q_[3];
        rs[r] = frsq(((((a_[0] + a_[1]) + (a_[2] + a_[3])) + ((b_[0] + b_[1]) + (b_[2] + b_[3]))) + (((c_[0] + c_[1]) + (c_[2] + c_[3])) + ((d_[0] + d_[1]) + (d_[2] + d_[3])))) * (1.0f / D) + EPS); }
#pragma unroll
    for (int r = 0; r < 10; ++r) { const int row = gw * 10 + r; float* yr = F.out + (size_t)row * D; const float* xr = XF + (size_t)row * D;
#pragma unroll
        for (int j = 0; j < 4; ++j) *(f32x4*)(yr + 4 * lane + 256 * j) = *(const f32x4*)(xr + 4 * lane + 256 * j) * rs[r] * gg[j]; }
}

__device__ __forceinline__ void attn_unit(Frame& F, int e, int kind, int b, int kvh, int qb, int hp) {
    const int lane = F.lane, w = F.wave, r32 = lane & 31, hh = lane >> 5;
    const bf16_t* ZE = WSP(bf16_t, WS_ZE);
    const int head = kvh * 4 + hp * 2 + (w >> 2);
    const int seqbase = kind == 0 ? MCTX + b * TLAT : b * TCTX;
    const int qloc = qb * 128 + (w & 3) * 32 + r32;
    const int iloc = (w & 3) * 32 + r32;
    bf16x8 qr[4];
#pragma unroll
    for (int d0 = 0; d0 < 4; ++d0) qr[d0] = *(const bf16x8*)(ZE + (size_t)(seqbase + qloc) * ZW + head * 64 + d0 * 16 + hh * 8);
    const int wt0 = (kind == 0 && qb == 0) ? 2 : 0, wt1 = (kind == 0) ? ((qb == 31) ? 4 : 6) : 0;
    const int NT = 4 + (wt1 - wt0);
    float m_run = FIN(I_SINK)[e * 8 + head] * LOG2E; float l_run = hh == 0 ? 1.0f : 0.0f;
    f32x16 o0 = {}, o1 = {};
    const int kkey = lane, kchunk = w;
    const int vkey = 16 * (w & 3) + (lane >> 2), vdh = w >> 2, vpiece = lane & 3;
    const unsigned kdstw = (unsigned)(kchunk * 1024), vdstw = (unsigned)(24576 + vdh * 4096 + (w & 3) * 1024);
    int mtype = 0, joff = 0;
    auto tile_ptrs = [&](int t, const bf16_t*& kp, const bf16_t*& vp, int& pitch, int& mt, int& jo) {
        if (kind == 0 && t < 4) { const size_t base = ((size_t)(b * 2 + e) * 256 + 64 * t) * 128 + kvh * 64; kp = WSP(bf16_t, WS_CK) + base; vp = WSP(bf16_t, WS_CV) + base; pitch = 128; mt = 0; jo = 0; }
        else if (kind == 0) { const int wt = t - 4 + wt0; const int blk = qb - 1 + (wt >> 1); const size_t row = (size_t)seqbase + blk * 128 + (wt & 1) * 64;
            kp = ZE + row * ZW + 512 + kvh * 64; vp = ZE + row * ZW + 640 + kvh * 64; pitch = ZW; mt = (blk < qb) ? 1 : (blk > qb) ? 2 : 0; jo = (wt & 1) * 64; }
        else { const size_t row = (size_t)seqbase + 64 * t; kp = ZE + row * ZW + 512 + kvh * 64; vp = ZE + row * ZW + 640 + kvh * 64; pitch = ZW; mt = 0; jo = 0; }
    };
#define ATT_ISSUE(t, slot) do { const bf16_t *kp_, *vp_; int pitch_, mt_, jo_; tile_ptrs((t), kp_, vp_, pitch_, mt_, jo_); \
        __builtin_amdgcn_global_load_lds((const unsigned*)(kp_ + (size_t)kkey * pitch_ + kchunk * 8), (LAS unsigned*)(F.lds + (slot) * 8192 + kdstw), 16, 0, 0); \
        __builtin_amdgcn_global_load_lds((const unsigned*)(vp_ + (size_t)vkey * pitch_ + vdh * 32 + vpiece * 8), (LAS unsigned*)(F.lds + (slot) * 8192 + vdstw), 16, 0, 0); } while (0)
    ATT_ISSUE(0, 0); if (NT > 1) ATT_ISSUE(1, 1);
    int slot = 0;
    for (int t = 0; t < NT; ++t) {
        if (t + 1 < NT) asm volatile("s_waitcnt vmcnt(2)" ::: "memory"); else asm volatile("s_waitcnt vmcnt(0)" ::: "memory");
        asm volatile("s_waitcnt lgkmcnt(0)" ::: "memory"); __builtin_amdgcn_s_barrier(); asm volatile("" ::: "memory");
        if (t + 2 < NT) { const int s2 = slot >= 1 ? slot - 1 : 2; ATT_ISSUE(t + 2, s2); }
        { const bf16_t *kp_, *vp_; int pitch_; tile_ptrs(t, kp_, vp_, pitch_, mtype, joff); }
        const int buf = slot;
        const lptr kb = F.lds + buf * 8192 + hh * 1024 + r32 * 16;
        f32x16 p0 = {}, p1 = {};
#pragma unroll
        for (int d0 = 0; d0 < 4; ++d0) { const bf16x8 k0 = *(const LAS bf16x8*)(kb + d0 * 2048), k1 = *(const LAS bf16x8*)(kb + d0 * 2048 + 512);
            p0 = __builtin_amdgcn_mfma_f32_32x32x16_bf16(k0, qr[d0], p0, 0, 0, 0); p1 = __builtin_amdgcn_mfma_f32_32x32x16_bf16(k1, qr[d0], p1, 0, 0, 0); }
        if (mtype != 0) {
#pragma unroll
            for (int r = 0; r < 16; ++r) { const int j0 = joff + crow(r, hh), j1 = j0 + 32;
                const bool bad0 = (mtype == 1) ? (j0 < iloc) : (j0 > iloc), bad1 = (mtype == 1) ? (j1 < iloc) : (j1 > iloc);
                if (bad0) p0[r] = -1e30f; if (bad1) p1[r] = -1e30f; }
        }
        float mx = fmaxf(p0[0], p1[0]);
#pragma unroll
        for (int r = 1; r < 16; ++r) mx = fmaxf(mx, fmaxf(p0[r], p1[r]));
        mx = fmaxf(mx, shfl_x(mx, lane, 32));
        const float m_new = fmaxf(m_run, mx); const float alpha = fexp2(m_run - m_new); m_run = m_new;
        float ps = 0.f;
#pragma unroll
        for (int r = 0; r < 16; ++r) { p0[r] = fexp2(p0[r] - m_new); p1[r] = fexp2(p1[r] - m_new); ps += p0[r] + p1[r]; }
        l_run = l_run * alpha + ps;
#pragma unroll
        for (int r = 0; r < 16; ++r) { o0[r] *= alpha; o1[r] *= alpha; }
        u32x4 pw[4];
#pragma unroll
        for (int s = 0; s < 2; ++s) { pw[s] = (u32x4){pk2(p0[8 * s], p0[8 * s + 1]), pk2(p0[8 * s + 2], p0[8 * s + 3]), pk2(p0[8 * s + 4], p0[8 * s + 5]), pk2(p0[8 * s + 6], p0[8 * s + 7])};
            pw[2 + s] = (u32x4){pk2(p1[8 * s], p1[8 * s + 1]), pk2(p1[8 * s + 2], p1[8 * s + 3]), pk2(p1[8 * s + 4], p1[8 * s + 5]), pk2(p1[8 * s + 6], p1[8 * s + 7])}; }
        const lptr vb = F.lds + 24576 + buf * 8192 + ((lane >> 4) & 1) * 32 + (lane & 3) * 8 + (4 * hh + ((lane & 15) >> 2)) * 64;
#pragma unroll
        for (int s = 0; s < 4; ++s) { const bf16x8 v0 = tr_frag(vb + s * 1024), v1 = tr_frag(vb + 4096 + s * 1024);
            o0 = __builtin_amdgcn_mfma_f32_32x32x16_bf16(v0, __builtin_bit_cast(bf16x8, pw[s]), o0, 0, 0, 0);
            o1 = __builtin_amdgcn_mfma_f32_32x32x16_bf16(v1, __builtin_bit_cast(bf16x8, pw[s]), o1, 0, 0, 0); }
        slot = slot == 2 ? 0 : slot + 1;
    }
#undef ATT_ISSUE
    asm volatile("s_waitcnt lgkmcnt(0)" ::: "memory"); __builtin_amdgcn_s_barrier(); asm volatile("" ::: "memory");
    const float lt = l_run + shfl_x(l_run, lane, 32); const float inv = frcp(lt);
    bf16_t* orow = WSP(bf16_t, WS_MIX) + (size_t)(seqbase + qloc) * D + head * 64;
#pragma unroll
    for (int g = 0; g < 4; ++g) { u32x2 a; a.x = pk2(o0[4 * g] * inv, o0[4 * g + 1] * inv); a.y = pk2(o0[4 * g + 2] * inv, o0[4 * g + 3] * inv); *(u32x2*)(orow + 8 * g + 4 * hh) = a;
        a.x = pk2(o1[4 * g] * inv, o1[4 * g + 1] * inv); a.y = pk2(o1[4 * g + 2] * inv, o1[4 * g + 3] * inv); *(u32x2*)(orow + 32 + 8 * g + 4 * hh) = a; }
}

constexpr int GL_LA = 0;
constexpr int GL_LR = 32768;
constexpr int GL_WA = 40960;
constexpr int GL_BA = 49152;
constexpr int GL_BL = 49664;
constexpr int GL_A = 51200;
constexpr int GL_B = 67584;
constexpr int GL_C = 83968;
__device__ __forceinline__ int timg(int r, int c, int R) { return (c >> 5) * (R * 64) + (r >> 3) * 512 + (r & 7) * 64 + (c & 31) * 2; }

struct GlaPre { f32x4 lr, wa; float ba; u32x4 gk, gq, v0, v1; };
__device__ __forceinline__ GlaPre gla_load(Frame& F, int e, int gc, int hd, bool with_q) {
    const int tid = F.tid; const int R0 = gc * 64; GlaPre p; const bf16_t* ZE = WSP(bf16_t, WS_ZE);
    { const int row = tid >> 3, c4 = tid & 7; p.lr = *(const f32x4*)(WSP(float, WS_LR) + (size_t)(R0 + row) * 32 + 4 * c4);
      const int z = tid >> 8, r = (tid >> 4) & 15, k4 = tid & 15; p.wa = *(const f32x4*)(FIN(I_WALPHA) + ((size_t)(e * 2 + z) * 16 + r) * 256 + hd * 64 + 4 * k4);
      p.ba = FIN(I_BALPHA)[(e * 2 + ((tid >> 6) & 1)) * 256 + hd * 64 + (tid & 63)]; }
    { const int t = tid >> 3, k8 = (tid & 7) * 8; p.gk = *(const u32x4*)(ZE + (size_t)(R0 + t) * ZW + 1024 + hd * 64 + k8);
      p.gq = with_q ? *(const u32x4*)(ZE + (size_t)(R0 + t) * ZW + 768 + hd * 64 + k8) : p.gk; }
    { const int p0 = tid, p1 = tid + 512; p.v0 = *(const u32x4*)(ZE + (size_t)(R0 + (p0 >> 4)) * ZW + 1280 + hd * 128 + (p0 & 15) * 8); p.v1 = *(const u32x4*)(ZE + (size_t)(R0 + (p1 >> 4)) * ZW + 1280 + hd * 128 + (p1 & 15) * 8); }
    return p;
}
__device__ __forceinline__ void gla_bcum(Frame& F, const GlaPre& p) {
    const int tid = F.tid;
    LAS float* LA = (LAS float*)(F.lds + GL_LA); LAS float* LRs = (LAS float*)(F.lds + GL_LR); LAS float* WA = (LAS float*)(F.lds + GL_WA);
    LAS float* BA = (LAS float*)(F.lds + GL_BA); LAS float* BL = (LAS float*)(F.lds + GL_BL);
    { const int row = tid >> 3, c4 = tid & 7; *(LAS f32x4*)(LRs + row * 32 + 4 * c4) = p.lr;
      const int z = tid >> 8, r = (tid >> 4) & 15, k4 = tid & 15; *(LAS f32x4*)(WA + (z * 16 + r) * 64 + 4 * k4) = p.wa;
      if (tid < 128) BA[tid] = p.ba; }
    __syncthreads();
    { const int lane = F.lane, w = F.wave; const int z = w >> 2, kl = lane & 15, seg = lane >> 4, k = (w & 3) * 16 + kl, t0 = seg * 16;
      float wa[16];
#pragma unroll
      for (int r = 0; r < 16; ++r) wa[r] = WA[(z * 16 + r) * 64 + k];
      const float bz = BA[z * 64 + k];
      float la[16];
#pragma unroll
      for (int tt = 0; tt < 16; ++tt) { float x = bz;
#pragma unroll
          for (int r4 = 0; r4 < 4; ++r4) { const f32x4 l4 = *(const LAS f32x4*)(LRs + (t0 + tt) * 32 + z * 16 + 4 * r4); x += (l4[0] * wa[4 * r4] + l4[1] * wa[4 * r4 + 1]) + (l4[2] * wa[4 * r4 + 2] + l4[3] * wa[4 * r4 + 3]); }
          la[tt] = (fminf(x, 0.f) - flog(1.0f + fexp(-fabsf(x)))) * (1.0f / 16.0f); }
      float run = 0.f;
      if (z == 0) {
#pragma unroll
          for (int tt = 0; tt < 16; ++tt) { run += la[tt]; la[tt] = run; }
      } else {
#pragma unroll
          for (int tt = 15; tt >= 0; --tt) { run += la[tt]; la[tt] = run; }
      }
      const float s0 = shfl_idx(run, kl), s1 = shfl_idx(run, kl + 16), s2 = shfl_idx(run, kl + 32), s3 = shfl_idx(run, kl + 48);
      float add;
      if (z == 0) add = (seg > 0 ? s0 : 0.f) + (seg > 1 ? s1 : 0.f) + (seg > 2 ? s2 : 0.f);
      else        add = (seg < 3 ? s3 : 0.f) + (seg < 2 ? s2 : 0.f) + (seg < 1 ? s1 : 0.f);
#pragma unroll
      for (int tt = 0; tt < 16; ++tt) LA[(z * 64 + t0 + tt) * 64 + k] = la[tt] + add;
      if (seg == 0) BL[z * 64 + k] = (s0 + s1) + (s2 + s3); }
    __syncthreads();
}
__device__ __forceinline__ void gla_stage_v(Frame& F, const GlaPre& p, int off) {
    { const int q = F.tid, t = q >> 4, v8 = (q & 15) * 8; *(LAS u32x4*)(F.lds + off + timg(t, v8, 64)) = p.v0; }
    { const int q = F.tid + 512, t = q >> 4, v8 = (q & 15) * 8; *(LAS u32x4*)(F.lds + off + timg(t, v8, 64)) = p.v1; }
}
__device__ __forceinline__ void gla_g1_item(Frame& F, int e, int gc, int hd, const GlaPre& pre) {
    const int tid = F.tid, lane = F.lane, w = F.wave;
    gla_stage_v(F, pre, GL_B);
    gla_bcum(F, pre);
    LAS float* LA = (LAS float*)(F.lds + GL_LA); LAS float* BL = (LAS float*)(F.lds + GL_BL);
    { const int t = tid >> 3, k8 = (tid & 7) * 8; const u32x4 gk = pre.gk;
      const float kf[8] = {bflo(gk.x), bfhi(gk.x), bflo(gk.y), bfhi(gk.y), bflo(gk.z), bfhi(gk.z), bflo(gk.w), bfhi(gk.w)};
#pragma unroll
      for (int z = 0; z < 2; ++z) { float ks[8];
#pragma unroll
        for (int j = 0; j < 8; ++j) ks[j] = kf[j] * fexp(BL[z * 64 + k8 + j] - LA[(z * 64 + t) * 64 + k8 + j]);
        *(LAS u32x4*)(F.lds + GL_A + z * 8192 + timg(t, k8, 64)) = (u32x4){pk2(ks[0], ks[1]), pk2(ks[2], ks[3]), pk2(ks[4], ks[5]), pk2(ks[6], ks[7])}; } }
    __syncthreads();
    { const int vb = w & 3, z = w >> 2; const int hh = lane >> 5, q = (lane & 15) >> 2;
      const int lofs = q * 64 + (((lane >> 4) & 1) * 16 + (lane & 3) * 4) * 2;
      f32x16 a0 = {}, a1 = {};
#pragma unroll
      for (int s = 0; s < 4; ++s) { const int rofs = (2 * s + hh) * 512;
        const lptr vp = F.lds + GL_B + vb * 4096 + rofs + lofs; const s16x4 va = tr_read(vp), vb2 = tr_read(vp + 256);
        const bf16x8 vf = (bf16x8){va[0], va[1], va[2], va[3], vb2[0], vb2[1], vb2[2], vb2[3]};
        const lptr kp = F.lds + GL_A + z * 8192 + rofs + lofs; const s16x4 ka = tr_read(kp), kb2 = tr_read(kp + 256), kc = tr_read(kp + 4096), kd = tr_read(kp + 4096 + 256);
        const bf16x8 kf0 = (bf16x8){ka[0], ka[1], ka[2], ka[3], kb2[0], kb2[1], kb2[2], kb2[3]}, kf1 = (bf16x8){kc[0], kc[1], kc[2], kc[3], kd[0], kd[1], kd[2], kd[3]};
        a0 = __builtin_amdgcn_mfma_f32_32x32x16_bf16(vf, kf0, a0, 0, 0, 0); a1 = __builtin_amdgcn_mfma_f32_32x32x16_bf16(vf, kf1, a1, 0, 0, 0); }
      float* kv = WSP(float, WS_KV) + ((size_t)(gc * 4 + hd) * 2 + z) * 8192;
#pragma unroll
      for (int r = 0; r < 16; ++r) { const int v = 32 * vb + crow(r, hh); kv[v * 64 + (lane & 31)] = a0[r]; kv[v * 64 + 32 + (lane & 31)] = a1[r]; } }
    if (tid < 128) WSP(float, WS_DL)[((size_t)(gc * 4 + hd) * 2 + (tid >> 6)) * 64 + (tid & 63)] = fexp(BL[tid]);
    __syncthreads();
}
__device__ __forceinline__ void phase_g2(Frame& F, int e) {
    const int tid = F.tid; float* KV = WSP(float, WS_KV); const float* DL = WSP(float, WS_DL);
    {
        const int v = F.vcu; const int chain = v >> 3, slice = v & 7; const int b = chain >> 3, hd = (chain >> 1) & 3, z = chain & 1;
        const int off = slice * 1024 + tid * 2, k = off & 63, vv = off >> 6;
        const float* s0 = FIN(I_SGLA) + ((size_t)((b * 2 + e) * 2 + z) * 4 + hd) * 8192;
        f32x2 S = (f32x2){s0[(size_t)k * 128 + vv], s0[(size_t)(k + 1) * 128 + vv]};
        f32x2 kvA[8], dlA[8], kvB[8], dlB[8];
#define G2_LOAD(KVR, DLR, C8) _Pragma("unroll") for (int i = 0; i < 8; ++i) { const int c = z ? 63 - ((C8) + i) : (C8) + i; const size_t it = (size_t)((64 + b * 64 + c) * 4 + hd) * 2 + z; \
                KVR[i] = *(const f32x2*)(KV + it * 8192 + off); DLR[i] = *(const f32x2*)(DL + it * 64 + k); }
#define G2_FOLD(KVR, DLR, C8) _Pragma("unroll") for (int i = 0; i < 8; ++i) { const int c = z ? 63 - ((C8) + i) : (C8) + i; const size_t it = (size_t)((64 + b * 64 + c) * 4 + hd) * 2 + z; \
                *(f32x2*)(KV + it * 8192 + off) = S; S = DLR[i] * S + KVR[i]; }
        G2_LOAD(kvA, dlA, 0)
        for (int c8 = 0; c8 < 64; c8 += 16) {
            G2_LOAD(kvB, dlB, c8 + 8)
            G2_FOLD(kvA, dlA, c8)
            if (c8 + 16 < 64) { G2_LOAD(kvA, dlA, c8 + 16) }
            G2_FOLD(kvB, dlB, c8 + 8)
        }
#undef G2_LOAD
#undef G2_FOLD
    }
    for (int item = F.vcu; item < 512; item += F.G) {
        const int chain = item >> 2, slice = item & 3; const int b = chain >> 3, hd = (chain >> 1) & 3, z = chain & 1;
        const int off = slice * 2048 + tid * 4, k = off & 63, vv = off >> 6;
        const float zf = (float)F.oz; f32x4 S = {zf, zf, zf, zf};
        f32x4 kv4[4], dl4[4];
#pragma unroll
        for (int i = 0; i < 4; ++i) { const int c = z ? 3 - i : i; const size_t it = (size_t)((b * 4 + c) * 4 + hd) * 2 + z; kv4[i] = *(const f32x4*)(KV + it * 8192 + off); dl4[i] = *(const f32x4*)(DL + it * 64 + k); }
#pragma unroll
        for (int i = 0; i < 4; ++i) { const int c = z ? 3 - i : i; const size_t it = (size_t)((b * 4 + c) * 4 + hd) * 2 + z; *(f32x4*)(KV + it * 8192 + off) = S; S = dl4[i] * S + kv4[i]; }
        float* dst = F.out + OUT_GLA + ((size_t)((b * 2 + e) * 2 + z) * 4 + hd) * 8192;
#pragma unroll
        for (int j = 0; j < 4; ++j) dst[(size_t)(k + j) * 128 + vv] = S[j];
    }
}
__device__ __forceinline__ void gla_g3_item(Frame& F, int e, int gc, int hd, const GlaPre& pre) {
    const int tid = F.tid, lane = F.lane, w = F.wave; const int R0 = gc * 64;
    const bf16_t* ZE = WSP(bf16_t, WS_ZE);
    f32x4 sreg[8];
    { const float* KV = WSP(float, WS_KV) + (size_t)(gc * 4 + hd) * 2 * 8192;
#pragma unroll
      for (int i = 0; i < 8; ++i) { const int idx = tid + 512 * i, z = idx >> 11, rem = idx & 2047, v = rem >> 4, k4 = (rem & 15) * 4; sreg[i] = *(const f32x4*)(KV + (size_t)z * 8192 + v * 64 + k4); } }
    u32x2 grreg[4];
    { const int vb_ = w >> 1, ib_ = w & 1, i_ = 32 * ib_ + (lane & 31), hh_ = lane >> 5;
#pragma unroll
      for (int g = 0; g < 4; ++g) grreg[g] = *(const u32x2*)(ZE + (size_t)(R0 + i_) * ZW + 1792 + hd * 128 + 32 * vb_ + 8 * g + 4 * hh_); }
    gla_stage_v(F, pre, GL_C);
    gla_bcum(F, pre);
    LAS float* LA = (LAS float*)(F.lds + GL_LA);
    { const int t = tid >> 3, c = tid & 7, k8 = c * 8;
      const u32x4 gq = pre.gq, gk = pre.gk;
      const float qf[8] = {bflo(gq.x), bfhi(gq.x), bflo(gq.y), bfhi(gq.y), bflo(gq.z), bfhi(gq.z), bflo(gq.w), bfhi(gq.w)};
      const float kf[8] = {bflo(gk.x), bfhi(gk.x), bflo(gk.y), bfhi(gk.y), bflo(gk.z), bfhi(gk.z), bflo(gk.w), bfhi(gk.w)};
      const int so = t * 128 + ((c ^ (t & 7)) * 16);
#pragma unroll
      for (int z = 0; z < 2; ++z) { float qe[8], ke[8];
#pragma unroll
        for (int j = 0; j < 8; ++j) { const float bc = LA[(z * 64 + t) * 64 + k8 + j]; qe[j] = qf[j] * fexp(bc); ke[j] = kf[j] * fexp(-bc); }
        *(LAS u32x4*)(F.lds + GL_A + z * 8192 + so) = (u32x4){pk2(qe[0], qe[1]), pk2(qe[2], qe[3]), pk2(qe[4], qe[5]), pk2(qe[6], qe[7])};
        *(LAS u32x4*)(F.lds + GL_B + z * 8192 + so) = (u32x4){pk2(ke[0], ke[1]), pk2(ke[2], ke[3]), pk2(ke[4], ke[5]), pk2(ke[6], ke[7])}; } }
    __syncthreads();
    {
#pragma unroll
      for (int i = 0; i < 8; ++i) { const int idx = tid + 512 * i, z = idx >> 11, rem = idx & 2047, v = rem >> 4, k4 = (rem & 15) * 4;
        const f32x4 s = sreg[i];
        *(LAS u32x2*)(F.lds + GL_LA + z * 16384 + v * 128 + (((k4 >> 3) ^ (v & 7)) * 16) + (k4 & 7) * 2) = (u32x2){pk2(s[0], s[1]), pk2(s[2], s[3])}; } }
    __syncthreads();
    const int vb = w >> 1, ib = w & 1, r32 = lane & 31, hh = lane >> 5;
    f32x16 o = {};
    bf16x8 qf[2][4];
    { const int i = 32 * ib + r32;
#pragma unroll
      for (int z = 0; z < 2; ++z)
#pragma unroll
        for (int s = 0; s < 4; ++s) qf[z][s] = *(const LAS bf16x8*)(F.lds + GL_A + z * 8192 + i * 128 + (((2 * s + hh) ^ (i & 7)) * 16)); }
    { const int v = 32 * vb + r32;
#pragma unroll
      for (int z = 0; z < 2; ++z)
#pragma unroll
        for (int s = 0; s < 4; ++s) { const bf16x8 sf = *(const LAS bf16x8*)(F.lds + GL_LA + z * 16384 + v * 128 + (((2 * s + hh) ^ (v & 7)) * 16));
            o = __builtin_amdgcn_mfma_f32_32x32x16_bf16(sf, qf[z][s], o, 0, 0, 0); } }
    const lptr vbase = F.lds + GL_C + vb * 4096 + ((lane >> 4) & 1) * 32 + (lane & 3) * 8 + (4 * hh + ((lane & 15) >> 2)) * 64;
#pragma unroll
    for (int jb = 0; jb < 2; ++jb) {
        const int j = 32 * jb + r32; f32x16 xf = {}, xb = {};
        const bool do_f = !(jb == 1 && ib == 0), do_b = !(jb == 0 && ib == 1);
#pragma unroll
        for (int s = 0; s < 4; ++s) { const int so = j * 128 + (((2 * s + hh) ^ (j & 7)) * 16);
            if (do_f) { const bf16x8 kf = *(const LAS bf16x8*)(F.lds + GL_B + so); xf = __builtin_amdgcn_mfma_f32_32x32x16_bf16(kf, qf[0][s], xf, 0, 0, 0); }
            if (do_b) { const bf16x8 kb = *(const LAS bf16x8*)(F.lds + GL_B + 8192 + so); xb = __builtin_amdgcn_mfma_f32_32x32x16_bf16(kb, qf[1][s], xb, 0, 0, 0); } }
        float x[16]; const int ii = 32 * ib + r32;
#pragma unroll
        for (int r = 0; r < 16; ++r) { const int jj = 32 * jb + crow(r, hh); x[r] = ((do_f && jj <= ii) ? xf[r] : 0.f) + ((do_b && jj >= ii) ? xb[r] : 0.f); }
#pragma unroll
        for (int s2 = 0; s2 < 2; ++s2) { const u32x4 pw = (u32x4){pk2(x[8 * s2], x[8 * s2 + 1]), pk2(x[8 * s2 + 2], x[8 * s2 + 3]), pk2(x[8 * s2 + 4], x[8 * s2 + 5]), pk2(x[8 * s2 + 6], x[8 * s2 + 7])};
            const bf16x8 vf = tr_frag(vbase + (4 * jb + 2 * s2) * 512);
            o = __builtin_amdgcn_mfma_f32_32x32x16_bf16(vf, __builtin_bit_cast(bf16x8, pw), o, 0, 0, 0); }
    }
    LAS float* SSQ = (LAS float*)(F.lds + GL_LR);
    { float s = 0.f;
#pragma unroll
      for (int r = 0; r < 16; ++r) s += o[r] * o[r];
      s += shfl_x(s, lane, 32);
      if (hh == 0) SSQ[vb * 64 + 32 * ib + r32] = s; }
    __syncthreads();
    { const int i = 32 * ib + r32; const float tot = SSQ[i] + SSQ[64 + i] + SSQ[128 + i] + SSQ[192 + i]; const float rs = frsq(tot * (1.0f / 128.0f) + EPS);
      const float* gain = FIN(I_GGAIN) + e * 512 + hd * 128; const size_t row = (size_t)(R0 + i);
#pragma unroll
      for (int g = 0; g < 4; ++g) { const int v0 = 32 * vb + 8 * g + 4 * hh; const f32x4 gn = *(const f32x4*)(gain + v0);
        const u32x2 gr = grreg[g];
        const float r0 = o[4 * g] * rs * gn[0] * bflo(gr.x), r1 = o[4 * g + 1] * rs * gn[1] * bfhi(gr.x), r2 = o[4 * g + 2] * rs * gn[2] * bflo(gr.y), r3 = o[4 * g + 3] * rs * gn[3] * bfhi(gr.y);
        *(u32x2*)(WSP(bf16_t, WS_MIX) + row * D + 512 + hd * 128 + v0) = (u32x2){pk2(r0, r1), pk2(r2, r3)}; } }
    __syncthreads();
}

__device__ __forceinline__ void phase_attn_g1(Frame& F, int e) {
    const int v = F.vcu;
    for (int i = 0; i < 2; ++i) { const int uid = 2 * v + i; const int hp = uid & 1, qb = (uid >> 1) & 31, kvh = (uid >> 6) & 1, b = uid >> 7; attn_unit(F, e, 0, b, kvh, qb, hp); }
    if (v < 128) { const int hp = v & 1, qb = (v >> 1) & 1, kvh = (v >> 2) & 1, b = v >> 3; attn_unit(F, e, 1, b, kvh, qb, hp); }
    { GlaPre pre = gla_load(F, e, (v * 5) >> 2, (v * 5) & 3, false);
      for (int it = v * 5; it < v * 5 + 5; ++it) { const int nx = it + 1 < v * 5 + 5 ? it + 1 : it; const GlaPre nxt = gla_load(F, e, nx >> 2, nx & 3, false); gla_g1_item(F, e, it >> 2, it & 3, pre); pre = nxt; } }
}
__device__ __forceinline__ void phase_g3(Frame& F, int e) {
    const int v = F.vcu;
    GlaPre pre = gla_load(F, e, (v * 5) >> 2, (v * 5) & 3, true);
    for (int it = v * 5; it < v * 5 + 5; ++it) { const int nx = it + 1 < v * 5 + 5 ? it + 1 : it; const GlaPre nxt = gla_load(F, e, nx >> 2, nx & 3, true); gla_g3_item(F, e, it >> 2, it & 3, pre); pre = nxt; }
}

__device__ __forceinline__ void phase_conv(Frame& F, int o) {
    const bf16_t* U = WSP(bf16_t, WS_U); bf16_t* UC = WSP(bf16_t, WS_UC);
    const int gt = F.vcu * NTHREADS + F.tid, NGT = F.G * NTHREADS;
    for (int it = gt; it < 1280 * 128; it += NGT) {
        const int cg = it & 127, rg = it >> 7, c0 = cg * 8, r0 = rg * 16;
        const int seqlen = r0 < MCTX ? TCTX : TLAT; const int sb = r0 < MCTX ? (r0 & ~(TCTX - 1)) : MCTX + ((r0 - MCTX) & ~(TLAT - 1)); const int se = sb + seqlen;
        float w[4][8], bias[8];
#pragma unroll
        for (int i = 0; i < 4; ++i)
#pragma unroll
            for (int j = 0; j < 8; ++j) w[i][j] = FIN(I_CONVW)[(size_t)(o * 4 + i) * 1024 + c0 + j];
#pragma unroll
        for (int j = 0; j < 8; ++j) bias[j] = FIN(I_CONVB)[o * 1024 + c0 + j];
        u32x4 raw[19];
#pragma unroll
        for (int r = 0; r < 19; ++r) { const int row = r0 - 2 + r; const int rc = row < sb ? sb : (row >= se ? se - 1 : row); raw[r] = *(const u32x4*)(U + (size_t)rc * D + c0); }
#pragma unroll
        for (int r = 0; r < 19; ++r) { const int row = r0 - 2 + r; if (row < sb || row >= se) raw[r] = (u32x4){0u, 0u, 0u, 0u}; }
#pragma unroll
        for (int r = 0; r < 16; ++r) { float y[8];
#pragma unroll
            for (int j = 0; j < 8; ++j) { const int w2 = j >> 1;
                const float x0 = (j & 1) ? bfhi(raw[r][w2]) : bflo(raw[r][w2]), x1 = (j & 1) ? bfhi(raw[r + 1][w2]) : bflo(raw[r + 1][w2]), x2 = (j & 1) ? bfhi(raw[r + 2][w2]) : bflo(raw[r + 2][w2]), x3 = (j & 1) ? bfhi(raw[r + 3][w2]) : bflo(raw[r + 3][w2]);
                y[j] = bias[j] + w[0][j] * x0 + w[1][j] * x1 + w[2][j] * x2 + w[3][j] * x3; }
            *(u32x4*)(UC + (size_t)(r0 + r) * D + c0) = (u32x4){pk2(y[0], y[1]), pk2(y[2], y[3]), pk2(y[4], y[5]), pk2(y[6], y[7])}; }
    }
}
__device__ __forceinline__ void phase_carry(Frame& F, int o) {
    const float* AGG = WSP(float, WS_AGG); float* CAR = WSP(float, WS_CARRY);
    const int gt = F.vcu * NTHREADS + F.tid, NGT = F.G * NTHREADS;
    for (int c = gt; c < 8192 + 32768; c += NGT) {
        if (c < 8192) { const int b = c >> 11, z = (c >> 10) & 1, ch = c & 1023; const int base = 64 + b * 64;
            float h = FIN(I_SLRU)[(size_t)((b * 2 + o) * 2 + z) * 1024 + ch];
            for (int i8 = 0; i8 < 64; i8 += 8) { f32x2 a[8];
#pragma unroll
                for (int i = 0; i < 8; ++i) { const int ck = base + (z ? 63 - (i8 + i) : i8 + i); a[i] = *(const f32x2*)(AGG + ((size_t)(ck * 2 + z) * 1024 + ch) * 2); }
#pragma unroll
                for (int i = 0; i < 8; ++i) { const int ck = base + (z ? 63 - (i8 + i) : i8 + i); CAR[(size_t)(ck * 2 + z) * 1024 + ch] = h; h = a[i].x * h + a[i].y; } }
        } else { const int cc = c - 8192; const int b = cc >> 11, z = (cc >> 10) & 1, ch = cc & 1023; const int base = b * 4; float h = 0.f;
#pragma unroll
            for (int i = 0; i < 4; ++i) { const int ck = base + (z ? 3 - i : i); const f32x2 a = *(const f32x2*)(AGG + ((size_t)(ck * 2 + z) * 1024 + ch) * 2); CAR[(size_t)(ck * 2 + z) * 1024 + ch] = h; h = a.x * h + a.y; }
            F.out[OUT_LRU + (size_t)((b * 2 + o) * 2 + z) * 1024 + ch] = h; }
    }
}
__device__ __forceinline__ void phase_lru_out(Frame& F) {
    const bf16_t* ACF = WSP(bf16_t, WS_LAF); const bf16_t* ACB = WSP(bf16_t, WS_LAB); const bf16_t* HLF = WSP(bf16_t, WS_U); const bf16_t* HLB = WSP(bf16_t, WS_BB);
    const bf16_t* Gg = WSP(bf16_t, WS_G); bf16_t* YG = WSP(bf16_t, WS_BB); const float* CAR = WSP(float, WS_CARRY);
    const int gt = F.vcu * NTHREADS + F.tid, NGT = F.G * NTHREADS;
    for (int it = gt; it < 1280 * 128; it += NGT) {
        const int cg = it & 127, rg = it >> 7, c0 = cg * 8, r0 = rg * 16, ck = r0 >> 6;
        float cf[8], cb[8];
        { const f32x4 a0 = *(const f32x4*)(CAR + (size_t)(ck * 2) * 1024 + c0), a1 = *(const f32x4*)(CAR + (size_t)(ck * 2) * 1024 + c0 + 4), b0 = *(const f32x4*)(CAR + (size_t)(ck * 2 + 1) * 1024 + c0), b1 = *(const f32x4*)(CAR + (size_t)(ck * 2 + 1) * 1024 + c0 + 4);
#pragma unroll
          for (int j = 0; j < 4; ++j) { cf[j] = a0[j]; cf[4 + j] = a1[j]; cb[j] = b0[j]; cb[4 + j] = b1[j]; } }
#pragma unroll 4
        for (int r = 0; r < 16; ++r) { const size_t ix = (size_t)(r0 + r) * D + c0;
            const u32x4 af = *(const u32x4*)(ACF + ix), ab = *(const u32x4*)(ACB + ix), hf = *(const u32x4*)(HLF + ix), hb = *(const u32x4*)(HLB + ix), gg = *(const u32x4*)(Gg + ix);
            float y[8];
#pragma unroll
            for (int w2 = 0; w2 < 4; ++w2) { y[2 * w2] = bflo(gg[w2]) * ((bflo(hf[w2]) + bflo(af[w2]) * cf[2 * w2]) + (bflo(hb[w2]) + bflo(ab[w2]) * cb[2 * w2]));
                y[2 * w2 + 1] = bfhi(gg[w2]) * ((bfhi(hf[w2]) + bfhi(af[w2]) * cf[2 * w2 + 1]) + (bfhi(hb[w2]) + bfhi(ab[w2]) * cb[2 * w2 + 1])); }
            *(u32x4*)(YG + ix) = (u32x4){pk2(y[0], y[1]), pk2(y[2], y[3]), pk2(y[4], y[5]), pk2(y[6], y[7])}; }
    }
}

constexpr int NSTEPS = 42;
template <int KIND>
__device__ __forceinline__ void run_gemm(Frame& F, int l, int sub, int gidx, const bf16_t* A, int lda, int K, int a_grp, const bf16_t* Bt, int nN, bool perm, int dep, int depneed, int pub, int rot, int qidx) {
    pg8::Gemm g; g.A = A; g.Bt = Bt; g.lda = lda; g.K = K; g.nM = M / 256; g.nN = nN; g.a_grp = a_grp; g.perm = perm;
    Epi<KIND> E; E.layer = l; E.sub = sub; E.gidx = gidx; E.p = F.p; E.oz = F.oz;
    pg8::StaticOrder S; S.init(g.nM, g.nN, F.G, F.bid); S.rot = rot;
    unsigned* cw = WSP(unsigned, WS_CTL) + CW_CNT;
    if (dep >= 0) { S.ready = cw + (size_t)dep * 80 * 16; S.need = (unsigned)depneed * 8u; }
    if (pub >= 0) S.fin = cw + (size_t)pub * 80 * 16;
    if (qidx >= 0 && F.G == 256) { S.queue = WSP(unsigned, WS_CTL) + CW_Q + (size_t)qidx * 8 * 16; S.word = (LAS unsigned*)(F.lds + MISC_OFF + 64); }
    pg8::gemm_phase<Epi<KIND>>(F.lds, F.tid, (float)F.oz, g, S, E);
}
__global__ void __launch_bounds__(NTHREADS, 2) mk_fwd(Params P) {
    extern __shared__ __attribute__((aligned(16))) unsigned char lds_raw[];
    const lptr lds0 = (lptr)lds_raw;
    volatile LAS unsigned* MISC = (volatile LAS unsigned*)(lds0 + MISC_OFF);
    static_assert((LDS_BYTES - LDSCTL_OFF) == 8 * NTHREADS * 4, "LDS control region");
#pragma unroll
    for (int u = 0; u < 8; ++u) ((LAS unsigned*)(lds0 + LDSCTL_OFF))[u * NTHREADS + threadIdx.x] = 0u;
    __syncthreads();
    unsigned* ctl = (unsigned*)(P.ws + WS_CTL);
    XcdBarrier bar; bar.bar = ctl + 1024; bar.x = 0; bar.st = nullptr;
    const int lo = P.step_lo, hi = P.step_hi;
    const bool multi = (hi - lo) > 1;
    if (multi) bar = xcd_barrier_post(ctl + 1024, MISC + 8);
    volatile LAS unsigned long long* TS = (volatile LAS unsigned long long*)(lds0 + LDSCTL_OFF + 1024);
    if (PROBE_K1 >= 0 && blockIdx.x == 0 && threadIdx.x == 0) TS[0] = __builtin_amdgcn_s_memrealtime();
#define STEP_BEGIN(s) if (lo <= (s) && (s) < hi) { Frame F; F.lds = lds0; F.p = &P; \
        { int tid = threadIdx.x; asm volatile("" : "+v"(tid)); F.tid = tid; F.lane = tid & 63; F.wave = __builtin_amdgcn_readfirstlane(tid >> 6); } \
        { int G = gridDim.x, bx = blockIdx.x, oz = 0; asm volatile("" : "+s"(G), "+s"(bx), "+s"(oz)); F.G = G; F.bid = bx; F.vcu = (G % 8 == 0) ? (bx % 8) * (G / 8) + bx / 8 : bx; F.oz = oz; F.out = P.out + oz; }
#define STAMP() do { if (PROBE_K1 >= 0 && blockIdx.x == 0 && threadIdx.x == 0) { const int o_ = (int)TS[63]; if (o_ < 62) TS[o_ + 1] = __builtin_amdgcn_s_memrealtime(); TS[63] = (unsigned long long)(o_ + 1); } } while (0)
#define STEP_END(s) if (multi && (s) + 1 < hi) { XcdBarrier bb = bar; asm volatile("" : "+s"(bb.bar), "+s"(bb.x)); xcd_barrier(bb, F.tid); } else __syncthreads(); STAMP(); }

#define STEP_LINK(s) __syncthreads(); STAMP(); }
    STEP_BEGIN(0) phase_prologue(F); STEP_END(0)
    for (int l = 0; l < DEPTH; ++l) {
        const int s0 = 1 + 10 * l; const bool even = (l & 1) == 0; const int sub = l >> 1;
        const int dep_in = l > 0 ? (l - 1) * 3 + 2 : -1;
        if (l == 0) { STEP_BEGIN(1) phase_pre(F); STEP_END(1) }
        if (even) {
            STEP_BEGIN(s0 + 1) run_gemm<EK_EVEN_IN>(F, l, sub, 0, WSP(bf16_t, WS_XN), D, D, 0, WSP(bf16_t, WS_WINE) + (size_t)sub * PEP * D, 10, true, dep_in, 4, -1, 0, l * 4 + 3); STEP_END(s0 + 1)
            STEP_BEGIN(s0 + 2) phase_attn_g1(F, sub); STEP_END(s0 + 2)
            STEP_BEGIN(s0 + 3) phase_g2(F, sub); STEP_END(s0 + 3)
            STEP_BEGIN(s0 + 4) phase_g3(F, sub); STEP_END(s0 + 4)
            STEP_BEGIN(s0 + 6) run_gemm<EK_RES>(F, l, sub, 2, WSP(bf16_t, WS_MIX), D, D, 0, WSP(bf16_t, WS_WOUTE) + (size_t)sub * D * D, 4, true, -1, 0, l * 3 + 0, 0, -1); STEP_LINK(s0 + 6)
        } else {
            STEP_BEGIN(s0 + 1) run_gemm<EK_ODD_IN>(F, l, sub, 0, WSP(bf16_t, WS_XN), D, D, 0, WSP(bf16_t, WS_WINO) + (size_t)sub * 2048 * D, 8, true, dep_in, 4, -1, 0, l * 4 + 3); STEP_END(s0 + 1)
            STEP_BEGIN(s0 + 2) phase_conv(F, sub); STEP_END(s0 + 2)
            STEP_BEGIN(s0 + 3) run_gemm<EK_GATES>(F, l, sub, 0, WSP(bf16_t, WS_UC), D, 256, 4, WSP(bf16_t, WS_WG) + (size_t)sub * 4096 * 256, 16, true, -1, 0, -1, 0, -1); STEP_END(s0 + 3)
            STEP_BEGIN(s0 + 4) phase_carry(F, sub); STEP_END(s0 + 4)
            STEP_BEGIN(s0 + 5) phase_lru_out(F); STEP_END(s0 + 5)
            STEP_BEGIN(s0 + 6) run_gemm<EK_RES>(F, l, sub, 2, WSP(bf16_t, WS_BB), D, D, 0, WSP(bf16_t, WS_WOUTO) + (size_t)sub * D * D, 4, true, -1, 0, l * 3 + 0, 0, -1); STEP_LINK(s0 + 6)
        }
        STEP_BEGIN(s0 + 8) run_gemm<EK_SWIGLU>(F, l, sub, 0, WSP(bf16_t, WS_XN), D, D, 0, WSP(bf16_t, WS_WF1) + (size_t)l * 5632 * D, 22, true, l * 3 + 0, 4, l * 3 + 1, 0, l * 4 + 1); STEP_LINK(s0 + 8)
        if (l + 1 < DEPTH) { STEP_BEGIN(s0 + 9) run_gemm<EK_RES>(F, l, sub, 5, WSP(bf16_t, WS_H), DFF, DFF, 0, WSP(bf16_t, WS_WF2) + (size_t)l * D * DFF, 4, true, l * 3 + 1, 22, l * 3 + 2, 0, -1); STEP_LINK(s0 + 9) }
        else           { STEP_BEGIN(s0 + 9) run_gemm<EK_RES>(F, l, sub, 5, WSP(bf16_t, WS_H), DFF, DFF, 0, WSP(bf16_t, WS_WF2) + (size_t)l * D * DFF, 4, true, l * 3 + 1, 22, -1, 0, -1); STEP_END(s0 + 9) }
    }
    STEP_BEGIN(41) phase_final(F); STEP_END(41)
#undef STEP_LINK
    if (PROBE_K1 >= 0 && blockIdx.x == 0 && threadIdx.x == 0) {
        unsigned long long q1 = (TS[PROBE_K1 + 1] - TS[PROBE_K1]) / 800ull; if (q1 > 63) q1 = 63;
        unsigned long long q2 = PROBE_K2 >= 0 ? (TS[PROBE_K2 + 1] - TS[PROBE_K2]) / 800ull : 0ull; if (q2 > 63) q2 = 63;
        const unsigned long long wait = (64ull * q1 + 4096ull * q2) * 100ull, t0 = __builtin_amdgcn_s_memrealtime();
        while (__builtin_amdgcn_s_memrealtime() - t0 < wait) __builtin_amdgcn_s_sleep(32);
    }
#undef STEP_BEGIN
#undef STEP_END
}

extern "C" void kernel_launch(void* const* d_in, const int* in_sizes, int n_in, void* d_out, int out_size, void* d_ws, size_t ws_size, hipStream_t stream) {
    static int grid = 0;
    if (grid == 0) {
        if (n_in != 30 || (size_t)out_size != OUT_END || ws_size < WS_END) { fprintf(stderr, "kernel_launch: unexpected shapes: n_in %d out %d ws %zu (need %zu)\n", n_in, out_size, ws_size, (size_t)WS_END); grid = -1; return; }
        int dev = 0, cus = 0;
        if (hipGetDevice(&dev) != hipSuccess || hipDeviceGetAttribute(&cus, hipDeviceAttributeMultiprocessorCount, dev) != hipSuccess) { grid = -1; return; }
        if (hipFuncSetAttribute((const void*)mk_fwd, hipFuncAttributeMaxDynamicSharedMemorySize, LDS_BYTES) != hipSuccess) { fprintf(stderr, "kernel_launch: hipFuncSetAttribute failed\n"); grid = -1; return; }
        (void)hipGetLastError();
        grid = cus;
        if (grid != 256) fprintf(stderr, "kernel_launch: %d CUs (built for 256)\n", grid);
    }
    if (grid < 0) return;
    (void)hipMemsetAsync((char*)d_ws + WS_CTL, 0, CTL_ZERO_BYTES, stream);
    Params p{};
    for (int i = 0; i < 30; ++i) p.in[i] = (const float*)d_in[i];
    p.out = (float*)d_out; p.ws = (unsigned char*)d_ws;
#if MK_MULTI
    for (int s = 0; s < NSTEPS; ++s) {
        if (s >= 1 && s <= 40) { const int l = (s - 1) / 10, j = (s - 1) % 10; if (((l & 1) == 0 && j == 5) || j == 7 || (j == 0 && l > 0)) continue; }
        p.step_lo = s; p.step_hi = s + 1;
        hipLaunchKernelGGL(mk_fwd, dim3(grid), dim3(NTHREADS), LDS_BYTES, stream, p);
    }
#else
    p.step_lo = 0; p.step_hi = NSTEPS;
    hipLaunchKernelGGL(mk_fwd, dim3(grid), dim3(NTHREADS), LDS_BYTES, stream, p);
#endif
}
```

```cpp
#include <hip/hip_runtime.h>
#include <cstdio>
#include <cstdint>

#ifndef MK_MULTI
#define MK_MULTI 0
#endif

#ifndef PROBE_K1
#define PROBE_K1 -1
#endif
#ifndef PROBE_K2
#define PROBE_K2 -1
#endif
#define LAS __attribute__((address_space(3)))
#define GAS __attribute__((address_space(1)))
typedef unsigned short bf16_t;
typedef short bf16x8 __attribute__((ext_vector_type(8)));
typedef short s16x4 __attribute__((ext_vector_type(4)));
typedef float f32x2 __attribute__((ext_vector_type(2)));
typedef float f32x4 __attribute__((ext_vector_type(4)));
typedef float f32x16 __attribute__((ext_vector_type(16)));
typedef unsigned u32x2 __attribute__((ext_vector_type(2)));
typedef unsigned u32x4 __attribute__((ext_vector_type(4)));
typedef LAS unsigned char* lptr;

constexpr int D = 1024, NCTX = 16, TCTX = 256, NLAT = 4, TLAT = 4096, DEPTH = 4;
constexpr int MCTX = NCTX * TCTX;
constexpr int M = MCTX + NLAT * TLAT;
constexpr int PE = 2336, PEP = 2560;
constexpr int ZW = 2304;
constexpr int DFF = 2816;
constexpr float EPS = 1e-6f;
constexpr float LOG2E = 1.4426950408889634f;
constexpr float QSCALE = 0.125f * LOG2E;
constexpr int NCHUNK = M / 64;

constexpr size_t OUT_CK = (size_t)M * D, OUT_CV = OUT_CK + 1048576, OUT_GLA = OUT_CV + 1048576, OUT_LRU = OUT_GLA + 2097152, OUT_END = OUT_LRU + 65536;

constexpr size_t MiB = 1u << 20;
constexpr size_t WS_CTL = 0, CTL_ZERO_BYTES = 128 * 1024;
constexpr int CW_Q = 12288;
constexpr int CW_CNT = 16384;
constexpr size_t WS_BIAS = 256 * 1024;
constexpr size_t BIAS_E = 0, BIAS_O = 2 * 5 * 2560, BIAS_F = BIAS_O + 2 * 5 * 2048, BIAS_TOTAL = BIAS_F + 4 * 5 * 5632;
constexpr size_t SSQP_OFF = 10485760;
constexpr size_t WS_SSQ_UNUSED = 3 * MiB;
constexpr size_t WS_MOD = 1 * MiB;
constexpr size_t WS_ROPE = WS_MOD + 512 * 1024;
constexpr size_t WS_CK = 2 * MiB, WS_CV = 2 * MiB + 512 * 1024;
constexpr size_t WS_WINE = 4 * MiB;
constexpr size_t WS_WOUTE = WS_WINE + 10 * MiB;
constexpr size_t WS_WINO = WS_WOUTE + 4 * MiB;
constexpr size_t WS_WG = WS_WINO + 8 * MiB;
constexpr size_t WS_WOUTO = WS_WG + 4 * MiB;
constexpr size_t WS_WF1 = WS_WOUTO + 4 * MiB;
constexpr size_t WS_WF2 = WS_WF1 + 44 * MiB;
constexpr size_t WS_XN = WS_WF2 + 22 * MiB;
static_assert(WS_XN == 100 * MiB, "ws map");
constexpr size_t WS_BIG = 140 * MiB;
constexpr size_t WS_ZE = 140 * MiB;
constexpr size_t WS_KV = 230 * MiB;
constexpr size_t WS_MIX = 340 * MiB;
constexpr size_t WS_LR = 380 * MiB;
constexpr size_t WS_DL = 383 * MiB;
constexpr size_t WS_G = 140 * MiB;
constexpr size_t WS_U = 180 * MiB;
constexpr size_t WS_UC = 220 * MiB;
constexpr size_t WS_LAF = 260 * MiB;
constexpr size_t WS_LAB = 300 * MiB;
constexpr size_t WS_BB = 340 * MiB;
constexpr size_t WS_AGG = WS_XN;
constexpr size_t WS_CARRY = WS_XN + 8 * MiB;
constexpr size_t WS_H = 230 * MiB;
constexpr size_t WS_SSQ8 = 220 * MiB;
constexpr size_t WS_XF = 140 * MiB;
constexpr size_t WS_END = 384 * MiB;

constexpr int RING_BYTES = 131072;
constexpr int LDSCTL_OFF = RING_BYTES, MISC_OFF = LDSCTL_OFF + 320;
constexpr int LDS_BYTES = 147456;
constexpr int NWAVES = 8, NTHREADS = 512;

__device__ __forceinline__ unsigned f2bf(float f) { unsigned u = __builtin_bit_cast(unsigned, f); return (u + 0x7fffu + ((u >> 16) & 1u)) >> 16; }
typedef __bf16 bf16x2_t __attribute__((ext_vector_type(2)));
__device__ __forceinline__ unsigned pk2(float lo, float hi) { const f32x2 v = {lo, hi}; return __builtin_bit_cast(unsigned, __builtin_convertvector(v, bf16x2_t)); }
__device__ __forceinline__ float bf2f(unsigned short b) { return __builtin_bit_cast(float, (unsigned)b << 16); }
__device__ __forceinline__ float bflo(unsigned w) { return __builtin_bit_cast(float, w << 16); }
__device__ __forceinline__ float bfhi(unsigned w) { return __builtin_bit_cast(float, w & 0xffff0000u); }
__device__ __forceinline__ float fexp2(float x) { return __builtin_amdgcn_exp2f(x); }
__device__ __forceinline__ float fexp(float x) { return __builtin_amdgcn_exp2f(x * LOG2E); }
__device__ __forceinline__ float frcp(float x) { return __builtin_amdgcn_rcpf(x); }
__device__ __forceinline__ float frsq(float x) { return __builtin_amdgcn_rsqf(x); }
__device__ __forceinline__ float fsqrt(float x) { return __builtin_amdgcn_sqrtf(x); }
__device__ __forceinline__ float flog(float x) { return __builtin_amdgcn_logf(x) * 0.6931471805599453f; }
__device__ __forceinline__ float sigmoidf_(float x) { return frcp(1.0f + fexp(-x)); }
__device__ __forceinline__ float siluf_(float x) { return x * frcp(1.0f + fexp(-x)); }
__device__ __forceinline__ float gelu_tanh(float x) { const float z = 0.7978845608028654f * (x + 0.044715f * x * x * x); const float t = 1.0f - 2.0f * frcp(fexp(2.0f * z) + 1.0f); return 0.5f * x * (1.0f + t); }
__device__ __forceinline__ int crow(int r, int hh) { return (r & 3) + 8 * (r >> 2) + 4 * hh; }
__device__ __forceinline__ int cond_of_row(int row) { return row < MCTX ? 0 : 1 + ((row - MCTX) >> 12); }
#define LDS_WAIT() asm volatile("s_waitcnt lgkmcnt(0)" ::: "memory")
#define VM_WAIT() asm volatile("s_waitcnt vmcnt(0)" ::: "memory")
__device__ __forceinline__ s16x4 tr_read(lptr p) { typedef short v4i16_t __attribute__((ext_vector_type(4))); return __builtin_bit_cast(s16x4, __builtin_amdgcn_ds_read_tr16_b64_v4i16((LAS v4i16_t*)p)); }
__device__ __forceinline__ bf16x8 tr_frag(lptr p) { const s16x4 a = tr_read(p), b = tr_read(p + 512); return (bf16x8){a[0], a[1], a[2], a[3], b[0], b[1], b[2], b[3]}; }
__device__ __forceinline__ float shfl_idx(float v, int src_lane) { return __builtin_bit_cast(float, __builtin_amdgcn_ds_bpermute(src_lane << 2, __builtin_bit_cast(int, v))); }
__device__ __forceinline__ float shfl_x(float v, int lane, int mask) { return shfl_idx(v, lane ^ mask); }
__device__ __forceinline__ float wave_sum(float v, int lane) {
#pragma unroll
    for (int o = 1; o < 64; o <<= 1) v += shfl_x(v, lane, o);
    return v;
}

struct Params {
    const float* in[30];
    float* out; unsigned char* ws;
    int step_lo, step_hi;
};
enum { I_XP = 0, I_XS, I_C, I_CK, I_CV, I_SGLA, I_SLRU, I_CCTX, I_WADA, I_BADA, I_NMIX, I_NFFN, I_WINE, I_SINK, I_WALPHA, I_BALPHA, I_GGAIN, I_WOUTE,
       I_WINO, I_CONVW, I_CONVB, I_WGA, I_BGA, I_WGX, I_BGX, I_LAM, I_WOUTO, I_WF1, I_WF2, I_NFIN };

namespace pg8 {
constexpr int BM = 256, BK = 64, HALF = 128, HTB = HALF * BK * 2, STAGE_BYTES = 8 * HTB, NXCD = 8, WGM = 8;
__device__ __forceinline__ int lds_byte(int r, int c) { const int st = (r >> 4) * 2 + (c >> 5), rr = r & 15, cc = c & 31, ob = rr * 64 + cc * 2; return st * 1024 + (ob ^ (((ob >> 9) & 1) << 5)); }
__device__ __forceinline__ void stage_rc(int b, int& R, int& C) { const int st = b / 1024, sb = b % 1024, swz = sb ^ (((sb >> 9) & 1) << 5); R = (st >> 1) * 16 + swz / 64; C = (st & 1) * 32 + (swz % 64) / 2; }
__device__ __forceinline__ int perm32(int rho) { const int n = rho >> 4, i = rho & 15; return 8 * (i >> 2) + 4 * n + (i & 3); }
struct Unit { int pm, pn; };
struct Gemm { const bf16_t* A; const bf16_t* Bt; int lda, K, nM, nN, a_grp; bool perm; };
struct StaticOrder {
    int nM, nN, nwg, G, c;
    unsigned* queue; LAS unsigned* word;
    int rot;
    unsigned* ready; unsigned need; unsigned* fin;
    __device__ void init(int nM_, int nN_, int G_, int c_) { nM = nM_; nN = nN_; nwg = nM * nN; G = G_; c = c_; rot = 0; ready = nullptr; need = 0; fin = nullptr; queue = nullptr; word = nullptr; }
    __device__ __forceinline__ void a_ready(const Unit& u, int tid) const {
        if (ready == nullptr) return;
        if (tid < 64) { unsigned* p = ready + 16 * u.pm; unsigned sp = 0;
            while ((unsigned)__builtin_amdgcn_readfirstlane(__hip_atomic_load(p, __ATOMIC_RELAXED, __HIP_MEMORY_SCOPE_AGENT)) < need) { __builtin_amdgcn_s_sleep(2); if (++sp > (1u << 22)) break; }
            __builtin_amdgcn_fence(__ATOMIC_ACQUIRE, "agent");
            asm volatile("s_waitcnt vmcnt(0)" ::: "memory"); }
        asm volatile("" ::: "memory"); __builtin_amdgcn_s_barrier(); asm volatile("" ::: "memory");
    }
    __device__ __forceinline__ void unit_of(int j, Unit& u) const { const int x = c & 7, g = j / (5 * nN), jj = j % (5 * nN); u.pn = jj / 5; u.pm = 10 * x + 5 * g + jj % 5; }
    __device__ __forceinline__ bool fetch(int i, Unit& u, int tid) const {
        if (queue == nullptr) { const bool h = next(i, u); if (h) a_ready(u, tid); return h; }
        if (tid < 64) { unsigned j = 0; if (tid == 0) j = __hip_atomic_fetch_add(queue + 16 * (c & 7), 1u, __ATOMIC_RELAXED, __HIP_MEMORY_SCOPE_AGENT);
            j = (unsigned)__builtin_amdgcn_readfirstlane((int)j);
            if (j < (unsigned)(10 * nN) && ready != nullptr) { Unit t; unit_of((int)j, t); unsigned* p = ready + 16 * t.pm; unsigned sp = 0;
                while ((unsigned)__builtin_amdgcn_readfirstlane(__hip_atomic_load(p, __ATOMIC_RELAXED, __HIP_MEMORY_SCOPE_AGENT)) < need) { __builtin_amdgcn_s_sleep(2); if (++sp > (1u << 22)) break; }
                __builtin_amdgcn_fence(__ATOMIC_ACQUIRE, "agent"); asm volatile("s_waitcnt vmcnt(0)" ::: "memory"); }
            if (tid == 0) *word = j;
            asm volatile("s_waitcnt lgkmcnt(0)" ::: "memory"); }
        asm volatile("" ::: "memory"); __builtin_amdgcn_s_barrier(); asm volatile("" ::: "memory");
        const unsigned j = *(volatile LAS unsigned*)word;
        if (j >= (unsigned)(10 * nN)) return false;
        unit_of((int)j, u); return true;
    }
    __device__ __forceinline__ void done(const Unit& u, int lane) const {
        if (fin == nullptr) return;
        asm volatile("s_waitcnt vmcnt(0)" ::: "memory");
        if (lane == 0) __hip_atomic_fetch_add(fin + 16 * u.pm, 1u, __ATOMIC_RELAXED, __HIP_MEMORY_SCOPE_AGENT);
    }
    __device__ bool next(int i, Unit& u) const {
        if (G == 256 && nM == 80) { const int x = c & 7, j = i * 32 + (((c >> 3) + rot) & 31); if (j >= 10 * nN) return false;
            const int g = j / (5 * nN), jj = j % (5 * nN); u.pn = jj / 5; u.pm = 10 * x + 5 * g + jj % 5; return true; }
        const long L = (long)i * G + c; if (L >= nwg) return false;
        int wgid = (int)L; { const int q = nwg / NXCD, r = nwg % NXCD, xcd = wgid % NXCD, off = wgid / NXCD; wgid = (xcd < r ? xcd * (q + 1) : r * (q + 1) + (xcd - r) * q) + off; }
        const int nig = WGM * nN, gid = wgid / nig, fm = gid * WGM, gsz = (nM - fm) < WGM ? (nM - fm) : WGM;
        u.pm = fm + ((wgid % nig) % gsz); u.pn = (wgid % nig) / gsz; return true;
    }
};

template <class Epi>
__device__ __forceinline__ void gemm_phase(lptr lds, const int tid, const float zf, const Gemm g, const StaticOrder& S, const Epi& E) {
    const int wid = __builtin_amdgcn_readfirstlane(tid >> 6), lane = tid & 63, wr = wid >> 2, wc = wid & 3, fr = lane & 15, fq = lane >> 4;
    const int K = g.K, nt = K / BK, lda = g.lda;
    unsigned voffA[2], voffB[2];
#pragma unroll
    for (int i = 0; i < 2; ++i) { int R, C; stage_rc(tid * 16 + i * 8192, R, C); const int Rb = g.perm ? ((R & ~31) + perm32(R & 31)) : R;
        voffA[i] = (unsigned)(R * lda + C) * 2u; voffB[i] = (unsigned)(Rb * K + C) * 2u; }
    const size_t kstep = (size_t)(BK * 2);
    const size_t hsA = (size_t)HALF * lda * 2, hsB = (size_t)HALF * K * 2;
    const unsigned ldsw = (unsigned)wid * 1024u;
    const int aoff = lds_byte(wr * 64 + fr, fq * 8), boff = lds_byte(wc * 32 + fr, fq * 8);
#define PG8_SA(b, h) (((b) * 2 + (h)) * HTB)
#define PG8_SB(b, h) ((4 + (b) * 2 + (h)) * HTB)
#define PG8_STAGE(bufoff, gbase, voff) do { _Pragma("unroll") for (int _i = 0; _i < 2; ++_i) \
        __builtin_amdgcn_global_load_lds((const unsigned*)((const char*)(gbase) + (voff)[_i]), (LAS unsigned*)(lds + (bufoff) + ldsw + _i * 8192), 16, 0, 0); } while (0)
#define PG8_LDA(dst, b, h) do { _Pragma("unroll") for (int m = 0; m < 4; ++m) _Pragma("unroll") for (int k = 0; k < 2; ++k) dst[m][k] = *(const LAS bf16x8*)(lds + PG8_SA(b, h) + aoff + m * 2048 + k * 1024); } while (0)
#define PG8_LDB(dst, b, h) do { _Pragma("unroll") for (int n = 0; n < 2; ++n) _Pragma("unroll") for (int k = 0; k < 2; ++k) dst[n][k] = *(const LAS bf16x8*)(lds + PG8_SB(b, h) + boff + n * 2048 + k * 1024); } while (0)
#define PG8_MMA(ai, bj, At, Bt) do { __builtin_amdgcn_s_setprio(1); _Pragma("unroll") for (int m = 0; m < 4; ++m) _Pragma("unroll") for (int n = 0; n < 2; ++n) _Pragma("unroll") for (int k = 0; k < 2; ++k) \
        acc[ai][bj][m][n] = __builtin_amdgcn_mfma_f32_16x16x32_bf16(Bt[n][k], At[m][k], acc[ai][bj][m][n], 0, 0, 0); __builtin_amdgcn_s_setprio(0); } while (0)
#define PG8_WAIT_V(n) asm volatile("s_waitcnt vmcnt(" #n ")" ::: "memory")
#define PG8_WAIT_L(n) asm volatile("s_waitcnt lgkmcnt(" #n ")" ::: "memory")
#define PG8_BAR __builtin_amdgcn_s_barrier()
#define PG8_SCHED __builtin_amdgcn_sched_barrier(0)
#define PG8_ABASE(u) ((const char*)g.A + ((size_t)(u).pm * BM * lda + (g.a_grp ? (size_t)((u).pn / g.a_grp) * K : 0)) * 2)
#define PG8_BBASE(u) ((const char*)g.Bt + (size_t)(u).pn * BM * K * 2)
    Unit cur, nxt; int ui = 0;
    if (!S.fetch(0, cur, tid)) return;
    f32x4 acc[2][2][4][2];
#pragma unroll
    for (int a = 0; a < 2; ++a)
#pragma unroll
        for (int b = 0; b < 2; ++b)
#pragma unroll
            for (int m = 0; m < 4; ++m)
#pragma unroll
                for (int n = 0; n < 2; ++n) acc[a][b][m][n] = (f32x4){zf, zf, zf, zf};
    bf16x8 At[4][2], B0[2][2], B1[2][2];
    const char* cA = PG8_ABASE(cur); const char* cB = PG8_BBASE(cur);
    PG8_STAGE(PG8_SB(0, 0), cB, voffB); PG8_STAGE(PG8_SB(0, 1), cB + hsB, voffB); PG8_STAGE(PG8_SA(0, 0), cA, voffA); PG8_STAGE(PG8_SA(0, 1), cA + hsA, voffA);
    if (wr == 1) PG8_BAR;
    PG8_WAIT_V(2); PG8_BAR;
    PG8_STAGE(PG8_SB(1, 0), cB + kstep, voffB); PG8_STAGE(PG8_SA(1, 0), cA + kstep, voffA); PG8_STAGE(PG8_SB(1, 1), cB + hsB + kstep, voffB);
    PG8_WAIT_V(6); PG8_BAR;
    for (;;) {
        bool has_next = false; const char* nA = cA; const char* nB = cB;
#pragma unroll 1
        for (int t = 0; t < nt; t += 2) {
            const bool last = (t == nt - 2);
            if (last) { has_next = S.fetch(ui + 1, nxt, tid); if (has_next) { nA = PG8_ABASE(nxt); nB = PG8_BBASE(nxt); } }
            const char* a1 = cA + (size_t)(t + 1) * kstep;
            const char* a2 = last ? nA : cA + (size_t)(t + 2) * kstep; const char* b2 = last ? nB : cB + (size_t)(t + 2) * kstep;
            const char* a3 = a2 + kstep; const char* b3 = b2 + kstep;
            PG8_LDB(B0, 0, 0); PG8_LDB(B1, 0, 1); PG8_SCHED; PG8_LDA(At, 0, 0); PG8_STAGE(PG8_SA(1, 1), a1 + hsA, voffA);
            PG8_WAIT_V(8); PG8_WAIT_L(0); PG8_BAR; PG8_MMA(0, 0, At, B0); PG8_MMA(0, 1, At, B1); PG8_BAR; PG8_SCHED;
            PG8_LDA(At, 0, 1); PG8_STAGE(PG8_SB(0, 0), b2, voffB); PG8_STAGE(PG8_SB(0, 1), b2 + hsB, voffB); PG8_STAGE(PG8_SA(0, 0), a2, voffA);
            PG8_WAIT_V(8); PG8_WAIT_L(0); PG8_BAR; PG8_MMA(1, 0, At, B0); PG8_MMA(1, 1, At, B1); PG8_BAR; PG8_SCHED;
            PG8_LDB(B0, 1, 0); PG8_LDB(B1, 1, 1); PG8_SCHED; PG8_LDA(At, 1, 0); PG8_STAGE(PG8_SA(0, 1), a2 + hsA, voffA);
            PG8_WAIT_V(8); PG8_WAIT_L(0); PG8_BAR; PG8_MMA(0, 0, At, B0); PG8_MMA(0, 1, At, B1); PG8_BAR; PG8_SCHED;
            PG8_LDA(At, 1, 1); PG8_STAGE(PG8_SB(1, 0), b3, voffB); PG8_STAGE(PG8_SB(1, 1), b3 + hsB, voffB); PG8_STAGE(PG8_SA(1, 0), a3, voffA);
            PG8_WAIT_V(8); PG8_WAIT_L(0); PG8_BAR; PG8_MMA(1, 0, At, B0); PG8_MMA(1, 1, At, B1); PG8_BAR; PG8_SCHED;
        }
        if (wr == 0) PG8_BAR;
        { int fr_ = fr, fq_ = fq; asm volatile("" : "+v"(fr_), "+v"(fq_)); E(acc, cur, wr, wc, fr_, fq_); S.done(cur, fq_ * 16 + fr_); }
        if (!has_next) break;
#pragma unroll
        for (int a = 0; a < 2; ++a)
#pragma unroll
            for (int b = 0; b < 2; ++b)
#pragma unroll
                for (int m = 0; m < 4; ++m)
#pragma unroll
                    for (int n = 0; n < 2; ++n) acc[a][b][m][n] = (f32x4){zf, zf, zf, zf};
        cur = nxt; cA = nA; cB = nB; ++ui;
        if (wr == 1) PG8_BAR;
    }
    PG8_WAIT_V(0);
    PG8_BAR;
#undef PG8_SA
#undef PG8_SB
#undef PG8_STAGE
#undef PG8_LDA
#undef PG8_LDB
#undef PG8_MMA
#undef PG8_WAIT_V
#undef PG8_WAIT_L
#undef PG8_BAR
#undef PG8_SCHED
#undef PG8_ABASE
#undef PG8_BBASE
}
}

enum EpiKind { EK_EVEN_IN = 0, EK_ODD_IN, EK_GATES, EK_RES, EK_SWIGLU };
template <int kind> struct Epi {
    int layer, sub; int gidx;
    const Params* p; int oz;
#define EWS(T, off) ((T*)(p->ws + ((size_t)(off) + (size_t)oz)))
#define EIN(i) (p->in[(i) + oz])
#define NORM_FIX_SETUP(NIDX, BOFF, NTOT) float rs_[2][4]; f32x4 bia_[2][2]; { const float* sq_ = p->out + oz + SSQP_OFF + (size_t)(NIDX) * M * 16; \
        _Pragma("unroll") for (int ai = 0; ai < 2; ++ai) _Pragma("unroll") for (int m = 0; m < 4; ++m) { const f32x4 a_ = *(const f32x4*)(sq_ + (size_t)(row0 + ai * 128 + m * 16) * 16 + 4 * fq); \
            float s_ = (a_[0] + a_[1]) + (a_[2] + a_[3]); s_ += shfl_x(s_, fq * 16 + fr, 16); s_ += shfl_x(s_, fq * 16 + fr, 32); rs_[ai][m] = frsq(s_ * (1.0f / D) + EPS); }     \
        const float* bp_ = EWS(const float, WS_BIAS) + (BOFF) + (size_t)cond_of_row(u.pm * 256) * (NTOT) + u.pn * 256 + wc * 32 + 8 * fq; \
        _Pragma("unroll") for (int bj = 0; bj < 2; ++bj) _Pragma("unroll") for (int n = 0; n < 2; ++n) bia_[bj][n] = *(const f32x4*)(bp_ + bj * 128 + 4 * n); }
#define FIXV(ai, bj, m, n) (acc[ai][bj][m][n] * rs_[ai][m] + bia_[bj][n])
    __device__ __forceinline__ void operator()(const f32x4 (&acc)[2][2][4][2], const pg8::Unit& u, int wr, int wc, int fr, int fq) const {
        const int row0 = u.pm * 256 + wr * 64 + fr;
        float* const X = p->out + oz;
        if constexpr (kind == EK_RES) {
            const float* mod = EWS(const float, WS_MOD);
            const int ci = cond_of_row(u.pm * 256);
            const float* gate = mod + ((size_t)(layer * 5 + ci) * 6 + gidx) * 1024;
            const int col0 = u.pn * 256 + wc * 32 + 8 * fq;
            const int nn = (gidx == 2) ? 2 * layer + 1 : 2 * layer + 2;
            const bool fin = nn == 8;
            const float* nw = (gidx == 2) ? EIN(I_NFFN) + layer * 1024 : (fin ? EIN(I_NFIN) : EIN(I_NMIX) + (layer + 1) * 1024);
            const float* scv = mod + ((size_t)((gidx == 2 ? layer : (fin ? layer : layer + 1)) * 5 + ci) * 6 + (gidx == 2 ? 4 : 1)) * 1024;
            f32x4 gv[2][2], gp[2][2];
#pragma unroll
            for (int bj = 0; bj < 2; ++bj)
#pragma unroll
                for (int n = 0; n < 2; ++n) { gv[bj][n] = *(const f32x4*)(gate + col0 + bj * 128 + n * 4);
                    gp[bj][n] = *(const f32x4*)(nw + col0 + bj * 128 + n * 4); if (!fin) gp[bj][n] = gp[bj][n] * (1.0f + *(const f32x4*)(scv + col0 + bj * 128 + n * 4)); }
            bf16_t* XN = EWS(bf16_t, WS_XN); float* ssq = (fin ? EWS(float, WS_SSQ8) : p->out + oz + SSQP_OFF + (size_t)nn * M * 16) + u.pn * 4 + wc;
            const int lane_ = fq * 16 + fr;
            bf16_t* Xb = (bf16_t*)X; const bool from_in = (layer == 0 && gidx == 2);
            const float* Xr = u.pm < 16 ? EIN(I_XP) : EIN(I_XS) - (size_t)MCTX * D;
#pragma unroll
            for (int h8 = 0; h8 < 4; ++h8) { const int ai = h8 >> 1, mb = (h8 & 1) * 2;
                f32x4 xo[2][2][2];
                if (from_in) {
#pragma unroll
                    for (int mm = 0; mm < 2; ++mm)
#pragma unroll
                        for (int bj = 0; bj < 2; ++bj)
#pragma unroll
                            for (int n = 0; n < 2; ++n) xo[mm][bj][n] = *(const f32x4*)(Xr + (size_t)(row0 + ai * 128 + (mb + mm) * 16) * D + col0 + bj * 128 + n * 4);
                } else { u32x4 xw[2][2];
#pragma unroll
                    for (int mm = 0; mm < 2; ++mm)
#pragma unroll
                        for (int bj = 0; bj < 2; ++bj) xw[mm][bj] = *(const u32x4*)(Xb + (size_t)(row0 + ai * 128 + (mb + mm) * 16) * D + col0 + bj * 128);
#pragma unroll
                    for (int mm = 0; mm < 2; ++mm)
#pragma unroll
                        for (int bj = 0; bj < 2; ++bj) { const u32x4 w = xw[mm][bj]; xo[mm][bj][0] = (f32x4){bflo(w.x), bfhi(w.x), bflo(w.y), bfhi(w.y)}; xo[mm][bj][1] = (f32x4){bflo(w.z), bfhi(w.z), bflo(w.w), bfhi(w.w)}; } }
#pragma unroll
                for (int mm = 0; mm < 2; ++mm) { const int m = mb + mm; const int row = row0 + ai * 128 + m * 16; float sq = 0.f;
#pragma unroll
                    for (int bj = 0; bj < 2; ++bj) { const f32x4 x0 = xo[mm][bj][0] + gv[bj][0] * acc[ai][bj][m][0], x1 = xo[mm][bj][1] + gv[bj][1] * acc[ai][bj][m][1];
                        *(u32x4*)((fin ? EWS(bf16_t, WS_XF) : Xb) + (size_t)row * D + col0 + bj * 128) = (u32x4){pk2(x0[0], x0[1]), pk2(x0[2], x0[3]), pk2(x1[0], x1[1]), pk2(x1[2], x1[3])};
                        sq += ((x0[0] * x0[0] + x0[1] * x0[1]) + (x0[2] * x0[2] + x0[3] * x0[3])) + ((x1[0] * x1[0] + x1[1] * x1[1]) + (x1[2] * x1[2] + x1[3] * x1[3]));
                        if (!fin) { const f32x4 y0 = x0 * gp[bj][0], y1 = x1 * gp[bj][1]; const u32x4 w = (u32x4){pk2(y0[0], y0[1]), pk2(y0[2], y0[3]), pk2(y1[0], y1[1]), pk2(y1[2], y1[3])};
                            bf16_t* xp = XN + (size_t)row * D + col0 + bj * 128;
                            asm volatile("global_store_dwordx4 %0, %1, off sc1\n\ts_nop 1" :: "v"(xp), "v"(w) : "memory"); } }
                    sq += shfl_x(sq, lane_, 16); sq += shfl_x(sq, lane_, 32);
                    if (fq == 0) __hip_atomic_store(ssq + (size_t)row * 16, sq, __ATOMIC_RELAXED, __HIP_MEMORY_SCOPE_AGENT); }
            }
        } else if constexpr (kind == EK_SWIGLU) {
            bf16_t* H = EWS(bf16_t, WS_H); const int col0 = u.pn * 128 + wc * 32 + 8 * fq;
            NORM_FIX_SETUP(2 * layer + 1, BIAS_F + (size_t)layer * 5 * 5632, 5632)
#pragma unroll
            for (int ai = 0; ai < 2; ++ai)
#pragma unroll
                for (int m = 0; m < 4; ++m) { const f32x4 g0 = FIXV(ai, 0, m, 0), g1 = FIXV(ai, 0, m, 1), u0 = FIXV(ai, 1, m, 0), u1 = FIXV(ai, 1, m, 1);
                    u32x4 w; w.x = pk2(siluf_(g0[0]) * u0[0], siluf_(g0[1]) * u0[1]); w.y = pk2(siluf_(g0[2]) * u0[2], siluf_(g0[3]) * u0[3]);
                    w.z = pk2(siluf_(g1[0]) * u1[0], siluf_(g1[1]) * u1[1]); w.w = pk2(siluf_(g1[2]) * u1[2], siluf_(g1[3]) * u1[3]);
                    bf16_t* hp = H + (size_t)(row0 + ai * 128 + m * 16) * DFF + col0;
                    asm volatile("global_store_dwordx4 %0, %1, off sc1\n\ts_nop 1" :: "v"(hp), "v"(w) : "memory"); }
        } else if constexpr (kind == EK_ODD_IN) {
            const bool isg = u.pn < 4; bf16_t* O = isg ? EWS(bf16_t, WS_G) : EWS(bf16_t, WS_U); const int colt = (isg ? u.pn : u.pn - 4) * 256 + wc * 32 + 8 * fq;
            NORM_FIX_SETUP(2 * layer, BIAS_O + (size_t)sub * 5 * 2048, 2048)
#pragma unroll
            for (int ai = 0; ai < 2; ++ai)
#pragma unroll
                for (int m = 0; m < 4; ++m) { bf16_t* rowp = O + (size_t)(row0 + ai * 128 + m * 16) * D + colt;
#pragma unroll
                    for (int bj = 0; bj < 2; ++bj) { f32x4 v0 = FIXV(ai, bj, m, 0), v1 = FIXV(ai, bj, m, 1);
                        if (isg) {
#pragma unroll
                            for (int j = 0; j < 4; ++j) { v0[j] = gelu_tanh(v0[j]); v1[j] = gelu_tanh(v1[j]); } }
                        u32x4 w; w.x = pk2(v0[0], v0[1]); w.y = pk2(v0[2], v0[3]); w.z = pk2(v1[0], v1[1]); w.w = pk2(v1[2], v1[3]);
                        *(u32x4*)(rowp + bj * 128) = w; } }
        } else if constexpr (kind == EK_GATES) {
            const int blk = u.pn >> 2, t = u.pn & 3, dir = t >> 1, half = t & 1;
            const int ch0 = blk * 256 + half * 128 + wc * 32 + 8 * fq;
            const size_t pofs = (size_t)(sub * 2 + dir) * 1024 + ch0;
            bf16_t* AC = dir ? EWS(bf16_t, WS_LAB) : EWS(bf16_t, WS_LAF); bf16_t* HL = dir ? EWS(bf16_t, WS_BB) : EWS(bf16_t, WS_U);
            const bf16_t* uc = EWS(const bf16_t, WS_UC); const float* ba = EIN(I_BGA); const float* bx = EIN(I_BGX); const float* lam = EIN(I_LAM); float* agg = EWS(float, WS_AGG);
            const int lane_ = fq * 16 + fr;
#define DPPF(old, x, ctrl) __builtin_bit_cast(float, __builtin_amdgcn_update_dpp(__builtin_bit_cast(int, (float)(old)), __builtin_bit_cast(int, (float)(x)), (ctrl), 0xf, 0xf, false))
#define SCAN_STEP(ctrl) { const float Ap = DPPF(1.0f, A[q], ctrl), Hp = DPPF(0.0f, H[q], ctrl); H[q] = A[q] * Hp + H[q]; A[q] *= Ap; }
#define GATE_GROUP(m, C1, C2, C4, C8, LASTLANE) { const size_t ro = (size_t)(row0 + ai * 128 + (m) * 16) * D + ch0; \
                const u32x4 ucw = *(const u32x4*)(uc + ro); \
                const float ucv[8] = {bflo(ucw.x), bfhi(ucw.x), bflo(ucw.y), bfhi(ucw.y), bflo(ucw.z), bfhi(ucw.z), bflo(ucw.w), bfhi(ucw.w)}; \
                float A[8], H[8]; \
                _Pragma("unroll") for (int q = 0; q < 8; ++q) { const float r = sigmoidf_(acc[ai][0][m][q >> 2][q & 3] + ba_[q]), ig = sigmoidf_(acc[ai][1][m][q >> 2][q & 3] + bx_[q]); \
                    const float av = fexp2(c8_[q] * r); A[q] = av; H[q] = fsqrt(fmaxf(1.0f - av * av, 0.0f)) * ig * ucv[q]; } \
                _Pragma("unroll") for (int q = 0; q < 8; ++q) { SCAN_STEP(C1) SCAN_STEP(C2) SCAN_STEP(C4) SCAN_STEP(C8) } \
                _Pragma("unroll") for (int q = 0; q < 8; ++q) { H[q] = A[q] * Hc[q] + H[q]; A[q] *= Ac[q]; } \
                *(u32x4*)(AC + ro) = (u32x4){pk2(A[0], A[1]), pk2(A[2], A[3]), pk2(A[4], A[5]), pk2(A[6], A[7])}; \
                *(u32x4*)(HL + ro) = (u32x4){pk2(H[0], H[1]), pk2(H[2], H[3]), pk2(H[4], H[5]), pk2(H[6], H[7])}; \
                _Pragma("unroll") for (int q = 0; q < 8; ++q) { Ac[q] = shfl_idx(A[q], (LASTLANE)); Hc[q] = shfl_idx(H[q], (LASTLANE)); } }
            float ba_[8], bx_[8], c8_[8];
#pragma unroll
            for (int q = 0; q < 8; ++q) { ba_[q] = ba[pofs + q]; bx_[q] = bx[pofs + q]; c8_[q] = -8.0f * LOG2E * flog(1.0f + fexp(-lam[pofs + q])); }
#pragma unroll
            for (int ai = 0; ai < 2; ++ai) {
                float Ac[8], Hc[8];
#pragma unroll
                for (int q = 0; q < 8; ++q) { Ac[q] = 1.0f; Hc[q] = 0.0f; }
                if (dir == 0) { GATE_GROUP(0, 0x111, 0x112, 0x114, 0x118, (lane_ & 48) | 15) GATE_GROUP(1, 0x111, 0x112, 0x114, 0x118, (lane_ & 48) | 15)
                                GATE_GROUP(2, 0x111, 0x112, 0x114, 0x118, (lane_ & 48) | 15) GATE_GROUP(3, 0x111, 0x112, 0x114, 0x118, (lane_ & 48) | 15) }
                else          { GATE_GROUP(3, 0x101, 0x102, 0x104, 0x108, lane_ & 48) GATE_GROUP(2, 0x101, 0x102, 0x104, 0x108, lane_ & 48)
                                GATE_GROUP(1, 0x101, 0x102, 0x104, 0x108, lane_ & 48) GATE_GROUP(0, 0x101, 0x102, 0x104, 0x108, lane_ & 48) }
                if (fr == 0) { float* ag = agg + ((size_t)((u.pm * 4 + ai * 2 + wr) * 2 + dir) * 1024 + ch0) * 2;
#pragma unroll
                    for (int q = 0; q < 8; q += 2) *(f32x4*)(ag + 2 * q) = (f32x4){Ac[q], Hc[q], Ac[q + 1], Hc[q + 1]}; }
            }
#undef GATE_GROUP
#undef SCAN_STEP
#undef DPPF
        } else {
            bf16_t* ZE = EWS(bf16_t, WS_ZE); const int pn = u.pn; const bool lat = u.pm >= 16; float* lr = EWS(float, WS_LR); const float* rope = EWS(const float, WS_ROPE);
            NORM_FIX_SETUP(2 * layer, BIAS_E + (size_t)sub * 5 * 2560, 2560)
            if (pn == 9) {
                if (wc == 0) {
#pragma unroll
                    for (int ai = 0; ai < 2; ++ai)
#pragma unroll
                        for (int m = 0; m < 4; ++m) { float* p = lr + (size_t)(row0 + ai * 128 + m * 16) * 32 + 8 * fq; *(f32x4*)p = FIXV(ai, 0, m, 0); *(f32x4*)(p + 4) = FIXV(ai, 0, m, 1); }
                }
            } else if (pn <= 2) {
                const int half = wc & 1;
#pragma unroll
                for (int ai = 0; ai < 2; ++ai)
#pragma unroll
                    for (int m = 0; m < 4; ++m) { const int row = row0 + ai * 128 + m * 16;
                        const int tpos = (row - MCTX) & 4095; const int pos = half ? (tpos & 63) : (tpos >> 6);
                        f32x4 cs[4];
                        if (lat) {
#pragma unroll
                            for (int q = 0; q < 4; ++q) cs[q] = *(const f32x4*)(rope + (size_t)(pos * 16 + 8 * (fq & 1)) * 2 + q * 4);
                        }
#pragma unroll
                        for (int bj = 0; bj < 2; ++bj) { f32x4 v0 = FIXV(ai, bj, m, 0), v1 = FIXV(ai, bj, m, 1);
                            const bool isv = (pn == 2 && bj == 1), isk = (pn == 2 && bj == 0);
                            if (pn == 2 && !lat) {
                                const int b = row >> 8, tt = row & 255; const int kc = wc * 32 + 8 * fq;
                                float* dst = X + (isv ? OUT_CV : OUT_CK) + ((size_t)(b * 2 + sub) * 256 + tt) * 128 + kc;
                                *(f32x4*)dst = v0; *(f32x4*)(dst + 4) = v1;
                            }
                            if (lat && !isv) {
                                float x[8] = {v0[0], v0[1], v0[2], v0[3], v1[0], v1[1], v1[2], v1[3]}; float o[8];
#pragma unroll
                                for (int q = 0; q < 8; ++q) { const float pr = shfl_x(x[q], fq * 16 + fr, 32); const float c = cs[q >> 1][(q & 1) * 2], s = cs[q >> 1][(q & 1) * 2 + 1];
                                    o[q] = x[q] * c + (fq < 2 ? -pr : pr) * s; }
                                v0 = (f32x4){o[0], o[1], o[2], o[3]}; v1 = (f32x4){o[4], o[5], o[6], o[7]};
                            }
                            if (!isk && !isv) { v0 *= QSCALE; v1 *= QSCALE; }
                            u32x4 w; w.x = pk2(v0[0], v0[1]); w.y = pk2(v0[2], v0[3]); w.z = pk2(v1[0], v1[1]); w.w = pk2(v1[2], v1[3]);
                            *(u32x4*)(ZE + (size_t)row * ZW + pn * 256 + bj * 128 + wc * 32 + 8 * fq) = w; } }
            } else {
                const float sc = (pn == 3) ? 0.125f : 1.0f; const bool act = pn >= 7;
#pragma unroll
                for (int ai = 0; ai < 2; ++ai)
#pragma unroll
                    for (int m = 0; m < 4; ++m) { bf16_t* rowp = ZE + (size_t)(row0 + ai * 128 + m * 16) * ZW + pn * 256 + wc * 32 + 8 * fq;
#pragma unroll
                        for (int bj = 0; bj < 2; ++bj) { f32x4 v0 = FIXV(ai, bj, m, 0) * sc, v1 = FIXV(ai, bj, m, 1) * sc;
                            if (act) {
#pragma unroll
                                for (int j = 0; j < 4; ++j) { v0[j] = siluf_(v0[j]); v1[j] = siluf_(v1[j]); } }
                            u32x4 w; w.x = pk2(v0[0], v0[1]); w.y = pk2(v0[2], v0[3]); w.z = pk2(v1[0], v1[1]); w.w = pk2(v1[2], v1[3]);
                            *(u32x4*)(rowp + bj * 128) = w; } }
            }
        }
    }
#undef EWS
#undef EIN
#undef NORM_FIX_SETUP
#undef FIXV
};

#define XB_TMO      128
#define XB_XCNT(j)  (256  + 64 * (j))
#define XB_XSUB(j)  (1280 + 64 * (j))
#define XB_XGEN(j)  (2304 + 64 * (j))
#define XB_TOP      3328
#define XB_TOPGEN   3392
#define XCD_BAR_WORDS 3456
#define XB_SPIN_CAP (1u << 18)
__device__ __forceinline__ unsigned xb_ld(unsigned* p)              { return __hip_atomic_load(p, __ATOMIC_RELAXED, __HIP_MEMORY_SCOPE_AGENT); }
__device__ __forceinline__ unsigned xb_add(unsigned* p, unsigned v) { return __hip_atomic_fetch_add(p, v, __ATOMIC_RELAXED, __HIP_MEMORY_SCOPE_AGENT); }
__device__ __forceinline__ unsigned xb_xcc_id() { return (unsigned)__builtin_amdgcn_s_getreg((3 << 11) | 20) & 0xFu; }
#define XB_SPIN(cond, bar) do { unsigned _sp = 0; while (cond) { __builtin_amdgcn_s_sleep(1); \
    if ((++_sp & 255u) == 0u) { if (xb_ld(&(bar)[XB_TMO])) break; if (_sp > XB_SPIN_CAP) { atomicAdd(&(bar)[XB_TMO], 1u); break; } } } } while (0)
struct XcdBarrier { unsigned* bar; unsigned x; volatile LAS unsigned* st; };
__device__ __forceinline__ XcdBarrier xcd_barrier_post(unsigned* bar, volatile LAS unsigned* st) {
    XcdBarrier b; b.bar = bar; b.x = xb_xcc_id(); b.st = st;
    if (threadIdx.x == 0) (void)xb_add(&bar[XB_XCNT(b.x)], 1u);
    return b;
}
__device__ __forceinline__ void xcd_barrier_complete(unsigned* bar, unsigned x, unsigned& nloc, unsigned& nx) {
    const unsigned G = gridDim.x * gridDim.y * gridDim.z;
    unsigned sum, cnt, mine, sp = 0u;
    for (;;) {
        sum = 0u; cnt = 0u; mine = 0u;
#pragma unroll
        for (unsigned j = 0; j < 16; ++j) { const unsigned c = xb_ld(&bar[XB_XCNT(j)]); sum += c; cnt += (c > 0u) ? 1u : 0u; mine = (j == x) ? c : mine; }
        if (sum == G) break;
        __builtin_amdgcn_s_sleep(1);
        if ((++sp & 255u) == 0u) { if (xb_ld(&bar[XB_TMO])) break; if (sp > XB_SPIN_CAP) { atomicAdd(&bar[XB_TMO], 1u); break; } }
    }
    nloc = mine > 0u ? mine : 1u; nx = cnt > 0u ? cnt : 1u;
}
__device__ __forceinline__ void xcd_barrier(const XcdBarrier& b, const int tid) {
    asm volatile("s_waitcnt vmcnt(0)" ::: "memory");
    __syncthreads();
    if (tid == 0) {
        unsigned* bar = b.bar;
        __builtin_amdgcn_s_waitcnt(0);
        unsigned nloc = b.st[0], nx = b.st[1];
        if (nloc == 0u) { xcd_barrier_complete(bar, b.x, nloc, nx); b.st[0] = nloc; b.st[1] = nx; }
        const unsigned old = xb_add(&bar[XB_XSUB(b.x)], 1u);
        const unsigned gen = old / nloc;
        if (old + 1u == (gen + 1u) * nloc) {
            __builtin_amdgcn_fence(__ATOMIC_RELEASE, "agent");
            asm volatile("s_waitcnt vmcnt(0)" ::: "memory");
            const unsigned og = xb_add(&bar[XB_TOP], 1u);
            const unsigned tg = og / nx;
            if (og + 1u == (tg + 1u) * nx) xb_add(&bar[XB_TOPGEN], 1u);
            else XB_SPIN(xb_ld(&bar[XB_TOPGEN]) == tg, bar);
            __builtin_amdgcn_fence(__ATOMIC_ACQUIRE, "agent");
            xb_add(&bar[XB_XGEN(b.x)], 1u);
            asm volatile("s_waitcnt vmcnt(0)" ::: "memory");
        } else {
            XB_SPIN(xb_ld(&bar[XB_XGEN(b.x)]) == gen, bar);
            __builtin_amdgcn_fence(__ATOMIC_ACQUIRE, "agent");
            asm volatile("s_waitcnt vmcnt(0)" ::: "memory");
        }
    }
    __syncthreads();
}

struct Frame {
    lptr lds; int tid, lane, wave, vcu, G;
    const Params* p; float* out; int oz, bid;
};
#define FIN(i) (F.p->in[(i) + F.oz])
#define WSP(T, off) ((T*)(F.p->ws + ((size_t)(off) + (size_t)F.oz)))

__device__ __forceinline__ void transpose_block(const float* src, int ldw, bf16_t* dst, int ldt, LAS float* scr, int lane) {
#pragma unroll
    for (int hb = 0; hb < 2; ++hb) { float tv[16];
#pragma unroll
        for (int i = 0; i < 16; ++i) { const int kk = 2 * (16 * hb + i) + (lane >> 5); tv[i] = src[(size_t)kk * ldw + (lane & 31)]; }
#pragma unroll
        for (int i = 0; i < 16; ++i) { const int kk = 2 * (16 * hb + i) + (lane >> 5); scr[kk * 33 + (lane & 31)] = tv[i]; } }
    LDS_WAIT(); asm volatile("" ::: "memory");
    const int c = lane & 7;
#pragma unroll
    for (int j = 0; j < 4; ++j) { const int n = (lane >> 3) + 8 * j; const LAS float* s = scr + (8 * c) * 33 + n;
        u32x4 o; o.x = pk2(s[0 * 33], s[1 * 33]); o.y = pk2(s[2 * 33], s[3 * 33]); o.z = pk2(s[4 * 33], s[5 * 33]); o.w = pk2(s[6 * 33], s[7 * 33]);
        *(u32x4*)(dst + (size_t)n * ldt + 8 * c) = o; }
    LDS_WAIT(); asm volatile("" ::: "memory");
}
constexpr int IT_WINE = 16 * 73, IT_SQ = 512, IT_WINO = 1024, IT_GATES = 512, IT_F1 = 16 * 176, IT_F2 = 44 * 32;
constexpr int IT_E = IT_WINE + IT_SQ, IT_O = IT_WINO + IT_GATES + IT_SQ, IT_L = IT_F1 + IT_F2;
constexpr int IT_TOTAL = 2 * IT_E + 2 * IT_O + 4 * IT_L;

__device__ __forceinline__ void convert_item(Frame& F, int it, LAS float* scr) {
    const float* src; int ldw; bf16_t* dst; int ldt;
    if (it < 2 * IT_E) {
        const int e = it / IT_E; int r = it % IT_E;
        if (r < IT_WINE) { const int kb = r / 73, nb = r % 73;
            src = FIN(I_WINE) + (size_t)e * D * PE + (size_t)(64 * kb) * PE + 32 * nb; ldw = PE; dst = WSP(bf16_t, WS_WINE) + (size_t)e * PEP * D + (size_t)(32 * nb) * D + 64 * kb; ldt = D;
        } else { r -= IT_WINE; const int kb = r / 32, nb = r % 32;
            src = FIN(I_WOUTE) + (size_t)e * D * D + (size_t)(64 * kb) * D + 32 * nb; ldw = D; dst = WSP(bf16_t, WS_WOUTE) + (size_t)e * D * D + (size_t)(32 * nb) * D + 64 * kb; ldt = D; }
    } else if (it < 2 * IT_E + 2 * IT_O) {
        const int i2 = it - 2 * IT_E; const int o = i2 / IT_O; int r = i2 % IT_O;
        if (r < IT_WINO) { const int kb = r / 64, nb = r % 64;
            src = FIN(I_WINO) + (size_t)o * D * 2048 + (size_t)(64 * kb) * 2048 + 32 * nb; ldw = 2048; dst = WSP(bf16_t, WS_WINO) + (size_t)o * 2048 * D + (size_t)(32 * nb) * D + 64 * kb; ldt = D;
        } else if (r < IT_WINO + IT_GATES) { r -= IT_WINO;
            const int mat = r >> 5, q = r & 31, kb = q >> 3, nb = q & 7; const int isx = mat >> 3, dir = (mat >> 2) & 1, blk = mat & 3;
            src = FIN(isx ? I_WGX : I_WGA) + ((size_t)((o * 2 + dir) * 4 + blk)) * 65536 + (size_t)(64 * kb) * 256 + 32 * nb; ldw = 256;
            const int d0 = 32 * nb, half = d0 >> 7; const int drow = blk * 1024 + (dir * 2 + half) * 256 + isx * 128 + (d0 & 127);
            dst = WSP(bf16_t, WS_WG) + (size_t)o * 4096 * 256 + (size_t)drow * 256 + 64 * kb; ldt = 256;
        } else { r -= IT_WINO + IT_GATES; const int kb = r / 32, nb = r % 32;
            src = FIN(I_WOUTO) + (size_t)o * D * D + (size_t)(64 * kb) * D + 32 * nb; ldw = D; dst = WSP(bf16_t, WS_WOUTO) + (size_t)o * D * D + (size_t)(32 * nb) * D + 64 * kb; ldt = D; }
    } else {
        const int i3 = it - 2 * IT_E - 2 * IT_O; const int l = i3 / IT_L; int r = i3 % IT_L;
        if (r < IT_F1) { const int kb = r / 176, nb = r % 176; const int n0 = 32 * nb; const int isu = n0 >= DFF; const int c = n0 - isu * DFF; const int drow = (c >> 7) * 256 + isu * 128 + (c & 127);
            src = FIN(I_WF1) + (size_t)l * D * 5632 + (size_t)(64 * kb) * 5632 + n0; ldw = 5632; dst = WSP(bf16_t, WS_WF1) + (size_t)l * 5632 * D + (size_t)drow * D + 64 * kb; ldt = D;
        } else { r -= IT_F1; const int kb = r / 32, nb = r % 32;
            src = FIN(I_WF2) + (size_t)l * DFF * D + (size_t)(64 * kb) * D + 32 * nb; ldw = D; dst = WSP(bf16_t, WS_WF2) + (size_t)l * D * DFF + (size_t)(32 * nb) * DFF + 64 * kb; ldt = DFF; }
    }
    transpose_block(src, ldw, dst, ldt, scr, F.lane);
}

__device__ __forceinline__ void phase_prologue(Frame& F) {
    const int tid = F.tid, lane = F.lane, wave = F.wave;
    const int gt = F.vcu * NTHREADS + tid, NGT = F.G * NTHREADS;
    {
        LAS float* sil = (LAS float*)F.lds;
        LAS float* red = (LAS float*)(F.lds + 20480);
        for (int i = tid; i < 5 * 1024; i += NTHREADS) { const int ci = i >> 10, k = i & 1023; const float v = ci == 0 ? FIN(I_CCTX)[k] : FIN(I_C)[(ci - 1) * 1024 + k]; sil[i] = siluf_(v); }
        __syncthreads();
        for (int item = F.vcu; item < 4 * 48; item += F.G) {
            const int l = item / 48, n0 = (item % 48) * 128;
            const float* wp = FIN(I_WADA) + ((size_t)l * 1024 + wave * 128) * 6144 + n0 + 2 * lane;
            float a0[5] = {0.f, 0.f, 0.f, 0.f, 0.f}, a1[5] = {0.f, 0.f, 0.f, 0.f, 0.f};
#pragma unroll 8
            for (int kk = 0; kk < 128; ++kk) { const f32x2 w = *(const f32x2*)(wp + (size_t)kk * 6144);
#pragma unroll
                for (int ci = 0; ci < 5; ++ci) { const float s = sil[ci * 1024 + wave * 128 + kk]; a0[ci] += s * w.x; a1[ci] += s * w.y; } }
#pragma unroll
            for (int ci = 0; ci < 5; ++ci) { red[(wave * 5 + ci) * 128 + 2 * lane] = a0[ci]; red[(wave * 5 + ci) * 128 + 2 * lane + 1] = a1[ci]; }
            __syncthreads();
            for (int i = tid; i < 640; i += NTHREADS) { const int ci = i >> 7, n = i & 127; float s = FIN(I_BADA)[l * 6144 + n0 + n];
#pragma unroll
                for (int w = 0; w < 8; ++w) s += red[(w * 5 + ci) * 128 + n];
                WSP(float, WS_MOD)[(size_t)(l * 5 + ci) * 6144 + n0 + n] = s; }
            __syncthreads();
        }
    }
    for (int i = gt; i < 1024; i += NGT) { const int pos = i >> 4, fi = i & 15; const float inv = fexp2(-(float)fi * (13.287712379549449f / 16.0f)); const float a = (float)pos * inv;
        WSP(float, WS_ROPE)[2 * i] = __cosf(a); WSP(float, WS_ROPE)[2 * i + 1] = __sinf(a); }
    for (int i = gt; i < 4 * 2 * 256 * 128 / 4; i += NGT) { const f32x4 k = ((const f32x4*)FIN(I_CK))[i], v = ((const f32x4*)FIN(I_CV))[i];
        u32x2 a; a.x = pk2(k[0], k[1]); a.y = pk2(k[2], k[3]); ((u32x2*)WSP(bf16_t, WS_CK))[i] = a; a.x = pk2(v[0], v[1]); a.y = pk2(v[2], v[3]); ((u32x2*)WSP(bf16_t, WS_CV))[i] = a; }
    for (int i = gt; i < 2 * (PEP - PE) * D / 8; i += NGT) { const int e = i / ((PEP - PE) * D / 8), r = i % ((PEP - PE) * D / 8);
        ((u32x4*)(WSP(bf16_t, WS_WINE) + (size_t)e * PEP * D + (size_t)PE * D))[r] = (u32x4){0u, 0u, 0u, 0u}; }
    {
        LAS float* scr = (LAS float*)(F.lds + 40960 + wave * 8704);
        const int gw = F.vcu * NWAVES + wave, NGW = F.G * NWAVES;
        for (int it = gw; it < IT_TOTAL; it += NGW) convert_item(F, it, scr);
    }
}

__device__ __forceinline__ void phase_pre(Frame& F) {
    const int lane = F.lane; const int gw = F.vcu * NWAVES + F.wave, NGW = F.G * NWAVES;
    const float* mod = WSP(float, WS_MOD); float* bias = WSP(float, WS_BIAS);
    for (int mi = 0; mi < 8; ++mi) {
        const int l = mi < 2 ? 2 * mi : mi < 4 ? 2 * (mi - 2) + 1 : mi - 4; const int shj = mi < 4 ? 0 : 3;
        const int N = mi < 2 ? 2560 : mi < 4 ? 2048 : 5632;
        const bf16_t* W = mi < 2 ? WSP(bf16_t, WS_WINE) + (size_t)mi * PEP * D : mi < 4 ? WSP(bf16_t, WS_WINO) + (size_t)(mi - 2) * 2048 * D : WSP(bf16_t, WS_WF1) + (size_t)(mi - 4) * 5632 * D;
        float* bo = bias + (mi < 2 ? BIAS_E + (size_t)mi * 5 * 2560 : mi < 4 ? BIAS_O + (size_t)(mi - 2) * 5 * 2048 : BIAS_F + (size_t)(mi - 4) * 5 * 5632);
        f32x4 sh[5][4];
#pragma unroll
        for (int ci = 0; ci < 5; ++ci)
#pragma unroll
            for (int q = 0; q < 4; ++q) sh[ci][q] = *(const f32x4*)(mod + ((size_t)(l * 5 + ci) * 6 + shj) * 1024 + 16 * lane + 4 * q);
        for (int n = gw; n < N; n += NGW) {
            const u32x4 w0 = *(const u32x4*)(W + (size_t)n * D + 16 * lane), w1 = *(const u32x4*)(W + (size_t)n * D + 16 * lane + 8);
            const float wf[16] = {bflo(w0.x), bfhi(w0.x), bflo(w0.y), bfhi(w0.y), bflo(w0.z), bfhi(w0.z), bflo(w0.w), bfhi(w0.w), bflo(w1.x), bfhi(w1.x), bflo(w1.y), bfhi(w1.y), bflo(w1.z), bfhi(w1.z), bflo(w1.w), bfhi(w1.w)};
            float r[5];
#pragma unroll
            for (int ci = 0; ci < 5; ++ci) { float a = 0.f;
#pragma unroll
                for (int q = 0; q < 16; ++q) a += sh[ci][q >> 2][q & 3] * wf[q];
                r[ci] = wave_sum(a, lane); }
            if (lane < 5) bo[(size_t)lane * N + n] = lane == 0 ? r[0] : lane == 1 ? r[1] : lane == 2 ? r[2] : lane == 3 ? r[3] : r[4];
        }
    }
    {
        const float* gvec = FIN(I_NMIX); bf16_t* XN = WSP(bf16_t, WS_XN); float* ssq = F.out + SSQP_OFF;
        f32x4 gg[4]; int cur_ci = -1;
        for (int r = 0; r < 10; ++r) {
            const int row = gw * 10 + r; const int ci = cond_of_row(row);
            if (ci != cur_ci) { cur_ci = ci;
#pragma unroll
                for (int j = 0; j < 4; ++j) { const int col = 4 * lane + 256 * j; gg[j] = *(const f32x4*)(gvec + col) * (1.0f + *(const f32x4*)(mod + ((size_t)ci * 6 + 1) * 1024 + col)); } }
            const float* xin = row < MCTX ? FIN(I_XP) + (size_t)row * D : FIN(I_XS) + (size_t)(row - MCTX) * D;
            f32x4 v[4]; float s = 0.f;
#pragma unroll
            for (int j = 0; j < 4; ++j) { v[j] = *(const f32x4*)(xin + 4 * lane + 256 * j); s += (v[j].x * v[j].x + v[j].y * v[j].y) + (v[j].z * v[j].z + v[j].w * v[j].w); }
            s = wave_sum(s, lane);
            if (lane < 16) ssq[(size_t)row * 16 + lane] = lane == 0 ? s : 0.f;
#pragma unroll
            for (int j = 0; j < 4; ++j) { const f32x4 y = v[j] * gg[j]; *(u32x2*)(XN + (size_t)row * D + 4 * lane + 256 * j) = (u32x2){pk2(y[0], y[1]), pk2(y[2], y[3])}; }
        }
    }
}
__device__ __forceinline__ void phase_final(Frame& F) {
    const int lane = F.lane; const int gw = F.vcu * NWAVES + F.wave;
    const float* gvec = FIN(I_NFIN); const float* ssq = WSP(float, WS_SSQ8); const bf16_t* XF = WSP(bf16_t, WS_XF);
    f32x4 gg[4];
#pragma unroll
    for (int j = 0; j < 4; ++j) gg[j] = *(const f32x4*)(gvec + 4 * lane + 256 * j);
    float rs[10];
#pragma unroll
    for (int r = 0; r < 10; ++r) { const int row = gw * 10 + r; const f32x4* q_ = (const f32x4*)(ssq + (size_t)row * 16); const f32x4 a_ = q_[0], b_ = q_[1], c_ = q_[2], d_ = q_[3];
        rs[r] = frsq(((((a_[0] + a_[1]) + (a_[2] + a_[3])) + ((b_[0] + b_[1]) + (b_[2] + b_[3]))) + (((c_[0] + c_[1]) + (c_[2] + c_[3])) + ((d_[0] + d_[1]) + (d_[2] + d_[3])))) * (1.0f / D) + EPS); }
#pragma unroll
    for (int r = 0; r < 10; ++r) { const int row = gw * 10 + r; float* yr = F.out + (size_t)row * D; const bf16_t* xr = XF + (size_t)row * D;
#pragma unroll
        for (int j = 0; j < 4; ++j) { const u32x2 w = *(const u32x2*)(xr + 4 * lane + 256 * j); const f32x4 x = {bflo(w.x), bfhi(w.x), bflo(w.y), bfhi(w.y)}; *(f32x4*)(yr + 4 * lane + 256 * j) = x * rs[r] * gg[j]; } }
}

__device__ __forceinline__ void attn_unit(Frame& F, int e, int kind, int b, int kvh, int qb, int hp) {
    const int lane = F.lane, w = F.wave, r32 = lane & 31, hh = lane >> 5;
    const bf16_t* ZE = WSP(bf16_t, WS_ZE);
    const int head = kvh * 4 + hp * 2 + (w >> 2);
    const int seqbase = kind == 0 ? MCTX + b * TLAT : b * TCTX;
    const int qloc = qb * 128 + (w & 3) * 32 + r32;
    const int iloc = (w & 3) * 32 + r32;
    bf16x8 qr[4];
#pragma unroll
    for (int d0 = 0; d0 < 4; ++d0) qr[d0] = *(const bf16x8*)(ZE + (size_t)(seqbase + qloc) * ZW + head * 64 + d0 * 16 + hh * 8);
    const int wt0 = (kind == 0 && qb == 0) ? 2 : 0, wt1 = (kind == 0) ? ((qb == 31) ? 4 : 6) : 0;
    const int NT = 4 + (wt1 - wt0);
    float m_run = FIN(I_SINK)[e * 8 + head] * LOG2E; float l_run = hh == 0 ? 1.0f : 0.0f;
    f32x16 o0 = {}, o1 = {};
    const int kkey = lane, kchunk = w;
    const int vkey = 16 * (w & 3) + (lane >> 2), vdh = w >> 2, vpiece = lane & 3;
    const unsigned kdstw = (unsigned)(kchunk * 1024), vdstw = (unsigned)(24576 + vdh * 4096 + (w & 3) * 1024);
    int mtype = 0, joff = 0;
    auto tile_ptrs = [&](int t, const bf16_t*& kp, const bf16_t*& vp, int& pitch, int& mt, int& jo) {
        if (kind == 0 && t < 4) { const size_t base = ((size_t)(b * 2 + e) * 256 + 64 * t) * 128 + kvh * 64; kp = WSP(bf16_t, WS_CK) + base; vp = WSP(bf16_t, WS_CV) + base; pitch = 128; mt = 0; jo = 0; }
        else if (kind == 0) { const int wt = t - 4 + wt0; const int blk = qb - 1 + (wt >> 1); const size_t row = (size_t)seqbase + blk * 128 + (wt & 1) * 64;
            kp = ZE + row * ZW + 512 + kvh * 64; vp = ZE + row * ZW + 640 + kvh * 64; pitch = ZW; mt = (blk < qb) ? 1 : (blk > qb) ? 2 : 0; jo = (wt & 1) * 64; }
        else { const size_t row = (size_t)seqbase + 64 * t; kp = ZE + row * ZW + 512 + kvh * 64; vp = ZE + row * ZW + 640 + kvh * 64; pitch = ZW; mt = 0; jo = 0; }
    };
#define ATT_ISSUE(t, slot) do { const bf16_t *kp_, *vp_; int pitch_, mt_, jo_; tile_ptrs((t), kp_, vp_, pitch_, mt_, jo_); \
        __builtin_amdgcn_global_load_lds((const unsigned*)(kp_ + (size_t)kkey * pitch_ + kchunk * 8), (LAS unsigned*)(F.lds + (slot) * 8192 + kdstw), 16, 0, 0); \
        __builtin_amdgcn_global_load_lds((const unsigned*)(vp_ + (size_t)vkey * pitch_ + vdh * 32 + vpiece * 8), (LAS unsigned*)(F.lds + (slot) * 8192 + vdstw), 16, 0, 0); } while (0)
    ATT_ISSUE(0, 0); if (NT > 1) ATT_ISSUE(1, 1);
    int slot = 0;
    for (int t = 0; t < NT; ++t) {
        if (t + 1 < NT) asm volatile("s_waitcnt vmcnt(2)" ::: "memory"); else asm volatile("s_waitcnt vmcnt(0)" ::: "memory");
        asm volatile("s_waitcnt lgkmcnt(0)" ::: "memory"); __builtin_amdgcn_s_barrier(); asm volatile("" ::: "memory");
        if (t + 2 < NT) { const int s2 = slot >= 1 ? slot - 1 : 2; ATT_ISSUE(t + 2, s2); }
        { const bf16_t *kp_, *vp_; int pitch_; tile_ptrs(t, kp_, vp_, pitch_, mtype, joff); }
        const int buf = slot;
        const lptr kb = F.lds + buf * 8192 + hh * 1024 + r32 * 16;
        f32x16 p0 = {}, p1 = {};
#pragma unroll
        for (int d0 = 0; d0 < 4; ++d0) { const bf16x8 k0 = *(const LAS bf16x8*)(kb + d0 * 2048), k1 = *(const LAS bf16x8*)(kb + d0 * 2048 + 512);
            p0 = __builtin_amdgcn_mfma_f32_32x32x16_bf16(k0, qr[d0], p0, 0, 0, 0); p1 = __builtin_amdgcn_mfma_f32_32x32x16_bf16(k1, qr[d0], p1, 0, 0, 0); }
        if (mtype != 0) {
#pragma unroll
            for (int r = 0; r < 16; ++r) { const int j0 = joff + crow(r, hh), j1 = j0 + 32;
                const bool bad0 = (mtype == 1) ? (j0 < iloc) : (j0 > iloc), bad1 = (mtype == 1) ? (j1 < iloc) : (j1 > iloc);
                if (bad0) p0[r] = -1e30f; if (bad1) p1[r] = -1e30f; }
        }
        float mx = fmaxf(p0[0], p1[0]);
#pragma unroll
        for (int r = 1; r < 16; ++r) mx = fmaxf(mx, fmaxf(p0[r], p1[r]));
        mx = fmaxf(mx, shfl_x(mx, lane, 32));
        const float m_new = fmaxf(m_run, mx); const float alpha = fexp2(m_run - m_new); m_run = m_new;
        float ps = 0.f;
#pragma unroll
        for (int r = 0; r < 16; ++r) { p0[r] = fexp2(p0[r] - m_new); p1[r] = fexp2(p1[r] - m_new); ps += p0[r] + p1[r]; }
        l_run = l_run * alpha + ps;
#pragma unroll
        for (int r = 0; r < 16; ++r) { o0[r] *= alpha; o1[r] *= alpha; }
        u32x4 pw[4];
#pragma unroll
        for (int s = 0; s < 2; ++s) { pw[s] = (u32x4){pk2(p0[8 * s], p0[8 * s + 1]), pk2(p0[8 * s + 2], p0[8 * s + 3]), pk2(p0[8 * s + 4], p0[8 * s + 5]), pk2(p0[8 * s + 6], p0[8 * s + 7])};
            pw[2 + s] = (u32x4){pk2(p1[8 * s], p1[8 * s + 1]), pk2(p1[8 * s + 2], p1[8 * s + 3]), pk2(p1[8 * s + 4], p1[8 * s + 5]), pk2(p1[8 * s + 6], p1[8 * s + 7])}; }
        const lptr vb = F.lds + 24576 + buf * 8192 + ((lane >> 4) & 1) * 32 + (lane & 3) * 8 + (4 * hh + ((lane & 15) >> 2)) * 64;
#pragma unroll
        for (int s = 0; s < 4; ++s) { const bf16x8 v0 = tr_frag(vb + s * 1024), v1 = tr_frag(vb + 4096 + s * 1024);
            o0 = __builtin_amdgcn_mfma_f32_32x32x16_bf16(v0, __builtin_bit_cast(bf16x8, pw[s]), o0, 0, 0, 0);
            o1 = __builtin_amdgcn_mfma_f32_32x32x16_bf16(v1, __builtin_bit_cast(bf16x8, pw[s]), o1, 0, 0, 0); }
        slot = slot == 2 ? 0 : slot + 1;
    }
#undef ATT_ISSUE
    asm volatile("s_waitcnt lgkmcnt(0)" ::: "memory"); __builtin_amdgcn_s_barrier(); asm volatile("" ::: "memory");
    const float lt = l_run + shfl_x(l_run, lane, 32); const float inv = frcp(lt);
    bf16_t* orow = WSP(bf16_t, WS_MIX) + (size_t)(seqbase + qloc) * D + head * 64;
#pragma unroll
    for (int g = 0; g < 4; ++g) { u32x2 a; a.x = pk2(o0[4 * g] * inv, o0[4 * g + 1] * inv); a.y = pk2(o0[4 * g + 2] * inv, o0[4 * g + 3] * inv); *(u32x2*)(orow + 8 * g + 4 * hh) = a;
        a.x = pk2(o1[4 * g] * inv, o1[4 * g + 1] * inv); a.y = pk2(o1[4 * g + 2] * inv, o1[4 * g + 3] * inv); *(u32x2*)(orow + 32 + 8 * g + 4 * hh) = a; }
}

constexpr int GL_LA = 0;
constexpr int GL_LR = 32768;
constexpr int GL_WA = 40960;
constexpr int GL_BA = 49152;
constexpr int GL_BL = 49664;
constexpr int GL_A = 51200;
constexpr int GL_B = 67584;
constexpr int GL_C = 83968;
__device__ __forceinline__ int timg(int r, int c, int R) { return (c >> 5) * (R * 64) + (r >> 3) * 512 + (r & 7) * 64 + (c & 31) * 2; }

struct GlaPre { f32x4 lr, wa; float ba; u32x4 gk, gq, v0, v1; };
__device__ __forceinline__ GlaPre gla_load(Frame& F, int e, int gc, int hd, bool with_q) {
    const int tid = F.tid; const int R0 = gc * 64; GlaPre p; const bf16_t* ZE = WSP(bf16_t, WS_ZE);
    { const int row = tid >> 3, c4 = tid & 7; p.lr = *(const f32x4*)(WSP(float, WS_LR) + (size_t)(R0 + row) * 32 + 4 * c4);
      const int z = tid >> 8, r = (tid >> 4) & 15, k4 = tid & 15; p.wa = *(const f32x4*)(FIN(I_WALPHA) + ((size_t)(e * 2 + z) * 16 + r) * 256 + hd * 64 + 4 * k4);
      p.ba = FIN(I_BALPHA)[(e * 2 + ((tid >> 6) & 1)) * 256 + hd * 64 + (tid & 63)]; }
    { const int t = tid >> 3, k8 = (tid & 7) * 8; p.gk = *(const u32x4*)(ZE + (size_t)(R0 + t) * ZW + 1024 + hd * 64 + k8);
      p.gq = with_q ? *(const u32x4*)(ZE + (size_t)(R0 + t) * ZW + 768 + hd * 64 + k8) : p.gk; }
    { const int p0 = tid, p1 = tid + 512; p.v0 = *(const u32x4*)(ZE + (size_t)(R0 + (p0 >> 4)) * ZW + 1280 + hd * 128 + (p0 & 15) * 8); p.v1 = *(const u32x4*)(ZE + (size_t)(R0 + (p1 >> 4)) * ZW + 1280 + hd * 128 + (p1 & 15) * 8); }
    return p;
}
__device__ __forceinline__ void gla_bcum(Frame& F, const GlaPre& p) {
    const int tid = F.tid;
    LAS float* LA = (LAS float*)(F.lds + GL_LA); LAS float* LRs = (LAS float*)(F.lds + GL_LR); LAS float* WA = (LAS float*)(F.lds + GL_WA);
    LAS float* BA = (LAS float*)(F.lds + GL_BA); LAS float* BL = (LAS float*)(F.lds + GL_BL);
    { const int row = tid >> 3, c4 = tid & 7; *(LAS f32x4*)(LRs + row * 32 + 4 * c4) = p.lr;
      const int z = tid >> 8, r = (tid >> 4) & 15, k4 = tid & 15; *(LAS f32x4*)(WA + (z * 16 + r) * 64 + 4 * k4) = p.wa;
      if (tid < 128) BA[tid] = p.ba; }
    __syncthreads();
    { const int lane = F.lane, w = F.wave; const int z = w >> 2, kl = lane & 15, seg = lane >> 4, k = (w & 3) * 16 + kl, t0 = seg * 16;
      float wa[16];
#pragma unroll
      for (int r = 0; r < 16; ++r) wa[r] = WA[(z * 16 + r) * 64 + k];
      const float bz = BA[z * 64 + k];
      float la[16];
#pragma unroll
      for (int tt = 0; tt < 16; ++tt) { float x = bz;
#pragma unroll
          for (int r4 = 0; r4 < 4; ++r4) { const f32x4 l4 = *(const LAS f32x4*)(LRs + (t0 + tt) * 32 + z * 16 + 4 * r4); x += (l4[0] * wa[4 * r4] + l4[1] * wa[4 * r4 + 1]) + (l4[2] * wa[4 * r4 + 2] + l4[3] * wa[4 * r4 + 3]); }
          la[tt] = (fminf(x, 0.f) - flog(1.0f + fexp(-fabsf(x)))) * (1.0f / 16.0f); }
      float run = 0.f;
      if (z == 0) {
#pragma unroll
          for (int tt = 0; tt < 16; ++tt) { run += la[tt]; la[tt] = run; }
      } else {
#pragma unroll
          for (int tt = 15; tt >= 0; --tt) { run += la[tt]; la[tt] = run; }
      }
      const float s0 = shfl_idx(run, kl), s1 = shfl_idx(run, kl + 16), s2 = shfl_idx(run, kl + 32), s3 = shfl_idx(run, kl + 48);
      float add;
      if (z == 0) add = (seg > 0 ? s0 : 0.f) + (seg > 1 ? s1 : 0.f) + (seg > 2 ? s2 : 0.f);
      else        add = (seg < 3 ? s3 : 0.f) + (seg < 2 ? s2 : 0.f) + (seg < 1 ? s1 : 0.f);
#pragma unroll
      for (int tt = 0; tt < 16; ++tt) LA[(z * 64 + t0 + tt) * 64 + k] = la[tt] + add;
      if (seg == 0) BL[z * 64 + k] = (s0 + s1) + (s2 + s3); }
    __syncthreads();
}
__device__ __forceinline__ void gla_stage_v(Frame& F, const GlaPre& p, int off) {
    { const int q = F.tid, t = q >> 4, v8 = (q & 15) * 8; *(LAS u32x4*)(F.lds + off + timg(t, v8, 64)) = p.v0; }
    { const int q = F.tid + 512, t = q >> 4, v8 = (q & 15) * 8; *(LAS u32x4*)(F.lds + off + timg(t, v8, 64)) = p.v1; }
}
__device__ __forceinline__ void gla_g1_item(Frame& F, int e, int gc, int hd, const GlaPre& pre) {
    const int tid = F.tid, lane = F.lane, w = F.wave;
    gla_stage_v(F, pre, GL_B);
    gla_bcum(F, pre);
    LAS float* LA = (LAS float*)(F.lds + GL_LA); LAS float* BL = (LAS float*)(F.lds + GL_BL);
    { const int t = tid >> 3, k8 = (tid & 7) * 8; const u32x4 gk = pre.gk;
      const float kf[8] = {bflo(gk.x), bfhi(gk.x), bflo(gk.y), bfhi(gk.y), bflo(gk.z), bfhi(gk.z), bflo(gk.w), bfhi(gk.w)};
#pragma unroll
      for (int z = 0; z < 2; ++z) { float ks[8];
#pragma unroll
        for (int j = 0; j < 8; ++j) ks[j] = kf[j] * fexp(BL[z * 64 + k8 + j] - LA[(z * 64 + t) * 64 + k8 + j]);
        *(LAS u32x4*)(F.lds + GL_A + z * 8192 + timg(t, k8, 64)) = (u32x4){pk2(ks[0], ks[1]), pk2(ks[2], ks[3]), pk2(ks[4], ks[5]), pk2(ks[6], ks[7])}; } }
    __syncthreads();
    { const int vb = w & 3, z = w >> 2; const int hh = lane >> 5, q = (lane & 15) >> 2;
      const int lofs = q * 64 + (((lane >> 4) & 1) * 16 + (lane & 3) * 4) * 2;
      f32x16 a0 = {}, a1 = {};
#pragma unroll
      for (int s = 0; s < 4; ++s) { const int rofs = (2 * s + hh) * 512;
        const lptr vp = F.lds + GL_B + vb * 4096 + rofs + lofs; const s16x4 va = tr_read(vp), vb2 = tr_read(vp + 256);
        const bf16x8 vf = (bf16x8){va[0], va[1], va[2], va[3], vb2[0], vb2[1], vb2[2], vb2[3]};
        const lptr kp = F.lds + GL_A + z * 8192 + rofs + lofs; const s16x4 ka = tr_read(kp), kb2 = tr_read(kp + 256), kc = tr_read(kp + 4096), kd = tr_read(kp + 4096 + 256);
        const bf16x8 kf0 = (bf16x8){ka[0], ka[1], ka[2], ka[3], kb2[0], kb2[1], kb2[2], kb2[3]}, kf1 = (bf16x8){kc[0], kc[1], kc[2], kc[3], kd[0], kd[1], kd[2], kd[3]};
        a0 = __builtin_amdgcn_mfma_f32_32x32x16_bf16(vf, kf0, a0, 0, 0, 0); a1 = __builtin_amdgcn_mfma_f32_32x32x16_bf16(vf, kf1, a1, 0, 0, 0); }
      float* kv = WSP(float, WS_KV) + ((size_t)(gc * 4 + hd) * 2 + z) * 8192;
#pragma unroll
      for (int r = 0; r < 16; ++r) { const int v = 32 * vb + crow(r, hh); kv[v * 64 + (lane & 31)] = a0[r]; kv[v * 64 + 32 + (lane & 31)] = a1[r]; } }
    if (tid < 128) WSP(float, WS_DL)[((size_t)(gc * 4 + hd) * 2 + (tid >> 6)) * 64 + (tid & 63)] = fexp(BL[tid]);
    __syncthreads();
}
__device__ __forceinline__ void phase_g2(Frame& F, int e) {
    const int tid = F.tid; float* KV = WSP(float, WS_KV); const float* DL = WSP(float, WS_DL);
    {
        const int v = F.vcu; const int chain = v >> 3, slice = v & 7; const int b = chain >> 3, hd = (chain >> 1) & 3, z = chain & 1;
        const int off = slice * 1024 + tid * 2, k = off & 63, vv = off >> 6;
        const float* s0 = FIN(I_SGLA) + ((size_t)((b * 2 + e) * 2 + z) * 4 + hd) * 8192;
        f32x2 S = (f32x2){s0[(size_t)k * 128 + vv], s0[(size_t)(k + 1) * 128 + vv]};
        f32x2 kvA[8], dlA[8], kvB[8], dlB[8];
#define G2_LOAD(KVR, DLR, C8) _Pragma("unroll") for (int i = 0; i < 8; ++i) { const int c = z ? 63 - ((C8) + i) : (C8) + i; const size_t it = (size_t)((64 + b * 64 + c) * 4 + hd) * 2 + z; \
                KVR[i] = *(const f32x2*)(KV + it * 8192 + off); DLR[i] = *(const f32x2*)(DL + it * 64 + k); }
#define G2_FOLD(KVR, DLR, C8) _Pragma("unroll") for (int i = 0; i < 8; ++i) { const int c = z ? 63 - ((C8) + i) : (C8) + i; const size_t it = (size_t)((64 + b * 64 + c) * 4 + hd) * 2 + z; \
                *(f32x2*)(KV + it * 8192 + off) = S; S = DLR[i] * S + KVR[i]; }
        G2_LOAD(kvA, dlA, 0)
        for (int c8 = 0; c8 < 64; c8 += 16) {
            G2_LOAD(kvB, dlB, c8 + 8)
            G2_FOLD(kvA, dlA, c8)
            if (c8 + 16 < 64) { G2_LOAD(kvA, dlA, c8 + 16) }
            G2_FOLD(kvB, dlB, c8 + 8)
        }
#undef G2_LOAD
#undef G2_FOLD
    }
    for (int item = F.vcu; item < 512; item += F.G) {
        const int chain = item >> 2, slice = item & 3; const int b = chain >> 3, hd = (chain >> 1) & 3, z = chain & 1;
        const int off = slice * 2048 + tid * 4, k = off & 63, vv = off >> 6;
        const float zf = (float)F.oz; f32x4 S = {zf, zf, zf, zf};
        f32x4 kv4[4], dl4[4];
#pragma unroll
        for (int i = 0; i < 4; ++i) { const int c = z ? 3 - i : i; const size_t it = (size_t)((b * 4 + c) * 4 + hd) * 2 + z; kv4[i] = *(const f32x4*)(KV + it * 8192 + off); dl4[i] = *(const f32x4*)(DL + it * 64 + k); }
#pragma unroll
        for (int i = 0; i < 4; ++i) { const int c = z ? 3 - i : i; const size_t it = (size_t)((b * 4 + c) * 4 + hd) * 2 + z; *(f32x4*)(KV + it * 8192 + off) = S; S = dl4[i] * S + kv4[i]; }
        float* dst = F.out + OUT_GLA + ((size_t)((b * 2 + e) * 2 + z) * 4 + hd) * 8192;
#pragma unroll
        for (int j = 0; j < 4; ++j) dst[(size_t)(k + j) * 128 + vv] = S[j];
    }
}
__device__ __forceinline__ void gla_g3_item(Frame& F, int e, int gc, int hd, const GlaPre& pre) {
    const int tid = F.tid, lane = F.lane, w = F.wave; const int R0 = gc * 64;
    const bf16_t* ZE = WSP(bf16_t, WS_ZE);
    f32x4 sreg[8];
    { const float* KV = WSP(float, WS_KV) + (size_t)(gc * 4 + hd) * 2 * 8192;
#pragma unroll
      for (int i = 0; i < 8; ++i) { const int idx = tid + 512 * i, z = idx >> 11, rem = idx & 2047, v = rem >> 4, k4 = (rem & 15) * 4; sreg[i] = *(const f32x4*)(KV + (size_t)z * 8192 + v * 64 + k4); } }
    u32x2 grreg[4];
    { const int vb_ = w >> 1, ib_ = w & 1, i_ = 32 * ib_ + (lane & 31), hh_ = lane >> 5;
#pragma unroll
      for (int g = 0; g < 4; ++g) grreg[g] = *(const u32x2*)(ZE + (size_t)(R0 + i_) * ZW + 1792 + hd * 128 + 32 * vb_ + 8 * g + 4 * hh_); }
    gla_stage_v(F, pre, GL_C);
    gla_bcum(F, pre);
    LAS float* LA = (LAS float*)(F.lds + GL_LA);
    { const int t = tid >> 3, c = tid & 7, k8 = c * 8;
      const u32x4 gq = pre.gq, gk = pre.gk;
      const float qf[8] = {bflo(gq.x), bfhi(gq.x), bflo(gq.y), bfhi(gq.y), bflo(gq.z), bfhi(gq.z), bflo(gq.w), bfhi(gq.w)};
      const float kf[8] = {bflo(gk.x), bfhi(gk.x), bflo(gk.y), bfhi(gk.y), bflo(gk.z), bfhi(gk.z), bflo(gk.w), bfhi(gk.w)};
      const int so = t * 128 + ((c ^ (t & 7)) * 16);
#pragma unroll
      for (int z = 0; z < 2; ++z) { float qe[8], ke[8];
#pragma unroll
        for (int j = 0; j < 8; ++j) { const float bc = LA[(z * 64 + t) * 64 + k8 + j]; qe[j] = qf[j] * fexp(bc); ke[j] = kf[j] * fexp(-bc); }
        *(LAS u32x4*)(F.lds + GL_A + z * 8192 + so) = (u32x4){pk2(qe[0], qe[1]), pk2(qe[2], qe[3]), pk2(qe[4], qe[5]), pk2(qe[6], qe[7])};
        *(LAS u32x4*)(F.lds + GL_B + z * 8192 + so) = (u32x4){pk2(ke[0], ke[1]), pk2(ke[2], ke[3]), pk2(ke[4], ke[5]), pk2(ke[6], ke[7])}; } }
    __syncthreads();
    {
#pragma unroll
      for (int i = 0; i < 8; ++i) { const int idx = tid + 512 * i, z = idx >> 11, rem = idx & 2047, v = rem >> 4, k4 = (rem & 15) * 4;
        const f32x4 s = sreg[i];
        *(LAS u32x2*)(F.lds + GL_LA + z * 16384 + v * 128 + (((k4 >> 3) ^ (v & 7)) * 16) + (k4 & 7) * 2) = (u32x2){pk2(s[0], s[1]), pk2(s[2], s[3])}; } }
    __syncthreads();
    const int vb = w >> 1, ib = w & 1, r32 = lane & 31, hh = lane >> 5;
    f32x16 o = {};
    bf16x8 qf[2][4];
    { const int i = 32 * ib + r32;
#pragma unroll
      for (int z = 0; z < 2; ++z)
#pragma unroll
        for (int s = 0; s < 4; ++s) qf[z][s] = *(const LAS bf16x8*)(F.lds + GL_A + z * 8192 + i * 128 + (((2 * s + hh) ^ (i & 7)) * 16)); }
    { const int v = 32 * vb + r32;
#pragma unroll
      for (int z = 0; z < 2; ++z)
#pragma unroll
        for (int s = 0; s < 4; ++s) { const bf16x8 sf = *(const LAS bf16x8*)(F.lds + GL_LA + z * 16384 + v * 128 + (((2 * s + hh) ^ (v & 7)) * 16));
            o = __builtin_amdgcn_mfma_f32_32x32x16_bf16(sf, qf[z][s], o, 0, 0, 0); } }
    const lptr vbase = F.lds + GL_C + vb * 4096 + ((lane >> 4) & 1) * 32 + (lane & 3) * 8 + (4 * hh + ((lane & 15) >> 2)) * 64;
#pragma unroll
    for (int jb = 0; jb < 2; ++jb) {
        const int j = 32 * jb + r32; f32x16 xf = {}, xb = {};
        const bool do_f = !(jb == 1 && ib == 0), do_b = !(jb == 0 && ib == 1);
#pragma unroll
        for (int s = 0; s < 4; ++s) { const int so = j * 128 + (((2 * s + hh) ^ (j & 7)) * 16);
            if (do_f) { const bf16x8 kf = *(const LAS bf16x8*)(F.lds + GL_B + so); xf = __builtin_amdgcn_mfma_f32_32x32x16_bf16(kf, qf[0][s], xf, 0, 0, 0); }
            if (do_b) { const bf16x8 kb = *(const LAS bf16x8*)(F.lds + GL_B + 8192 + so); xb = __builtin_amdgcn_mfma_f32_32x32x16_bf16(kb, qf[1][s], xb, 0, 0, 0); } }
        float x[16]; const int ii = 32 * ib + r32;
#pragma unroll
        for (int r = 0; r < 16; ++r) { const int jj = 32 * jb + crow(r, hh); x[r] = ((do_f && jj <= ii) ? xf[r] : 0.f) + ((do_b && jj >= ii) ? xb[r] : 0.f); }
#pragma unroll
        for (int s2 = 0; s2 < 2; ++s2) { const u32x4 pw = (u32x4){pk2(x[8 * s2], x[8 * s2 + 1]), pk2(x[8 * s2 + 2], x[8 * s2 + 3]), pk2(x[8 * s2 + 4], x[8 * s2 + 5]), pk2(x[8 * s2 + 6], x[8 * s2 + 7])};
            const bf16x8 vf = tr_frag(vbase + (4 * jb + 2 * s2) * 512);
            o = __builtin_amdgcn_mfma_f32_32x32x16_bf16(vf, __builtin_bit_cast(bf16x8, pw), o, 0, 0, 0); }
    }
    LAS float* SSQ = (LAS float*)(F.lds + GL_LR);
    { float s = 0.f;
#pragma unroll
      for (int r = 0; r < 16; ++r) s += o[r] * o[r];
      s += shfl_x(s, lane, 32);
      if (hh == 0) SSQ[vb * 64 + 32 * ib + r32] = s; }
    __syncthreads();
    { const int i = 32 * ib + r32; const float tot = SSQ[i] + SSQ[64 + i] + SSQ[128 + i] + SSQ[192 + i]; const float rs = frsq(tot * (1.0f / 128.0f) + EPS);
      const float* gain = FIN(I_GGAIN) + e * 512 + hd * 128; const size_t row = (size_t)(R0 + i);
#pragma unroll
      for (int g = 0; g < 4; ++g) { const int v0 = 32 * vb + 8 * g + 4 * hh; const f32x4 gn = *(const f32x4*)(gain + v0);
        const u32x2 gr = grreg[g];
        const float r0 = o[4 * g] * rs * gn[0] * bflo(gr.x), r1 = o[4 * g + 1] * rs * gn[1] * bfhi(gr.x), r2 = o[4 * g + 2] * rs * gn[2] * bflo(gr.y), r3 = o[4 * g + 3] * rs * gn[3] * bfhi(gr.y);
        *(u32x2*)(WSP(bf16_t, WS_MIX) + row * D + 512 + hd * 128 + v0) = (u32x2){pk2(r0, r1), pk2(r2, r3)}; } }
    __syncthreads();
}

__device__ __forceinline__ void phase_attn_g1(Frame& F, int e) {
    const int v = F.vcu;
    for (int i = 0; i < 2; ++i) { const int uid = 2 * v + i; const int hp = uid & 1, qb = (uid >> 1) & 31, kvh = (uid >> 6) & 1, b = uid >> 7; attn_unit(F, e, 0, b, kvh, qb, hp); }
    if (v < 128) { const int hp = v & 1, qb = (v >> 1) & 1, kvh = (v >> 2) & 1, b = v >> 3; attn_unit(F, e, 1, b, kvh, qb, hp); }
    { GlaPre pre = gla_load(F, e, (v * 5) >> 2, (v * 5) & 3, false);
      for (int it = v * 5; it < v * 5 + 5; ++it) { const int nx = it + 1 < v * 5 + 5 ? it + 1 : it; const GlaPre nxt = gla_load(F, e, nx >> 2, nx & 3, false); gla_g1_item(F, e, it >> 2, it & 3, pre); pre = nxt; } }
}
__device__ __forceinline__ void phase_g3(Frame& F, int e) {
    const int v = F.vcu;
    GlaPre pre = gla_load(F, e, (v * 5) >> 2, (v * 5) & 3, true);
    for (int it = v * 5; it < v * 5 + 5; ++it) { const int nx = it + 1 < v * 5 + 5 ? it + 1 : it; const GlaPre nxt = gla_load(F, e, nx >> 2, nx & 3, true); gla_g3_item(F, e, it >> 2, it & 3, pre); pre = nxt; }
}

__device__ __forceinline__ void phase_conv(Frame& F, int o) {
    const bf16_t* U = WSP(bf16_t, WS_U); bf16_t* UC = WSP(bf16_t, WS_UC);
    const int gt = F.vcu * NTHREADS + F.tid, NGT = F.G * NTHREADS;
    for (int it = gt; it < 1280 * 128; it += NGT) {
        const int cg = it & 127, rg = it >> 7, c0 = cg * 8, r0 = rg * 16;
        const int seqlen = r0 < MCTX ? TCTX : TLAT; const int sb = r0 < MCTX ? (r0 & ~(TCTX - 1)) : MCTX + ((r0 - MCTX) & ~(TLAT - 1)); const int se = sb + seqlen;
        float w[4][8], bias[8];
#pragma unroll
        for (int i = 0; i < 4; ++i)
#pragma unroll
            for (int j = 0; j < 8; ++j) w[i][j] = FIN(I_CONVW)[(size_t)(o * 4 + i) * 1024 + c0 + j];
#pragma unroll
        for (int j = 0; j < 8; ++j) bias[j] = FIN(I_CONVB)[o * 1024 + c0 + j];
        u32x4 raw[19];
#pragma unroll
        for (int r = 0; r < 19; ++r) { const int row = r0 - 2 + r; const int rc = row < sb ? sb : (row >= se ? se - 1 : row); raw[r] = *(const u32x4*)(U + (size_t)rc * D + c0); }
#pragma unroll
        for (int r = 0; r < 19; ++r) { const int row = r0 - 2 + r; if (row < sb || row >= se) raw[r] = (u32x4){0u, 0u, 0u, 0u}; }
#pragma unroll
        for (int r = 0; r < 16; ++r) { float y[8];
#pragma unroll
            for (int j = 0; j < 8; ++j) { const int w2 = j >> 1;
                const float x0 = (j & 1) ? bfhi(raw[r][w2]) : bflo(raw[r][w2]), x1 = (j & 1) ? bfhi(raw[r + 1][w2]) : bflo(raw[r + 1][w2]), x2 = (j & 1) ? bfhi(raw[r + 2][w2]) : bflo(raw[r + 2][w2]), x3 = (j & 1) ? bfhi(raw[r + 3][w2]) : bflo(raw[r + 3][w2]);
                y[j] = bias[j] + w[0][j] * x0 + w[1][j] * x1 + w[2][j] * x2 + w[3][j] * x3; }
            *(u32x4*)(UC + (size_t)(r0 + r) * D + c0) = (u32x4){pk2(y[0], y[1]), pk2(y[2], y[3]), pk2(y[4], y[5]), pk2(y[6], y[7])}; }
    }
}
__device__ __forceinline__ void phase_carry(Frame& F, int o) {
    const float* AGG = WSP(float, WS_AGG); float* CAR = WSP(float, WS_CARRY);
    const int gt = F.vcu * NTHREADS + F.tid, NGT = F.G * NTHREADS;
    for (int c = gt; c < 8192 + 32768; c += NGT) {
        if (c < 8192) { const int b = c >> 11, z = (c >> 10) & 1, ch = c & 1023; const int base = 64 + b * 64;
            float h = FIN(I_SLRU)[(size_t)((b * 2 + o) * 2 + z) * 1024 + ch];
            for (int i8 = 0; i8 < 64; i8 += 8) { f32x2 a[8];
#pragma unroll
                for (int i = 0; i < 8; ++i) { const int ck = base + (z ? 63 - (i8 + i) : i8 + i); a[i] = *(const f32x2*)(AGG + ((size_t)(ck * 2 + z) * 1024 + ch) * 2); }
#pragma unroll
                for (int i = 0; i < 8; ++i) { const int ck = base + (z ? 63 - (i8 + i) : i8 + i); CAR[(size_t)(ck * 2 + z) * 1024 + ch] = h; h = a[i].x * h + a[i].y; } }
        } else { const int cc = c - 8192; const int b = cc >> 11, z = (cc >> 10) & 1, ch = cc & 1023; const int base = b * 4; float h = 0.f;
#pragma unroll
            for (int i = 0; i < 4; ++i) { const int ck = base + (z ? 3 - i : i); const f32x2 a = *(const f32x2*)(AGG + ((size_t)(ck * 2 + z) * 1024 + ch) * 2); CAR[(size_t)(ck * 2 + z) * 1024 + ch] = h; h = a.x * h + a.y; }
            F.out[OUT_LRU + (size_t)((b * 2 + o) * 2 + z) * 1024 + ch] = h; }
    }
}
__device__ __forceinline__ void phase_lru_out(Frame& F) {
    const bf16_t* ACF = WSP(bf16_t, WS_LAF); const bf16_t* ACB = WSP(bf16_t, WS_LAB); const bf16_t* HLF = WSP(bf16_t, WS_U); const bf16_t* HLB = WSP(bf16_t, WS_BB);
    const bf16_t* Gg = WSP(bf16_t, WS_G); bf16_t* YG = WSP(bf16_t, WS_BB); const float* CAR = WSP(float, WS_CARRY);
    const int gt = F.vcu * NTHREADS + F.tid, NGT = F.G * NTHREADS;
    for (int it = gt; it < 1280 * 128; it += NGT) {
        const int cg = it & 127, rg = it >> 7, c0 = cg * 8, r0 = rg * 16, ck = r0 >> 6;
        float cf[8], cb[8];
        { const f32x4 a0 = *(const f32x4*)(CAR + (size_t)(ck * 2) * 1024 + c0), a1 = *(const f32x4*)(CAR + (size_t)(ck * 2) * 1024 + c0 + 4), b0 = *(const f32x4*)(CAR + (size_t)(ck * 2 + 1) * 1024 + c0), b1 = *(const f32x4*)(CAR + (size_t)(ck * 2 + 1) * 1024 + c0 + 4);
#pragma unroll
          for (int j = 0; j < 4; ++j) { cf[j] = a0[j]; cf[4 + j] = a1[j]; cb[j] = b0[j]; cb[4 + j] = b1[j]; } }
#pragma unroll 4
        for (int r = 0; r < 16; ++r) { const size_t ix = (size_t)(r0 + r) * D + c0;
            const u32x4 af = *(const u32x4*)(ACF + ix), ab = *(const u32x4*)(ACB + ix), hf = *(const u32x4*)(HLF + ix), hb = *(const u32x4*)(HLB + ix), gg = *(const u32x4*)(Gg + ix);
            float y[8];
#pragma unroll
            for (int w2 = 0; w2 < 4; ++w2) { y[2 * w2] = bflo(gg[w2]) * ((bflo(hf[w2]) + bflo(af[w2]) * cf[2 * w2]) + (bflo(hb[w2]) + bflo(ab[w2]) * cb[2 * w2]));
                y[2 * w2 + 1] = bfhi(gg[w2]) * ((bfhi(hf[w2]) + bfhi(af[w2]) * cf[2 * w2 + 1]) + (bfhi(hb[w2]) + bfhi(ab[w2]) * cb[2 * w2 + 1])); }
            *(u32x4*)(YG + ix) = (u32x4){pk2(y[0], y[1]), pk2(y[2], y[3]), pk2(y[4], y[5]), pk2(y[6], y[7])}; }
    }
}

constexpr int NSTEPS = 42;
template <int KIND>
__device__ __forceinline__ void run_gemm(Frame& F, int l, int sub, int gidx, const bf16_t* A, int lda, int K, int a_grp, const bf16_t* Bt, int nN, bool perm, int dep, int depneed, int pub, int rot, int qidx) {
    pg8::Gemm g; g.A = A; g.Bt = Bt; g.lda = lda; g.K = K; g.nM = M / 256; g.nN = nN; g.a_grp = a_grp; g.perm = perm;
    Epi<KIND> E; E.layer = l; E.sub = sub; E.gidx = gidx; E.p = F.p; E.oz = F.oz;
    pg8::StaticOrder S; S.init(g.nM, g.nN, F.G, F.bid); S.rot = rot;
    unsigned* cw = WSP(unsigned, WS_CTL) + CW_CNT;
    if (dep >= 0) { S.ready = cw + (size_t)dep * 80 * 16; S.need = (unsigned)depneed * 8u; }
    if (pub >= 0) S.fin = cw + (size_t)pub * 80 * 16;
    if (qidx >= 0 && F.G == 256) { S.queue = WSP(unsigned, WS_CTL) + CW_Q + (size_t)qidx * 8 * 16; S.word = (LAS unsigned*)(F.lds + MISC_OFF + 64); }
    pg8::gemm_phase<Epi<KIND>>(F.lds, F.tid, (float)F.oz, g, S, E);
}
__global__ void __launch_bounds__(NTHREADS, 2) mk_fwd(Params P) {
    extern __shared__ __attribute__((aligned(16))) unsigned char lds_raw[];
    const lptr lds0 = (lptr)lds_raw;
    volatile LAS unsigned* MISC = (volatile LAS unsigned*)(lds0 + MISC_OFF);
    static_assert((LDS_BYTES - LDSCTL_OFF) == 8 * NTHREADS * 4, "LDS control region");
#pragma unroll
    for (int u = 0; u < 8; ++u) ((LAS unsigned*)(lds0 + LDSCTL_OFF))[u * NTHREADS + threadIdx.x] = 0u;
    __syncthreads();
    unsigned* ctl = (unsigned*)(P.ws + WS_CTL);
    XcdBarrier bar; bar.bar = ctl + 1024; bar.x = 0; bar.st = nullptr;
    const int lo = P.step_lo, hi = P.step_hi;
    const bool multi = (hi - lo) > 1;
    if (multi) bar = xcd_barrier_post(ctl + 1024, MISC + 8);
    volatile LAS unsigned long long* TS = (volatile LAS unsigned long long*)(lds0 + LDSCTL_OFF + 1024);
    if (PROBE_K1 >= 0 && blockIdx.x == 0 && threadIdx.x == 0) TS[0] = __builtin_amdgcn_s_memrealtime();
#define STEP_BEGIN(s) if (lo <= (s) && (s) < hi) { Frame F; F.lds = lds0; F.p = &P; \
        { int tid = threadIdx.x; asm volatile("" : "+v"(tid)); F.tid = tid; F.lane = tid & 63; F.wave = __builtin_amdgcn_readfirstlane(tid >> 6); } \
        { int G = gridDim.x, bx = blockIdx.x, oz = 0; asm volatile("" : "+s"(G), "+s"(bx), "+s"(oz)); F.G = G; F.bid = bx; F.vcu = (G % 8 == 0) ? (bx % 8) * (G / 8) + bx / 8 : bx; F.oz = oz; F.out = P.out + oz; }
#define STAMP() do { if (PROBE_K1 >= 0 && blockIdx.x == 0 && threadIdx.x == 0) { const int o_ = (int)TS[63]; if (o_ < 62) TS[o_ + 1] = __builtin_amdgcn_s_memrealtime(); TS[63] = (unsigned long long)(o_ + 1); } } while (0)
#define STEP_END(s) if (multi && (s) + 1 < hi) { XcdBarrier bb = bar; asm volatile("" : "+s"(bb.bar), "+s"(bb.x)); xcd_barrier(bb, F.tid); } else __syncthreads(); STAMP(); }

#define STEP_LINK(s) __syncthreads(); STAMP(); }
    STEP_BEGIN(0) phase_prologue(F); STEP_END(0)
    for (int l = 0; l < DEPTH; ++l) {
        const int s0 = 1 + 10 * l; const bool even = (l & 1) == 0; const int sub = l >> 1;
        const int dep_in = l > 0 ? (l - 1) * 3 + 2 : -1;
        if (l == 0) { STEP_BEGIN(1) phase_pre(F); STEP_END(1) }
        if (even) {
            STEP_BEGIN(s0 + 1) run_gemm<EK_EVEN_IN>(F, l, sub, 0, WSP(bf16_t, WS_XN), D, D, 0, WSP(bf16_t, WS_WINE) + (size_t)sub * PEP * D, 10, true, dep_in, 4, -1, 0, l * 4 + 3); STEP_END(s0 + 1)
            STEP_BEGIN(s0 + 2) phase_attn_g1(F, sub); STEP_END(s0 + 2)
            STEP_BEGIN(s0 + 3) phase_g2(F, sub); STEP_END(s0 + 3)
            STEP_BEGIN(s0 + 4) phase_g3(F, sub); STEP_END(s0 + 4)
            STEP_BEGIN(s0 + 6) run_gemm<EK_RES>(F, l, sub, 2, WSP(bf16_t, WS_MIX), D, D, 0, WSP(bf16_t, WS_WOUTE) + (size_t)sub * D * D, 4, true, -1, 0, l * 3 + 0, 0, -1); STEP_LINK(s0 + 6)
        } else {
            STEP_BEGIN(s0 + 1) run_gemm<EK_ODD_IN>(F, l, sub, 0, WSP(bf16_t, WS_XN), D, D, 0, WSP(bf16_t, WS_WINO) + (size_t)sub * 2048 * D, 8, true, dep_in, 4, -1, 0, l * 4 + 3); STEP_END(s0 + 1)
            STEP_BEGIN(s0 + 2) phase_conv(F, sub); STEP_END(s0 + 2)
            STEP_BEGIN(s0 + 3) run_gemm<EK_GATES>(F, l, sub, 0, WSP(bf16_t, WS_UC), D, 256, 4, WSP(bf16_t, WS_WG) + (size_t)sub * 4096 * 256, 16, true, -1, 0, -1, 0, -1); STEP_END(s0 + 3)
            STEP_BEGIN(s0 + 4) phase_carry(F, sub); STEP_END(s0 + 4)
            STEP_BEGIN(s0 + 5) phase_lru_out(F); STEP_END(s0 + 5)
            STEP_BEGIN(s0 + 6) run_gemm<EK_RES>(F, l, sub, 2, WSP(bf16_t, WS_BB), D, D, 0, WSP(bf16_t, WS_WOUTO) + (size_t)sub * D * D, 4, true, -1, 0, l * 3 + 0, 0, -1); STEP_LINK(s0 + 6)
        }
        STEP_BEGIN(s0 + 8) run_gemm<EK_SWIGLU>(F, l, sub, 0, WSP(bf16_t, WS_XN), D, D, 0, WSP(bf16_t, WS_WF1) + (size_t)l * 5632 * D, 22, true, l * 3 + 0, 4, l * 3 + 1, 0, l * 4 + 1); STEP_LINK(s0 + 8)
        if (l + 1 < DEPTH) { STEP_BEGIN(s0 + 9) run_gemm<EK_RES>(F, l, sub, 5, WSP(bf16_t, WS_H), DFF, DFF, 0, WSP(bf16_t, WS_WF2) + (size_t)l * D * DFF, 4, true, l * 3 + 1, 22, l * 3 + 2, 0, -1); STEP_LINK(s0 + 9) }
        else           { STEP_BEGIN(s0 + 9) run_gemm<EK_RES>(F, l, sub, 5, WSP(bf16_t, WS_H), DFF, DFF, 0, WSP(bf16_t, WS_WF2) + (size_t)l * D * DFF, 4, true, l * 3 + 1, 22, -1, 0, -1); STEP_END(s0 + 9) }
    }
    STEP_BEGIN(41) phase_final(F); STEP_END(41)
#undef STEP_LINK
    if (PROBE_K1 >= 0 && blockIdx.x == 0 && threadIdx.x == 0) {
        unsigned long long q1 = (TS[PROBE_K1 + 1] - TS[PROBE_K1]) / 800ull; if (q1 > 63) q1 = 63;
        unsigned long long q2 = PROBE_K2 >= 0 ? (TS[PROBE_K2 + 1] - TS[PROBE_K2]) / 800ull : 0ull; if (q2 > 63) q2 = 63;
        const unsigned long long wait = (64ull * q1 + 4096ull * q2) * 100ull, t0 = __builtin_amdgcn_s_memrealtime();
        while (__builtin_amdgcn_s_memrealtime() - t0 < wait) __builtin_amdgcn_s_sleep(32);
    }
#undef STEP_BEGIN
#undef STEP_END
}

extern "C" void kernel_launch(void* const* d_in, const int* in_sizes, int n_in, void* d_out, int out_size, void* d_ws, size_t ws_size, hipStream_t stream) {
    static int grid = 0;
    if (grid == 0) {
        if (n_in != 30 || (size_t)out_size != OUT_END || ws_size < WS_END) { fprintf(stderr, "kernel_launch: unexpected shapes: n_in %d out %d ws %zu (need %zu)\n", n_in, out_size, ws_size, (size_t)WS_END); grid = -1; return; }
        int dev = 0, cus = 0;
        if (hipGetDevice(&dev) != hipSuccess || hipDeviceGetAttribute(&cus, hipDeviceAttributeMultiprocessorCount, dev) != hipSuccess) { grid = -1; return; }
        if (hipFuncSetAttribute((const void*)mk_fwd, hipFuncAttributeMaxDynamicSharedMemorySize, LDS_BYTES) != hipSuccess) { fprintf(stderr, "kernel_launch: hipFuncSetAttribute failed\n"); grid = -1; return; }
        (void)hipGetLastError();
        grid = cus;
        if (grid != 256) fprintf(stderr, "kernel_launch: %d CUs (built for 256)\n", grid);
    }
    if (grid < 0) return;
    (void)hipMemsetAsync((char*)d_ws + WS_CTL, 0, CTL_ZERO_BYTES, stream);
    Params p{};
    for (int i = 0; i < 30; ++i) p.in[i] = (const float*)d_in[i];
    p.out = (float*)d_out; p.ws = (unsigned char*)d_ws;
#if MK_MULTI
    for (int s = 0; s < NSTEPS; ++s) {
        if (s >= 1 && s <= 40) { const int l = (s - 1) / 10, j = (s - 1) % 10; if (((l & 1) == 0 && j == 5) || j == 7 || (j == 0 && l > 0)) continue; }
        p.step_lo = s; p.step_hi = s + 1;
        hipLaunchKernelGGL(mk_fwd, dim3(grid), dim3(NTHREADS), LDS_BYTES, stream, p);
    }
#else
    p.step_lo = 0; p.step_hi = NSTEPS;
    hipLaunchKernelGGL(mk_fwd, dim3(grid), dim3(NTHREADS), LDS_BYTES, stream, p);
#endif
}
```

```cpp
#include <hip/hip_runtime.h>
#include <cstdio>
#include <cstdint>

#ifndef MK_MULTI
#define MK_MULTI 0
#endif

#ifndef PROBE_K1
#define PROBE_K1 -1
#endif
#ifndef PROBE_K2
#define PROBE_K2 -1
#endif
#define LAS __attribute__((address_space(3)))
#define GAS __attribute__((address_space(1)))
typedef unsigned short bf16_t;
typedef short bf16x8 __attribute__((ext_vector_type(8)));
typedef short s16x4 __attribute__((ext_vector_type(4)));
typedef float f32x2 __attribute__((ext_vector_type(2)));
typedef float f32x4 __attribute__((ext_vector_type(4)));
typedef float f32x16 __attribute__((ext_vector_type(16)));
typedef unsigned u32x2 __attribute__((ext_vector_type(2)));
typedef unsigned u32x4 __attribute__((ext_vector_type(4)));
typedef LAS unsigned char* lptr;

constexpr int D = 1024, NCTX = 16, TCTX = 256, NLAT = 4, TLAT = 4096, DEPTH = 4;
constexpr int MCTX = NCTX * TCTX;
constexpr int M = MCTX + NLAT * TLAT;
constexpr int PE = 2336, PEP = 2560;
constexpr int ZW = 2304;
constexpr int DFF = 2816;
constexpr float EPS = 1e-6f;
constexpr float LOG2E = 1.4426950408889634f;
constexpr float QSCALE = 0.125f * LOG2E;
constexpr int NCHUNK = M / 64;

constexpr size_t OUT_CK = (size_t)M * D, OUT_CV = OUT_CK + 1048576, OUT_GLA = OUT_CV + 1048576, OUT_LRU = OUT_GLA + 2097152, OUT_END = OUT_LRU + 65536;

constexpr size_t MiB = 1u << 20;
constexpr size_t WS_CTL = 0, CTL_ZERO_BYTES = 128 * 1024;
constexpr unsigned F2_T0 = 144;
constexpr int CW_Q = 12288;
constexpr int CW_CNT = 16384;
constexpr size_t WS_BIAS = 256 * 1024;
constexpr size_t BIAS_E = 0, BIAS_O = 2 * 5 * 2560, BIAS_F = BIAS_O + 2 * 5 * 2048, BIAS_TOTAL = BIAS_F + 4 * 5 * 5632;
constexpr size_t SSQP_OFF = 10485760;
constexpr size_t WS_SSQ_UNUSED = 3 * MiB;
constexpr size_t WS_MOD = 1 * MiB;
constexpr size_t WS_ROPE = WS_MOD + 512 * 1024;
constexpr size_t WS_CK = 2 * MiB, WS_CV = 2 * MiB + 512 * 1024;
constexpr size_t WS_WINE = 4 * MiB;
constexpr size_t WS_WOUTE = WS_WINE + 10 * MiB;
constexpr size_t WS_WINO = WS_WOUTE + 4 * MiB;
constexpr size_t WS_WG = WS_WINO + 8 * MiB;
constexpr size_t WS_WOUTO = WS_WG + 4 * MiB;
constexpr size_t WS_WF1 = WS_WOUTO + 4 * MiB;
constexpr size_t WS_WF2 = WS_WF1 + 44 * MiB;
constexpr size_t WS_XN = WS_WF2 + 22 * MiB;
static_assert(WS_XN == 100 * MiB, "ws map");
constexpr size_t WS_BIG = 140 * MiB;
constexpr size_t WS_ZE = 140 * MiB;
constexpr size_t WS_KV = 230 * MiB;
constexpr size_t WS_MIX = 340 * MiB;
constexpr size_t WS_LR = 380 * MiB;
constexpr size_t WS_DL = 383 * MiB;
constexpr size_t WS_G = 140 * MiB;
constexpr size_t WS_U = 180 * MiB;
constexpr size_t WS_UC = 220 * MiB;
constexpr size_t WS_LAF = 260 * MiB;
constexpr size_t WS_LAB = 300 * MiB;
constexpr size_t WS_BB = 340 * MiB;
constexpr size_t WS_AGG = WS_XN;
constexpr size_t WS_CARRY = WS_XN + 8 * MiB;
constexpr size_t WS_H = 230 * MiB;
constexpr size_t WS_SSQ8 = 220 * MiB;
constexpr size_t WS_XF = 140 * MiB;
constexpr size_t WS_END = 384 * MiB;

constexpr int RING_BYTES = 131072;
constexpr int LDSCTL_OFF = RING_BYTES, MISC_OFF = LDSCTL_OFF + 320;
constexpr int LDS_BYTES = 147456;
constexpr int NWAVES = 8, NTHREADS = 512;

__device__ __forceinline__ unsigned f2bf(float f) { unsigned u = __builtin_bit_cast(unsigned, f); return (u + 0x7fffu + ((u >> 16) & 1u)) >> 16; }
typedef __bf16 bf16x2_t __attribute__((ext_vector_type(2)));
__device__ __forceinline__ unsigned pk2(float lo, float hi) { const f32x2 v = {lo, hi}; return __builtin_bit_cast(unsigned, __builtin_convertvector(v, bf16x2_t)); }
__device__ __forceinline__ float bf2f(unsigned short b) { return __builtin_bit_cast(float, (unsigned)b << 16); }
__device__ __forceinline__ float bflo(unsigned w) { return __builtin_bit_cast(float, w << 16); }
__device__ __forceinline__ float bfhi(unsigned w) { return __builtin_bit_cast(float, w & 0xffff0000u); }
__device__ __forceinline__ float fexp2(float x) { return __builtin_amdgcn_exp2f(x); }
__device__ __forceinline__ float fexp(float x) { return __builtin_amdgcn_exp2f(x * LOG2E); }
__device__ __forceinline__ float frcp(float x) { return __builtin_amdgcn_rcpf(x); }
__device__ __forceinline__ float frsq(float x) { return __builtin_amdgcn_rsqf(x); }
__device__ __forceinline__ float fsqrt(float x) { return __builtin_amdgcn_sqrtf(x); }
__device__ __forceinline__ float flog(float x) { return __builtin_amdgcn_logf(x) * 0.6931471805599453f; }
__device__ __forceinline__ float sigmoidf_(float x) { return frcp(1.0f + fexp(-x)); }
__device__ __forceinline__ float siluf_(float x) { return x * frcp(1.0f + fexp(-x)); }
__device__ __forceinline__ float gelu_tanh(float x) { const float z = 0.7978845608028654f * (x + 0.044715f * x * x * x); const float t = 1.0f - 2.0f * frcp(fexp(2.0f * z) + 1.0f); return 0.5f * x * (1.0f + t); }
__device__ __forceinline__ int crow(int r, int hh) { return (r & 3) + 8 * (r >> 2) + 4 * hh; }
__device__ __forceinline__ int cond_of_row(int row) { return row < MCTX ? 0 : 1 + ((row - MCTX) >> 12); }
#define LDS_WAIT() asm volatile("s_waitcnt lgkmcnt(0)" ::: "memory")
#define VM_WAIT() asm volatile("s_waitcnt vmcnt(0)" ::: "memory")
__device__ __forceinline__ s16x4 tr_read(lptr p) { typedef short v4i16_t __attribute__((ext_vector_type(4))); return __builtin_bit_cast(s16x4, __builtin_amdgcn_ds_read_tr16_b64_v4i16((LAS v4i16_t*)p)); }
__device__ __forceinline__ bf16x8 tr_frag(lptr p) { const s16x4 a = tr_read(p), b = tr_read(p + 512); return (bf16x8){a[0], a[1], a[2], a[3], b[0], b[1], b[2], b[3]}; }
__device__ __forceinline__ float shfl_idx(float v, int src_lane) { return __builtin_bit_cast(float, __builtin_amdgcn_ds_bpermute(src_lane << 2, __builtin_bit_cast(int, v))); }
__device__ __forceinline__ float shfl_x(float v, int lane, int mask) { return shfl_idx(v, lane ^ mask); }
__device__ __forceinline__ float wave_sum(float v, int lane) {
#pragma unroll
    for (int o = 1; o < 64; o <<= 1) v += shfl_x(v, lane, o);
    return v;
}

struct Params {
    const float* in[30];
    float* out; unsigned char* ws;
    int step_lo, step_hi;
};
enum { I_XP = 0, I_XS, I_C, I_CK, I_CV, I_SGLA, I_SLRU, I_CCTX, I_WADA, I_BADA, I_NMIX, I_NFFN, I_WINE, I_SINK, I_WALPHA, I_BALPHA, I_GGAIN, I_WOUTE,
       I_WINO, I_CONVW, I_CONVB, I_WGA, I_BGA, I_WGX, I_BGX, I_LAM, I_WOUTO, I_WF1, I_WF2, I_NFIN };

namespace pg8 {
constexpr int BM = 256, BK = 64, HALF = 128, HTB = HALF * BK * 2, STAGE_BYTES = 8 * HTB, NXCD = 8, WGM = 8;
__device__ __forceinline__ int lds_byte(int r, int c) { const int st = (r >> 4) * 2 + (c >> 5), rr = r & 15, cc = c & 31, ob = rr * 64 + cc * 2; return st * 1024 + (ob ^ (((ob >> 9) & 1) << 5)); }
__device__ __forceinline__ void stage_rc(int b, int& R, int& C) { const int st = b / 1024, sb = b % 1024, swz = sb ^ (((sb >> 9) & 1) << 5); R = (st >> 1) * 16 + swz / 64; C = (st & 1) * 32 + (swz % 64) / 2; }
__device__ __forceinline__ int perm32(int rho) { const int n = rho >> 4, i = rho & 15; return 8 * (i >> 2) + 4 * n + (i & 3); }
struct Unit { int pm, pn; };
struct Gemm { const bf16_t* A; const bf16_t* Bt; int lda, K, nM, nN, a_grp; bool perm; };
struct StaticOrder {
    int nM, nN, nwg, G, c;
    unsigned* queue; LAS unsigned* word;
    int rot;
    unsigned stop_at; int jlo, jhi; bool again;
    unsigned* ready; unsigned need; unsigned* fin;
    __device__ void init(int nM_, int nN_, int G_, int c_) { nM = nM_; nN = nN_; nwg = nM * nN; G = G_; c = c_; rot = 0; ready = nullptr; need = 0; fin = nullptr; queue = nullptr; word = nullptr; stop_at = 0; jlo = 0; jhi = 1 << 30; again = false; }
    __device__ __forceinline__ void a_ready(const Unit& u, int tid) const {
        if (ready == nullptr) return;
        if (tid < 64) { unsigned* p = ready + 16 * u.pm; unsigned sp = 0;
            while ((unsigned)__builtin_amdgcn_readfirstlane(__hip_atomic_load(p, __ATOMIC_RELAXED, __HIP_MEMORY_SCOPE_AGENT)) < need) { __builtin_amdgcn_s_sleep(2); if (++sp > (1u << 22)) break; }
            __builtin_amdgcn_fence(__ATOMIC_ACQUIRE, "agent");
            asm volatile("s_waitcnt vmcnt(0)" ::: "memory"); }
        asm volatile("" ::: "memory"); __builtin_amdgcn_s_barrier(); asm volatile("" ::: "memory");
    }
    __device__ __forceinline__ void unit_of(int j, Unit& u) const { const int x = c & 7, g = j / (5 * nN), jj = j % (5 * nN); u.pn = jj / 5; u.pm = 10 * x + 5 * g + jj % 5; }
    __device__ __forceinline__ bool fetch(int i, Unit& u, int tid) const {
        if (queue == nullptr) { const bool h = next(i, u); if (h) a_ready(u, tid); return h; }
        if (tid < 64) { unsigned j = 0; if (tid == 0) { unsigned* q = queue + 16 * (c & 7);
                if (stop_at != 0 && __hip_atomic_load(q, __ATOMIC_RELAXED, __HIP_MEMORY_SCOPE_AGENT) >= stop_at) j = 0xffffffffu; else j = __hip_atomic_fetch_add(q, 1u, __ATOMIC_RELAXED, __HIP_MEMORY_SCOPE_AGENT); }
            j = (unsigned)__builtin_amdgcn_readfirstlane((int)j);
            if (j < (unsigned)(10 * nN) && ready != nullptr) { Unit t; unit_of((int)j, t); unsigned* p = ready + 16 * t.pm; unsigned sp = 0;
                while ((unsigned)__builtin_amdgcn_readfirstlane(__hip_atomic_load(p, __ATOMIC_RELAXED, __HIP_MEMORY_SCOPE_AGENT)) < need) { __builtin_amdgcn_s_sleep(2); if (++sp > (1u << 22)) break; }
                __builtin_amdgcn_fence(__ATOMIC_ACQUIRE, "agent"); asm volatile("s_waitcnt vmcnt(0)" ::: "memory"); }
            if (tid == 0) *word = j;
            asm volatile("s_waitcnt lgkmcnt(0)" ::: "memory"); }
        asm volatile("" ::: "memory"); __builtin_amdgcn_s_barrier(); asm volatile("" ::: "memory");
        const unsigned j = *(volatile LAS unsigned*)word;
        if (j >= (unsigned)(10 * nN)) return false;
        unit_of((int)j, u); return true;
    }
    __device__ __forceinline__ void done(const Unit& u, int lane) const {
        if (fin == nullptr) return;
        asm volatile("s_waitcnt vmcnt(0)" ::: "memory");
        if (lane == 0) __hip_atomic_fetch_add(fin + 16 * u.pm, 1u, __ATOMIC_RELAXED, __HIP_MEMORY_SCOPE_AGENT);
    }
    __device__ bool next(int i, Unit& u) const {
        if (G == 256 && nM == 80) { const int x = c & 7, idx = ((c >> 3) + rot) & 31; int j = -1, cnt = 0;
            for (int jj = idx; jj < 10 * nN; jj += 32) if (jj >= jlo && jj < jhi) { if (cnt == i) j = jj; ++cnt; }
            if (j < 0) return false;
            const int g = j / (5 * nN), jj = j % (5 * nN); u.pn = jj / 5; u.pm = 10 * x + 5 * g + jj % 5; return true; }
        if (again) return false;
        const long L = (long)i * G + c; if (L >= nwg) return false;
        int wgid = (int)L; { const int q = nwg / NXCD, r = nwg % NXCD, xcd = wgid % NXCD, off = wgid / NXCD; wgid = (xcd < r ? xcd * (q + 1) : r * (q + 1) + (xcd - r) * q) + off; }
        const int nig = WGM * nN, gid = wgid / nig, fm = gid * WGM, gsz = (nM - fm) < WGM ? (nM - fm) : WGM;
        u.pm = fm + ((wgid % nig) % gsz); u.pn = (wgid % nig) / gsz; return true;
    }
};

template <class Epi>
__device__ __forceinline__ void gemm_phase(lptr lds, const int tid, const float zf, const Gemm g, const StaticOrder& S, const Epi& E) {
    const int wid = __builtin_amdgcn_readfirstlane(tid >> 6), lane = tid & 63, wr = wid >> 2, wc = wid & 3, fr = lane & 15, fq = lane >> 4;
    const int K = g.K, nt = K / BK, lda = g.lda;
    unsigned voffA[2], voffB[2];
#pragma unroll
    for (int i = 0; i < 2; ++i) { int R, C; stage_rc(tid * 16 + i * 8192, R, C); const int Rb = g.perm ? ((R & ~31) + perm32(R & 31)) : R;
        voffA[i] = (unsigned)(R * lda + C) * 2u; voffB[i] = (unsigned)(Rb * K + C) * 2u; }
    const size_t kstep = (size_t)(BK * 2);
    const size_t hsA = (size_t)HALF * lda * 2, hsB = (size_t)HALF * K * 2;
    const unsigned ldsw = (unsigned)wid * 1024u;
    const int aoff = lds_byte(wr * 64 + fr, fq * 8), boff = lds_byte(wc * 32 + fr, fq * 8);
#define PG8_SA(b, h) (((b) * 2 + (h)) * HTB)
#define PG8_SB(b, h) ((4 + (b) * 2 + (h)) * HTB)
#define PG8_STAGE(bufoff, gbase, voff) do { _Pragma("unroll") for (int _i = 0; _i < 2; ++_i) \
        __builtin_amdgcn_global_load_lds((const unsigned*)((const char*)(gbase) + (voff)[_i]), (LAS unsigned*)(lds + (bufoff) + ldsw + _i * 8192), 16, 0, 0); } while (0)
#define PG8_LDA(dst, b, h) do { _Pragma("unroll") for (int m = 0; m < 4; ++m) _Pragma("unroll") for (int k = 0; k < 2; ++k) dst[m][k] = *(const LAS bf16x8*)(lds + PG8_SA(b, h) + aoff + m * 2048 + k * 1024); } while (0)
#define PG8_LDB(dst, b, h) do { _Pragma("unroll") for (int n = 0; n < 2; ++n) _Pragma("unroll") for (int k = 0; k < 2; ++k) dst[n][k] = *(const LAS bf16x8*)(lds + PG8_SB(b, h) + boff + n * 2048 + k * 1024); } while (0)
#define PG8_MMA(ai, bj, At, Bt) do { __builtin_amdgcn_s_setprio(1); _Pragma("unroll") for (int m = 0; m < 4; ++m) _Pragma("unroll") for (int n = 0; n < 2; ++n) _Pragma("unroll") for (int k = 0; k < 2; ++k) \
        acc[ai][bj][m][n] = __builtin_amdgcn_mfma_f32_16x16x32_bf16(Bt[n][k], At[m][k], acc[ai][bj][m][n], 0, 0, 0); __builtin_amdgcn_s_setprio(0); } while (0)
#define PG8_WAIT_V(n) asm volatile("s_waitcnt vmcnt(" #n ")" ::: "memory")
#define PG8_WAIT_L(n) asm volatile("s_waitcnt lgkmcnt(" #n ")" ::: "memory")
#define PG8_BAR __builtin_amdgcn_s_barrier()
#define PG8_SCHED __builtin_amdgcn_sched_barrier(0)
#define PG8_ABASE(u) ((const char*)g.A + ((size_t)(u).pm * BM * lda + (g.a_grp ? (size_t)((u).pn / g.a_grp) * K : 0)) * 2)
#define PG8_BBASE(u) ((const char*)g.Bt + (size_t)(u).pn * BM * K * 2)
    Unit cur, nxt; int ui = 0;
    if (!S.fetch(0, cur, tid)) return;
    f32x4 acc[2][2][4][2];
#pragma unroll
    for (int a = 0; a < 2; ++a)
#pragma unroll
        for (int b = 0; b < 2; ++b)
#pragma unroll
            for (int m = 0; m < 4; ++m)
#pragma unroll
                for (int n = 0; n < 2; ++n) acc[a][b][m][n] = (f32x4){zf, zf, zf, zf};
    bf16x8 At[4][2], B0[2][2], B1[2][2];
    const char* cA = PG8_ABASE(cur); const char* cB = PG8_BBASE(cur);
    PG8_STAGE(PG8_SB(0, 0), cB, voffB); PG8_STAGE(PG8_SB(0, 1), cB + hsB, voffB); PG8_STAGE(PG8_SA(0, 0), cA, voffA); PG8_STAGE(PG8_SA(0, 1), cA + hsA, voffA);
    if (wr == 1) PG8_BAR;
    PG8_WAIT_V(2); PG8_BAR;
    PG8_STAGE(PG8_SB(1, 0), cB + kstep, voffB); PG8_STAGE(PG8_SA(1, 0), cA + kstep, voffA); PG8_STAGE(PG8_SB(1, 1), cB + hsB + kstep, voffB);
    PG8_WAIT_V(6); PG8_BAR;
    for (;;) {
        bool has_next = false; const char* nA = cA; const char* nB = cB;
#pragma unroll 1
        for (int t = 0; t < nt; t += 2) {
            const bool last = (t == nt - 2);
            if (last) { has_next = S.fetch(ui + 1, nxt, tid); if (has_next) { nA = PG8_ABASE(nxt); nB = PG8_BBASE(nxt); } }
            const char* a1 = cA + (size_t)(t + 1) * kstep;
            const char* a2 = last ? nA : cA + (size_t)(t + 2) * kstep; const char* b2 = last ? nB : cB + (size_t)(t + 2) * kstep;
            const char* a3 = a2 + kstep; const char* b3 = b2 + kstep;
            PG8_LDB(B0, 0, 0); PG8_LDB(B1, 0, 1); PG8_SCHED; PG8_LDA(At, 0, 0); PG8_STAGE(PG8_SA(1, 1), a1 + hsA, voffA);
            PG8_WAIT_V(8); PG8_WAIT_L(0); PG8_BAR; PG8_MMA(0, 0, At, B0); PG8_MMA(0, 1, At, B1); PG8_BAR; PG8_SCHED;
            PG8_LDA(At, 0, 1); PG8_STAGE(PG8_SB(0, 0), b2, voffB); PG8_STAGE(PG8_SB(0, 1), b2 + hsB, voffB); PG8_STAGE(PG8_SA(0, 0), a2, voffA);
            PG8_WAIT_V(8); PG8_WAIT_L(0); PG8_BAR; PG8_MMA(1, 0, At, B0); PG8_MMA(1, 1, At, B1); PG8_BAR; PG8_SCHED;
            PG8_LDB(B0, 1, 0); PG8_LDB(B1, 1, 1); PG8_SCHED; PG8_LDA(At, 1, 0); PG8_STAGE(PG8_SA(0, 1), a2 + hsA, voffA);
            PG8_WAIT_V(8); PG8_WAIT_L(0); PG8_BAR; PG8_MMA(0, 0, At, B0); PG8_MMA(0, 1, At, B1); PG8_BAR; PG8_SCHED;
            PG8_LDA(At, 1, 1); PG8_STAGE(PG8_SB(1, 0), b3, voffB); PG8_STAGE(PG8_SB(1, 1), b3 + hsB, voffB); PG8_STAGE(PG8_SA(1, 0), a3, voffA);
            PG8_WAIT_V(8); PG8_WAIT_L(0); PG8_BAR; PG8_MMA(1, 0, At, B0); PG8_MMA(1, 1, At, B1); PG8_BAR; PG8_SCHED;
        }
        if (wr == 0) PG8_BAR;
        { int fr_ = fr, fq_ = fq; asm volatile("" : "+v"(fr_), "+v"(fq_)); E(acc, cur, wr, wc, fr_, fq_); S.done(cur, fq_ * 16 + fr_); }
        if (!has_next) break;
#pragma unroll
        for (int a = 0; a < 2; ++a)
#pragma unroll
            for (int b = 0; b < 2; ++b)
#pragma unroll
                for (int m = 0; m < 4; ++m)
#pragma unroll
                    for (int n = 0; n < 2; ++n) acc[a][b][m][n] = (f32x4){zf, zf, zf, zf};
        cur = nxt; cA = nA; cB = nB; ++ui;
        if (wr == 1) PG8_BAR;
    }
    PG8_WAIT_V(0);
    PG8_BAR;
#undef PG8_SA
#undef PG8_SB
#undef PG8_STAGE
#undef PG8_LDA
#undef PG8_LDB
#undef PG8_MMA
#undef PG8_WAIT_V
#undef PG8_WAIT_L
#undef PG8_BAR
#undef PG8_SCHED
#undef PG8_ABASE
#undef PG8_BBASE
}
}

enum EpiKind { EK_EVEN_IN = 0, EK_ODD_IN, EK_GATES, EK_RES, EK_SWIGLU };
template <int kind> struct Epi {
    int layer, sub; int gidx;
    const Params* p; int oz;
#define EWS(T, off) ((T*)(p->ws + ((size_t)(off) + (size_t)oz)))
#define EIN(i) (p->in[(i) + oz])
#define NORM_FIX_SETUP(NIDX, BOFF, NTOT) float rs_[2][4]; f32x4 bia_[2][2]; { const float* sq_ = p->out + oz + SSQP_OFF + (size_t)(NIDX) * M * 16; \
        _Pragma("unroll") for (int ai = 0; ai < 2; ++ai) _Pragma("unroll") for (int m = 0; m < 4; ++m) { const f32x4 a_ = *(const f32x4*)(sq_ + (size_t)(row0 + ai * 128 + m * 16) * 16 + 4 * fq); \
            float s_ = (a_[0] + a_[1]) + (a_[2] + a_[3]); s_ += shfl_x(s_, fq * 16 + fr, 16); s_ += shfl_x(s_, fq * 16 + fr, 32); rs_[ai][m] = frsq(s_ * (1.0f / D) + EPS); }     \
        const float* bp_ = EWS(const float, WS_BIAS) + (BOFF) + (size_t)cond_of_row(u.pm * 256) * (NTOT) + u.pn * 256 + wc * 32 + 8 * fq; \
        _Pragma("unroll") for (int bj = 0; bj < 2; ++bj) _Pragma("unroll") for (int n = 0; n < 2; ++n) bia_[bj][n] = *(const f32x4*)(bp_ + bj * 128 + 4 * n); }
#define FIXV(ai, bj, m, n) (acc[ai][bj][m][n] * rs_[ai][m] + bia_[bj][n])
    __device__ __forceinline__ void operator()(const f32x4 (&acc)[2][2][4][2], const pg8::Unit& u, int wr, int wc, int fr, int fq) const {
        const int row0 = u.pm * 256 + wr * 64 + fr;
        float* const X = p->out + oz;
        if constexpr (kind == EK_RES) {
            const float* mod = EWS(const float, WS_MOD);
            const int ci = cond_of_row(u.pm * 256);
            const float* gate = mod + ((size_t)(layer * 5 + ci) * 6 + gidx) * 1024;
            const int col0 = u.pn * 256 + wc * 32 + 8 * fq;
            const int nn = (gidx == 2) ? 2 * layer + 1 : 2 * layer + 2;
            const bool fin = nn == 8;
            const float* nw = (gidx == 2) ? EIN(I_NFFN) + layer * 1024 : (fin ? EIN(I_NFIN) : EIN(I_NMIX) + (layer + 1) * 1024);
            const float* scv = mod + ((size_t)((gidx == 2 ? layer : (fin ? layer : layer + 1)) * 5 + ci) * 6 + (gidx == 2 ? 4 : 1)) * 1024;
            f32x4 gv[2][2], gp[2][2];
#pragma unroll
            for (int bj = 0; bj < 2; ++bj)
#pragma unroll
                for (int n = 0; n < 2; ++n) { gv[bj][n] = *(const f32x4*)(gate + col0 + bj * 128 + n * 4);
                    gp[bj][n] = *(const f32x4*)(nw + col0 + bj * 128 + n * 4); if (!fin) gp[bj][n] = gp[bj][n] * (1.0f + *(const f32x4*)(scv + col0 + bj * 128 + n * 4)); }
            bf16_t* XN = EWS(bf16_t, WS_XN); float* ssq = (fin ? EWS(float, WS_SSQ8) : p->out + oz + SSQP_OFF + (size_t)nn * M * 16) + u.pn * 4 + wc;
            const int lane_ = fq * 16 + fr;
            bf16_t* Xb = (bf16_t*)X; const bool from_in = (layer == 0 && gidx == 2);
            const float* Xr = u.pm < 16 ? EIN(I_XP) : EIN(I_XS) - (size_t)MCTX * D;
#pragma unroll
            for (int h8 = 0; h8 < 4; ++h8) { const int ai = h8 >> 1, mb = (h8 & 1) * 2;
                f32x4 xo[2][2][2];
                if (from_in) {
#pragma unroll
                    for (int mm = 0; mm < 2; ++mm)
#pragma unroll
                        for (int bj = 0; bj < 2; ++bj)
#pragma unroll
                            for (int n = 0; n < 2; ++n) xo[mm][bj][n] = *(const f32x4*)(Xr + (size_t)(row0 + ai * 128 + (mb + mm) * 16) * D + col0 + bj * 128 + n * 4);
                } else { u32x4 xw[2][2];
#pragma unroll
                    for (int mm = 0; mm < 2; ++mm)
#pragma unroll
                        for (int bj = 0; bj < 2; ++bj) xw[mm][bj] = *(const u32x4*)(Xb + (size_t)(row0 + ai * 128 + (mb + mm) * 16) * D + col0 + bj * 128);
#pragma unroll
                    for (int mm = 0; mm < 2; ++mm)
#pragma unroll
                        for (int bj = 0; bj < 2; ++bj) { const u32x4 w = xw[mm][bj]; xo[mm][bj][0] = (f32x4){bflo(w.x), bfhi(w.x), bflo(w.y), bfhi(w.y)}; xo[mm][bj][1] = (f32x4){bflo(w.z), bfhi(w.z), bflo(w.w), bfhi(w.w)}; } }
#pragma unroll
                for (int mm = 0; mm < 2; ++mm) { const int m = mb + mm; const int row = row0 + ai * 128 + m * 16; float sq = 0.f;
#pragma unroll
                    for (int bj = 0; bj < 2; ++bj) { const f32x4 x0 = xo[mm][bj][0] + gv[bj][0] * acc[ai][bj][m][0], x1 = xo[mm][bj][1] + gv[bj][1] * acc[ai][bj][m][1];
                        *(u32x4*)((fin ? EWS(bf16_t, WS_XF) : Xb) + (size_t)row * D + col0 + bj * 128) = (u32x4){pk2(x0[0], x0[1]), pk2(x0[2], x0[3]), pk2(x1[0], x1[1]), pk2(x1[2], x1[3])};
                        sq += ((x0[0] * x0[0] + x0[1] * x0[1]) + (x0[2] * x0[2] + x0[3] * x0[3])) + ((x1[0] * x1[0] + x1[1] * x1[1]) + (x1[2] * x1[2] + x1[3] * x1[3]));
                        if (!fin) { const f32x4 y0 = x0 * gp[bj][0], y1 = x1 * gp[bj][1]; const u32x4 w = (u32x4){pk2(y0[0], y0[1]), pk2(y0[2], y0[3]), pk2(y1[0], y1[1]), pk2(y1[2], y1[3])};
                            bf16_t* xp = XN + (size_t)row * D + col0 + bj * 128;
                            asm volatile("global_store_dwordx4 %0, %1, off sc1\n\ts_nop 1" :: "v"(xp), "v"(w) : "memory"); } }
                    sq += shfl_x(sq, lane_, 16); sq += shfl_x(sq, lane_, 32);
                    if (fq == 0) __hip_atomic_store(ssq + (size_t)row * 16, sq, __ATOMIC_RELAXED, __HIP_MEMORY_SCOPE_AGENT); }
            }
        } else if constexpr (kind == EK_SWIGLU) {
            bf16_t* H = EWS(bf16_t, WS_H); const int col0 = u.pn * 128 + wc * 32 + 8 * fq;
            NORM_FIX_SETUP(2 * layer + 1, BIAS_F + (size_t)layer * 5 * 5632, 5632)
#pragma unroll
            for (int ai = 0; ai < 2; ++ai)
#pragma unroll
                for (int m = 0; m < 4; ++m) { const f32x4 g0 = FIXV(ai, 0, m, 0), g1 = FIXV(ai, 0, m, 1), u0 = FIXV(ai, 1, m, 0), u1 = FIXV(ai, 1, m, 1);
                    u32x4 w; w.x = pk2(siluf_(g0[0]) * u0[0], siluf_(g0[1]) * u0[1]); w.y = pk2(siluf_(g0[2]) * u0[2], siluf_(g0[3]) * u0[3]);
                    w.z = pk2(siluf_(g1[0]) * u1[0], siluf_(g1[1]) * u1[1]); w.w = pk2(siluf_(g1[2]) * u1[2], siluf_(g1[3]) * u1[3]);
                    bf16_t* hp = H + (size_t)(row0 + ai * 128 + m * 16) * DFF + col0;
                    asm volatile("global_store_dwordx4 %0, %1, off sc1\n\ts_nop 1" :: "v"(hp), "v"(w) : "memory"); }
        } else if constexpr (kind == EK_ODD_IN) {
            const bool isg = u.pn < 4; bf16_t* O = isg ? EWS(bf16_t, WS_G) : EWS(bf16_t, WS_U); const int colt = (isg ? u.pn : u.pn - 4) * 256 + wc * 32 + 8 * fq;
            NORM_FIX_SETUP(2 * layer, BIAS_O + (size_t)sub * 5 * 2048, 2048)
#pragma unroll
            for (int ai = 0; ai < 2; ++ai)
#pragma unroll
                for (int m = 0; m < 4; ++m) { bf16_t* rowp = O + (size_t)(row0 + ai * 128 + m * 16) * D + colt;
#pragma unroll
                    for (int bj = 0; bj < 2; ++bj) { f32x4 v0 = FIXV(ai, bj, m, 0), v1 = FIXV(ai, bj, m, 1);
                        if (isg) {
#pragma unroll
                            for (int j = 0; j < 4; ++j) { v0[j] = gelu_tanh(v0[j]); v1[j] = gelu_tanh(v1[j]); } }
                        u32x4 w; w.x = pk2(v0[0], v0[1]); w.y = pk2(v0[2], v0[3]); w.z = pk2(v1[0], v1[1]); w.w = pk2(v1[2], v1[3]);
                        *(u32x4*)(rowp + bj * 128) = w; } }
        } else if constexpr (kind == EK_GATES) {
            const int blk = u.pn >> 2, t = u.pn & 3, dir = t >> 1, half = t & 1;
            const int ch0 = blk * 256 + half * 128 + wc * 32 + 8 * fq;
            const size_t pofs = (size_t)(sub * 2 + dir) * 1024 + ch0;
            bf16_t* AC = dir ? EWS(bf16_t, WS_LAB) : EWS(bf16_t, WS_LAF); bf16_t* HL = dir ? EWS(bf16_t, WS_BB) : EWS(bf16_t, WS_U);
            const bf16_t* uc = EWS(const bf16_t, WS_UC); const float* ba = EIN(I_BGA); const float* bx = EIN(I_BGX); const float* lam = EIN(I_LAM); float* agg = EWS(float, WS_AGG);
            const int lane_ = fq * 16 + fr;
#define DPPF(old, x, ctrl) __builtin_bit_cast(float, __builtin_amdgcn_update_dpp(__builtin_bit_cast(int, (float)(old)), __builtin_bit_cast(int, (float)(x)), (ctrl), 0xf, 0xf, false))
#define SCAN_STEP(ctrl) { const float Ap = DPPF(1.0f, A[q], ctrl), Hp = DPPF(0.0f, H[q], ctrl); H[q] = A[q] * Hp + H[q]; A[q] *= Ap; }
#define GATE_GROUP(m, C1, C2, C4, C8, LASTLANE) { const size_t ro = (size_t)(row0 + ai * 128 + (m) * 16) * D + ch0; \
                const u32x4 ucw = *(const u32x4*)(uc + ro); \
                const float ucv[8] = {bflo(ucw.x), bfhi(ucw.x), bflo(ucw.y), bfhi(ucw.y), bflo(ucw.z), bfhi(ucw.z), bflo(ucw.w), bfhi(ucw.w)}; \
                float A[8], H[8]; \
                _Pragma("unroll") for (int q = 0; q < 8; ++q) { const float r = sigmoidf_(acc[ai][0][m][q >> 2][q & 3] + ba_[q]), ig = sigmoidf_(acc[ai][1][m][q >> 2][q & 3] + bx_[q]); \
                    const float av = fexp2(c8_[q] * r); A[q] = av; H[q] = fsqrt(fmaxf(1.0f - av * av, 0.0f)) * ig * ucv[q]; } \
                _Pragma("unroll") for (int q = 0; q < 8; ++q) { SCAN_STEP(C1) SCAN_STEP(C2) SCAN_STEP(C4) SCAN_STEP(C8) } \
                _Pragma("unroll") for (int q = 0; q < 8; ++q) { H[q] = A[q] * Hc[q] + H[q]; A[q] *= Ac[q]; } \
                *(u32x4*)(AC + ro) = (u32x4){pk2(A[0], A[1]), pk2(A[2], A[3]), pk2(A[4], A[5]), pk2(A[6], A[7])}; \
                *(u32x4*)(HL + ro) = (u32x4){pk2(H[0], H[1]), pk2(H[2], H[3]), pk2(H[4], H[5]), pk2(H[6], H[7])}; \
                _Pragma("unroll") for (int q = 0; q < 8; ++q) { Ac[q] = shfl_idx(A[q], (LASTLANE)); Hc[q] = shfl_idx(H[q], (LASTLANE)); } }
            float ba_[8], bx_[8], c8_[8];
#pragma unroll
            for (int q = 0; q < 8; ++q) { ba_[q] = ba[pofs + q]; bx_[q] = bx[pofs + q]; c8_[q] = -8.0f * LOG2E * flog(1.0f + fexp(-lam[pofs + q])); }
#pragma unroll
            for (int ai = 0; ai < 2; ++ai) {
                float Ac[8], Hc[8];
#pragma unroll
                for (int q = 0; q < 8; ++q) { Ac[q] = 1.0f; Hc[q] = 0.0f; }
                if (dir == 0) { GATE_GROUP(0, 0x111, 0x112, 0x114, 0x118, (lane_ & 48) | 15) GATE_GROUP(1, 0x111, 0x112, 0x114, 0x118, (lane_ & 48) | 15)
                                GATE_GROUP(2, 0x111, 0x112, 0x114, 0x118, (lane_ & 48) | 15) GATE_GROUP(3, 0x111, 0x112, 0x114, 0x118, (lane_ & 48) | 15) }
                else          { GATE_GROUP(3, 0x101, 0x102, 0x104, 0x108, lane_ & 48) GATE_GROUP(2, 0x101, 0x102, 0x104, 0x108, lane_ & 48)
                                GATE_GROUP(1, 0x101, 0x102, 0x104, 0x108, lane_ & 48) GATE_GROUP(0, 0x101, 0x102, 0x104, 0x108, lane_ & 48) }
                if (fr == 0) { float* ag = agg + ((size_t)((u.pm * 4 + ai * 2 + wr) * 2 + dir) * 1024 + ch0) * 2;
#pragma unroll
                    for (int q = 0; q < 8; q += 2) *(f32x4*)(ag + 2 * q) = (f32x4){Ac[q], Hc[q], Ac[q + 1], Hc[q + 1]}; }
            }
#undef GATE_GROUP
#undef SCAN_STEP
#undef DPPF
        } else {
            bf16_t* ZE = EWS(bf16_t, WS_ZE); const int pn = u.pn; const bool lat = u.pm >= 16; float* lr = EWS(float, WS_LR); const float* rope = EWS(const float, WS_ROPE);
            NORM_FIX_SETUP(2 * layer, BIAS_E + (size_t)sub * 5 * 2560, 2560)
            if (pn == 9) {
                if (wc == 0) {
#pragma unroll
                    for (int ai = 0; ai < 2; ++ai)
#pragma unroll
                        for (int m = 0; m < 4; ++m) { float* p = lr + (size_t)(row0 + ai * 128 + m * 16) * 32 + 8 * fq; *(f32x4*)p = FIXV(ai, 0, m, 0); *(f32x4*)(p + 4) = FIXV(ai, 0, m, 1); }
                }
            } else if (pn <= 2) {
                const int half = wc & 1;
#pragma unroll
                for (int ai = 0; ai < 2; ++ai)
#pragma unroll
                    for (int m = 0; m < 4; ++m) { const int row = row0 + ai * 128 + m * 16;
                        const int tpos = (row - MCTX) & 4095; const int pos = half ? (tpos & 63) : (tpos >> 6);
                        f32x4 cs[4];
                        if (lat) {
#pragma unroll
                            for (int q = 0; q < 4; ++q) cs[q] = *(const f32x4*)(rope + (size_t)(pos * 16 + 8 * (fq & 1)) * 2 + q * 4);
                        }
#pragma unroll
                        for (int bj = 0; bj < 2; ++bj) { f32x4 v0 = FIXV(ai, bj, m, 0), v1 = FIXV(ai, bj, m, 1);
                            const bool isv = (pn == 2 && bj == 1), isk = (pn == 2 && bj == 0);
                            if (pn == 2 && !lat) {
                                const int b = row >> 8, tt = row & 255; const int kc = wc * 32 + 8 * fq;
                                float* dst = X + (isv ? OUT_CV : OUT_CK) + ((size_t)(b * 2 + sub) * 256 + tt) * 128 + kc;
                                *(f32x4*)dst = v0; *(f32x4*)(dst + 4) = v1;
                            }
                            if (lat && !isv) {
                                float x[8] = {v0[0], v0[1], v0[2], v0[3], v1[0], v1[1], v1[2], v1[3]}; float o[8];
#pragma unroll
                                for (int q = 0; q < 8; ++q) { const float pr = shfl_x(x[q], fq * 16 + fr, 32); const float c = cs[q >> 1][(q & 1) * 2], s = cs[q >> 1][(q & 1) * 2 + 1];
                                    o[q] = x[q] * c + (fq < 2 ? -pr : pr) * s; }
                                v0 = (f32x4){o[0], o[1], o[2], o[3]}; v1 = (f32x4){o[4], o[5], o[6], o[7]};
                            }
                            if (!isk && !isv) { v0 *= QSCALE; v1 *= QSCALE; }
                            u32x4 w; w.x = pk2(v0[0], v0[1]); w.y = pk2(v0[2], v0[3]); w.z = pk2(v1[0], v1[1]); w.w = pk2(v1[2], v1[3]);
                            *(u32x4*)(ZE + (size_t)row * ZW + pn * 256 + bj * 128 + wc * 32 + 8 * fq) = w; } }
            } else {
                const float sc = (pn == 3) ? 0.125f : 1.0f; const bool act = pn >= 7;
#pragma unroll
                for (int ai = 0; ai < 2; ++ai)
#pragma unroll
                    for (int m = 0; m < 4; ++m) { bf16_t* rowp = ZE + (size_t)(row0 + ai * 128 + m * 16) * ZW + pn * 256 + wc * 32 + 8 * fq;
#pragma unroll
                        for (int bj = 0; bj < 2; ++bj) { f32x4 v0 = FIXV(ai, bj, m, 0) * sc, v1 = FIXV(ai, bj, m, 1) * sc;
                            if (act) {
#pragma unroll
                                for (int j = 0; j < 4; ++j) { v0[j] = siluf_(v0[j]); v1[j] = siluf_(v1[j]); } }
                            u32x4 w; w.x = pk2(v0[0], v0[1]); w.y = pk2(v0[2], v0[3]); w.z = pk2(v1[0], v1[1]); w.w = pk2(v1[2], v1[3]);
                            *(u32x4*)(rowp + bj * 128) = w; } }
            }
        }
    }
#undef EWS
#undef EIN
#undef NORM_FIX_SETUP
#undef FIXV
};

#define XB_TMO      128
#define XB_XCNT(j)  (256  + 64 * (j))
#define XB_XSUB(j)  (1280 + 64 * (j))
#define XB_XGEN(j)  (2304 + 64 * (j))
#define XB_TOP      3328
#define XB_TOPGEN   3392
#define XCD_BAR_WORDS 3456
#define XB_SPIN_CAP (1u << 18)
__device__ __forceinline__ unsigned xb_ld(unsigned* p)              { return __hip_atomic_load(p, __ATOMIC_RELAXED, __HIP_MEMORY_SCOPE_AGENT); }
__device__ __forceinline__ unsigned xb_add(unsigned* p, unsigned v) { return __hip_atomic_fetch_add(p, v, __ATOMIC_RELAXED, __HIP_MEMORY_SCOPE_AGENT); }
__device__ __forceinline__ unsigned xb_xcc_id() { return (unsigned)__builtin_amdgcn_s_getreg((3 << 11) | 20) & 0xFu; }
#define XB_SPIN(cond, bar) do { unsigned _sp = 0; while (cond) { __builtin_amdgcn_s_sleep(1); \
    if ((++_sp & 255u) == 0u) { if (xb_ld(&(bar)[XB_TMO])) break; if (_sp > XB_SPIN_CAP) { atomicAdd(&(bar)[XB_TMO], 1u); break; } } } } while (0)
struct XcdBarrier { unsigned* bar; unsigned x; volatile LAS unsigned* st; };
__device__ __forceinline__ XcdBarrier xcd_barrier_post(unsigned* bar, volatile LAS unsigned* st) {
    XcdBarrier b; b.bar = bar; b.x = xb_xcc_id(); b.st = st;
    if (threadIdx.x == 0) (void)xb_add(&bar[XB_XCNT(b.x)], 1u);
    return b;
}
__device__ __forceinline__ void xcd_barrier_complete(unsigned* bar, unsigned x, unsigned& nloc, unsigned& nx) {
    const unsigned G = gridDim.x * gridDim.y * gridDim.z;
    unsigned sum, cnt, mine, sp = 0u;
    for (;;) {
        sum = 0u; cnt = 0u; mine = 0u;
#pragma unroll
        for (unsigned j = 0; j < 16; ++j) { const unsigned c = xb_ld(&bar[XB_XCNT(j)]); sum += c; cnt += (c > 0u) ? 1u : 0u; mine = (j == x) ? c : mine; }
        if (sum == G) break;
        __builtin_amdgcn_s_sleep(1);
        if ((++sp & 255u) == 0u) { if (xb_ld(&bar[XB_TMO])) break; if (sp > XB_SPIN_CAP) { atomicAdd(&bar[XB_TMO], 1u); break; } }
    }
    nloc = mine > 0u ? mine : 1u; nx = cnt > 0u ? cnt : 1u;
}
__device__ __forceinline__ void xcd_barrier(const XcdBarrier& b, const int tid) {
    asm volatile("s_waitcnt vmcnt(0)" ::: "memory");
    __syncthreads();
    if (tid == 0) {
        unsigned* bar = b.bar;
        __builtin_amdgcn_s_waitcnt(0);
        unsigned nloc = b.st[0], nx = b.st[1];
        if (nloc == 0u) { xcd_barrier_complete(bar, b.x, nloc, nx); b.st[0] = nloc; b.st[1] = nx; }
        const unsigned old = xb_add(&bar[XB_XSUB(b.x)], 1u);
        const unsigned gen = old / nloc;
        if (old + 1u == (gen + 1u) * nloc) {
            __builtin_amdgcn_fence(__ATOMIC_RELEASE, "agent");
            asm volatile("s_waitcnt vmcnt(0)" ::: "memory");
            const unsigned og = xb_add(&bar[XB_TOP], 1u);
            const unsigned tg = og / nx;
            if (og + 1u == (tg + 1u) * nx) xb_add(&bar[XB_TOPGEN], 1u);
            else XB_SPIN(xb_ld(&bar[XB_TOPGEN]) == tg, bar);
            __builtin_amdgcn_fence(__ATOMIC_ACQUIRE, "agent");
            xb_add(&bar[XB_XGEN(b.x)], 1u);
            asm volatile("s_waitcnt vmcnt(0)" ::: "memory");
        } else {
            XB_SPIN(xb_ld(&bar[XB_XGEN(b.x)]) == gen, bar);
            __builtin_amdgcn_fence(__ATOMIC_ACQUIRE, "agent");
            asm volatile("s_waitcnt vmcnt(0)" ::: "memory");
        }
    }
    __syncthreads();
}

struct Frame {
    lptr lds; int tid, lane, wave, vcu, G;
    const Params* p; float* out; int oz, bid;
};
#define FIN(i) (F.p->in[(i) + F.oz])
#define WSP(T, off) ((T*)(F.p->ws + ((size_t)(off) + (size_t)F.oz)))

__device__ __forceinline__ void transpose_block(const float* src, int ldw, bf16_t* dst, int ldt, LAS float* scr, int lane) {
#pragma unroll
    for (int hb = 0; hb < 2; ++hb) { float tv[16];
#pragma unroll
        for (int i = 0; i < 16; ++i) { const int kk = 2 * (16 * hb + i) + (lane >> 5); tv[i] = src[(size_t)kk * ldw + (lane & 31)]; }
#pragma unroll
        for (int i = 0; i < 16; ++i) { const int kk = 2 * (16 * hb + i) + (lane >> 5); scr[kk * 33 + (lane & 31)] = tv[i]; } }
    LDS_WAIT(); asm volatile("" ::: "memory");
    const int c = lane & 7;
#pragma unroll
    for (int j = 0; j < 4; ++j) { const int n = (lane >> 3) + 8 * j; const LAS float* s = scr + (8 * c) * 33 + n;
        u32x4 o; o.x = pk2(s[0 * 33], s[1 * 33]); o.y = pk2(s[2 * 33], s[3 * 33]); o.z = pk2(s[4 * 33], s[5 * 33]); o.w = pk2(s[6 * 33], s[7 * 33]);
        *(u32x4*)(dst + (size_t)n * ldt + 8 * c) = o; }
    LDS_WAIT(); asm volatile("" ::: "memory");
}
constexpr int IT_WINE = 16 * 73, IT_SQ = 512, IT_WINO = 1024, IT_GATES = 512, IT_F1 = 16 * 176, IT_F2 = 44 * 32;
constexpr int IT_E = IT_WINE + IT_SQ, IT_O = IT_WINO + IT_GATES + IT_SQ, IT_L = IT_F1 + IT_F2;
constexpr int IT_TOTAL = 2 * IT_E + 2 * IT_O + 4 * IT_L;

__device__ __forceinline__ void convert_item(Frame& F, int it, LAS float* scr) {
    const float* src; int ldw; bf16_t* dst; int ldt;
    if (it < 2 * IT_E) {
        const int e = it / IT_E; int r = it % IT_E;
        if (r < IT_WINE) { const int kb = r / 73, nb = r % 73;
            src = FIN(I_WINE) + (size_t)e * D * PE + (size_t)(64 * kb) * PE + 32 * nb; ldw = PE; dst = WSP(bf16_t, WS_WINE) + (size_t)e * PEP * D + (size_t)(32 * nb) * D + 64 * kb; ldt = D;
        } else { r -= IT_WINE; const int kb = r / 32, nb = r % 32;
            src = FIN(I_WOUTE) + (size_t)e * D * D + (size_t)(64 * kb) * D + 32 * nb; ldw = D; dst = WSP(bf16_t, WS_WOUTE) + (size_t)e * D * D + (size_t)(32 * nb) * D + 64 * kb; ldt = D; }
    } else if (it < 2 * IT_E + 2 * IT_O) {
        const int i2 = it - 2 * IT_E; const int o = i2 / IT_O; int r = i2 % IT_O;
        if (r < IT_WINO) { const int kb = r / 64, nb = r % 64;
            src = FIN(I_WINO) + (size_t)o * D * 2048 + (size_t)(64 * kb) * 2048 + 32 * nb; ldw = 2048; dst = WSP(bf16_t, WS_WINO) + (size_t)o * 2048 * D + (size_t)(32 * nb) * D + 64 * kb; ldt = D;
        } else if (r < IT_WINO + IT_GATES) { r -= IT_WINO;
            const int mat = r >> 5, q = r & 31, kb = q >> 3, nb = q & 7; const int isx = mat >> 3, dir = (mat >> 2) & 1, blk = mat & 3;
            src = FIN(isx ? I_WGX : I_WGA) + ((size_t)((o * 2 + dir) * 4 + blk)) * 65536 + (size_t)(64 * kb) * 256 + 32 * nb; ldw = 256;
            const int d0 = 32 * nb, half = d0 >> 7; const int drow = blk * 1024 + (dir * 2 + half) * 256 + isx * 128 + (d0 & 127);
            dst = WSP(bf16_t, WS_WG) + (size_t)o * 4096 * 256 + (size_t)drow * 256 + 64 * kb; ldt = 256;
        } else { r -= IT_WINO + IT_GATES; const int kb = r / 32, nb = r % 32;
            src = FIN(I_WOUTO) + (size_t)o * D * D + (size_t)(64 * kb) * D + 32 * nb; ldw = D; dst = WSP(bf16_t, WS_WOUTO) + (size_t)o * D * D + (size_t)(32 * nb) * D + 64 * kb; ldt = D; }
    } else {
        const int i3 = it - 2 * IT_E - 2 * IT_O; const int l = i3 / IT_L; int r = i3 % IT_L;
        if (r < IT_F1) { const int kb = r / 176, nb = r % 176; const int n0 = 32 * nb; const int isu = n0 >= DFF; const int c = n0 - isu * DFF; const int drow = (c >> 7) * 256 + isu * 128 + (c & 127);
            src = FIN(I_WF1) + (size_t)l * D * 5632 + (size_t)(64 * kb) * 5632 + n0; ldw = 5632; dst = WSP(bf16_t, WS_WF1) + (size_t)l * 5632 * D + (size_t)drow * D + 64 * kb; ldt = D;
        } else { r -= IT_F1; const int kb = r / 32, nb = r % 32;
            src = FIN(I_WF2) + (size_t)l * DFF * D + (size_t)(64 * kb) * D + 32 * nb; ldw = D; dst = WSP(bf16_t, WS_WF2) + (size_t)l * D * DFF + (size_t)(32 * nb) * DFF + 64 * kb; ldt = DFF; }
    }
    transpose_block(src, ldw, dst, ldt, scr, F.lane);
}

__device__ __forceinline__ void phase_prologue(Frame& F) {
    const int tid = F.tid, lane = F.lane, wave = F.wave;
    const int gt = F.vcu * NTHREADS + tid, NGT = F.G * NTHREADS;
    {
        LAS float* sil = (LAS float*)F.lds;
        LAS float* red = (LAS float*)(F.lds + 20480);
        for (int i = tid; i < 5 * 1024; i += NTHREADS) { const int ci = i >> 10, k = i & 1023; const float v = ci == 0 ? FIN(I_CCTX)[k] : FIN(I_C)[(ci - 1) * 1024 + k]; sil[i] = siluf_(v); }
        __syncthreads();
        for (int item = F.vcu; item < 4 * 48; item += F.G) {
            const int l = item / 48, n0 = (item % 48) * 128;
            const float* wp = FIN(I_WADA) + ((size_t)l * 1024 + wave * 128) * 6144 + n0 + 2 * lane;
            float a0[5] = {0.f, 0.f, 0.f, 0.f, 0.f}, a1[5] = {0.f, 0.f, 0.f, 0.f, 0.f};
#pragma unroll 8
            for (int kk = 0; kk < 128; ++kk) { const f32x2 w = *(const f32x2*)(wp + (size_t)kk * 6144);
#pragma unroll
                for (int ci = 0; ci < 5; ++ci) { const float s = sil[ci * 1024 + wave * 128 + kk]; a0[ci] += s * w.x; a1[ci] += s * w.y; } }
#pragma unroll
            for (int ci = 0; ci < 5; ++ci) { red[(wave * 5 + ci) * 128 + 2 * lane] = a0[ci]; red[(wave * 5 + ci) * 128 + 2 * lane + 1] = a1[ci]; }
            __syncthreads();
            for (int i = tid; i < 640; i += NTHREADS) { const int ci = i >> 7, n = i & 127; float s = FIN(I_BADA)[l * 6144 + n0 + n];
#pragma unroll
                for (int w = 0; w < 8; ++w) s += red[(w * 5 + ci) * 128 + n];
                WSP(float, WS_MOD)[(size_t)(l * 5 + ci) * 6144 + n0 + n] = s; }
            __syncthreads();
        }
    }
    for (int i = gt; i < 1024; i += NGT) { const int pos = i >> 4, fi = i & 15; const float inv = fexp2(-(float)fi * (13.287712379549449f / 16.0f)); const float a = (float)pos * inv;
        WSP(float, WS_ROPE)[2 * i] = __cosf(a); WSP(float, WS_ROPE)[2 * i + 1] = __sinf(a); }
    for (int i = gt; i < 4 * 2 * 256 * 128 / 4; i += NGT) { const f32x4 k = ((const f32x4*)FIN(I_CK))[i], v = ((const f32x4*)FIN(I_CV))[i];
        u32x2 a; a.x = pk2(k[0], k[1]); a.y = pk2(k[2], k[3]); ((u32x2*)WSP(bf16_t, WS_CK))[i] = a; a.x = pk2(v[0], v[1]); a.y = pk2(v[2], v[3]); ((u32x2*)WSP(bf16_t, WS_CV))[i] = a; }
    for (int i = gt; i < 2 * (PEP - PE) * D / 8; i += NGT) { const int e = i / ((PEP - PE) * D / 8), r = i % ((PEP - PE) * D / 8);
        ((u32x4*)(WSP(bf16_t, WS_WINE) + (size_t)e * PEP * D + (size_t)PE * D))[r] = (u32x4){0u, 0u, 0u, 0u}; }
    {
        LAS float* scr = (LAS float*)(F.lds + 40960 + wave * 8704);
        const int gw = F.vcu * NWAVES + wave, NGW = F.G * NWAVES;
        for (int it = gw; it < IT_TOTAL; it += NGW) convert_item(F, it, scr);
    }
}

__device__ __forceinline__ void phase_pre(Frame& F) {
    const int lane = F.lane; const int gw = F.vcu * NWAVES + F.wave, NGW = F.G * NWAVES;
    const float* mod = WSP(float, WS_MOD); float* bias = WSP(float, WS_BIAS);
    for (int mi = 0; mi < 8; ++mi) {
        const int l = mi < 2 ? 2 * mi : mi < 4 ? 2 * (mi - 2) + 1 : mi - 4; const int shj = mi < 4 ? 0 : 3;
        const int N = mi < 2 ? 2560 : mi < 4 ? 2048 : 5632;
        const bf16_t* W = mi < 2 ? WSP(bf16_t, WS_WINE) + (size_t)mi * PEP * D : mi < 4 ? WSP(bf16_t, WS_WINO) + (size_t)(mi - 2) * 2048 * D : WSP(bf16_t, WS_WF1) + (size_t)(mi - 4) * 5632 * D;
        float* bo = bias + (mi < 2 ? BIAS_E + (size_t)mi * 5 * 2560 : mi < 4 ? BIAS_O + (size_t)(mi - 2) * 5 * 2048 : BIAS_F + (size_t)(mi - 4) * 5 * 5632);
        f32x4 sh[5][4];
#pragma unroll
        for (int ci = 0; ci < 5; ++ci)
#pragma unroll
            for (int q = 0; q < 4; ++q) sh[ci][q] = *(const f32x4*)(mod + ((size_t)(l * 5 + ci) * 6 + shj) * 1024 + 16 * lane + 4 * q);
        for (int n = gw; n < N; n += NGW) {
            const u32x4 w0 = *(const u32x4*)(W + (size_t)n * D + 16 * lane), w1 = *(const u32x4*)(W + (size_t)n * D + 16 * lane + 8);
            const float wf[16] = {bflo(w0.x), bfhi(w0.x), bflo(w0.y), bfhi(w0.y), bflo(w0.z), bfhi(w0.z), bflo(w0.w), bfhi(w0.w), bflo(w1.x), bfhi(w1.x), bflo(w1.y), bfhi(w1.y), bflo(w1.z), bfhi(w1.z), bflo(w1.w), bfhi(w1.w)};
            float r[5];
#pragma unroll
            for (int ci = 0; ci < 5; ++ci) { float a = 0.f;
#pragma unroll
                for (int q = 0; q < 16; ++q) a += sh[ci][q >> 2][q & 3] * wf[q];
                r[ci] = wave_sum(a, lane); }
            if (lane < 5) bo[(size_t)lane * N + n] = lane == 0 ? r[0] : lane == 1 ? r[1] : lane == 2 ? r[2] : lane == 3 ? r[3] : r[4];
        }
    }
    {
        const float* gvec = FIN(I_NMIX); bf16_t* XN = WSP(bf16_t, WS_XN); float* ssq = F.out + SSQP_OFF;
        f32x4 gg[4]; int cur_ci = -1;
        for (int r = 0; r < 10; ++r) {
            const int row = gw * 10 + r; const int ci = cond_of_row(row);
            if (ci != cur_ci) { cur_ci = ci;
#pragma unroll
                for (int j = 0; j < 4; ++j) { const int col = 4 * lane + 256 * j; gg[j] = *(const f32x4*)(gvec + col) * (1.0f + *(const f32x4*)(mod + ((size_t)ci * 6 + 1) * 1024 + col)); } }
            const float* xin = row < MCTX ? FIN(I_XP) + (size_t)row * D : FIN(I_XS) + (size_t)(row - MCTX) * D;
            f32x4 v[4]; float s = 0.f;
#pragma unroll
            for (int j = 0; j < 4; ++j) { v[j] = *(const f32x4*)(xin + 4 * lane + 256 * j); s += (v[j].x * v[j].x + v[j].y * v[j].y) + (v[j].z * v[j].z + v[j].w * v[j].w); }
            s = wave_sum(s, lane);
            if (lane < 16) ssq[(size_t)row * 16 + lane] = lane == 0 ? s : 0.f;
#pragma unroll
            for (int j = 0; j < 4; ++j) { const f32x4 y = v[j] * gg[j]; *(u32x2*)(XN + (size_t)row * D + 4 * lane + 256 * j) = (u32x2){pk2(y[0], y[1]), pk2(y[2], y[3])}; }
        }
    }
}
__device__ __forceinline__ void phase_final(Frame& F) {
    const int lane = F.lane; const int gw = F.vcu * NWAVES + F.wave;
    const float* gvec = FIN(I_NFIN); const float* ssq = WSP(float, WS_SSQ8); const bf16_t* XF = WSP(bf16_t, WS_XF);
    f32x4 gg[4];
#pragma unroll
    for (int j = 0; j < 4; ++j) gg[j] = *(const f32x4*)(gvec + 4 * lane + 256 * j);
    float rs[10];
#pragma unroll
    for (int r = 0; r < 10; ++r) { const int row = gw * 10 + r; const f32x4* q_ = (const f32x4*)(ssq + (size_t)row * 16); const f32x4 a_ = q_[0], b_ = q_[1], c_ = q_[2], d_ = q_[3];
        rs[r] = frsq(((((a_[0] + a_[1]) + (a_[2] + a_[3])) + ((b_[0] + b_[1]) + (b_[2] + b_[3]))) + (((c_[0] + c_[1]) + (c_[2] + c_[3])) + ((d_[0] + d_[1]) + (d_[2] + d_[3])))) * (1.0f / D) + EPS); }
#pragma unroll
    for (int r = 0; r < 10; ++r) { const int row = gw * 10 + r; float* yr = F.out + (size_t)row * D; const bf16_t* xr = XF + (size_t)row * D;
#pragma unroll
        for (int j = 0; j < 4; ++j) { const u32x2 w = *(const u32x2*)(xr + 4 * lane + 256 * j); const f32x4 x = {bflo(w.x), bfhi(w.x), bflo(w.y), bfhi(w.y)}; *(f32x4*)(yr + 4 * lane + 256 * j) = x * rs[r] * gg[j]; } }
}

__device__ __forceinline__ void attn_unit(Frame& F, int e, int kind, int b, int kvh, int qb, int hp) {
    const int lane = F.lane, w = F.wave, r32 = lane & 31, hh = lane >> 5;
    const bf16_t* ZE = WSP(bf16_t, WS_ZE);
    const int head = kvh * 4 + hp * 2 + (w >> 2);
    const int seqbase = kind == 0 ? MCTX + b * TLAT : b * TCTX;
    const int qloc = qb * 128 + (w & 3) * 32 + r32;
    const int iloc = (w & 3) * 32 + r32;
    bf16x8 qr[4];
#pragma unroll
    for (int d0 = 0; d0 < 4; ++d0) qr[d0] = *(const bf16x8*)(ZE + (size_t)(seqbase + qloc) * ZW + head * 64 + d0 * 16 + hh * 8);
    const int wt0 = (kind == 0 && qb == 0) ? 2 : 0, wt1 = (kind == 0) ? ((qb == 31) ? 4 : 6) : 0;
    const int NT = 4 + (wt1 - wt0);
    float m_run = FIN(I_SINK)[e * 8 + head] * LOG2E; float l_run = hh == 0 ? 1.0f : 0.0f;
    f32x16 o0 = {}, o1 = {};
    const int kkey = lane, kchunk = w;
    const int vkey = 16 * (w & 3) + (lane >> 2), vdh = w >> 2, vpiece = lane & 3;
    const unsigned kdstw = (unsigned)(kchunk * 1024), vdstw = (unsigned)(24576 + vdh * 4096 + (w & 3) * 1024);
    int mtype = 0, joff = 0;
    auto tile_ptrs = [&](int t, const bf16_t*& kp, const bf16_t*& vp, int& pitch, int& mt, int& jo) {
        if (kind == 0 && t < 4) { const size_t base = ((size_t)(b * 2 + e) * 256 + 64 * t) * 128 + kvh * 64; kp = WSP(bf16_t, WS_CK) + base; vp = WSP(bf16_t, WS_CV) + base; pitch = 128; mt = 0; jo = 0; }
        else if (kind == 0) { const int wt = t - 4 + wt0; const int blk = qb - 1 + (wt >> 1); const size_t row = (size_t)seqbase + blk * 128 + (wt & 1) * 64;
            kp = ZE + row * ZW + 512 + kvh * 64; vp = ZE + row * ZW + 640 + kvh * 64; pitch = ZW; mt = (blk < qb) ? 1 : (blk > qb) ? 2 : 0; jo = (wt & 1) * 64; }
        else { const size_t row = (size_t)seqbase + 64 * t; kp = ZE + row * ZW + 512 + kvh * 64; vp = ZE + row * ZW + 640 + kvh * 64; pitch = ZW; mt = 0; jo = 0; }
    };
#define ATT_ISSUE(t, slot) do { const bf16_t *kp_, *vp_; int pitch_, mt_, jo_; tile_ptrs((t), kp_, vp_, pitch_, mt_, jo_); \
        __builtin_amdgcn_global_load_lds((const unsigned*)(kp_ + (size_t)kkey * pitch_ + kchunk * 8), (LAS unsigned*)(F.lds + (slot) * 8192 + kdstw), 16, 0, 0); \
        __builtin_amdgcn_global_load_lds((const unsigned*)(vp_ + (size_t)vkey * pitch_ + vdh * 32 + vpiece * 8), (LAS unsigned*)(F.lds + (slot) * 8192 + vdstw), 16, 0, 0); } while (0)
    ATT_ISSUE(0, 0); if (NT > 1) ATT_ISSUE(1, 1);
    int slot = 0;
    for (int t = 0; t < NT; ++t) {
        if (t + 1 < NT) asm volatile("s_waitcnt vmcnt(2)" ::: "memory"); else asm volatile("s_waitcnt vmcnt(0)" ::: "memory");
        asm volatile("s_waitcnt lgkmcnt(0)" ::: "memory"); __builtin_amdgcn_s_barrier(); asm volatile("" ::: "memory");
        if (t + 2 < NT) { const int s2 = slot >= 1 ? slot - 1 : 2; ATT_ISSUE(t + 2, s2); }
        { const bf16_t *kp_, *vp_; int pitch_; tile_ptrs(t, kp_, vp_, pitch_, mtype, joff); }
        const int buf = slot;
        const lptr kb = F.lds + buf * 8192 + hh * 1024 + r32 * 16;
        f32x16 p0 = {}, p1 = {};
#pragma unroll
        for (int d0 = 0; d0 < 4; ++d0) { const bf16x8 k0 = *(const LAS bf16x8*)(kb + d0 * 2048), k1 = *(const LAS bf16x8*)(kb + d0 * 2048 + 512);
            p0 = __builtin_amdgcn_mfma_f32_32x32x16_bf16(k0, qr[d0], p0, 0, 0, 0); p1 = __builtin_amdgcn_mfma_f32_32x32x16_bf16(k1, qr[d0], p1, 0, 0, 0); }
        if (mtype != 0) {
#pragma unroll
            for (int r = 0; r < 16; ++r) { const int j0 = joff + crow(r, hh), j1 = j0 + 32;
                const bool bad0 = (mtype == 1) ? (j0 < iloc) : (j0 > iloc), bad1 = (mtype == 1) ? (j1 < iloc) : (j1 > iloc);
                if (bad0) p0[r] = -1e30f; if (bad1) p1[r] = -1e30f; }
        }
        float mx = fmaxf(p0[0], p1[0]);
#pragma unroll
        for (int r = 1; r < 16; ++r) mx = fmaxf(mx, fmaxf(p0[r], p1[r]));
        mx = fmaxf(mx, shfl_x(mx, lane, 32));
        const float m_new = fmaxf(m_run, mx); const float alpha = fexp2(m_run - m_new); m_run = m_new;
        float ps = 0.f;
#pragma unroll
        for (int r = 0; r < 16; ++r) { p0[r] = fexp2(p0[r] - m_new); p1[r] = fexp2(p1[r] - m_new); ps += p0[r] + p1[r]; }
        l_run = l_run * alpha + ps;
#pragma unroll
        for (int r = 0; r < 16; ++r) { o0[r] *= alpha; o1[r] *= alpha; }
        u32x4 pw[4];
#pragma unroll
        for (int s = 0; s < 2; ++s) { pw[s] = (u32x4){pk2(p0[8 * s], p0[8 * s + 1]), pk2(p0[8 * s + 2], p0[8 * s + 3]), pk2(p0[8 * s + 4], p0[8 * s + 5]), pk2(p0[8 * s + 6], p0[8 * s + 7])};
            pw[2 + s] = (u32x4){pk2(p1[8 * s], p1[8 * s + 1]), pk2(p1[8 * s + 2], p1[8 * s + 3]), pk2(p1[8 * s + 4], p1[8 * s + 5]), pk2(p1[8 * s + 6], p1[8 * s + 7])}; }
        const lptr vb = F.lds + 24576 + buf * 8192 + ((lane >> 4) & 1) * 32 + (lane & 3) * 8 + (4 * hh + ((lane & 15) >> 2)) * 64;
#pragma unroll
        for (int s = 0; s < 4; ++s) { const bf16x8 v0 = tr_frag(vb + s * 1024), v1 = tr_frag(vb + 4096 + s * 1024);
            o0 = __builtin_amdgcn_mfma_f32_32x32x16_bf16(v0, __builtin_bit_cast(bf16x8, pw[s]), o0, 0, 0, 0);
            o1 = __builtin_amdgcn_mfma_f32_32x32x16_bf16(v1, __builtin_bit_cast(bf16x8, pw[s]), o1, 0, 0, 0); }
        slot = slot == 2 ? 0 : slot + 1;
    }
#undef ATT_ISSUE
    asm volatile("s_waitcnt lgkmcnt(0)" ::: "memory"); __builtin_amdgcn_s_barrier(); asm volatile("" ::: "memory");
    const float lt = l_run + shfl_x(l_run, lane, 32); const float inv = frcp(lt);
    bf16_t* orow = WSP(bf16_t, WS_MIX) + (size_t)(seqbase + qloc) * D + head * 64;
#pragma unroll
    for (int g = 0; g < 4; ++g) { u32x2 a; a.x = pk2(o0[4 * g] * inv, o0[4 * g + 1] * inv); a.y = pk2(o0[4 * g + 2] * inv, o0[4 * g + 3] * inv); *(u32x2*)(orow + 8 * g + 4 * hh) = a;
        a.x = pk2(o1[4 * g] * inv, o1[4 * g + 1] * inv); a.y = pk2(o1[4 * g + 2] * inv, o1[4 * g + 3] * inv); *(u32x2*)(orow + 32 + 8 * g + 4 * hh) = a; }
}

constexpr int GL_LA = 0;
constexpr int GL_LR = 32768;
constexpr int GL_WA = 40960;
constexpr int GL_BA = 49152;
constexpr int GL_BL = 49664;
constexpr int GL_A = 51200;
constexpr int GL_B = 67584;
constexpr int GL_C = 83968;
__device__ __forceinline__ int timg(int r, int c, int R) { return (c >> 5) * (R * 64) + (r >> 3) * 512 + (r & 7) * 64 + (c & 31) * 2; }

struct GlaPre { f32x4 lr, wa; float ba; u32x4 gk, gq, v0, v1; };
__device__ __forceinline__ GlaPre gla_load(Frame& F, int e, int gc, int hd, bool with_q) {
    const int tid = F.tid; const int R0 = gc * 64; GlaPre p; const bf16_t* ZE = WSP(bf16_t, WS_ZE);
    { const int row = tid >> 3, c4 = tid & 7; p.lr = *(const f32x4*)(WSP(float, WS_LR) + (size_t)(R0 + row) * 32 + 4 * c4);
      const int z = tid >> 8, r = (tid >> 4) & 15, k4 = tid & 15; p.wa = *(const f32x4*)(FIN(I_WALPHA) + ((size_t)(e * 2 + z) * 16 + r) * 256 + hd * 64 + 4 * k4);
      p.ba = FIN(I_BALPHA)[(e * 2 + ((tid >> 6) & 1)) * 256 + hd * 64 + (tid & 63)]; }
    { const int t = tid >> 3, k8 = (tid & 7) * 8; p.gk = *(const u32x4*)(ZE + (size_t)(R0 + t) * ZW + 1024 + hd * 64 + k8);
      p.gq = with_q ? *(const u32x4*)(ZE + (size_t)(R0 + t) * ZW + 768 + hd * 64 + k8) : p.gk; }
    { const int p0 = tid, p1 = tid + 512; p.v0 = *(const u32x4*)(ZE + (size_t)(R0 + (p0 >> 4)) * ZW + 1280 + hd * 128 + (p0 & 15) * 8); p.v1 = *(const u32x4*)(ZE + (size_t)(R0 + (p1 >> 4)) * ZW + 1280 + hd * 128 + (p1 & 15) * 8); }
    return p;
}
__device__ __forceinline__ void gla_bcum(Frame& F, const GlaPre& p) {
    const int tid = F.tid;
    LAS float* LA = (LAS float*)(F.lds + GL_LA); LAS float* LRs = (LAS float*)(F.lds + GL_LR); LAS float* WA = (LAS float*)(F.lds + GL_WA);
    LAS float* BA = (LAS float*)(F.lds + GL_BA); LAS float* BL = (LAS float*)(F.lds + GL_BL);
    { const int row = tid >> 3, c4 = tid & 7; *(LAS f32x4*)(LRs + row * 32 + 4 * c4) = p.lr;
      const int z = tid >> 8, r = (tid >> 4) & 15, k4 = tid & 15; *(LAS f32x4*)(WA + (z * 16 + r) * 64 + 4 * k4) = p.wa;
      if (tid < 128) BA[tid] = p.ba; }
    __syncthreads();
    { const int lane = F.lane, w = F.wave; const int z = w >> 2, kl = lane & 15, seg = lane >> 4, k = (w & 3) * 16 + kl, t0 = seg * 16;
      float wa[16];
#pragma unroll
      for (int r = 0; r < 16; ++r) wa[r] = WA[(z * 16 + r) * 64 + k];
      const float bz = BA[z * 64 + k];
      float la[16];
#pragma unroll
      for (int tt = 0; tt < 16; ++tt) { float x = bz;
#pragma unroll
          for (int r4 = 0; r4 < 4; ++r4) { const f32x4 l4 = *(const LAS f32x4*)(LRs + (t0 + tt) * 32 + z * 16 + 4 * r4); x += (l4[0] * wa[4 * r4] + l4[1] * wa[4 * r4 + 1]) + (l4[2] * wa[4 * r4 + 2] + l4[3] * wa[4 * r4 + 3]); }
          la[tt] = (fminf(x, 0.f) - flog(1.0f + fexp(-fabsf(x)))) * (1.0f / 16.0f); }
      float run = 0.f;
      if (z == 0) {
#pragma unroll
          for (int tt = 0; tt < 16; ++tt) { run += la[tt]; la[tt] = run; }
      } else {
#pragma unroll
          for (int tt = 15; tt >= 0; --tt) { run += la[tt]; la[tt] = run; }
      }
      const float s0 = shfl_idx(run, kl), s1 = shfl_idx(run, kl + 16), s2 = shfl_idx(run, kl + 32), s3 = shfl_idx(run, kl + 48);
      float add;
      if (z == 0) add = (seg > 0 ? s0 : 0.f) + (seg > 1 ? s1 : 0.f) + (seg > 2 ? s2 : 0.f);
      else        add = (seg < 3 ? s3 : 0.f) + (seg < 2 ? s2 : 0.f) + (seg < 1 ? s1 : 0.f);
#pragma unroll
      for (int tt = 0; tt < 16; ++tt) LA[(z * 64 + t0 + tt) * 64 + k] = la[tt] + add;
      if (seg == 0) BL[z * 64 + k] = (s0 + s1) + (s2 + s3); }
    __syncthreads();
}
__device__ __forceinline__ void gla_stage_v(Frame& F, const GlaPre& p, int off) {
    { const int q = F.tid, t = q >> 4, v8 = (q & 15) * 8; *(LAS u32x4*)(F.lds + off + timg(t, v8, 64)) = p.v0; }
    { const int q = F.tid + 512, t = q >> 4, v8 = (q & 15) * 8; *(LAS u32x4*)(F.lds + off + timg(t, v8, 64)) = p.v1; }
}
__device__ __forceinline__ void gla_g1_item(Frame& F, int e, int gc, int hd, const GlaPre& pre) {
    const int tid = F.tid, lane = F.lane, w = F.wave;
    gla_stage_v(F, pre, GL_B);
    gla_bcum(F, pre);
    LAS float* LA = (LAS float*)(F.lds + GL_LA); LAS float* BL = (LAS float*)(F.lds + GL_BL);
    { const int t = tid >> 3, k8 = (tid & 7) * 8; const u32x4 gk = pre.gk;
      const float kf[8] = {bflo(gk.x), bfhi(gk.x), bflo(gk.y), bfhi(gk.y), bflo(gk.z), bfhi(gk.z), bflo(gk.w), bfhi(gk.w)};
#pragma unroll
      for (int z = 0; z < 2; ++z) { float ks[8];
#pragma unroll
        for (int j = 0; j < 8; ++j) ks[j] = kf[j] * fexp(BL[z * 64 + k8 + j] - LA[(z * 64 + t) * 64 + k8 + j]);
        *(LAS u32x4*)(F.lds + GL_A + z * 8192 + timg(t, k8, 64)) = (u32x4){pk2(ks[0], ks[1]), pk2(ks[2], ks[3]), pk2(ks[4], ks[5]), pk2(ks[6], ks[7])}; } }
    __syncthreads();
    { const int vb = w & 3, z = w >> 2; const int hh = lane >> 5, q = (lane & 15) >> 2;
      const int lofs = q * 64 + (((lane >> 4) & 1) * 16 + (lane & 3) * 4) * 2;
      f32x16 a0 = {}, a1 = {};
#pragma unroll
      for (int s = 0; s < 4; ++s) { const int rofs = (2 * s + hh) * 512;
        const lptr vp = F.lds + GL_B + vb * 4096 + rofs + lofs; const s16x4 va = tr_read(vp), vb2 = tr_read(vp + 256);
        const bf16x8 vf = (bf16x8){va[0], va[1], va[2], va[3], vb2[0], vb2[1], vb2[2], vb2[3]};
        const lptr kp = F.lds + GL_A + z * 8192 + rofs + lofs; const s16x4 ka = tr_read(kp), kb2 = tr_read(kp + 256), kc = tr_read(kp + 4096), kd = tr_read(kp + 4096 + 256);
        const bf16x8 kf0 = (bf16x8){ka[0], ka[1], ka[2], ka[3], kb2[0], kb2[1], kb2[2], kb2[3]}, kf1 = (bf16x8){kc[0], kc[1], kc[2], kc[3], kd[0], kd[1], kd[2], kd[3]};
        a0 = __builtin_amdgcn_mfma_f32_32x32x16_bf16(vf, kf0, a0, 0, 0, 0); a1 = __builtin_amdgcn_mfma_f32_32x32x16_bf16(vf, kf1, a1, 0, 0, 0); }
      float* kv = WSP(float, WS_KV) + ((size_t)(gc * 4 + hd) * 2 + z) * 8192;
#pragma unroll
      for (int r = 0; r < 16; ++r) { const int v = 32 * vb + crow(r, hh); kv[v * 64 + (lane & 31)] = a0[r]; kv[v * 64 + 32 + (lane & 31)] = a1[r]; } }
    if (tid < 128) WSP(float, WS_DL)[((size_t)(gc * 4 + hd) * 2 + (tid >> 6)) * 64 + (tid & 63)] = fexp(BL[tid]);
    __syncthreads();
}
__device__ __forceinline__ void phase_g2(Frame& F, int e) {
    const int tid = F.tid; float* KV = WSP(float, WS_KV); const float* DL = WSP(float, WS_DL);
    {
        const int v = F.vcu; const int chain = v >> 3, slice = v & 7; const int b = chain >> 3, hd = (chain >> 1) & 3, z = chain & 1;
        const int off = slice * 1024 + tid * 2, k = off & 63, vv = off >> 6;
        const float* s0 = FIN(I_SGLA) + ((size_t)((b * 2 + e) * 2 + z) * 4 + hd) * 8192;
        f32x2 S = (f32x2){s0[(size_t)k * 128 + vv], s0[(size_t)(k + 1) * 128 + vv]};
        f32x2 kvA[8], dlA[8], kvB[8], dlB[8];
#define G2_LOAD(KVR, DLR, C8) _Pragma("unroll") for (int i = 0; i < 8; ++i) { const int c = z ? 63 - ((C8) + i) : (C8) + i; const size_t it = (size_t)((64 + b * 64 + c) * 4 + hd) * 2 + z; \
                KVR[i] = *(const f32x2*)(KV + it * 8192 + off); DLR[i] = *(const f32x2*)(DL + it * 64 + k); }
#define G2_FOLD(KVR, DLR, C8) _Pragma("unroll") for (int i = 0; i < 8; ++i) { const int c = z ? 63 - ((C8) + i) : (C8) + i; const size_t it = (size_t)((64 + b * 64 + c) * 4 + hd) * 2 + z; \
                *(f32x2*)(KV + it * 8192 + off) = S; S = DLR[i] * S + KVR[i]; }
        G2_LOAD(kvA, dlA, 0)
        for (int c8 = 0; c8 < 64; c8 += 16) {
            G2_LOAD(kvB, dlB, c8 + 8)
            G2_FOLD(kvA, dlA, c8)
            if (c8 + 16 < 64) { G2_LOAD(kvA, dlA, c8 + 16) }
            G2_FOLD(kvB, dlB, c8 + 8)
        }
#undef G2_LOAD
#undef G2_FOLD
    }
    for (int item = F.vcu; item < 512; item += F.G) {
        const int chain = item >> 2, slice = item & 3; const int b = chain >> 3, hd = (chain >> 1) & 3, z = chain & 1;
        const int off = slice * 2048 + tid * 4, k = off & 63, vv = off >> 6;
        const float zf = (float)F.oz; f32x4 S = {zf, zf, zf, zf};
        f32x4 kv4[4], dl4[4];
#pragma unroll
        for (int i = 0; i < 4; ++i) { const int c = z ? 3 - i : i; const size_t it = (size_t)((b * 4 + c) * 4 + hd) * 2 + z; kv4[i] = *(const f32x4*)(KV + it * 8192 + off); dl4[i] = *(const f32x4*)(DL + it * 64 + k); }
#pragma unroll
        for (int i = 0; i < 4; ++i) { const int c = z ? 3 - i : i; const size_t it = (size_t)((b * 4 + c) * 4 + hd) * 2 + z; *(f32x4*)(KV + it * 8192 + off) = S; S = dl4[i] * S + kv4[i]; }
        float* dst = F.out + OUT_GLA + ((size_t)((b * 2 + e) * 2 + z) * 4 + hd) * 8192;
#pragma unroll
        for (int j = 0; j < 4; ++j) dst[(size_t)(k + j) * 128 + vv] = S[j];
    }
}
__device__ __forceinline__ void gla_g3_item(Frame& F, int e, int gc, int hd, const GlaPre& pre) {
    const int tid = F.tid, lane = F.lane, w = F.wave; const int R0 = gc * 64;
    const bf16_t* ZE = WSP(bf16_t, WS_ZE);
    f32x4 sreg[8];
    { const float* KV = WSP(float, WS_KV) + (size_t)(gc * 4 + hd) * 2 * 8192;
#pragma unroll
      for (int i = 0; i < 8; ++i) { const int idx = tid + 512 * i, z = idx >> 11, rem = idx & 2047, v = rem >> 4, k4 = (rem & 15) * 4; sreg[i] = *(const f32x4*)(KV + (size_t)z * 8192 + v * 64 + k4); } }
    u32x2 grreg[4];
    { const int vb_ = w >> 1, ib_ = w & 1, i_ = 32 * ib_ + (lane & 31), hh_ = lane >> 5;
#pragma unroll
      for (int g = 0; g < 4; ++g) grreg[g] = *(const u32x2*)(ZE + (size_t)(R0 + i_) * ZW + 1792 + hd * 128 + 32 * vb_ + 8 * g + 4 * hh_); }
    gla_stage_v(F, pre, GL_C);
    gla_bcum(F, pre);
    LAS float* LA = (LAS float*)(F.lds + GL_LA);
    { const int t = tid >> 3, c = tid & 7, k8 = c * 8;
      const u32x4 gq = pre.gq, gk = pre.gk;
      const float qf[8] = {bflo(gq.x), bfhi(gq.x), bflo(gq.y), bfhi(gq.y), bflo(gq.z), bfhi(gq.z), bflo(gq.w), bfhi(gq.w)};
      const float kf[8] = {bflo(gk.x), bfhi(gk.x), bflo(gk.y), bfhi(gk.y), bflo(gk.z), bfhi(gk.z), bflo(gk.w), bfhi(gk.w)};
      const int so = t * 128 + ((c ^ (t & 7)) * 16);
#pragma unroll
      for (int z = 0; z < 2; ++z) { float qe[8], ke[8];
#pragma unroll
        for (int j = 0; j < 8; ++j) { const float bc = LA[(z * 64 + t) * 64 + k8 + j]; qe[j] = qf[j] * fexp(bc); ke[j] = kf[j] * fexp(-bc); }
        *(LAS u32x4*)(F.lds + GL_A + z * 8192 + so) = (u32x4){pk2(qe[0], qe[1]), pk2(qe[2], qe[3]), pk2(qe[4], qe[5]), pk2(qe[6], qe[7])};
        *(LAS u32x4*)(F.lds + GL_B + z * 8192 + so) = (u32x4){pk2(ke[0], ke[1]), pk2(ke[2], ke[3]), pk2(ke[4], ke[5]), pk2(ke[6], ke[7])}; } }
    __syncthreads();
    {
#pragma unroll
      for (int i = 0; i < 8; ++i) { const int idx = tid + 512 * i, z = idx >> 11, rem = idx & 2047, v = rem >> 4, k4 = (rem & 15) * 4;
        const f32x4 s = sreg[i];
        *(LAS u32x2*)(F.lds + GL_LA + z * 16384 + v * 128 + (((k4 >> 3) ^ (v & 7)) * 16) + (k4 & 7) * 2) = (u32x2){pk2(s[0], s[1]), pk2(s[2], s[3])}; } }
    __syncthreads();
    const int vb = w >> 1, ib = w & 1, r32 = lane & 31, hh = lane >> 5;
    f32x16 o = {};
    bf16x8 qf[2][4];
    { const int i = 32 * ib + r32;
#pragma unroll
      for (int z = 0; z < 2; ++z)
#pragma unroll
        for (int s = 0; s < 4; ++s) qf[z][s] = *(const LAS bf16x8*)(F.lds + GL_A + z * 8192 + i * 128 + (((2 * s + hh) ^ (i & 7)) * 16)); }
    { const int v = 32 * vb + r32;
#pragma unroll
      for (int z = 0; z < 2; ++z)
#pragma unroll
        for (int s = 0; s < 4; ++s) { const bf16x8 sf = *(const LAS bf16x8*)(F.lds + GL_LA + z * 16384 + v * 128 + (((2 * s + hh) ^ (v & 7)) * 16));
            o = __builtin_amdgcn_mfma_f32_32x32x16_bf16(sf, qf[z][s], o, 0, 0, 0); } }
    const lptr vbase = F.lds + GL_C + vb * 4096 + ((lane >> 4) & 1) * 32 + (lane & 3) * 8 + (4 * hh + ((lane & 15) >> 2)) * 64;
#pragma unroll
    for (int jb = 0; jb < 2; ++jb) {
        const int j = 32 * jb + r32; f32x16 xf = {}, xb = {};
        const bool do_f = !(jb == 1 && ib == 0), do_b = !(jb == 0 && ib == 1);
#pragma unroll
        for (int s = 0; s < 4; ++s) { const int so = j * 128 + (((2 * s + hh) ^ (j & 7)) * 16);
            if (do_f) { const bf16x8 kf = *(const LAS bf16x8*)(F.lds + GL_B + so); xf = __builtin_amdgcn_mfma_f32_32x32x16_bf16(kf, qf[0][s], xf, 0, 0, 0); }
            if (do_b) { const bf16x8 kb = *(const LAS bf16x8*)(F.lds + GL_B + 8192 + so); xb = __builtin_amdgcn_mfma_f32_32x32x16_bf16(kb, qf[1][s], xb, 0, 0, 0); } }
        float x[16]; const int ii = 32 * ib + r32;
#pragma unroll
        for (int r = 0; r < 16; ++r) { const int jj = 32 * jb + crow(r, hh); x[r] = ((do_f && jj <= ii) ? xf[r] : 0.f) + ((do_b && jj >= ii) ? xb[r] : 0.f); }
#pragma unroll
        for (int s2 = 0; s2 < 2; ++s2) { const u32x4 pw = (u32x4){pk2(x[8 * s2], x[8 * s2 + 1]), pk2(x[8 * s2 + 2], x[8 * s2 + 3]), pk2(x[8 * s2 + 4], x[8 * s2 + 5]), pk2(x[8 * s2 + 6], x[8 * s2 + 7])};
            const bf16x8 vf = tr_frag(vbase + (4 * jb + 2 * s2) * 512);
            o = __builtin_amdgcn_mfma_f32_32x32x16_bf16(vf, __builtin_bit_cast(bf16x8, pw), o, 0, 0, 0); }
    }
    LAS float* SSQ = (LAS float*)(F.lds + GL_LR);
    { float s = 0.f;
#pragma unroll
      for (int r = 0; r < 16; ++r) s += o[r] * o[r];
      s += shfl_x(s, lane, 32);
      if (hh == 0) SSQ[vb * 64 + 32 * ib + r32] = s; }
    __syncthreads();
    { const int i = 32 * ib + r32; const float tot = SSQ[i] + SSQ[64 + i] + SSQ[128 + i] + SSQ[192 + i]; const float rs = frsq(tot * (1.0f / 128.0f) + EPS);
      const float* gain = FIN(I_GGAIN) + e * 512 + hd * 128; const size_t row = (size_t)(R0 + i);
#pragma unroll
      for (int g = 0; g < 4; ++g) { const int v0 = 32 * vb + 8 * g + 4 * hh; const f32x4 gn = *(const f32x4*)(gain + v0);
        const u32x2 gr = grreg[g];
        const float r0 = o[4 * g] * rs * gn[0] * bflo(gr.x), r1 = o[4 * g + 1] * rs * gn[1] * bfhi(gr.x), r2 = o[4 * g + 2] * rs * gn[2] * bflo(gr.y), r3 = o[4 * g + 3] * rs * gn[3] * bfhi(gr.y);
        *(u32x2*)(WSP(bf16_t, WS_MIX) + row * D + 512 + hd * 128 + v0) = (u32x2){pk2(r0, r1), pk2(r2, r3)}; } }
    __syncthreads();
}

__device__ __forceinline__ void phase_attn_g1(Frame& F, int e) {
    const int v = F.vcu;
    for (int i = 0; i < 2; ++i) { const int uid = 2 * v + i; const int hp = uid & 1, qb = (uid >> 1) & 31, kvh = (uid >> 6) & 1, b = uid >> 7; attn_unit(F, e, 0, b, kvh, qb, hp); }
    if (v < 128) { const int hp = v & 1, qb = (v >> 1) & 1, kvh = (v >> 2) & 1, b = v >> 3; attn_unit(F, e, 1, b, kvh, qb, hp); }
    { GlaPre pre = gla_load(F, e, (v * 5) >> 2, (v * 5) & 3, false);
      for (int it = v * 5; it < v * 5 + 5; ++it) { const int nx = it + 1 < v * 5 + 5 ? it + 1 : it; const GlaPre nxt = gla_load(F, e, nx >> 2, nx & 3, false); gla_g1_item(F, e, it >> 2, it & 3, pre); pre = nxt; } }
}
__device__ __forceinline__ void phase_g3(Frame& F, int e) {
    const int v = F.vcu;
    GlaPre pre = gla_load(F, e, (v * 5) >> 2, (v * 5) & 3, true);
    for (int it = v * 5; it < v * 5 + 5; ++it) { const int nx = it + 1 < v * 5 + 5 ? it + 1 : it; const GlaPre nxt = gla_load(F, e, nx >> 2, nx & 3, true); gla_g3_item(F, e, it >> 2, it & 3, pre); pre = nxt; }
}

__device__ __forceinline__ void phase_conv(Frame& F, int o) {
    const bf16_t* U = WSP(bf16_t, WS_U); bf16_t* UC = WSP(bf16_t, WS_UC);
    const int gt = F.vcu * NTHREADS + F.tid, NGT = F.G * NTHREADS;
    for (int it = gt; it < 1280 * 128; it += NGT) {
        const int cg = it & 127, rg = it >> 7, c0 = cg * 8, r0 = rg * 16;
        const int seqlen = r0 < MCTX ? TCTX : TLAT; const int sb = r0 < MCTX ? (r0 & ~(TCTX - 1)) : MCTX + ((r0 - MCTX) & ~(TLAT - 1)); const int se = sb + seqlen;
        float w[4][8], bias[8];
#pragma unroll
        for (int i = 0; i < 4; ++i)
#pragma unroll
            for (int j = 0; j < 8; ++j) w[i][j] = FIN(I_CONVW)[(size_t)(o * 4 + i) * 1024 + c0 + j];
#pragma unroll
        for (int j = 0; j < 8; ++j) bias[j] = FIN(I_CONVB)[o * 1024 + c0 + j];
        u32x4 raw[19];
#pragma unroll
        for (int r = 0; r < 19; ++r) { const int row = r0 - 2 + r; const int rc = row < sb ? sb : (row >= se ? se - 1 : row); raw[r] = *(const u32x4*)(U + (size_t)rc * D + c0); }
#pragma unroll
        for (int r = 0; r < 19; ++r) { const int row = r0 - 2 + r; if (row < sb || row >= se) raw[r] = (u32x4){0u, 0u, 0u, 0u}; }
#pragma unroll
        for (int r = 0; r < 16; ++r) { float y[8];
#pragma unroll
            for (int j = 0; j < 8; ++j) { const int w2 = j >> 1;
                const float x0 = (j & 1) ? bfhi(raw[r][w2]) : bflo(raw[r][w2]), x1 = (j & 1) ? bfhi(raw[r + 1][w2]) : bflo(raw[r + 1][w2]), x2 = (j & 1) ? bfhi(raw[r + 2][w2]) : bflo(raw[r + 2][w2]), x3 = (j & 1) ? bfhi(raw[r + 3][w2]) : bflo(raw[r + 3][w2]);
                y[j] = bias[j] + w[0][j] * x0 + w[1][j] * x1 + w[2][j] * x2 + w[3][j] * x3; }
            *(u32x4*)(UC + (size_t)(r0 + r) * D + c0) = (u32x4){pk2(y[0], y[1]), pk2(y[2], y[3]), pk2(y[4], y[5]), pk2(y[6], y[7])}; }
    }
}
__device__ __forceinline__ void phase_carry(Frame& F, int o) {
    const float* AGG = WSP(float, WS_AGG); float* CAR = WSP(float, WS_CARRY);
    const int gt = F.vcu * NTHREADS + F.tid, NGT = F.G * NTHREADS;
    for (int c = gt; c < 8192 + 32768; c += NGT) {
        if (c < 8192) { const int b = c >> 11, z = (c >> 10) & 1, ch = c & 1023; const int base = 64 + b * 64;
            float h = FIN(I_SLRU)[(size_t)((b * 2 + o) * 2 + z) * 1024 + ch];
            for (int i8 = 0; i8 < 64; i8 += 8) { f32x2 a[8];
#pragma unroll
                for (int i = 0; i < 8; ++i) { const int ck = base + (z ? 63 - (i8 + i) : i8 + i); a[i] = *(const f32x2*)(AGG + ((size_t)(ck * 2 + z) * 1024 + ch) * 2); }
#pragma unroll
                for (int i = 0; i < 8; ++i) { const int ck = base + (z ? 63 - (i8 + i) : i8 + i); CAR[(size_t)(ck * 2 + z) * 1024 + ch] = h; h = a[i].x * h + a[i].y; } }
        } else { const int cc = c - 8192; const int b = cc >> 11, z = (cc >> 10) & 1, ch = cc & 1023; const int base = b * 4; float h = 0.f;
#pragma unroll
            for (int i = 0; i < 4; ++i) { const int ck = base + (z ? 3 - i : i); const f32x2 a = *(const f32x2*)(AGG + ((size_t)(ck * 2 + z) * 1024 + ch) * 2); CAR[(size_t)(ck * 2 + z) * 1024 + ch] = h; h = a.x * h + a.y; }
            F.out[OUT_LRU + (size_t)((b * 2 + o) * 2 + z) * 1024 + ch] = h; }
    }
}
__device__ __forceinline__ void phase_lru_out(Frame& F) {
    const bf16_t* ACF = WSP(bf16_t, WS_LAF); const bf16_t* ACB = WSP(bf16_t, WS_LAB); const bf16_t* HLF = WSP(bf16_t, WS_U); const bf16_t* HLB = WSP(bf16_t, WS_BB);
    const bf16_t* Gg = WSP(bf16_t, WS_G); bf16_t* YG = WSP(bf16_t, WS_BB); const float* CAR = WSP(float, WS_CARRY);
    const int gt = F.vcu * NTHREADS + F.tid, NGT = F.G * NTHREADS;
    for (int it = gt; it < 1280 * 128; it += NGT) {
        const int cg = it & 127, rg = it >> 7, c0 = cg * 8, r0 = rg * 16, ck = r0 >> 6;
        float cf[8], cb[8];
        { const f32x4 a0 = *(const f32x4*)(CAR + (size_t)(ck * 2) * 1024 + c0), a1 = *(const f32x4*)(CAR + (size_t)(ck * 2) * 1024 + c0 + 4), b0 = *(const f32x4*)(CAR + (size_t)(ck * 2 + 1) * 1024 + c0), b1 = *(const f32x4*)(CAR + (size_t)(ck * 2 + 1) * 1024 + c0 + 4);
#pragma unroll
          for (int j = 0; j < 4; ++j) { cf[j] = a0[j]; cf[4 + j] = a1[j]; cb[j] = b0[j]; cb[4 + j] = b1[j]; } }
#pragma unroll 4
        for (int r = 0; r < 16; ++r) { const size_t ix = (size_t)(r0 + r) * D + c0;
            const u32x4 af = *(const u32x4*)(ACF + ix), ab = *(const u32x4*)(ACB + ix), hf = *(const u32x4*)(HLF + ix), hb = *(const u32x4*)(HLB + ix), gg = *(const u32x4*)(Gg + ix);
            float y[8];
#pragma unroll
            for (int w2 = 0; w2 < 4; ++w2) { y[2 * w2] = bflo(gg[w2]) * ((bflo(hf[w2]) + bflo(af[w2]) * cf[2 * w2]) + (bflo(hb[w2]) + bflo(ab[w2]) * cb[2 * w2]));
                y[2 * w2 + 1] = bfhi(gg[w2]) * ((bfhi(hf[w2]) + bfhi(af[w2]) * cf[2 * w2 + 1]) + (bfhi(hb[w2]) + bfhi(ab[w2]) * cb[2 * w2 + 1])); }
            *(u32x4*)(YG + ix) = (u32x4){pk2(y[0], y[1]), pk2(y[2], y[3]), pk2(y[4], y[5]), pk2(y[6], y[7])}; }
    }
}

constexpr int NSTEPS = 42;
template <int KIND>
__device__ __forceinline__ void run_gemm(Frame& F, int l, int sub, int gidx, const bf16_t* A, int lda, int K, int a_grp, const bf16_t* Bt, int nN, bool perm, int dep, int depneed, int pub, int rot, int qidx, unsigned stop_at = 0, int jlo = 0, int jhi = 1 << 30, bool again = false) {
    pg8::Gemm g; g.A = A; g.Bt = Bt; g.lda = lda; g.K = K; g.nM = M / 256; g.nN = nN; g.a_grp = a_grp; g.perm = perm;
    Epi<KIND> E; E.layer = l; E.sub = sub; E.gidx = gidx; E.p = F.p; E.oz = F.oz;
    pg8::StaticOrder S; S.init(g.nM, g.nN, F.G, F.bid); S.rot = rot;
    S.stop_at = stop_at; S.jlo = jlo; S.jhi = jhi; S.again = again;
    unsigned* cw = WSP(unsigned, WS_CTL) + CW_CNT;
    if (dep >= 0) { S.ready = cw + (size_t)dep * 80 * 16; S.need = (unsigned)depneed * 8u; }
    if (pub >= 0) S.fin = cw + (size_t)pub * 80 * 16;
    if (qidx >= 0 && F.G == 256) { S.queue = WSP(unsigned, WS_CTL) + CW_Q + (size_t)qidx * 8 * 16; S.word = (LAS unsigned*)(F.lds + MISC_OFF + 64); }
    pg8::gemm_phase<Epi<KIND>>(F.lds, F.tid, (float)F.oz, g, S, E);
}
__global__ void __launch_bounds__(NTHREADS, 2) mk_fwd(Params P) {
    extern __shared__ __attribute__((aligned(16))) unsigned char lds_raw[];
    const lptr lds0 = (lptr)lds_raw;
    volatile LAS unsigned* MISC = (volatile LAS unsigned*)(lds0 + MISC_OFF);
    static_assert((LDS_BYTES - LDSCTL_OFF) == 8 * NTHREADS * 4, "LDS control region");
#pragma unroll
    for (int u = 0; u < 8; ++u) ((LAS unsigned*)(lds0 + LDSCTL_OFF))[u * NTHREADS + threadIdx.x] = 0u;
    __syncthreads();
    unsigned* ctl = (unsigned*)(P.ws + WS_CTL);
    XcdBarrier bar; bar.bar = ctl + 1024; bar.x = 0; bar.st = nullptr;
    const int lo = P.step_lo, hi = P.step_hi;
    const bool multi = (hi - lo) > 1;
    if (multi) bar = xcd_barrier_post(ctl + 1024, MISC + 8);
    volatile LAS unsigned long long* TS = (volatile LAS unsigned long long*)(lds0 + LDSCTL_OFF + 1024);
    if (PROBE_K1 >= 0 && blockIdx.x == 0 && threadIdx.x == 0) TS[0] = __builtin_amdgcn_s_memrealtime();
#define STEP_BEGIN(s) if (lo <= (s) && (s) < hi) { Frame F; F.lds = lds0; F.p = &P; \
        { int tid = threadIdx.x; asm volatile("" : "+v"(tid)); F.tid = tid; F.lane = tid & 63; F.wave = __builtin_amdgcn_readfirstlane(tid >> 6); } \
        { int G = gridDim.x, bx = blockIdx.x, oz = 0; asm volatile("" : "+s"(G), "+s"(bx), "+s"(oz)); F.G = G; F.bid = bx; F.vcu = (G % 8 == 0) ? (bx % 8) * (G / 8) + bx / 8 : bx; F.oz = oz; F.out = P.out + oz; }
#define STAMP() do { if (PROBE_K1 >= 0 && blockIdx.x == 0 && threadIdx.x == 0) { const int o_ = (int)TS[63]; if (o_ < 62) TS[o_ + 1] = __builtin_amdgcn_s_memrealtime(); TS[63] = (unsigned long long)(o_ + 1); } } while (0)
#define STEP_END(s) if (multi && (s) + 1 < hi) { XcdBarrier bb = bar; asm volatile("" : "+s"(bb.bar), "+s"(bb.x)); xcd_barrier(bb, F.tid); } else __syncthreads(); STAMP(); }

#define STEP_LINK(s) __syncthreads(); STAMP(); }
#define STEP_END_IF(c, s) if ((c) && multi && (s) + 1 < hi) { XcdBarrier bb = bar; asm volatile("" : "+s"(bb.bar), "+s"(bb.x)); xcd_barrier(bb, F.tid); } else __syncthreads(); STAMP(); }
    STEP_BEGIN(0) phase_prologue(F); STEP_END(0)
    for (int l = 0; l < DEPTH; ++l) {
        const int s0 = 1 + 10 * l; const bool even = (l & 1) == 0; const int sub = l >> 1;
        const int dep_in = l > 0 ? (l - 1) * 3 + 2 : -1;
        if (l == 0) { STEP_BEGIN(1) phase_pre(F); STEP_END(1) }
        if (even) {
            STEP_BEGIN(s0 + 1) run_gemm<EK_EVEN_IN>(F, l, sub, 0, WSP(bf16_t, WS_XN), D, D, 0, WSP(bf16_t, WS_WINE) + (size_t)sub * PEP * D, 10, true, dep_in, 4, -1, 0, l * 4 + 3); STEP_END(s0 + 1)
            STEP_BEGIN(s0 + 2) phase_attn_g1(F, sub); STEP_END(s0 + 2)
            STEP_BEGIN(s0 + 3) phase_g2(F, sub); STEP_END(s0 + 3)
            STEP_BEGIN(s0 + 4) phase_g3(F, sub); STEP_END(s0 + 4)
            STEP_BEGIN(s0 + 6) run_gemm<EK_RES>(F, l, sub, 2, WSP(bf16_t, WS_MIX), D, D, 0, WSP(bf16_t, WS_WOUTE) + (size_t)sub * D * D, 4, true, -1, 0, l * 3 + 0, 0, -1); STEP_LINK(s0 + 6)
        } else {
            STEP_BEGIN(s0 + 1) run_gemm<EK_ODD_IN>(F, l, sub, 0, WSP(bf16_t, WS_XN), D, D, 0, WSP(bf16_t, WS_WINO) + (size_t)sub * 2048 * D, 8, true, dep_in, 4, -1, 0, l * 4 + 3); STEP_END(s0 + 1)
            STEP_BEGIN(s0 + 2) phase_conv(F, sub); STEP_END(s0 + 2)
            STEP_BEGIN(s0 + 3) run_gemm<EK_GATES>(F, l, sub, 0, WSP(bf16_t, WS_UC), D, 256, 4, WSP(bf16_t, WS_WG) + (size_t)sub * 4096 * 256, 16, true, -1, 0, -1, 0, -1); STEP_END(s0 + 3)
            STEP_BEGIN(s0 + 4) phase_carry(F, sub); STEP_END(s0 + 4)
            STEP_BEGIN(s0 + 5) phase_lru_out(F); STEP_END(s0 + 5)
            STEP_BEGIN(s0 + 6) run_gemm<EK_RES>(F, l, sub, 2, WSP(bf16_t, WS_BB), D, D, 0, WSP(bf16_t, WS_WOUTO) + (size_t)sub * D * D, 4, true, -1, 0, l * 3 + 0, 0, -1); STEP_LINK(s0 + 6)
        }
        for (int ph = 0; ph < 2; ++ph) {
            const bool own0 = (((int)blockIdx.x >> 3) & 31) < 20;
            STEP_BEGIN(s0 + 8) run_gemm<EK_SWIGLU>(F, l, sub, 0, WSP(bf16_t, WS_XN), D, D, 0, WSP(bf16_t, WS_WF1) + (size_t)l * 5632 * D, 22, true, l * 3 + 0, 4, l * 3 + 1, 0, l * 4 + 1, (ph == 0 && own0) ? F2_T0 : 0u, 0, 1 << 30, ph != 0); STEP_LINK(s0 + 8)
            STEP_BEGIN(s0 + 9) run_gemm<EK_RES>(F, l, sub, 5, WSP(bf16_t, WS_H), DFF, DFF, 0, WSP(bf16_t, WS_WF2) + (size_t)l * D * DFF, 4, true, l * 3 + 1, 22, (l + 1 < DEPTH) ? l * 3 + 2 : -1, 0, -1, 0u, ph ? 20 : 0, ph ? 40 : 20, ph != 0);
            STEP_END_IF(ph == 1 && l + 1 == DEPTH, s0 + 9)
        }
    }
    STEP_BEGIN(41) phase_final(F); STEP_END(41)
#undef STEP_LINK
#undef STEP_END_IF
    if (PROBE_K1 >= 0 && blockIdx.x == 0 && threadIdx.x == 0) {
        unsigned long long q1 = (TS[PROBE_K1 + 1] - TS[PROBE_K1]) / 800ull; if (q1 > 63) q1 = 63;
        unsigned long long q2 = PROBE_K2 >= 0 ? (TS[PROBE_K2 + 1] - TS[PROBE_K2]) / 800ull : 0ull; if (q2 > 63) q2 = 63;
        const unsigned long long wait = (64ull * q1 + 4096ull * q2) * 100ull, t0 = __builtin_amdgcn_s_memrealtime();
        while (__builtin_amdgcn_s_memrealtime() - t0 < wait) __builtin_amdgcn_s_sleep(32);
    }
#undef STEP_BEGIN
#undef STEP_END
}

extern "C" void kernel_launch(void* const* d_in, const int* in_sizes, int n_in, void* d_out, int out_size, void* d_ws, size_t ws_size, hipStream_t stream) {
    static int grid = 0;
    if (grid == 0) {
        if (n_in != 30 || (size_t)out_size != OUT_END || ws_size < WS_END) { fprintf(stderr, "kernel_launch: unexpected shapes: n_in %d out %d ws %zu (need %zu)\n", n_in, out_size, ws_size, (size_t)WS_END); grid = -1; return; }
        int dev = 0, cus = 0;
        if (hipGetDevice(&dev) != hipSuccess || hipDeviceGetAttribute(&cus, hipDeviceAttributeMultiprocessorCount, dev) != hipSuccess) { grid = -1; return; }
        if (hipFuncSetAttribute((const void*)mk_fwd, hipFuncAttributeMaxDynamicSharedMemorySize, LDS_BYTES) != hipSuccess) { fprintf(stderr, "kernel_launch: hipFuncSetAttribute failed\n"); grid = -1; return; }
        (void)hipGetLastError();
        grid = cus;
        if (grid != 256) fprintf(stderr, "kernel_launch: %d CUs (built for 256)\n", grid);
    }
    if (grid < 0) return;
    (void)hipMemsetAsync((char*)d_ws + WS_CTL, 0, CTL_ZERO_BYTES, stream);
    Params p{};
    for (int i = 0; i < 30; ++i) p.in[i] = (const float*)d_in[i];
    p.out = (float*)d_out; p.ws = (unsigned char*)d_ws;
#if MK_MULTI
    for (int s = 0; s < NSTEPS; ++s) {
        if (s >= 1 && s <= 40) { const int l = (s - 1) / 10, j = (s - 1) % 10; if (((l & 1) == 0 && j == 5) || j == 7 || (j == 0 && l > 0)) continue; }
        p.step_lo = s; p.step_hi = s + 1;
        hipLaunchKernelGGL(mk_fwd, dim3(grid), dim3(NTHREADS), LDS_BYTES, stream, p);
    }
#else
    p.step_lo = 0; p.step_hi = NSTEPS;
    hipLaunchKernelGGL(mk_fwd, dim3(grid), dim3(NTHREADS), LDS_BYTES, stream, p);
#endif
}
```

```cpp
#include <hip/hip_runtime.h>
#include <cstdio>
#include <cstdint>

#ifndef MK_MULTI
#define MK_MULTI 0
#endif

#ifndef PROBE_K1
#define PROBE_K1 -1
#endif
#ifndef PROBE_K2
#define PROBE_K2 -1
#endif
#define LAS __attribute__((address_space(3)))
#define GAS __attribute__((address_space(1)))
typedef unsigned short bf16_t;
typedef short bf16x8 __attribute__((ext_vector_type(8)));
typedef short s16x4 __attribute__((ext_vector_type(4)));
typedef float f32x2 __attribute__((ext_vector_type(2)));
typedef float f32x4 __attribute__((ext_vector_type(4)));
typedef float f32x16 __attribute__((ext_vector_type(16)));
typedef unsigned u32x2 __attribute__((ext_vector_type(2)));
typedef unsigned u32x4 __attribute__((ext_vector_type(4)));
typedef LAS unsigned char* lptr;

constexpr int D = 1024, NCTX = 16, TCTX = 256, NLAT = 4, TLAT = 4096, DEPTH = 4;
constexpr int MCTX = NCTX * TCTX;
constexpr int M = MCTX + NLAT * TLAT;
constexpr int PE = 2336, PEP = 2560;
constexpr int ZW = 2304;
constexpr int DFF = 2816;
constexpr float EPS = 1e-6f;
constexpr float LOG2E = 1.4426950408889634f;
constexpr float QSCALE = 0.125f * LOG2E;
constexpr int NCHUNK = M / 64;

constexpr size_t OUT_CK = (size_t)M * D, OUT_CV = OUT_CK + 1048576, OUT_GLA = OUT_CV + 1048576, OUT_LRU = OUT_GLA + 2097152, OUT_END = OUT_LRU + 65536;

constexpr size_t MiB = 1u << 20;
constexpr size_t WS_CTL = 0, CTL_ZERO_BYTES = 128 * 1024;
constexpr unsigned F2_T0 = 144;
constexpr int CW_Q = 12288;
constexpr int CW_CNT = 16384;
constexpr size_t WS_BIAS = 256 * 1024;
constexpr size_t BIAS_E = 0, BIAS_O = 2 * 5 * 2560, BIAS_F = BIAS_O + 2 * 5 * 2048, BIAS_TOTAL = BIAS_F + 4 * 5 * 5632;
constexpr size_t SSQP_OFF = 10485760;
constexpr size_t WS_SSQ_UNUSED = 3 * MiB;
constexpr size_t WS_MOD = 1 * MiB;
constexpr size_t WS_ROPE = WS_MOD + 512 * 1024;
constexpr size_t WS_CK = 2 * MiB, WS_CV = 2 * MiB + 512 * 1024;
constexpr size_t WS_WINE = 4 * MiB;
constexpr size_t WS_WOUTE = WS_WINE + 10 * MiB;
constexpr size_t WS_WINO = WS_WOUTE + 4 * MiB;
constexpr size_t WS_WG = WS_WINO + 8 * MiB;
constexpr size_t WS_WOUTO = WS_WG + 4 * MiB;
constexpr size_t WS_WF1 = WS_WOUTO + 4 * MiB;
constexpr size_t WS_WF2 = WS_WF1 + 44 * MiB;
constexpr size_t WS_XN = WS_WF2 + 22 * MiB;
static_assert(WS_XN == 100 * MiB, "ws map");
constexpr size_t WS_BIG = 140 * MiB;
constexpr size_t WS_ZE = 140 * MiB;
constexpr size_t WS_KV = 230 * MiB;
constexpr size_t WS_MIX = 340 * MiB;
constexpr size_t WS_LR = 380 * MiB;
constexpr size_t WS_DL = 383 * MiB;
constexpr size_t WS_G = 140 * MiB;
constexpr size_t WS_U = 180 * MiB;
constexpr size_t WS_UC = 220 * MiB;
constexpr size_t WS_LAF = 260 * MiB;
constexpr size_t WS_LAB = 300 * MiB;
constexpr size_t WS_BB = 340 * MiB;
constexpr size_t WS_AGG = WS_XN;
constexpr size_t WS_CARRY = WS_XN + 8 * MiB;
constexpr size_t WS_H = 230 * MiB;
constexpr size_t WS_SSQ8 = 220 * MiB;
constexpr size_t WS_XF = 140 * MiB;
constexpr size_t WS_END = 384 * MiB;

constexpr int RING_BYTES = 131072;
constexpr int LDSCTL_OFF = RING_BYTES, MISC_OFF = LDSCTL_OFF + 320;
constexpr int LDS_BYTES = 147456;
constexpr int NWAVES = 8, NTHREADS = 512;

__device__ __forceinline__ unsigned f2bf(float f) { unsigned u = __builtin_bit_cast(unsigned, f); return (u + 0x7fffu + ((u >> 16) & 1u)) >> 16; }
typedef __bf16 bf16x2_t __attribute__((ext_vector_type(2)));
__device__ __forceinline__ unsigned pk2(float lo, float hi) { const f32x2 v = {lo, hi}; return __builtin_bit_cast(unsigned, __builtin_convertvector(v, bf16x2_t)); }
__device__ __forceinline__ float bf2f(unsigned short b) { return __builtin_bit_cast(float, (unsigned)b << 16); }
__device__ __forceinline__ float bflo(unsigned w) { return __builtin_bit_cast(float, w << 16); }
__device__ __forceinline__ float bfhi(unsigned w) { return __builtin_bit_cast(float, w & 0xffff0000u); }
__device__ __forceinline__ float fexp2(float x) { return __builtin_amdgcn_exp2f(x); }
__device__ __forceinline__ float fexp(float x) { return __builtin_amdgcn_exp2f(x * LOG2E); }
__device__ __forceinline__ float frcp(float x) { return __builtin_amdgcn_rcpf(x); }
__device__ __forceinline__ float frsq(float x) { return __builtin_amdgcn_rsqf(x); }
__device__ __forceinline__ float fsqrt(float x) { return __builtin_amdgcn_sqrtf(x); }
__device__ __forceinline__ float flog(float x) { return __builtin_amdgcn_logf(x) * 0.6931471805599453f; }
__device__ __forceinline__ float sigmoidf_(float x) { return frcp(1.0f + fexp(-x)); }
__device__ __forceinline__ float siluf_(float x) { return x * frcp(1.0f + fexp(-x)); }
__device__ __forceinline__ float gelu_tanh(float x) { const float z = 0.7978845608028654f * (x + 0.044715f * x * x * x); const float t = 1.0f - 2.0f * frcp(fexp(2.0f * z) + 1.0f); return 0.5f * x * (1.0f + t); }
__device__ __forceinline__ int crow(int r, int hh) { return (r & 3) + 8 * (r >> 2) + 4 * hh; }
__device__ __forceinline__ int cond_of_row(int row) { return row < MCTX ? 0 : 1 + ((row - MCTX) >> 12); }
#define LDS_WAIT() asm volatile("s_waitcnt lgkmcnt(0)" ::: "memory")
#define VM_WAIT() asm volatile("s_waitcnt vmcnt(0)" ::: "memory")
__device__ __forceinline__ s16x4 tr_read(lptr p) { typedef short v4i16_t __attribute__((ext_vector_type(4))); return __builtin_bit_cast(s16x4, __builtin_amdgcn_ds_read_tr16_b64_v4i16((LAS v4i16_t*)p)); }
__device__ __forceinline__ bf16x8 tr_frag(lptr p) { const s16x4 a = tr_read(p), b = tr_read(p + 512); return (bf16x8){a[0], a[1], a[2], a[3], b[0], b[1], b[2], b[3]}; }
__device__ __forceinline__ float shfl_idx(float v, int src_lane) { return __builtin_bit_cast(float, __builtin_amdgcn_ds_bpermute(src_lane << 2, __builtin_bit_cast(int, v))); }
__device__ __forceinline__ float shfl_x(float v, int lane, int mask) { return shfl_idx(v, lane ^ mask); }
__device__ __forceinline__ float wave_sum(float v, int lane) {
#pragma unroll
    for (int o = 1; o < 64; o <<= 1) v += shfl_x(v, lane, o);
    return v;
}

struct Params {
    const float* in[30];
    float* out; unsigned char* ws;
    int step_lo, step_hi;
};
enum { I_XP = 0, I_XS, I_C, I_CK, I_CV, I_SGLA, I_SLRU, I_CCTX, I_WADA, I_BADA, I_NMIX, I_NFFN, I_WINE, I_SINK, I_WALPHA, I_BALPHA, I_GGAIN, I_WOUTE,
       I_WINO, I_CONVW, I_CONVB, I_WGA, I_BGA, I_WGX, I_BGX, I_LAM, I_WOUTO, I_WF1, I_WF2, I_NFIN };

namespace pg8 {
constexpr int BM = 256, BK = 64, HALF = 128, HTB = HALF * BK * 2, STAGE_BYTES = 8 * HTB, NXCD = 8, WGM = 8;
__device__ __forceinline__ int lds_byte(int r, int c) { const int st = (r >> 4) * 2 + (c >> 5), rr = r & 15, cc = c & 31, ob = rr * 64 + cc * 2; return st * 1024 + (ob ^ (((ob >> 9) & 1) << 5)); }
__device__ __forceinline__ void stage_rc(int b, int& R, int& C) { const int st = b / 1024, sb = b % 1024, swz = sb ^ (((sb >> 9) & 1) << 5); R = (st >> 1) * 16 + swz / 64; C = (st & 1) * 32 + (swz % 64) / 2; }
__device__ __forceinline__ int perm32(int rho) { const int n = rho >> 4, i = rho & 15; return 8 * (i >> 2) + 4 * n + (i & 3); }
struct Unit { int pm, pn; };
struct Gemm { const bf16_t* A; const bf16_t* Bt; int lda, K, nM, nN, a_grp; bool perm; };
struct StaticOrder {
    int nM, nN, nwg, G, c;
    unsigned* queue; LAS unsigned* word;
    int rot;
    unsigned stop_at; int jlo, jhi; bool again;
    unsigned* ready; unsigned need; unsigned* fin;
    __device__ void init(int nM_, int nN_, int G_, int c_) { nM = nM_; nN = nN_; nwg = nM * nN; G = G_; c = c_; rot = 0; ready = nullptr; need = 0; fin = nullptr; queue = nullptr; word = nullptr; stop_at = 0; jlo = 0; jhi = 1 << 30; again = false; }
    __device__ __forceinline__ void a_ready(const Unit& u, int tid) const {
        if (ready == nullptr) return;
        if (tid < 64) { unsigned* p = ready + 16 * u.pm; unsigned sp = 0;
            while ((unsigned)__builtin_amdgcn_readfirstlane(__hip_atomic_load(p, __ATOMIC_RELAXED, __HIP_MEMORY_SCOPE_AGENT)) < need) { __builtin_amdgcn_s_sleep(2); if (++sp > (1u << 22)) break; }
            __builtin_amdgcn_fence(__ATOMIC_ACQUIRE, "agent");
            asm volatile("s_waitcnt vmcnt(0)" ::: "memory"); }
        asm volatile("" ::: "memory"); __builtin_amdgcn_s_barrier(); asm volatile("" ::: "memory");
    }
    __device__ __forceinline__ void unit_of(int j, Unit& u) const { const int x = c & 7, g = j / (5 * nN), jj = j % (5 * nN); u.pn = jj / 5; u.pm = 10 * x + 5 * g + jj % 5; }
    __device__ __forceinline__ bool fetch(int i, Unit& u, int tid) const {
        if (queue == nullptr) { const bool h = next(i, u); if (h) a_ready(u, tid); return h; }
        if (tid < 64) { unsigned j = 0; if (tid == 0) { unsigned* q = queue + 16 * (c & 7);
                if (stop_at != 0 && __hip_atomic_load(q, __ATOMIC_RELAXED, __HIP_MEMORY_SCOPE_AGENT) >= stop_at) j = 0xffffffffu; else j = __hip_atomic_fetch_add(q, 1u, __ATOMIC_RELAXED, __HIP_MEMORY_SCOPE_AGENT); }
            j = (unsigned)__builtin_amdgcn_readfirstlane((int)j);
            if (j < (unsigned)(10 * nN) && ready != nullptr) { Unit t; unit_of((int)j, t); unsigned* p = ready + 16 * t.pm; unsigned sp = 0;
                while ((unsigned)__builtin_amdgcn_readfirstlane(__hip_atomic_load(p, __ATOMIC_RELAXED, __HIP_MEMORY_SCOPE_AGENT)) < need) { __builtin_amdgcn_s_sleep(2); if (++sp > (1u << 22)) break; }
                __builtin_amdgcn_fence(__ATOMIC_ACQUIRE, "agent"); asm volatile("s_waitcnt vmcnt(0)" ::: "memory"); }
            if (tid == 0) *word = j;
            asm volatile("s_waitcnt lgkmcnt(0)" ::: "memory"); }
        asm volatile("" ::: "memory"); __builtin_amdgcn_s_barrier(); asm volatile("" ::: "memory");
        const unsigned j = *(volatile LAS unsigned*)word;
        if (j >= (unsigned)(10 * nN)) return false;
        unit_of((int)j, u); return true;
    }
    __device__ __forceinline__ void done(const Unit& u, int lane) const {
        if (fin == nullptr) return;
        asm volatile("s_waitcnt vmcnt(0)" ::: "memory");
        if (lane == 0) __hip_atomic_fetch_add(fin + 16 * u.pm, 1u, __ATOMIC_RELAXED, __HIP_MEMORY_SCOPE_AGENT);
    }
    __device__ bool next(int i, Unit& u) const {
        if (G == 256 && nM == 80) { const int x = c & 7, idx = ((c >> 3) + rot) & 31; int j = -1, cnt = 0;
            for (int jj = idx; jj < 10 * nN; jj += 32) if (jj >= jlo && jj < jhi) { if (cnt == i) j = jj; ++cnt; }
            if (j < 0) return false;
            const int g = j / (5 * nN), jj = j % (5 * nN); u.pn = jj / 5; u.pm = 10 * x + 5 * g + jj % 5; return true; }
        if (again) return false;
        const long L = (long)i * G + c; if (L >= nwg) return false;
        int wgid = (int)L; { const int q = nwg / NXCD, r = nwg % NXCD, xcd = wgid % NXCD, off = wgid / NXCD; wgid = (xcd < r ? xcd * (q + 1) : r * (q + 1) + (xcd - r) * q) + off; }
        const int nig = WGM * nN, gid = wgid / nig, fm = gid * WGM, gsz = (nM - fm) < WGM ? (nM - fm) : WGM;
        u.pm = fm + ((wgid % nig) % gsz); u.pn = (wgid % nig) / gsz; return true;
    }
};

template <class Epi>
__device__ __forceinline__ void gemm_phase(lptr lds, const int tid, const float zf, const Gemm g, const StaticOrder& S, const Epi& E) {
    const int wid = __builtin_amdgcn_readfirstlane(tid >> 6), lane = tid & 63, wr = wid >> 2, wc = wid & 3, fr = lane & 15, fq = lane >> 4;
    const int K = g.K, nt = K / BK, lda = g.lda;
    unsigned voffA[2], voffB[2];
#pragma unroll
    for (int i = 0; i < 2; ++i) { int R, C; stage_rc(tid * 16 + i * 8192, R, C); const int Rb = g.perm ? ((R & ~31) + perm32(R & 31)) : R;
        voffA[i] = (unsigned)(R * lda + C) * 2u; voffB[i] = (unsigned)(Rb * K + C) * 2u; }
    const size_t kstep = (size_t)(BK * 2);
    const size_t hsA = (size_t)HALF * lda * 2, hsB = (size_t)HALF * K * 2;
    const unsigned ldsw = (unsigned)wid * 1024u;
    const int aoff = lds_byte(wr * 64 + fr, fq * 8), boff = lds_byte(wc * 32 + fr, fq * 8);
#define PG8_SA(b, h) (((b) * 2 + (h)) * HTB)
#define PG8_SB(b, h) ((4 + (b) * 2 + (h)) * HTB)
#define PG8_STAGE(bufoff, gbase, voff) do { _Pragma("unroll") for (int _i = 0; _i < 2; ++_i) \
        __builtin_amdgcn_global_load_lds((const unsigned*)((const char*)(gbase) + (voff)[_i]), (LAS unsigned*)(lds + (bufoff) + ldsw + _i * 8192), 16, 0, 0); } while (0)
#define PG8_LDA(dst, b, h) do { _Pragma("unroll") for (int m = 0; m < 4; ++m) _Pragma("unroll") for (int k = 0; k < 2; ++k) dst[m][k] = *(const LAS bf16x8*)(lds + PG8_SA(b, h) + aoff + m * 2048 + k * 1024); } while (0)
#define PG8_LDB(dst, b, h) do { _Pragma("unroll") for (int n = 0; n < 2; ++n) _Pragma("unroll") for (int k = 0; k < 2; ++k) dst[n][k] = *(const LAS bf16x8*)(lds + PG8_SB(b, h) + boff + n * 2048 + k * 1024); } while (0)
#define PG8_MMA(ai, bj, At, Bt) do { __builtin_amdgcn_s_setprio(1); _Pragma("unroll") for (int m = 0; m < 4; ++m) _Pragma("unroll") for (int n = 0; n < 2; ++n) _Pragma("unroll") for (int k = 0; k < 2; ++k) \
        acc[ai][bj][m][n] = __builtin_amdgcn_mfma_f32_16x16x32_bf16(Bt[n][k], At[m][k], acc[ai][bj][m][n], 0, 0, 0); __builtin_amdgcn_s_setprio(0); } while (0)
#define PG8_WAIT_V(n) asm volatile("s_waitcnt vmcnt(" #n ")" ::: "memory")
#define PG8_WAIT_L(n) asm volatile("s_waitcnt lgkmcnt(" #n ")" ::: "memory")
#define PG8_BAR __builtin_amdgcn_s_barrier()
#define PG8_SCHED __builtin_amdgcn_sched_barrier(0)
#define PG8_ABASE(u) ((const char*)g.A + ((size_t)(u).pm * BM * lda + (g.a_grp ? (size_t)((u).pn / g.a_grp) * K : 0)) * 2)
#define PG8_BBASE(u) ((const char*)g.Bt + (size_t)(u).pn * BM * K * 2)
    Unit cur, nxt; int ui = 0;
    if (!S.fetch(0, cur, tid)) return;
    f32x4 acc[2][2][4][2];
#pragma unroll
    for (int a = 0; a < 2; ++a)
#pragma unroll
        for (int b = 0; b < 2; ++b)
#pragma unroll
            for (int m = 0; m < 4; ++m)
#pragma unroll
                for (int n = 0; n < 2; ++n) acc[a][b][m][n] = (f32x4){zf, zf, zf, zf};
    bf16x8 At[4][2], B0[2][2], B1[2][2];
    const char* cA = PG8_ABASE(cur); const char* cB = PG8_BBASE(cur);
    PG8_STAGE(PG8_SB(0, 0), cB, voffB); PG8_STAGE(PG8_SB(0, 1), cB + hsB, voffB); PG8_STAGE(PG8_SA(0, 0), cA, voffA); PG8_STAGE(PG8_SA(0, 1), cA + hsA, voffA);
    if (wr == 1) PG8_BAR;
    PG8_WAIT_V(2); PG8_BAR;
    PG8_STAGE(PG8_SB(1, 0), cB + kstep, voffB); PG8_STAGE(PG8_SA(1, 0), cA + kstep, voffA); PG8_STAGE(PG8_SB(1, 1), cB + hsB + kstep, voffB);
    PG8_WAIT_V(6); PG8_BAR;
    for (;;) {
        bool has_next = false; const char* nA = cA; const char* nB = cB;
#pragma unroll 1
        for (int t = 0; t < nt; t += 2) {
            const bool last = (t == nt - 2);
            if (last) { has_next = S.fetch(ui + 1, nxt, tid); if (has_next) { nA = PG8_ABASE(nxt); nB = PG8_BBASE(nxt); } }
            const char* a1 = cA + (size_t)(t + 1) * kstep;
            const char* a2 = last ? nA : cA + (size_t)(t + 2) * kstep; const char* b2 = last ? nB : cB + (size_t)(t + 2) * kstep;
            const char* a3 = a2 + kstep; const char* b3 = b2 + kstep;
            PG8_LDB(B0, 0, 0); PG8_LDB(B1, 0, 1); PG8_SCHED; PG8_LDA(At, 0, 0); PG8_STAGE(PG8_SA(1, 1), a1 + hsA, voffA);
            PG8_WAIT_V(8); PG8_WAIT_L(0); PG8_BAR; PG8_MMA(0, 0, At, B0); PG8_MMA(0, 1, At, B1); PG8_BAR; PG8_SCHED;
            PG8_LDA(At, 0, 1); PG8_STAGE(PG8_SB(0, 0), b2, voffB); PG8_STAGE(PG8_SB(0, 1), b2 + hsB, voffB); PG8_STAGE(PG8_SA(0, 0), a2, voffA);
            PG8_WAIT_V(8); PG8_WAIT_L(0); PG8_BAR; PG8_MMA(1, 0, At, B0); PG8_MMA(1, 1, At, B1); PG8_BAR; PG8_SCHED;
            PG8_LDB(B0, 1, 0); PG8_LDB(B1, 1, 1); PG8_SCHED; PG8_LDA(At, 1, 0); PG8_STAGE(PG8_SA(0, 1), a2 + hsA, voffA);
            PG8_WAIT_V(8); PG8_WAIT_L(0); PG8_BAR; PG8_MMA(0, 0, At, B0); PG8_MMA(0, 1, At, B1); PG8_BAR; PG8_SCHED;
            PG8_LDA(At, 1, 1); PG8_STAGE(PG8_SB(1, 0), b3, voffB); PG8_STAGE(PG8_SB(1, 1), b3 + hsB, voffB); PG8_STAGE(PG8_SA(1, 0), a3, voffA);
            PG8_WAIT_V(8); PG8_WAIT_L(0); PG8_BAR; PG8_MMA(1, 0, At, B0); PG8_MMA(1, 1, At, B1); PG8_BAR; PG8_SCHED;
        }
        if (wr == 0) PG8_BAR;
        { int fr_ = fr, fq_ = fq; asm volatile("" : "+v"(fr_), "+v"(fq_)); E(acc, cur, wr, wc, fr_, fq_); S.done(cur, fq_ * 16 + fr_); }
        if (!has_next) break;
#pragma unroll
        for (int a = 0; a < 2; ++a)
#pragma unroll
            for (int b = 0; b < 2; ++b)
#pragma unroll
                for (int m = 0; m < 4; ++m)
#pragma unroll
                    for (int n = 0; n < 2; ++n) acc[a][b][m][n] = (f32x4){zf, zf, zf, zf};
        cur = nxt; cA = nA; cB = nB; ++ui;
        if (wr == 1) PG8_BAR;
    }
    PG8_WAIT_V(0);
    PG8_BAR;
#undef PG8_SA
#undef PG8_SB
#undef PG8_STAGE
#undef PG8_LDA
#undef PG8_LDB
#undef PG8_MMA
#undef PG8_WAIT_V
#undef PG8_WAIT_L
#undef PG8_BAR
#undef PG8_SCHED
#undef PG8_ABASE
#undef PG8_BBASE
}
}

enum EpiKind { EK_EVEN_IN = 0, EK_ODD_IN, EK_GATES, EK_RES, EK_SWIGLU };
template <int kind> struct Epi {
    int layer, sub; int gidx;
    const Params* p; int oz;
#define EWS(T, off) ((T*)(p->ws + ((size_t)(off) + (size_t)oz)))
#define EIN(i) (p->in[(i) + oz])
#define NORM_FIX_SETUP(NIDX, BOFF, NTOT) float rs_[2][4]; f32x4 bia_[2][2]; { const float* sq_ = p->out + oz + SSQP_OFF + (size_t)(NIDX) * M * 16; \
        _Pragma("unroll") for (int ai = 0; ai < 2; ++ai) _Pragma("unroll") for (int m = 0; m < 4; ++m) { const f32x4 a_ = *(const f32x4*)(sq_ + (size_t)(row0 + ai * 128 + m * 16) * 16 + 4 * fq); \
            float s_ = (a_[0] + a_[1]) + (a_[2] + a_[3]); s_ += shfl_x(s_, fq * 16 + fr, 16); s_ += shfl_x(s_, fq * 16 + fr, 32); rs_[ai][m] = frsq(s_ * (1.0f / D) + EPS); }     \
        const float* bp_ = EWS(const float, WS_BIAS) + (BOFF) + (size_t)cond_of_row(u.pm * 256) * (NTOT) + u.pn * 256 + wc * 32 + 8 * fq; \
        _Pragma("unroll") for (int bj = 0; bj < 2; ++bj) _Pragma("unroll") for (int n = 0; n < 2; ++n) bia_[bj][n] = *(const f32x4*)(bp_ + bj * 128 + 4 * n); }
#define FIXV(ai, bj, m, n) (acc[ai][bj][m][n] * rs_[ai][m] + bia_[bj][n])
    __device__ __forceinline__ void operator()(f32x4 (&acc)[2][2][4][2], const pg8::Unit& u, int wr, int wc, int fr, int fq) const {
        const int row0 = u.pm * 256 + wr * 64 + fr;
        float* const X = p->out + oz;
        if constexpr (kind == EK_RES) {
            const float* mod = EWS(const float, WS_MOD);
            const int ci = cond_of_row(u.pm * 256);
            const float* gate = mod + ((size_t)(layer * 5 + ci) * 6 + gidx) * 1024;
            const int col0 = u.pn * 256 + wc * 32 + 8 * fq;
            const int nn = (gidx == 2) ? 2 * layer + 1 : 2 * layer + 2;
            const bool fin = nn == 8;
            const float* nw = (gidx == 2) ? EIN(I_NFFN) + layer * 1024 : (fin ? EIN(I_NFIN) : EIN(I_NMIX) + (layer + 1) * 1024);
            const float* scv = mod + ((size_t)((gidx == 2 ? layer : (fin ? layer : layer + 1)) * 5 + ci) * 6 + (gidx == 2 ? 4 : 1)) * 1024;
            f32x4 gv[2][2], gp[2][2];
#pragma unroll
            for (int bj = 0; bj < 2; ++bj)
#pragma unroll
                for (int n = 0; n < 2; ++n) { gv[bj][n] = *(const f32x4*)(gate + col0 + bj * 128 + n * 4);
                    gp[bj][n] = *(const f32x4*)(nw + col0 + bj * 128 + n * 4); if (!fin) gp[bj][n] = gp[bj][n] * (1.0f + *(const f32x4*)(scv + col0 + bj * 128 + n * 4)); }
            bf16_t* XN = EWS(bf16_t, WS_XN); float* ssq = (fin ? EWS(float, WS_SSQ8) : p->out + oz + SSQP_OFF + (size_t)nn * M * 16) + u.pn * 4 + wc;
            const int lane_ = fq * 16 + fr;
            const char* Xb = (const char*)X; char* Xo = fin ? (char*)EWS(bf16_t, WS_XF) : (char*)X;
            const unsigned vo = (unsigned)(row0 * D + col0) * 2u, so = (unsigned)(row0 * 16) * 4u;
#define RES_OFF(vo, h8_, mm_, bj_) ((vo) + (unsigned)(((((h8_) >> 1) * 128 + (((h8_) & 1) * 2 + (mm_)) * 16) * D + (bj_) * 128) * 2))
            u32x4 xw[4][2][2];
#pragma unroll
            for (int h8 = 0; h8 < 4; ++h8)
#pragma unroll
                for (int mm = 0; mm < 2; ++mm)
#pragma unroll
                    for (int bj = 0; bj < 2; ++bj) xw[h8][mm][bj] = *(const u32x4*)(Xb + RES_OFF(vo, h8, mm, bj));
#pragma unroll
            for (int ai = 0; ai < 2; ++ai)
#pragma unroll
                for (int bj = 0; bj < 2; ++bj)
#pragma unroll
                    for (int m = 0; m < 4; ++m)
                    { acc[ai][bj][m][0] = acc[ai][bj][m][0] * gv[bj][0]; acc[ai][bj][m][1] = acc[ai][bj][m][1] * gv[bj][1];
                        asm volatile("" : "+v"(acc[ai][bj][m][0]), "+v"(acc[ai][bj][m][1])); }
#pragma unroll
            for (int h8 = 0; h8 < 4; ++h8) { const int ai = h8 >> 1, mb = (h8 & 1) * 2;
                __builtin_amdgcn_sched_barrier(0);
                unsigned vq = vo, sq_o = so; asm volatile("" : "+v"(vq), "+v"(sq_o));
#pragma unroll
                for (int mm = 0; mm < 2; ++mm) { const int m = mb + mm; float sq = 0.f;
#pragma unroll
                    for (int bj = 0; bj < 2; ++bj) { const u32x4 w = xw[h8][mm][bj];
                        const f32x4 x0 = (f32x4){bflo(w.x), bfhi(w.x), bflo(w.y), bfhi(w.y)} + acc[ai][bj][m][0], x1 = (f32x4){bflo(w.z), bfhi(w.z), bflo(w.w), bfhi(w.w)} + acc[ai][bj][m][1];
                        *(u32x4*)(Xo + RES_OFF(vq, h8, mm, bj)) = (u32x4){pk2(x0[0], x0[1]), pk2(x0[2], x0[3]), pk2(x1[0], x1[1]), pk2(x1[2], x1[3])};
                        sq += ((x0[0] * x0[0] + x0[1] * x0[1]) + (x0[2] * x0[2] + x0[3] * x0[3])) + ((x1[0] * x1[0] + x1[1] * x1[1]) + (x1[2] * x1[2] + x1[3] * x1[3]));
                        if (!fin) { const f32x4 y0 = x0 * gp[bj][0], y1 = x1 * gp[bj][1]; const u32x4 wv = (u32x4){pk2(y0[0], y0[1]), pk2(y0[2], y0[3]), pk2(y1[0], y1[1]), pk2(y1[2], y1[3])};
                            asm volatile("global_store_dwordx4 %0, %1, %2 sc1\n\ts_nop 1" :: "v"(RES_OFF(vq, h8, mm, bj)), "v"(wv), "s"(XN) : "memory"); } }
                    sq += shfl_x(sq, lane_, 16); sq += shfl_x(sq, lane_, 32);
                    if (fq == 0) __hip_atomic_store((float*)((char*)ssq + (sq_o + (unsigned)((ai * 128 + m * 16) * 64))), sq, __ATOMIC_RELAXED, __HIP_MEMORY_SCOPE_AGENT); }
            }
#undef RES_OFF
        } else if constexpr (kind == EK_SWIGLU) {
            bf16_t* H = EWS(bf16_t, WS_H); const int col0 = u.pn * 128 + wc * 32 + 8 * fq;
            NORM_FIX_SETUP(2 * layer + 1, BIAS_F + (size_t)layer * 5 * 5632, 5632)
#pragma unroll
            for (int ai = 0; ai < 2; ++ai)
#pragma unroll
                for (int m = 0; m < 4; ++m) { const f32x4 g0 = FIXV(ai, 0, m, 0), g1 = FIXV(ai, 0, m, 1), u0 = FIXV(ai, 1, m, 0), u1 = FIXV(ai, 1, m, 1);
                    u32x4 w; w.x = pk2(siluf_(g0[0]) * u0[0], siluf_(g0[1]) * u0[1]); w.y = pk2(siluf_(g0[2]) * u0[2], siluf_(g0[3]) * u0[3]);
                    w.z = pk2(siluf_(g1[0]) * u1[0], siluf_(g1[1]) * u1[1]); w.w = pk2(siluf_(g1[2]) * u1[2], siluf_(g1[3]) * u1[3]);
                    bf16_t* hp = H + (size_t)(row0 + ai * 128 + m * 16) * DFF + col0;
                    asm volatile("global_store_dwordx4 %0, %1, off sc1\n\ts_nop 1" :: "v"(hp), "v"(w) : "memory"); }
        } else if constexpr (kind == EK_ODD_IN) {
            const bool isg = u.pn < 4; bf16_t* O = isg ? EWS(bf16_t, WS_G) : EWS(bf16_t, WS_U); const int colt = (isg ? u.pn : u.pn - 4) * 256 + wc * 32 + 8 * fq;
            NORM_FIX_SETUP(2 * layer, BIAS_O + (size_t)sub * 5 * 2048, 2048)
#pragma unroll
            for (int ai = 0; ai < 2; ++ai)
#pragma unroll
                for (int m = 0; m < 4; ++m) { bf16_t* rowp = O + (size_t)(row0 + ai * 128 + m * 16) * D + colt;
#pragma unroll
                    for (int bj = 0; bj < 2; ++bj) { f32x4 v0 = FIXV(ai, bj, m, 0), v1 = FIXV(ai, bj, m, 1);
                        if (isg) {
#pragma unroll
                            for (int j = 0; j < 4; ++j) { v0[j] = gelu_tanh(v0[j]); v1[j] = gelu_tanh(v1[j]); } }
                        u32x4 w; w.x = pk2(v0[0], v0[1]); w.y = pk2(v0[2], v0[3]); w.z = pk2(v1[0], v1[1]); w.w = pk2(v1[2], v1[3]);
                        *(u32x4*)(rowp + bj * 128) = w; } }
        } else if constexpr (kind == EK_GATES) {
            const int blk = u.pn >> 2, t = u.pn & 3, dir = t >> 1, half = t & 1;
            const int ch0 = blk * 256 + half * 128 + wc * 32 + 8 * fq;
            const size_t pofs = (size_t)(sub * 2 + dir) * 1024 + ch0;
            bf16_t* AC = dir ? EWS(bf16_t, WS_LAB) : EWS(bf16_t, WS_LAF); bf16_t* HL = dir ? EWS(bf16_t, WS_BB) : EWS(bf16_t, WS_U);
            const bf16_t* uc = EWS(const bf16_t, WS_UC); const float* ba = EIN(I_BGA); const float* bx = EIN(I_BGX); const float* lam = EIN(I_LAM); float* agg = EWS(float, WS_AGG);
            const int lane_ = fq * 16 + fr;
#define DPPF(old, x, ctrl) __builtin_bit_cast(float, __builtin_amdgcn_update_dpp(__builtin_bit_cast(int, (float)(old)), __builtin_bit_cast(int, (float)(x)), (ctrl), 0xf, 0xf, false))
#define SCAN_STEP(ctrl) { const float Ap = DPPF(1.0f, A[q], ctrl), Hp = DPPF(0.0f, H[q], ctrl); H[q] = A[q] * Hp + H[q]; A[q] *= Ap; }
#define GATE_GROUP(m, C1, C2, C4, C8, LASTLANE) { const size_t ro = (size_t)(row0 + ai * 128 + (m) * 16) * D + ch0; \
                const u32x4 ucw = *(const u32x4*)(uc + ro); \
                const float ucv[8] = {bflo(ucw.x), bfhi(ucw.x), bflo(ucw.y), bfhi(ucw.y), bflo(ucw.z), bfhi(ucw.z), bflo(ucw.w), bfhi(ucw.w)}; \
                float A[8], H[8]; \
                _Pragma("unroll") for (int q = 0; q < 8; ++q) { const float r = sigmoidf_(acc[ai][0][m][q >> 2][q & 3] + ba_[q]), ig = sigmoidf_(acc[ai][1][m][q >> 2][q & 3] + bx_[q]); \
                    const float av = fexp2(c8_[q] * r); A[q] = av; H[q] = fsqrt(fmaxf(1.0f - av * av, 0.0f)) * ig * ucv[q]; } \
                _Pragma("unroll") for (int q = 0; q < 8; ++q) { SCAN_STEP(C1) SCAN_STEP(C2) SCAN_STEP(C4) SCAN_STEP(C8) } \
                _Pragma("unroll") for (int q = 0; q < 8; ++q) { H[q] = A[q] * Hc[q] + H[q]; A[q] *= Ac[q]; } \
                *(u32x4*)(AC + ro) = (u32x4){pk2(A[0], A[1]), pk2(A[2], A[3]), pk2(A[4], A[5]), pk2(A[6], A[7])}; \
                *(u32x4*)(HL + ro) = (u32x4){pk2(H[0], H[1]), pk2(H[2], H[3]), pk2(H[4], H[5]), pk2(H[6], H[7])}; \
                _Pragma("unroll") for (int q = 0; q < 8; ++q) { Ac[q] = shfl_idx(A[q], (LASTLANE)); Hc[q] = shfl_idx(H[q], (LASTLANE)); } }
            float ba_[8], bx_[8], c8_[8];
#pragma unroll
            for (int q = 0; q < 8; ++q) { ba_[q] = ba[pofs + q]; bx_[q] = bx[pofs + q]; c8_[q] = -8.0f * LOG2E * flog(1.0f + fexp(-lam[pofs + q])); }
#pragma unroll
            for (int ai = 0; ai < 2; ++ai) {
                float Ac[8], Hc[8];
#pragma unroll
                for (int q = 0; q < 8; ++q) { Ac[q] = 1.0f; Hc[q] = 0.0f; }
                if (dir == 0) { GATE_GROUP(0, 0x111, 0x112, 0x114, 0x118, (lane_ & 48) | 15) GATE_GROUP(1, 0x111, 0x112, 0x114, 0x118, (lane_ & 48) | 15)
                                GATE_GROUP(2, 0x111, 0x112, 0x114, 0x118, (lane_ & 48) | 15) GATE_GROUP(3, 0x111, 0x112, 0x114, 0x118, (lane_ & 48) | 15) }
                else          { GATE_GROUP(3, 0x101, 0x102, 0x104, 0x108, lane_ & 48) GATE_GROUP(2, 0x101, 0x102, 0x104, 0x108, lane_ & 48)
                                GATE_GROUP(1, 0x101, 0x102, 0x104, 0x108, lane_ & 48) GATE_GROUP(0, 0x101, 0x102, 0x104, 0x108, lane_ & 48) }
                if (fr == 0) { float* ag = agg + ((size_t)((u.pm * 4 + ai * 2 + wr) * 2 + dir) * 1024 + ch0) * 2;
#pragma unroll
                    for (int q = 0; q < 8; q += 2) *(f32x4*)(ag + 2 * q) = (f32x4){Ac[q], Hc[q], Ac[q + 1], Hc[q + 1]}; }
            }
#undef GATE_GROUP
#undef SCAN_STEP
#undef DPPF
        } else {
            bf16_t* ZE = EWS(bf16_t, WS_ZE); const int pn = u.pn; const bool lat = u.pm >= 16; float* lr = EWS(float, WS_LR); const float* rope = EWS(const float, WS_ROPE);
            NORM_FIX_SETUP(2 * layer, BIAS_E + (size_t)sub * 5 * 2560, 2560)
            if (pn == 9) {
                if (wc == 0) {
#pragma unroll
                    for (int ai = 0; ai < 2; ++ai)
#pragma unroll
                        for (int m = 0; m < 4; ++m) { float* p = lr + (size_t)(row0 + ai * 128 + m * 16) * 32 + 8 * fq; *(f32x4*)p = FIXV(ai, 0, m, 0); *(f32x4*)(p + 4) = FIXV(ai, 0, m, 1); }
                }
            } else if (pn <= 2) {
                const int half = wc & 1;
#pragma unroll
                for (int ai = 0; ai < 2; ++ai)
#pragma unroll
                    for (int m = 0; m < 4; ++m) { const int row = row0 + ai * 128 + m * 16;
                        const int tpos = (row - MCTX) & 4095; const int pos = half ? (tpos & 63) : (tpos >> 6);
                        f32x4 cs[4];
                        if (lat) {
#pragma unroll
                            for (int q = 0; q < 4; ++q) cs[q] = *(const f32x4*)(rope + (size_t)(pos * 16 + 8 * (fq & 1)) * 2 + q * 4);
                        }
#pragma unroll
                        for (int bj = 0; bj < 2; ++bj) { f32x4 v0 = FIXV(ai, bj, m, 0), v1 = FIXV(ai, bj, m, 1);
                            const bool isv = (pn == 2 && bj == 1), isk = (pn == 2 && bj == 0);
                            if (pn == 2 && !lat) {
                                const int b = row >> 8, tt = row & 255; const int kc = wc * 32 + 8 * fq;
                                float* dst = X + (isv ? OUT_CV : OUT_CK) + ((size_t)(b * 2 + sub) * 256 + tt) * 128 + kc;
                                *(f32x4*)dst = v0; *(f32x4*)(dst + 4) = v1;
                            }
                            if (lat && !isv) {
                                float x[8] = {v0[0], v0[1], v0[2], v0[3], v1[0], v1[1], v1[2], v1[3]}; float o[8];
#pragma unroll
                                for (int q = 0; q < 8; ++q) { const float pr = shfl_x(x[q], fq * 16 + fr, 32); const float c = cs[q >> 1][(q & 1) * 2], s = cs[q >> 1][(q & 1) * 2 + 1];
                                    o[q] = x[q] * c + (fq < 2 ? -pr : pr) * s; }
                                v0 = (f32x4){o[0], o[1], o[2], o[3]}; v1 = (f32x4){o[4], o[5], o[6], o[7]};
                            }
                            if (!isk && !isv) { v0 *= QSCALE; v1 *= QSCALE; }
                            u32x4 w; w.x = pk2(v0[0], v0[1]); w.y = pk2(v0[2], v0[3]); w.z = pk2(v1[0], v1[1]); w.w = pk2(v1[2], v1[3]);
                            *(u32x4*)(ZE + (size_t)row * ZW + pn * 256 + bj * 128 + wc * 32 + 8 * fq) = w; } }
            } else {
                const float sc = (pn == 3) ? 0.125f : 1.0f; const bool act = pn >= 7;
#pragma unroll
                for (int ai = 0; ai < 2; ++ai)
#pragma unroll
                    for (int m = 0; m < 4; ++m) { bf16_t* rowp = ZE + (size_t)(row0 + ai * 128 + m * 16) * ZW + pn * 256 + wc * 32 + 8 * fq;
#pragma unroll
                        for (int bj = 0; bj < 2; ++bj) { f32x4 v0 = FIXV(ai, bj, m, 0) * sc, v1 = FIXV(ai, bj, m, 1) * sc;
                            if (act) {
#pragma unroll
                                for (int j = 0; j < 4; ++j) { v0[j] = siluf_(v0[j]); v1[j] = siluf_(v1[j]); } }
                            u32x4 w; w.x = pk2(v0[0], v0[1]); w.y = pk2(v0[2], v0[3]); w.z = pk2(v1[0], v1[1]); w.w = pk2(v1[2], v1[3]);
                            *(u32x4*)(rowp + bj * 128) = w; } }
            }
        }
    }
#undef EWS
#undef EIN
#undef NORM_FIX_SETUP
#undef FIXV
};

#define XB_TMO      128
#define XB_XCNT(j)  (256  + 64 * (j))
#define XB_XSUB(j)  (1280 + 64 * (j))
#define XB_XGEN(j)  (2304 + 64 * (j))
#define XB_TOP      3328
#define XB_TOPGEN   3392
#define XCD_BAR_WORDS 3456
#define XB_SPIN_CAP (1u << 18)
__device__ __forceinline__ unsigned xb_ld(unsigned* p)              { return __hip_atomic_load(p, __ATOMIC_RELAXED, __HIP_MEMORY_SCOPE_AGENT); }
__device__ __forceinline__ unsigned xb_add(unsigned* p, unsigned v) { return __hip_atomic_fetch_add(p, v, __ATOMIC_RELAXED, __HIP_MEMORY_SCOPE_AGENT); }
__device__ __forceinline__ unsigned xb_xcc_id() { return (unsigned)__builtin_amdgcn_s_getreg((3 << 11) | 20) & 0xFu; }
#define XB_SPIN(cond, bar) do { unsigned _sp = 0; while (cond) { __builtin_amdgcn_s_sleep(1); \
    if ((++_sp & 255u) == 0u) { if (xb_ld(&(bar)[XB_TMO])) break; if (_sp > XB_SPIN_CAP) { atomicAdd(&(bar)[XB_TMO], 1u); break; } } } } while (0)
struct XcdBarrier { unsigned* bar; unsigned x; volatile LAS unsigned* st; };
__device__ __forceinline__ XcdBarrier xcd_barrier_post(unsigned* bar, volatile LAS unsigned* st) {
    XcdBarrier b; b.bar = bar; b.x = xb_xcc_id(); b.st = st;
    if (threadIdx.x == 0) (void)xb_add(&bar[XB_XCNT(b.x)], 1u);
    return b;
}
__device__ __forceinline__ void xcd_barrier_complete(unsigned* bar, unsigned x, unsigned& nloc, unsigned& nx) {
    const unsigned G = gridDim.x * gridDim.y * gridDim.z;
    unsigned sum, cnt, mine, sp = 0u;
    for (;;) {
        sum = 0u; cnt = 0u; mine = 0u;
#pragma unroll
        for (unsigned j = 0; j < 16; ++j) { const unsigned c = xb_ld(&bar[XB_XCNT(j)]); sum += c; cnt += (c > 0u) ? 1u : 0u; mine = (j == x) ? c : mine; }
        if (sum == G) break;
        __builtin_amdgcn_s_sleep(1);
        if ((++sp & 255u) == 0u) { if (xb_ld(&bar[XB_TMO])) break; if (sp > XB_SPIN_CAP) { atomicAdd(&bar[XB_TMO], 1u); break; } }
    }
    nloc = mine > 0u ? mine : 1u; nx = cnt > 0u ? cnt : 1u;
}
__device__ __forceinline__ void xcd_barrier(const XcdBarrier& b, const int tid) {
    asm volatile("s_waitcnt vmcnt(0)" ::: "memory");
    __syncthreads();
    if (tid == 0) {
        unsigned* bar = b.bar;
        __builtin_amdgcn_s_waitcnt(0);
        unsigned nloc = b.st[0], nx = b.st[1];
        if (nloc == 0u) { xcd_barrier_complete(bar, b.x, nloc, nx); b.st[0] = nloc; b.st[1] = nx; }
        const unsigned old = xb_add(&bar[XB_XSUB(b.x)], 1u);
        const unsigned gen = old / nloc;
        if (old + 1u == (gen + 1u) * nloc) {
            __builtin_amdgcn_fence(__ATOMIC_RELEASE, "agent");
            asm volatile("s_waitcnt vmcnt(0)" ::: "memory");
            const unsigned og = xb_add(&bar[XB_TOP], 1u);
            const unsigned tg = og / nx;
            if (og + 1u == (tg + 1u) * nx) xb_add(&bar[XB_TOPGEN], 1u);
            else XB_SPIN(xb_ld(&bar[XB_TOPGEN]) == tg, bar);
            __builtin_amdgcn_fence(__ATOMIC_ACQUIRE, "agent");
            xb_add(&bar[XB_XGEN(b.x)], 1u);
            asm volatile("s_waitcnt vmcnt(0)" ::: "memory");
        } else {
            XB_SPIN(xb_ld(&bar[XB_XGEN(b.x)]) == gen, bar);
            __builtin_amdgcn_fence(__ATOMIC_ACQUIRE, "agent");
            asm volatile("s_waitcnt vmcnt(0)" ::: "memory");
        }
    }
    __syncthreads();
}

struct Frame {
    lptr lds; int tid, lane, wave, vcu, G;
    const Params* p; float* out; int oz, bid;
};
#define FIN(i) (F.p->in[(i) + F.oz])
#define WSP(T, off) ((T*)(F.p->ws + ((size_t)(off) + (size_t)F.oz)))

__device__ __forceinline__ void transpose_block(const float* src, int ldw, bf16_t* dst, int ldt, LAS float* scr, int lane) {
#pragma unroll
    for (int hb = 0; hb < 2; ++hb) { float tv[16];
#pragma unroll
        for (int i = 0; i < 16; ++i) { const int kk = 2 * (16 * hb + i) + (lane >> 5); tv[i] = src[(size_t)kk * ldw + (lane & 31)]; }
#pragma unroll
        for (int i = 0; i < 16; ++i) { const int kk = 2 * (16 * hb + i) + (lane >> 5); scr[kk * 33 + (lane & 31)] = tv[i]; } }
    LDS_WAIT(); asm volatile("" ::: "memory");
    const int c = lane & 7;
#pragma unroll
    for (int j = 0; j < 4; ++j) { const int n = (lane >> 3) + 8 * j; const LAS float* s = scr + (8 * c) * 33 + n;
        u32x4 o; o.x = pk2(s[0 * 33], s[1 * 33]); o.y = pk2(s[2 * 33], s[3 * 33]); o.z = pk2(s[4 * 33], s[5 * 33]); o.w = pk2(s[6 * 33], s[7 * 33]);
        *(u32x4*)(dst + (size_t)n * ldt + 8 * c) = o; }
    LDS_WAIT(); asm volatile("" ::: "memory");
}
constexpr int IT_WINE = 16 * 73, IT_SQ = 512, IT_WINO = 1024, IT_GATES = 512, IT_F1 = 16 * 176, IT_F2 = 44 * 32;
constexpr int IT_E = IT_WINE + IT_SQ, IT_O = IT_WINO + IT_GATES + IT_SQ, IT_L = IT_F1 + IT_F2;
constexpr int IT_TOTAL = 2 * IT_E + 2 * IT_O + 4 * IT_L;

__device__ __forceinline__ void convert_item(Frame& F, int it, LAS float* scr) {
    const float* src; int ldw; bf16_t* dst; int ldt;
    if (it < 2 * IT_E) {
        const int e = it / IT_E; int r = it % IT_E;
        if (r < IT_WINE) { const int kb = r / 73, nb = r % 73;
            src = FIN(I_WINE) + (size_t)e * D * PE + (size_t)(64 * kb) * PE + 32 * nb; ldw = PE; dst = WSP(bf16_t, WS_WINE) + (size_t)e * PEP * D + (size_t)(32 * nb) * D + 64 * kb; ldt = D;
        } else { r -= IT_WINE; const int kb = r / 32, nb = r % 32;
            src = FIN(I_WOUTE) + (size_t)e * D * D + (size_t)(64 * kb) * D + 32 * nb; ldw = D; dst = WSP(bf16_t, WS_WOUTE) + (size_t)e * D * D + (size_t)(32 * nb) * D + 64 * kb; ldt = D; }
    } else if (it < 2 * IT_E + 2 * IT_O) {
        const int i2 = it - 2 * IT_E; const int o = i2 / IT_O; int r = i2 % IT_O;
        if (r < IT_WINO) { const int kb = r / 64, nb = r % 64;
            src = FIN(I_WINO) + (size_t)o * D * 2048 + (size_t)(64 * kb) * 2048 + 32 * nb; ldw = 2048; dst = WSP(bf16_t, WS_WINO) + (size_t)o * 2048 * D + (size_t)(32 * nb) * D + 64 * kb; ldt = D;
        } else if (r < IT_WINO + IT_GATES) { r -= IT_WINO;
            const int mat = r >> 5, q = r & 31, kb = q >> 3, nb = q & 7; const int isx = mat >> 3, dir = (mat >> 2) & 1, blk = mat & 3;
            src = FIN(isx ? I_WGX : I_WGA) + ((size_t)((o * 2 + dir) * 4 + blk)) * 65536 + (size_t)(64 * kb) * 256 + 32 * nb; ldw = 256;
            const int d0 = 32 * nb, half = d0 >> 7; const int drow = blk * 1024 + (dir * 2 + half) * 256 + isx * 128 + (d0 & 127);
            dst = WSP(bf16_t, WS_WG) + (size_t)o * 4096 * 256 + (size_t)drow * 256 + 64 * kb; ldt = 256;
        } else { r -= IT_WINO + IT_GATES; const int kb = r / 32, nb = r % 32;
            src = FIN(I_WOUTO) + (size_t)o * D * D + (size_t)(64 * kb) * D + 32 * nb; ldw = D; dst = WSP(bf16_t, WS_WOUTO) + (size_t)o * D * D + (size_t)(32 * nb) * D + 64 * kb; ldt = D; }
    } else {
        const int i3 = it - 2 * IT_E - 2 * IT_O; const int l = i3 / IT_L; int r = i3 % IT_L;
        if (r < IT_F1) { const int kb = r / 176, nb = r % 176; const int n0 = 32 * nb; const int isu = n0 >= DFF; const int c = n0 - isu * DFF; const int drow = (c >> 7) * 256 + isu * 128 + (c & 127);
            src = FIN(I_WF1) + (size_t)l * D * 5632 + (size_t)(64 * kb) * 5632 + n0; ldw = 5632; dst = WSP(bf16_t, WS_WF1) + (size_t)l * 5632 * D + (size_t)drow * D + 64 * kb; ldt = D;
        } else { r -= IT_F1; const int kb = r / 32, nb = r % 32;
            src = FIN(I_WF2) + (size_t)l * DFF * D + (size_t)(64 * kb) * D + 32 * nb; ldw = D; dst = WSP(bf16_t, WS_WF2) + (size_t)l * D * DFF + (size_t)(32 * nb) * DFF + 64 * kb; ldt = DFF; }
    }
    transpose_block(src, ldw, dst, ldt, scr, F.lane);
}

__device__ __forceinline__ void phase_prologue(Frame& F) {
    const int tid = F.tid, lane = F.lane, wave = F.wave;
    const int gt = F.vcu * NTHREADS + tid, NGT = F.G * NTHREADS;
    {
        LAS float* sil = (LAS float*)F.lds;
        LAS float* red = (LAS float*)(F.lds + 20480);
        for (int i = tid; i < 5 * 1024; i += NTHREADS) { const int ci = i >> 10, k = i & 1023; const float v = ci == 0 ? FIN(I_CCTX)[k] : FIN(I_C)[(ci - 1) * 1024 + k]; sil[i] = siluf_(v); }
        __syncthreads();
        for (int item = F.vcu; item < 4 * 48; item += F.G) {
            const int l = item / 48, n0 = (item % 48) * 128;
            const float* wp = FIN(I_WADA) + ((size_t)l * 1024 + wave * 128) * 6144 + n0 + 2 * lane;
            float a0[5] = {0.f, 0.f, 0.f, 0.f, 0.f}, a1[5] = {0.f, 0.f, 0.f, 0.f, 0.f};
#pragma unroll 8
            for (int kk = 0; kk < 128; ++kk) { const f32x2 w = *(const f32x2*)(wp + (size_t)kk * 6144);
#pragma unroll
                for (int ci = 0; ci < 5; ++ci) { const float s = sil[ci * 1024 + wave * 128 + kk]; a0[ci] += s * w.x; a1[ci] += s * w.y; } }
#pragma unroll
            for (int ci = 0; ci < 5; ++ci) { red[(wave * 5 + ci) * 128 + 2 * lane] = a0[ci]; red[(wave * 5 + ci) * 128 + 2 * lane + 1] = a1[ci]; }
            __syncthreads();
            for (int i = tid; i < 640; i += NTHREADS) { const int ci = i >> 7, n = i & 127; float s = FIN(I_BADA)[l * 6144 + n0 + n];
#pragma unroll
                for (int w = 0; w < 8; ++w) s += red[(w * 5 + ci) * 128 + n];
                WSP(float, WS_MOD)[(size_t)(l * 5 + ci) * 6144 + n0 + n] = s; }
            __syncthreads();
        }
    }
    for (int i = gt; i < 1024; i += NGT) { const int pos = i >> 4, fi = i & 15; const float inv = fexp2(-(float)fi * (13.287712379549449f / 16.0f)); const float a = (float)pos * inv;
        WSP(float, WS_ROPE)[2 * i] = __cosf(a); WSP(float, WS_ROPE)[2 * i + 1] = __sinf(a); }
    for (int i = gt; i < 4 * 2 * 256 * 128 / 4; i += NGT) { const f32x4 k = ((const f32x4*)FIN(I_CK))[i], v = ((const f32x4*)FIN(I_CV))[i];
        u32x2 a; a.x = pk2(k[0], k[1]); a.y = pk2(k[2], k[3]); ((u32x2*)WSP(bf16_t, WS_CK))[i] = a; a.x = pk2(v[0], v[1]); a.y = pk2(v[2], v[3]); ((u32x2*)WSP(bf16_t, WS_CV))[i] = a; }
    for (int i = gt; i < 2 * (PEP - PE) * D / 8; i += NGT) { const int e = i / ((PEP - PE) * D / 8), r = i % ((PEP - PE) * D / 8);
        ((u32x4*)(WSP(bf16_t, WS_WINE) + (size_t)e * PEP * D + (size_t)PE * D))[r] = (u32x4){0u, 0u, 0u, 0u}; }
    {
        LAS float* scr = (LAS float*)(F.lds + 40960 + wave * 8704);
        const int gw = F.vcu * NWAVES + wave, NGW = F.G * NWAVES;
        for (int it = gw; it < IT_TOTAL; it += NGW) convert_item(F, it, scr);
    }
}

__device__ __forceinline__ void phase_pre(Frame& F) {
    const int lane = F.lane; const int gw = F.vcu * NWAVES + F.wave, NGW = F.G * NWAVES;
    const float* mod = WSP(float, WS_MOD); float* bias = WSP(float, WS_BIAS);
    for (int mi = 0; mi < 8; ++mi) {
        const int l = mi < 2 ? 2 * mi : mi < 4 ? 2 * (mi - 2) + 1 : mi - 4; const int shj = mi < 4 ? 0 : 3;
        const int N = mi < 2 ? 2560 : mi < 4 ? 2048 : 5632;
        const bf16_t* W = mi < 2 ? WSP(bf16_t, WS_WINE) + (size_t)mi * PEP * D : mi < 4 ? WSP(bf16_t, WS_WINO) + (size_t)(mi - 2) * 2048 * D : WSP(bf16_t, WS_WF1) + (size_t)(mi - 4) * 5632 * D;
        float* bo = bias + (mi < 2 ? BIAS_E + (size_t)mi * 5 * 2560 : mi < 4 ? BIAS_O + (size_t)(mi - 2) * 5 * 2048 : BIAS_F + (size_t)(mi - 4) * 5 * 5632);
        f32x4 sh[5][4];
#pragma unroll
        for (int ci = 0; ci < 5; ++ci)
#pragma unroll
            for (int q = 0; q < 4; ++q) sh[ci][q] = *(const f32x4*)(mod + ((size_t)(l * 5 + ci) * 6 + shj) * 1024 + 16 * lane + 4 * q);
        for (int n = gw; n < N; n += NGW) {
            const u32x4 w0 = *(const u32x4*)(W + (size_t)n * D + 16 * lane), w1 = *(const u32x4*)(W + (size_t)n * D + 16 * lane + 8);
            const float wf[16] = {bflo(w0.x), bfhi(w0.x), bflo(w0.y), bfhi(w0.y), bflo(w0.z), bfhi(w0.z), bflo(w0.w), bfhi(w0.w), bflo(w1.x), bfhi(w1.x), bflo(w1.y), bfhi(w1.y), bflo(w1.z), bfhi(w1.z), bflo(w1.w), bfhi(w1.w)};
            float r[5];
#pragma unroll
            for (int ci = 0; ci < 5; ++ci) { float a = 0.f;
#pragma unroll
                for (int q = 0; q < 16; ++q) a += sh[ci][q >> 2][q & 3] * wf[q];
                r[ci] = wave_sum(a, lane); }
            if (lane < 5) bo[(size_t)lane * N + n] = lane == 0 ? r[0] : lane == 1 ? r[1] : lane == 2 ? r[2] : lane == 3 ? r[3] : r[4];
        }
    }
    {
        const float* gvec = FIN(I_NMIX); bf16_t* XN = WSP(bf16_t, WS_XN); float* ssq = F.out + SSQP_OFF; bf16_t* Xb = (bf16_t*)F.out;
        f32x4 gg[4]; int cur_ci = -1;
        for (int r = 0; r < 10; ++r) {
            const int row = gw * 10 + r; const int ci = cond_of_row(row);
            if (ci != cur_ci) { cur_ci = ci;
#pragma unroll
                for (int j = 0; j < 4; ++j) { const int col = 4 * lane + 256 * j; gg[j] = *(const f32x4*)(gvec + col) * (1.0f + *(const f32x4*)(mod + ((size_t)ci * 6 + 1) * 1024 + col)); } }
            const float* xin = row < MCTX ? FIN(I_XP) + (size_t)row * D : FIN(I_XS) + (size_t)(row - MCTX) * D;
            f32x4 v[4]; float s = 0.f;
#pragma unroll
            for (int j = 0; j < 4; ++j) { v[j] = *(const f32x4*)(xin + 4 * lane + 256 * j); s += (v[j].x * v[j].x + v[j].y * v[j].y) + (v[j].z * v[j].z + v[j].w * v[j].w); }
            s = wave_sum(s, lane);
            if (lane < 16) ssq[(size_t)row * 16 + lane] = lane == 0 ? s : 0.f;
#pragma unroll
            for (int j = 0; j < 4; ++j) { const f32x4 y = v[j] * gg[j]; *(u32x2*)(XN + (size_t)row * D + 4 * lane + 256 * j) = (u32x2){pk2(y[0], y[1]), pk2(y[2], y[3])};
                *(u32x2*)(Xb + (size_t)row * D + 4 * lane + 256 * j) = (u32x2){pk2(v[j][0], v[j][1]), pk2(v[j][2], v[j][3])}; }
        }
    }
}
__device__ __forceinline__ void phase_final(Frame& F) {
    const int lane = F.lane; const int gw = F.vcu * NWAVES + F.wave;
    const float* gvec = FIN(I_NFIN); const float* ssq = WSP(float, WS_SSQ8); const bf16_t* XF = WSP(bf16_t, WS_XF);
    f32x4 gg[4];
#pragma unroll
    for (int j = 0; j < 4; ++j) gg[j] = *(const f32x4*)(gvec + 4 * lane + 256 * j);
    float rs[10];
#pragma unroll
    for (int r = 0; r < 10; ++r) { const int row = gw * 10 + r; const f32x4* q_ = (const f32x4*)(ssq + (size_t)row * 16); const f32x4 a_ = q_[0], b_ = q_[1], c_ = q_[2], d_ = q_[3];
        rs[r] = frsq(((((a_[0] + a_[1]) + (a_[2] + a_[3])) + ((b_[0] + b_[1]) + (b_[2] + b_[3]))) + (((c_[0] + c_[1]) + (c_[2] + c_[3])) + ((d_[0] + d_[1]) + (d_[2] + d_[3])))) * (1.0f / D) + EPS); }
#pragma unroll
    for (int r = 0; r < 10; ++r) { const int row = gw * 10 + r; float* yr = F.out + (size_t)row * D; const bf16_t* xr = XF + (size_t)row * D;
#pragma unroll
        for (int j = 0; j < 4; ++j) { const u32x2 w = *(const u32x2*)(xr + 4 * lane + 256 * j); const f32x4 x = {bflo(w.x), bfhi(w.x), bflo(w.y), bfhi(w.y)}; *(f32x4*)(yr + 4 * lane + 256 * j) = x * rs[r] * gg[j]; } }
}

__device__ __forceinline__ void attn_unit(Frame& F, int e, int kind, int b, int kvh, int qb, int hp) {
    const int lane = F.lane, w = F.wave, r32 = lane & 31, hh = lane >> 5;
    const bf16_t* ZE = WSP(bf16_t, WS_ZE);
    const int head = kvh * 4 + hp * 2 + (w >> 2);
    const int seqbase = kind == 0 ? MCTX + b * TLAT : b * TCTX;
    const int qloc = qb * 128 + (w & 3) * 32 + r32;
    const int iloc = (w & 3) * 32 + r32;
    bf16x8 qr[4];
#pragma unroll
    for (int d0 = 0; d0 < 4; ++d0) qr[d0] = *(const bf16x8*)(ZE + (size_t)(seqbase + qloc) * ZW + head * 64 + d0 * 16 + hh * 8);
    const int wt0 = (kind == 0 && qb == 0) ? 2 : 0, wt1 = (kind == 0) ? ((qb == 31) ? 4 : 6) : 0;
    const int NT = 4 + (wt1 - wt0);
    float m_run = FIN(I_SINK)[e * 8 + head] * LOG2E; float l_run = hh == 0 ? 1.0f : 0.0f;
    f32x16 o0 = {}, o1 = {};
    const int kkey = lane, kchunk = w;
    const int vkey = 16 * (w & 3) + (lane >> 2), vdh = w >> 2, vpiece = lane & 3;
    const unsigned kdstw = (unsigned)(kchunk * 1024), vdstw = (unsigned)(24576 + vdh * 4096 + (w & 3) * 1024);
    int mtype = 0, joff = 0;
    auto tile_ptrs = [&](int t, const bf16_t*& kp, const bf16_t*& vp, int& pitch, int& mt, int& jo) {
        if (kind == 0 && t < 4) { const size_t base = ((size_t)(b * 2 + e) * 256 + 64 * t) * 128 + kvh * 64; kp = WSP(bf16_t, WS_CK) + base; vp = WSP(bf16_t, WS_CV) + base; pitch = 128; mt = 0; jo = 0; }
        else if (kind == 0) { const int wt = t - 4 + wt0; const int blk = qb - 1 + (wt >> 1); const size_t row = (size_t)seqbase + blk * 128 + (wt & 1) * 64;
            kp = ZE + row * ZW + 512 + kvh * 64; vp = ZE + row * ZW + 640 + kvh * 64; pitch = ZW; mt = (blk < qb) ? 1 : (blk > qb) ? 2 : 0; jo = (wt & 1) * 64; }
        else { const size_t row = (size_t)seqbase + 64 * t; kp = ZE + row * ZW + 512 + kvh * 64; vp = ZE + row * ZW + 640 + kvh * 64; pitch = ZW; mt = 0; jo = 0; }
    };
#define ATT_ISSUE(t, slot) do { const bf16_t *kp_, *vp_; int pitch_, mt_, jo_; tile_ptrs((t), kp_, vp_, pitch_, mt_, jo_); \
        __builtin_amdgcn_global_load_lds((const unsigned*)(kp_ + (size_t)kkey * pitch_ + kchunk * 8), (LAS unsigned*)(F.lds + (slot) * 8192 + kdstw), 16, 0, 0); \
        __builtin_amdgcn_global_load_lds((const unsigned*)(vp_ + (size_t)vkey * pitch_ + vdh * 32 + vpiece * 8), (LAS unsigned*)(F.lds + (slot) * 8192 + vdstw), 16, 0, 0); } while (0)
    ATT_ISSUE(0, 0); if (NT > 1) ATT_ISSUE(1, 1);
    int slot = 0;
    for (int t = 0; t < NT; ++t) {
        if (t + 1 < NT) asm volatile("s_waitcnt vmcnt(2)" ::: "memory"); else asm volatile("s_waitcnt vmcnt(0)" ::: "memory");
        asm volatile("s_waitcnt lgkmcnt(0)" ::: "memory"); __builtin_amdgcn_s_barrier(); asm volatile("" ::: "memory");
        if (t + 2 < NT) { const int s2 = slot >= 1 ? slot - 1 : 2; ATT_ISSUE(t + 2, s2); }
        { const bf16_t *kp_, *vp_; int pitch_; tile_ptrs(t, kp_, vp_, pitch_, mtype, joff); }
        const int buf = slot;
        const lptr kb = F.lds + buf * 8192 + hh * 1024 + r32 * 16;
        f32x16 p0 = {}, p1 = {};
#pragma unroll
        for (int d0 = 0; d0 < 4; ++d0) { const bf16x8 k0 = *(const LAS bf16x8*)(kb + d0 * 2048), k1 = *(const LAS bf16x8*)(kb + d0 * 2048 + 512);
            p0 = __builtin_amdgcn_mfma_f32_32x32x16_bf16(k0, qr[d0], p0, 0, 0, 0); p1 = __builtin_amdgcn_mfma_f32_32x32x16_bf16(k1, qr[d0], p1, 0, 0, 0); }
        if (mtype != 0) {
#pragma unroll
            for (int r = 0; r < 16; ++r) { const int j0 = joff + crow(r, hh), j1 = j0 + 32;
                const bool bad0 = (mtype == 1) ? (j0 < iloc) : (j0 > iloc), bad1 = (mtype == 1) ? (j1 < iloc) : (j1 > iloc);
                if (bad0) p0[r] = -1e30f; if (bad1) p1[r] = -1e30f; }
        }
        float mx = fmaxf(p0[0], p1[0]);
#pragma unroll
        for (int r = 1; r < 16; ++r) mx = fmaxf(mx, fmaxf(p0[r], p1[r]));
        mx = fmaxf(mx, shfl_x(mx, lane, 32));
        const float m_new = fmaxf(m_run, mx); const float alpha = fexp2(m_run - m_new); m_run = m_new;
        float ps = 0.f;
#pragma unroll
        for (int r = 0; r < 16; ++r) { p0[r] = fexp2(p0[r] - m_new); p1[r] = fexp2(p1[r] - m_new); ps += p0[r] + p1[r]; }
        l_run = l_run * alpha + ps;
#pragma unroll
        for (int r = 0; r < 16; ++r) { o0[r] *= alpha; o1[r] *= alpha; }
        u32x4 pw[4];
#pragma unroll
        for (int s = 0; s < 2; ++s) { pw[s] = (u32x4){pk2(p0[8 * s], p0[8 * s + 1]), pk2(p0[8 * s + 2], p0[8 * s + 3]), pk2(p0[8 * s + 4], p0[8 * s + 5]), pk2(p0[8 * s + 6], p0[8 * s + 7])};
            pw[2 + s] = (u32x4){pk2(p1[8 * s], p1[8 * s + 1]), pk2(p1[8 * s + 2], p1[8 * s + 3]), pk2(p1[8 * s + 4], p1[8 * s + 5]), pk2(p1[8 * s + 6], p1[8 * s + 7])}; }
        const lptr vb = F.lds + 24576 + buf * 8192 + ((lane >> 4) & 1) * 32 + (lane & 3) * 8 + (4 * hh + ((lane & 15) >> 2)) * 64;
#pragma unroll
        for (int s = 0; s < 4; ++s) { const bf16x8 v0 = tr_frag(vb + s * 1024), v1 = tr_frag(vb + 4096 + s * 1024);
            o0 = __builtin_amdgcn_mfma_f32_32x32x16_bf16(v0, __builtin_bit_cast(bf16x8, pw[s]), o0, 0, 0, 0);
            o1 = __builtin_amdgcn_mfma_f32_32x32x16_bf16(v1, __builtin_bit_cast(bf16x8, pw[s]), o1, 0, 0, 0); }
        slot = slot == 2 ? 0 : slot + 1;
    }
#undef ATT_ISSUE
    asm volatile("s_waitcnt lgkmcnt(0)" ::: "memory"); __builtin_amdgcn_s_barrier(); asm volatile("" ::: "memory");
    const float lt = l_run + shfl_x(l_run, lane, 32); const float inv = frcp(lt);
    bf16_t* orow = WSP(bf16_t, WS_MIX) + (size_t)(seqbase + qloc) * D + head * 64;
#pragma unroll
    for (int g = 0; g < 4; ++g) { u32x2 a; a.x = pk2(o0[4 * g] * inv, o0[4 * g + 1] * inv); a.y = pk2(o0[4 * g + 2] * inv, o0[4 * g + 3] * inv); *(u32x2*)(orow + 8 * g + 4 * hh) = a;
        a.x = pk2(o1[4 * g] * inv, o1[4 * g + 1] * inv); a.y = pk2(o1[4 * g + 2] * inv, o1[4 * g + 3] * inv); *(u32x2*)(orow + 32 + 8 * g + 4 * hh) = a; }
}

constexpr int GL_LA = 0;
constexpr int GL_LR = 32768;
constexpr int GL_WA = 40960;
constexpr int GL_BA = 49152;
constexpr int GL_BL = 49664;
constexpr int GL_A = 51200;
constexpr int GL_B = 67584;
constexpr int GL_C = 83968;
__device__ __forceinline__ int timg(int r, int c, int R) { return (c >> 5) * (R * 64) + (r >> 3) * 512 + (r & 7) * 64 + (c & 31) * 2; }

struct GlaPre { f32x4 lr, wa; float ba; u32x4 gk, gq, v0, v1; };
__device__ __forceinline__ GlaPre gla_load(Frame& F, int e, int gc, int hd, bool with_q) {
    const int tid = F.tid; const int R0 = gc * 64; GlaPre p; const bf16_t* ZE = WSP(bf16_t, WS_ZE);
    { const int row = tid >> 3, c4 = tid & 7; p.lr = *(const f32x4*)(WSP(float, WS_LR) + (size_t)(R0 + row) * 32 + 4 * c4);
      const int z = tid >> 8, r = (tid >> 4) & 15, k4 = tid & 15; p.wa = *(const f32x4*)(FIN(I_WALPHA) + ((size_t)(e * 2 + z) * 16 + r) * 256 + hd * 64 + 4 * k4);
      p.ba = FIN(I_BALPHA)[(e * 2 + ((tid >> 6) & 1)) * 256 + hd * 64 + (tid & 63)]; }
    { const int t = tid >> 3, k8 = (tid & 7) * 8; p.gk = *(const u32x4*)(ZE + (size_t)(R0 + t) * ZW + 1024 + hd * 64 + k8);
      p.gq = with_q ? *(const u32x4*)(ZE + (size_t)(R0 + t) * ZW + 768 + hd * 64 + k8) : p.gk; }
    { const int p0 = tid, p1 = tid + 512; p.v0 = *(const u32x4*)(ZE + (size_t)(R0 + (p0 >> 4)) * ZW + 1280 + hd * 128 + (p0 & 15) * 8); p.v1 = *(const u32x4*)(ZE + (size_t)(R0 + (p1 >> 4)) * ZW + 1280 + hd * 128 + (p1 & 15) * 8); }
    return p;
}
__device__ __forceinline__ void gla_bcum(Frame& F, const GlaPre& p) {
    const int tid = F.tid;
    LAS float* LA = (LAS float*)(F.lds + GL_LA); LAS float* LRs = (LAS float*)(F.lds + GL_LR); LAS float* WA = (LAS float*)(F.lds + GL_WA);
    LAS float* BA = (LAS float*)(F.lds + GL_BA); LAS float* BL = (LAS float*)(F.lds + GL_BL);
    { const int row = tid >> 3, c4 = tid & 7; *(LAS f32x4*)(LRs + row * 32 + 4 * c4) = p.lr;
      const int z = tid >> 8, r = (tid >> 4) & 15, k4 = tid & 15; *(LAS f32x4*)(WA + (z * 16 + r) * 64 + 4 * k4) = p.wa;
      if (tid < 128) BA[tid] = p.ba; }
    __syncthreads();
    { const int lane = F.lane, w = F.wave; const int z = w >> 2, kl = lane & 15, seg = lane >> 4, k = (w & 3) * 16 + kl, t0 = seg * 16;
      float wa[16];
#pragma unroll
      for (int r = 0; r < 16; ++r) wa[r] = WA[(z * 16 + r) * 64 + k];
      const float bz = BA[z * 64 + k];
      float la[16];
#pragma unroll
      for (int tt = 0; tt < 16; ++tt) { float x = bz;
#pragma unroll
          for (int r4 = 0; r4 < 4; ++r4) { const f32x4 l4 = *(const LAS f32x4*)(LRs + (t0 + tt) * 32 + z * 16 + 4 * r4); x += (l4[0] * wa[4 * r4] + l4[1] * wa[4 * r4 + 1]) + (l4[2] * wa[4 * r4 + 2] + l4[3] * wa[4 * r4 + 3]); }
          la[tt] = (fminf(x, 0.f) - flog(1.0f + fexp(-fabsf(x)))) * (1.0f / 16.0f); }
      float run = 0.f;
      if (z == 0) {
#pragma unroll
          for (int tt = 0; tt < 16; ++tt) { run += la[tt]; la[tt] = run; }
      } else {
#pragma unroll
          for (int tt = 15; tt >= 0; --tt) { run += la[tt]; la[tt] = run; }
      }
      const float s0 = shfl_idx(run, kl), s1 = shfl_idx(run, kl + 16), s2 = shfl_idx(run, kl + 32), s3 = shfl_idx(run, kl + 48);
      float add;
      if (z == 0) add = (seg > 0 ? s0 : 0.f) + (seg > 1 ? s1 : 0.f) + (seg > 2 ? s2 : 0.f);
      else        add = (seg < 3 ? s3 : 0.f) + (seg < 2 ? s2 : 0.f) + (seg < 1 ? s1 : 0.f);
#pragma unroll
      for (int tt = 0; tt < 16; ++tt) LA[(z * 64 + t0 + tt) * 64 + k] = la[tt] + add;
      if (seg == 0) BL[z * 64 + k] = (s0 + s1) + (s2 + s3); }
    __syncthreads();
}
__device__ __forceinline__ void gla_stage_v(Frame& F, const GlaPre& p, int off) {
    { const int q = F.tid, t = q >> 4, v8 = (q & 15) * 8; *(LAS u32x4*)(F.lds + off + timg(t, v8, 64)) = p.v0; }
    { const int q = F.tid + 512, t = q >> 4, v8 = (q & 15) * 8; *(LAS u32x4*)(F.lds + off + timg(t, v8, 64)) = p.v1; }
}
__device__ __forceinline__ void gla_g1_item(Frame& F, int e, int gc, int hd, const GlaPre& pre) {
    const int tid = F.tid, lane = F.lane, w = F.wave;
    gla_stage_v(F, pre, GL_B);
    gla_bcum(F, pre);
    LAS float* LA = (LAS float*)(F.lds + GL_LA); LAS float* BL = (LAS float*)(F.lds + GL_BL);
    { const int t = tid >> 3, k8 = (tid & 7) * 8; const u32x4 gk = pre.gk;
      const float kf[8] = {bflo(gk.x), bfhi(gk.x), bflo(gk.y), bfhi(gk.y), bflo(gk.z), bfhi(gk.z), bflo(gk.w), bfhi(gk.w)};
#pragma unroll
      for (int z = 0; z < 2; ++z) { float ks[8];
#pragma unroll
        for (int j = 0; j < 8; ++j) ks[j] = kf[j] * fexp(BL[z * 64 + k8 + j] - LA[(z * 64 + t) * 64 + k8 + j]);
        *(LAS u32x4*)(F.lds + GL_A + z * 8192 + timg(t, k8, 64)) = (u32x4){pk2(ks[0], ks[1]), pk2(ks[2], ks[3]), pk2(ks[4], ks[5]), pk2(ks[6], ks[7])}; } }
    __syncthreads();
    { const int vb = w & 3, z = w >> 2; const int hh = lane >> 5, q = (lane & 15) >> 2;
      const int lofs = q * 64 + (((lane >> 4) & 1) * 16 + (lane & 3) * 4) * 2;
      f32x16 a0 = {}, a1 = {};
#pragma unroll
      for (int s = 0; s < 4; ++s) { const int rofs = (2 * s + hh) * 512;
        const lptr vp = F.lds + GL_B + vb * 4096 + rofs + lofs; const s16x4 va = tr_read(vp), vb2 = tr_read(vp + 256);
        const bf16x8 vf = (bf16x8){va[0], va[1], va[2], va[3], vb2[0], vb2[1], vb2[2], vb2[3]};
        const lptr kp = F.lds + GL_A + z * 8192 + rofs + lofs; const s16x4 ka = tr_read(kp), kb2 = tr_read(kp + 256), kc = tr_read(kp + 4096), kd = tr_read(kp + 4096 + 256);
        const bf16x8 kf0 = (bf16x8){ka[0], ka[1], ka[2], ka[3], kb2[0], kb2[1], kb2[2], kb2[3]}, kf1 = (bf16x8){kc[0], kc[1], kc[2], kc[3], kd[0], kd[1], kd[2], kd[3]};
        a0 = __builtin_amdgcn_mfma_f32_32x32x16_bf16(vf, kf0, a0, 0, 0, 0); a1 = __builtin_amdgcn_mfma_f32_32x32x16_bf16(vf, kf1, a1, 0, 0, 0); }
      float* kv = WSP(float, WS_KV) + ((size_t)(gc * 4 + hd) * 2 + z) * 8192;
#pragma unroll
      for (int r = 0; r < 16; ++r) { const int v = 32 * vb + crow(r, hh); kv[v * 64 + (lane & 31)] = a0[r]; kv[v * 64 + 32 + (lane & 31)] = a1[r]; } }
    if (tid < 128) WSP(float, WS_DL)[((size_t)(gc * 4 + hd) * 2 + (tid >> 6)) * 64 + (tid & 63)] = fexp(BL[tid]);
    __syncthreads();
}
__device__ __forceinline__ void phase_g2(Frame& F, int e) {
    const int tid = F.tid; float* KV = WSP(float, WS_KV); const float* DL = WSP(float, WS_DL);
    {
        const int v = F.vcu; const int chain = v >> 3, slice = v & 7; const int b = chain >> 3, hd = (chain >> 1) & 3, z = chain & 1;
        const int off = slice * 1024 + tid * 2, k = off & 63, vv = off >> 6;
        const float* s0 = FIN(I_SGLA) + ((size_t)((b * 2 + e) * 2 + z) * 4 + hd) * 8192;
        f32x2 S = (f32x2){s0[(size_t)k * 128 + vv], s0[(size_t)(k + 1) * 128 + vv]};
        f32x2 kvA[8], dlA[8], kvB[8], dlB[8];
#define G2_LOAD(KVR, DLR, C8) _Pragma("unroll") for (int i = 0; i < 8; ++i) { const int c = z ? 63 - ((C8) + i) : (C8) + i; const size_t it = (size_t)((64 + b * 64 + c) * 4 + hd) * 2 + z; \
                KVR[i] = *(const f32x2*)(KV + it * 8192 + off); DLR[i] = *(const f32x2*)(DL + it * 64 + k); }
#define G2_FOLD(KVR, DLR, C8) _Pragma("unroll") for (int i = 0; i < 8; ++i) { const int c = z ? 63 - ((C8) + i) : (C8) + i; const size_t it = (size_t)((64 + b * 64 + c) * 4 + hd) * 2 + z; \
                *(f32x2*)(KV + it * 8192 + off) = S; S = DLR[i] * S + KVR[i]; }
        G2_LOAD(kvA, dlA, 0)
        for (int c8 = 0; c8 < 64; c8 += 16) {
            G2_LOAD(kvB, dlB, c8 + 8)
            G2_FOLD(kvA, dlA, c8)
            if (c8 + 16 < 64) { G2_LOAD(kvA, dlA, c8 + 16) }
            G2_FOLD(kvB, dlB, c8 + 8)
        }
#undef G2_LOAD
#undef G2_FOLD
    }
    for (int item = F.vcu; item < 512; item += F.G) {
        const int chain = item >> 2, slice = item & 3; const int b = chain >> 3, hd = (chain >> 1) & 3, z = chain & 1;
        const int off = slice * 2048 + tid * 4, k = off & 63, vv = off >> 6;
        const float zf = (float)F.oz; f32x4 S = {zf, zf, zf, zf};
        f32x4 kv4[4], dl4[4];
#pragma unroll
        for (int i = 0; i < 4; ++i) { const int c = z ? 3 - i : i; const size_t it = (size_t)((b * 4 + c) * 4 + hd) * 2 + z; kv4[i] = *(const f32x4*)(KV + it * 8192 + off); dl4[i] = *(const f32x4*)(DL + it * 64 + k); }
#pragma unroll
        for (int i = 0; i < 4; ++i) { const int c = z ? 3 - i : i; const size_t it = (size_t)((b * 4 + c) * 4 + hd) * 2 + z; *(f32x4*)(KV + it * 8192 + off) = S; S = dl4[i] * S + kv4[i]; }
        float* dst = F.out + OUT_GLA + ((size_t)((b * 2 + e) * 2 + z) * 4 + hd) * 8192;
#pragma unroll
        for (int j = 0; j < 4; ++j) dst[(size_t)(k + j) * 128 + vv] = S[j];
    }
}
__device__ __forceinline__ void gla_g3_item(Frame& F, int e, int gc, int hd, const GlaPre& pre) {
    const int tid = F.tid, lane = F.lane, w = F.wave; const int R0 = gc * 64;
    const bf16_t* ZE = WSP(bf16_t, WS_ZE);
    f32x4 sreg[8];
    { const float* KV = WSP(float, WS_KV) + (size_t)(gc * 4 + hd) * 2 * 8192;
#pragma unroll
      for (int i = 0; i < 8; ++i) { const int idx = tid + 512 * i, z = idx >> 11, rem = idx & 2047, v = rem >> 4, k4 = (rem & 15) * 4; sreg[i] = *(const f32x4*)(KV + (size_t)z * 8192 + v * 64 + k4); } }
    u32x2 grreg[4];
    { const int vb_ = w >> 1, ib_ = w & 1, i_ = 32 * ib_ + (lane & 31), hh_ = lane >> 5;
#pragma unroll
      for (int g = 0; g < 4; ++g) grreg[g] = *(const u32x2*)(ZE + (size_t)(R0 + i_) * ZW + 1792 + hd * 128 + 32 * vb_ + 8 * g + 4 * hh_); }
    gla_stage_v(F, pre, GL_C);
    gla_bcum(F, pre);
    LAS float* LA = (LAS float*)(F.lds + GL_LA);
    { const int t = tid >> 3, c = tid & 7, k8 = c * 8;
      const u32x4 gq = pre.gq, gk = pre.gk;
      const float qf[8] = {bflo(gq.x), bfhi(gq.x), bflo(gq.y), bfhi(gq.y), bflo(gq.z), bfhi(gq.z), bflo(gq.w), bfhi(gq.w)};
      const float kf[8] = {bflo(gk.x), bfhi(gk.x), bflo(gk.y), bfhi(gk.y), bflo(gk.z), bfhi(gk.z), bflo(gk.w), bfhi(gk.w)};
      const int so = t * 128 + ((c ^ (t & 7)) * 16);
#pragma unroll
      for (int z = 0; z < 2; ++z) { float qe[8], ke[8];
#pragma unroll
        for (int j = 0; j < 8; ++j) { const float bc = LA[(z * 64 + t) * 64 + k8 + j]; qe[j] = qf[j] * fexp(bc); ke[j] = kf[j] * fexp(-bc); }
        *(LAS u32x4*)(F.lds + GL_A + z * 8192 + so) = (u32x4){pk2(qe[0], qe[1]), pk2(qe[2], qe[3]), pk2(qe[4], qe[5]), pk2(qe[6], qe[7])};
        *(LAS u32x4*)(F.lds + GL_B + z * 8192 + so) = (u32x4){pk2(ke[0], ke[1]), pk2(ke[2], ke[3]), pk2(ke[4], ke[5]), pk2(ke[6], ke[7])}; } }
    __syncthreads();
    {
#pragma unroll
      for (int i = 0; i < 8; ++i) { const int idx = tid + 512 * i, z = idx >> 11, rem = idx & 2047, v = rem >> 4, k4 = (rem & 15) * 4;
        const f32x4 s = sreg[i];
        *(LAS u32x2*)(F.lds + GL_LA + z * 16384 + v * 128 + (((k4 >> 3) ^ (v & 7)) * 16) + (k4 & 7) * 2) = (u32x2){pk2(s[0], s[1]), pk2(s[2], s[3])}; } }
    __syncthreads();
    const int vb = w >> 1, ib = w & 1, r32 = lane & 31, hh = lane >> 5;
    f32x16 o = {};
    bf16x8 qf[2][4];
    { const int i = 32 * ib + r32;
#pragma unroll
      for (int z = 0; z < 2; ++z)
#pragma unroll
        for (int s = 0; s < 4; ++s) qf[z][s] = *(const LAS bf16x8*)(F.lds + GL_A + z * 8192 + i * 128 + (((2 * s + hh) ^ (i & 7)) * 16)); }
    { const int v = 32 * vb + r32;
#pragma unroll
      for (int z = 0; z < 2; ++z)
#pragma unroll
        for (int s = 0; s < 4; ++s) { const bf16x8 sf = *(const LAS bf16x8*)(F.lds + GL_LA + z * 16384 + v * 128 + (((2 * s + hh) ^ (v & 7)) * 16));
            o = __builtin_amdgcn_mfma_f32_32x32x16_bf16(sf, qf[z][s], o, 0, 0, 0); } }
    const lptr vbase = F.lds + GL_C + vb * 4096 + ((lane >> 4) & 1) * 32 + (lane & 3) * 8 + (4 * hh + ((lane & 15) >> 2)) * 64;
#pragma unroll
    for (int jb = 0; jb < 2; ++jb) {
        const int j = 32 * jb + r32; f32x16 xf = {}, xb = {};
        const bool do_f = !(jb == 1 && ib == 0), do_b = !(jb == 0 && ib == 1);
#pragma unroll
        for (int s = 0; s < 4; ++s) { const int so = j * 128 + (((2 * s + hh) ^ (j & 7)) * 16);
            if (do_f) { const bf16x8 kf = *(const LAS bf16x8*)(F.lds + GL_B + so); xf = __builtin_amdgcn_mfma_f32_32x32x16_bf16(kf, qf[0][s], xf, 0, 0, 0); }
            if (do_b) { const bf16x8 kb = *(const LAS bf16x8*)(F.lds + GL_B + 8192 + so); xb = __builtin_amdgcn_mfma_f32_32x32x16_bf16(kb, qf[1][s], xb, 0, 0, 0); } }
        float x[16]; const int ii = 32 * ib + r32;
#pragma unroll
        for (int r = 0; r < 16; ++r) { const int jj = 32 * jb + crow(r, hh); x[r] = ((do_f && jj <= ii) ? xf[r] : 0.f) + ((do_b && jj >= ii) ? xb[r] : 0.f); }
#pragma unroll
        for (int s2 = 0; s2 < 2; ++s2) { const u32x4 pw = (u32x4){pk2(x[8 * s2], x[8 * s2 + 1]), pk2(x[8 * s2 + 2], x[8 * s2 + 3]), pk2(x[8 * s2 + 4], x[8 * s2 + 5]), pk2(x[8 * s2 + 6], x[8 * s2 + 7])};
            const bf16x8 vf = tr_frag(vbase + (4 * jb + 2 * s2) * 512);
            o = __builtin_amdgcn_mfma_f32_32x32x16_bf16(vf, __builtin_bit_cast(bf16x8, pw), o, 0, 0, 0); }
    }
    LAS float* SSQ = (LAS float*)(F.lds + GL_LR);
    { float s = 0.f;
#pragma unroll
      for (int r = 0; r < 16; ++r) s += o[r] * o[r];
      s += shfl_x(s, lane, 32);
      if (hh == 0) SSQ[vb * 64 + 32 * ib + r32] = s; }
    __syncthreads();
    { const int i = 32 * ib + r32; const float tot = SSQ[i] + SSQ[64 + i] + SSQ[128 + i] + SSQ[192 + i]; const float rs = frsq(tot * (1.0f / 128.0f) + EPS);
      const float* gain = FIN(I_GGAIN) + e * 512 + hd * 128; const size_t row = (size_t)(R0 + i);
#pragma unroll
      for (int g = 0; g < 4; ++g) { const int v0 = 32 * vb + 8 * g + 4 * hh; const f32x4 gn = *(const f32x4*)(gain + v0);
        const u32x2 gr = grreg[g];
        const float r0 = o[4 * g] * rs * gn[0] * bflo(gr.x), r1 = o[4 * g + 1] * rs * gn[1] * bfhi(gr.x), r2 = o[4 * g + 2] * rs * gn[2] * bflo(gr.y), r3 = o[4 * g + 3] * rs * gn[3] * bfhi(gr.y);
        *(u32x2*)(WSP(bf16_t, WS_MIX) + row * D + 512 + hd * 128 + v0) = (u32x2){pk2(r0, r1), pk2(r2, r3)}; } }
    __syncthreads();
}

__device__ __forceinline__ void phase_attn_g1(Frame& F, int e) {
    const int v = F.vcu;
    for (int i = 0; i < 2; ++i) { const int uid = 2 * v + i; const int hp = uid & 1, qb = (uid >> 1) & 31, kvh = (uid >> 6) & 1, b = uid >> 7; attn_unit(F, e, 0, b, kvh, qb, hp); }
    if (v < 128) { const int hp = v & 1, qb = (v >> 1) & 1, kvh = (v >> 2) & 1, b = v >> 3; attn_unit(F, e, 1, b, kvh, qb, hp); }
    { GlaPre pre = gla_load(F, e, (v * 5) >> 2, (v * 5) & 3, false);
      for (int it = v * 5; it < v * 5 + 5; ++it) { const int nx = it + 1 < v * 5 + 5 ? it + 1 : it; const GlaPre nxt = gla_load(F, e, nx >> 2, nx & 3, false); gla_g1_item(F, e, it >> 2, it & 3, pre); pre = nxt; } }
}
__device__ __forceinline__ void phase_g3(Frame& F, int e) {
    const int v = F.vcu;
    GlaPre pre = gla_load(F, e, (v * 5) >> 2, (v * 5) & 3, true);
    for (int it = v * 5; it < v * 5 + 5; ++it) { const int nx = it + 1 < v * 5 + 5 ? it + 1 : it; const GlaPre nxt = gla_load(F, e, nx >> 2, nx & 3, true); gla_g3_item(F, e, it >> 2, it & 3, pre); pre = nxt; }
}

__device__ __forceinline__ void phase_conv(Frame& F, int o) {
    const bf16_t* U = WSP(bf16_t, WS_U); bf16_t* UC = WSP(bf16_t, WS_UC);
    const int gt = F.vcu * NTHREADS + F.tid, NGT = F.G * NTHREADS;
    for (int it = gt; it < 1280 * 128; it += NGT) {
        const int cg = it & 127, rg = it >> 7, c0 = cg * 8, r0 = rg * 16;
        const int seqlen = r0 < MCTX ? TCTX : TLAT; const int sb = r0 < MCTX ? (r0 & ~(TCTX - 1)) : MCTX + ((r0 - MCTX) & ~(TLAT - 1)); const int se = sb + seqlen;
        float w[4][8], bias[8];
#pragma unroll
        for (int i = 0; i < 4; ++i)
#pragma unroll
            for (int j = 0; j < 8; ++j) w[i][j] = FIN(I_CONVW)[(size_t)(o * 4 + i) * 1024 + c0 + j];
#pragma unroll
        for (int j = 0; j < 8; ++j) bias[j] = FIN(I_CONVB)[o * 1024 + c0 + j];
        u32x4 raw[19];
#pragma unroll
        for (int r = 0; r < 19; ++r) { const int row = r0 - 2 + r; const int rc = row < sb ? sb : (row >= se ? se - 1 : row); raw[r] = *(const u32x4*)(U + (size_t)rc * D + c0); }
#pragma unroll
        for (int r = 0; r < 19; ++r) { const int row = r0 - 2 + r; if (row < sb || row >= se) raw[r] = (u32x4){0u, 0u, 0u, 0u}; }
#pragma unroll
        for (int r = 0; r < 16; ++r) { float y[8];
#pragma unroll
            for (int j = 0; j < 8; ++j) { const int w2 = j >> 1;
                const float x0 = (j & 1) ? bfhi(raw[r][w2]) : bflo(raw[r][w2]), x1 = (j & 1) ? bfhi(raw[r + 1][w2]) : bflo(raw[r + 1][w2]), x2 = (j & 1) ? bfhi(raw[r + 2][w2]) : bflo(raw[r + 2][w2]), x3 = (j & 1) ? bfhi(raw[r + 3][w2]) : bflo(raw[r + 3][w2]);
                y[j] = bias[j] + w[0][j] * x0 + w[1][j] * x1 + w[2][j] * x2 + w[3][j] * x3; }
            *(u32x4*)(UC + (size_t)(r0 + r) * D + c0) = (u32x4){pk2(y[0], y[1]), pk2(y[2], y[3]), pk2(y[4], y[5]), pk2(y[6], y[7])}; }
    }
}
__device__ __forceinline__ void phase_carry(Frame& F, int o) {
    const float* AGG = WSP(float, WS_AGG); float* CAR = WSP(float, WS_CARRY);
    const int gt = F.vcu * NTHREADS + F.tid, NGT = F.G * NTHREADS;
    for (int c = gt; c < 8192 + 32768; c += NGT) {
        if (c < 8192) { const int b = c >> 11, z = (c >> 10) & 1, ch = c & 1023; const int base = 64 + b * 64;
            float h = FIN(I_SLRU)[(size_t)((b * 2 + o) * 2 + z) * 1024 + ch];
            for (int i8 = 0; i8 < 64; i8 += 8) { f32x2 a[8];
#pragma unroll
                for (int i = 0; i < 8; ++i) { const int ck = base + (z ? 63 - (i8 + i) : i8 + i); a[i] = *(const f32x2*)(AGG + ((size_t)(ck * 2 + z) * 1024 + ch) * 2); }
#pragma unroll
                for (int i = 0; i < 8; ++i) { const int ck = base + (z ? 63 - (i8 + i) : i8 + i); CAR[(size_t)(ck * 2 + z) * 1024 + ch] = h; h = a[i].x * h + a[i].y; } }
        } else { const int cc = c - 8192; const int b = cc >> 11, z = (cc >> 10) & 1, ch = cc & 1023; const int base = b * 4; float h = 0.f;
#pragma unroll
            for (int i = 0; i < 4; ++i) { const int ck = base + (z ? 3 - i : i); const f32x2 a = *(const f32x2*)(AGG + ((size_t)(ck * 2 + z) * 1024 + ch) * 2); CAR[(size_t)(ck * 2 + z) * 1024 + ch] = h; h = a.x * h + a.y; }
            F.out[OUT_LRU + (size_t)((b * 2 + o) * 2 + z) * 1024 + ch] = h; }
    }
}
__device__ __forceinline__ void phase_lru_out(Frame& F) {
    const bf16_t* ACF = WSP(bf16_t, WS_LAF); const bf16_t* ACB = WSP(bf16_t, WS_LAB); const bf16_t* HLF = WSP(bf16_t, WS_U); const bf16_t* HLB = WSP(bf16_t, WS_BB);
    const bf16_t* Gg = WSP(bf16_t, WS_G); bf16_t* YG = WSP(bf16_t, WS_BB); const float* CAR = WSP(float, WS_CARRY);
    const int gt = F.vcu * NTHREADS + F.tid, NGT = F.G * NTHREADS;
    for (int it = gt; it < 1280 * 128; it += NGT) {
        const int cg = it & 127, rg = it >> 7, c0 = cg * 8, r0 = rg * 16, ck = r0 >> 6;
        float cf[8], cb[8];
        { const f32x4 a0 = *(const f32x4*)(CAR + (size_t)(ck * 2) * 1024 + c0), a1 = *(const f32x4*)(CAR + (size_t)(ck * 2) * 1024 + c0 + 4), b0 = *(const f32x4*)(CAR + (size_t)(ck * 2 + 1) * 1024 + c0), b1 = *(const f32x4*)(CAR + (size_t)(ck * 2 + 1) * 1024 + c0 + 4);
#pragma unroll
          for (int j = 0; j < 4; ++j) { cf[j] = a0[j]; cf[4 + j] = a1[j]; cb[j] = b0[j]; cb[4 + j] = b1[j]; } }
#pragma unroll 4
        for (int r = 0; r < 16; ++r) { const size_t ix = (size_t)(r0 + r) * D + c0;
            const u32x4 af = *(const u32x4*)(ACF + ix), ab = *(const u32x4*)(ACB + ix), hf = *(const u32x4*)(HLF + ix), hb = *(const u32x4*)(HLB + ix), gg = *(const u32x4*)(Gg + ix);
            float y[8];
#pragma unroll
            for (int w2 = 0; w2 < 4; ++w2) { y[2 * w2] = bflo(gg[w2]) * ((bflo(hf[w2]) + bflo(af[w2]) * cf[2 * w2]) + (bflo(hb[w2]) + bflo(ab[w2]) * cb[2 * w2]));
                y[2 * w2 + 1] = bfhi(gg[w2]) * ((bfhi(hf[w2]) + bfhi(af[w2]) * cf[2 * w2 + 1]) + (bfhi(hb[w2]) + bfhi(ab[w2]) * cb[2 * w2 + 1])); }
            *(u32x4*)(YG + ix) = (u32x4){pk2(y[0], y[1]), pk2(y[2], y[3]), pk2(y[4], y[5]), pk2(y[6], y[7])}; }
    }
}

constexpr int NSTEPS = 42;
template <int KIND>
__device__ __forceinline__ void run_gemm(Frame& F, int l, int sub, int gidx, const bf16_t* A, int lda, int K, int a_grp, const bf16_t* Bt, int nN, bool perm, int dep, int depneed, int pub, int rot, int qidx, unsigned stop_at = 0, int jlo = 0, int jhi = 1 << 30, bool again = false) {
    pg8::Gemm g; g.A = A; g.Bt = Bt; g.lda = lda; g.K = K; g.nM = M / 256; g.nN = nN; g.a_grp = a_grp; g.perm = perm;
    Epi<KIND> E; E.layer = l; E.sub = sub; E.gidx = gidx; E.p = F.p; E.oz = F.oz;
    pg8::StaticOrder S; S.init(g.nM, g.nN, F.G, F.bid); S.rot = rot;
    S.stop_at = stop_at; S.jlo = jlo; S.jhi = jhi; S.again = again;
    unsigned* cw = WSP(unsigned, WS_CTL) + CW_CNT;
    if (dep >= 0) { S.ready = cw + (size_t)dep * 80 * 16; S.need = (unsigned)depneed * 8u; }
    if (pub >= 0) S.fin = cw + (size_t)pub * 80 * 16;
    if (qidx >= 0 && F.G == 256) { S.queue = WSP(unsigned, WS_CTL) + CW_Q + (size_t)qidx * 8 * 16; S.word = (LAS unsigned*)(F.lds + MISC_OFF + 64); }
    pg8::gemm_phase<Epi<KIND>>(F.lds, F.tid, (float)F.oz, g, S, E);
}
__global__ void __launch_bounds__(NTHREADS, 2) mk_fwd(Params P) {
    extern __shared__ __attribute__((aligned(16))) unsigned char lds_raw[];
    const lptr lds0 = (lptr)lds_raw;
    volatile LAS unsigned* MISC = (volatile LAS unsigned*)(lds0 + MISC_OFF);
    static_assert((LDS_BYTES - LDSCTL_OFF) == 8 * NTHREADS * 4, "LDS control region");
#pragma unroll
    for (int u = 0; u < 8; ++u) ((LAS unsigned*)(lds0 + LDSCTL_OFF))[u * NTHREADS + threadIdx.x] = 0u;
    __syncthreads();
    unsigned* ctl = (unsigned*)(P.ws + WS_CTL);
    XcdBarrier bar; bar.bar = ctl + 1024; bar.x = 0; bar.st = nullptr;
    const int lo = P.step_lo, hi = P.step_hi;
    const bool multi = (hi - lo) > 1;
    if (multi) bar = xcd_barrier_post(ctl + 1024, MISC + 8);
    volatile LAS unsigned long long* TS = (volatile LAS unsigned long long*)(lds0 + LDSCTL_OFF + 1024);
    if (PROBE_K1 >= 0 && blockIdx.x == 0 && threadIdx.x == 0) TS[0] = __builtin_amdgcn_s_memrealtime();
#define STEP_BEGIN(s) if (lo <= (s) && (s) < hi) { Frame F; F.lds = lds0; F.p = &P; \
        { int tid = threadIdx.x; asm volatile("" : "+v"(tid)); F.tid = tid; F.lane = tid & 63; F.wave = __builtin_amdgcn_readfirstlane(tid >> 6); } \
        { int G = gridDim.x, bx = blockIdx.x, oz = 0; asm volatile("" : "+s"(G), "+s"(bx), "+s"(oz)); F.G = G; F.bid = bx; F.vcu = (G % 8 == 0) ? (bx % 8) * (G / 8) + bx / 8 : bx; F.oz = oz; F.out = P.out + oz; }
#define STAMP() do { if (PROBE_K1 >= 0 && blockIdx.x == 0 && threadIdx.x == 0) { const int o_ = (int)TS[63]; if (o_ < 62) TS[o_ + 1] = __builtin_amdgcn_s_memrealtime(); TS[63] = (unsigned long long)(o_ + 1); } } while (0)
#define STEP_END(s) if (multi && (s) + 1 < hi) { XcdBarrier bb = bar; asm volatile("" : "+s"(bb.bar), "+s"(bb.x)); xcd_barrier(bb, F.tid); } else __syncthreads(); STAMP(); }

#define STEP_LINK(s) __syncthreads(); STAMP(); }
#define STEP_END_IF(c, s) if ((c) && multi && (s) + 1 < hi) { XcdBarrier bb = bar; asm volatile("" : "+s"(bb.bar), "+s"(bb.x)); xcd_barrier(bb, F.tid); } else __syncthreads(); STAMP(); }
    STEP_BEGIN(0) phase_prologue(F); STEP_END(0)
    for (int l = 0; l < DEPTH; ++l) {
        const int s0 = 1 + 10 * l; const bool even = (l & 1) == 0; const int sub = l >> 1;
        const int dep_in = l > 0 ? (l - 1) * 3 + 2 : -1;
        if (l == 0) { STEP_BEGIN(1) phase_pre(F); STEP_END(1) }
        if (even) {
            STEP_BEGIN(s0 + 1) run_gemm<EK_EVEN_IN>(F, l, sub, 0, WSP(bf16_t, WS_XN), D, D, 0, WSP(bf16_t, WS_WINE) + (size_t)sub * PEP * D, 10, true, dep_in, 4, -1, 0, l * 4 + 3); STEP_END(s0 + 1)
            STEP_BEGIN(s0 + 2) phase_attn_g1(F, sub); STEP_END(s0 + 2)
            STEP_BEGIN(s0 + 3) phase_g2(F, sub); STEP_END(s0 + 3)
            STEP_BEGIN(s0 + 4) phase_g3(F, sub); STEP_END(s0 + 4)
            STEP_BEGIN(s0 + 6) run_gemm<EK_RES>(F, l, sub, 2, WSP(bf16_t, WS_MIX), D, D, 0, WSP(bf16_t, WS_WOUTE) + (size_t)sub * D * D, 4, true, -1, 0, l * 3 + 0, 0, -1); STEP_LINK(s0 + 6)
        } else {
            STEP_BEGIN(s0 + 1) run_gemm<EK_ODD_IN>(F, l, sub, 0, WSP(bf16_t, WS_XN), D, D, 0, WSP(bf16_t, WS_WINO) + (size_t)sub * 2048 * D, 8, true, dep_in, 4, -1, 0, l * 4 + 3); STEP_END(s0 + 1)
            STEP_BEGIN(s0 + 2) phase_conv(F, sub); STEP_END(s0 + 2)
            STEP_BEGIN(s0 + 3) run_gemm<EK_GATES>(F, l, sub, 0, WSP(bf16_t, WS_UC), D, 256, 4, WSP(bf16_t, WS_WG) + (size_t)sub * 4096 * 256, 16, true, -1, 0, -1, 0, -1); STEP_END(s0 + 3)
            STEP_BEGIN(s0 + 4) phase_carry(F, sub); STEP_END(s0 + 4)
            STEP_BEGIN(s0 + 5) phase_lru_out(F); STEP_END(s0 + 5)
            STEP_BEGIN(s0 + 6) run_gemm<EK_RES>(F, l, sub, 2, WSP(bf16_t, WS_BB), D, D, 0, WSP(bf16_t, WS_WOUTO) + (size_t)sub * D * D, 4, true, -1, 0, l * 3 + 0, 0, -1); STEP_LINK(s0 + 6)
        }
        for (int ph = 0; ph < 2; ++ph) {
            const bool own0 = (((int)blockIdx.x >> 3) & 31) < 20;
            STEP_BEGIN(s0 + 8) run_gemm<EK_SWIGLU>(F, l, sub, 0, WSP(bf16_t, WS_XN), D, D, 0, WSP(bf16_t, WS_WF1) + (size_t)l * 5632 * D, 22, true, l * 3 + 0, 4, l * 3 + 1, 0, l * 4 + 1, (ph == 0 && own0) ? F2_T0 : 0u, 0, 1 << 30, ph != 0); STEP_LINK(s0 + 8)
            STEP_BEGIN(s0 + 9) run_gemm<EK_RES>(F, l, sub, 5, WSP(bf16_t, WS_H), DFF, DFF, 0, WSP(bf16_t, WS_WF2) + (size_t)l * D * DFF, 4, true, l * 3 + 1, 22, (l + 1 < DEPTH) ? l * 3 + 2 : -1, 0, -1, 0u, ph ? 20 : 0, ph ? 40 : 20, ph != 0);
            STEP_END_IF(ph == 1 && l + 1 == DEPTH, s0 + 9)
        }
    }
    STEP_BEGIN(41) phase_final(F); STEP_END(41)
#undef STEP_LINK
#undef STEP_END_IF
    if (PROBE_K1 >= 0 && blockIdx.x == 0 && threadIdx.x == 0) {
        unsigned long long q1 = (TS[PROBE_K1 + 1] - TS[PROBE_K1]) / 800ull; if (q1 > 63) q1 = 63;
        unsigned long long q2 = PROBE_K2 >= 0 ? (TS[PROBE_K2 + 1] - TS[PROBE_K2]) / 800ull : 0ull; if (q2 > 63) q2 = 63;
        const unsigned long long wait = (64ull * q1 + 4096ull * q2) * 100ull, t0 = __builtin_amdgcn_s_memrealtime();
        while (__builtin_amdgcn_s_memrealtime() - t0 < wait) __builtin_amdgcn_s_sleep(32);
    }
#undef STEP_BEGIN
#undef STEP_END
}

extern "C" void kernel_launch(void* const* d_in, const int* in_sizes, int n_in, void* d_out, int out_size, void* d_ws, size_t ws_size, hipStream_t stream) {
    static int grid = 0;
    if (grid == 0) {
        if (n_in != 30 || (size_t)out_size != OUT_END || ws_size < WS_END) { fprintf(stderr, "kernel_launch: unexpected shapes: n_in %d out %d ws %zu (need %zu)\n", n_in, out_size, ws_size, (size_t)WS_END); grid = -1; return; }
        int dev = 0, cus = 0;
        if (hipGetDevice(&dev) != hipSuccess || hipDeviceGetAttribute(&cus, hipDeviceAttributeMultiprocessorCount, dev) != hipSuccess) { grid = -1; return; }
        if (hipFuncSetAttribute((const void*)mk_fwd, hipFuncAttributeMaxDynamicSharedMemorySize, LDS_BYTES) != hipSuccess) { fprintf(stderr, "kernel_launch: hipFuncSetAttribute failed\n"); grid = -1; return; }
        (void)hipGetLastError();
        grid = cus;
        if (grid != 256) fprintf(stderr, "kernel_launch: %d CUs (built for 256)\n", grid);
    }
    if (grid < 0) return;
    (void)hipMemsetAsync((char*)d_ws + WS_CTL, 0, CTL_ZERO_BYTES, stream);
    Params p{};
    for (int i = 0; i < 30; ++i) p.in[i] = (const float*)d_in[i];
    p.out = (float*)d_out; p.ws = (unsigned char*)d_ws;
#if MK_MULTI
    for (int s = 0; s < NSTEPS; ++s) {
        if (s >= 1 && s <= 40) { const int l = (s - 1) / 10, j = (s - 1) % 10; if (((l & 1) == 0 && j == 5) || j == 7 || (j == 0 && l > 0)) continue; }
        p.step_lo = s; p.step_hi = s + 1;
        hipLaunchKernelGGL(mk_fwd, dim3(grid), dim3(NTHREADS), LDS_BYTES, stream, p);
    }
#else
    p.step_lo = 0; p.step_hi = NSTEPS;
    hipLaunchKernelGGL(mk_fwd, dim3(grid), dim3(NTHREADS), LDS_BYTES, stream, p);
#endif
}
```

```cpp
#include <hip/hip_runtime.h>
#include <cstdio>
#include <cstdint>

#ifndef MK_MULTI
#define MK_MULTI 0
#endif

#ifndef PROBE_K1
#define PROBE_K1 -1
#endif
#ifndef PROBE_K2
#define PROBE_K2 -1
#endif
#define LAS __attribute__((address_space(3)))
#define GAS __attribute__((address_space(1)))
typedef unsigned short bf16_t;
typedef short bf16x8 __attribute__((ext_vector_type(8)));
typedef short s16x4 __attribute__((ext_vector_type(4)));
typedef float f32x2 __attribute__((ext_vector_type(2)));
typedef float f32x4 __attribute__((ext_vector_type(4)));
typedef float f32x16 __attribute__((ext_vector_type(16)));
typedef unsigned u32x2 __attribute__((ext_vector_type(2)));
typedef unsigned u32x4 __attribute__((ext_vector_type(4)));
typedef LAS unsigned char* lptr;

constexpr int D = 1024, NCTX = 16, TCTX = 256, NLAT = 4, TLAT = 4096, DEPTH = 4;
constexpr int MCTX = NCTX * TCTX;
constexpr int M = MCTX + NLAT * TLAT;
constexpr int PE = 2336, PEP = 2560;
constexpr int ZW = 2304;
constexpr int DFF = 2816;
constexpr float EPS = 1e-6f;
constexpr float LOG2E = 1.4426950408889634f;
constexpr float QSCALE = 0.125f * LOG2E;
constexpr int NCHUNK = M / 64;

constexpr size_t OUT_CK = (size_t)M * D, OUT_CV = OUT_CK + 1048576, OUT_GLA = OUT_CV + 1048576, OUT_LRU = OUT_GLA + 2097152, OUT_END = OUT_LRU + 65536;

constexpr size_t MiB = 1u << 20;
constexpr size_t WS_CTL = 0, CTL_ZERO_BYTES = 128 * 1024;
constexpr unsigned F2_T0 = 144;
constexpr int CW_BIAS = 8192;
constexpr int CW_Q = 12288;
constexpr int CW_CNT = 16384;
constexpr size_t WS_BIAS = 256 * 1024;
constexpr size_t BIAS_E = 0, BIAS_O = 2 * 5 * 2560, BIAS_F = BIAS_O + 2 * 5 * 2048, BIAS_TOTAL = BIAS_F + 4 * 5 * 5632;
constexpr size_t SSQP_OFF = 10485760;
constexpr size_t WS_SSQ_UNUSED = 3 * MiB;
constexpr size_t WS_MOD = 1 * MiB;
constexpr size_t WS_ROPE = WS_MOD + 512 * 1024;
constexpr size_t WS_CK = 2 * MiB, WS_CV = 2 * MiB + 512 * 1024;
constexpr size_t WS_WINE = 4 * MiB;
constexpr size_t WS_WOUTE = WS_WINE + 10 * MiB;
constexpr size_t WS_WINO = WS_WOUTE + 4 * MiB;
constexpr size_t WS_WG = WS_WINO + 8 * MiB;
constexpr size_t WS_WOUTO = WS_WG + 4 * MiB;
constexpr size_t WS_WF1 = WS_WOUTO + 4 * MiB;
constexpr size_t WS_WF2 = WS_WF1 + 44 * MiB;
constexpr size_t WS_XN = WS_WF2 + 22 * MiB;
static_assert(WS_XN == 100 * MiB, "ws map");
constexpr size_t WS_BIG = 140 * MiB;
constexpr size_t WS_ZE = 140 * MiB;
constexpr size_t WS_KV = 230 * MiB;
constexpr size_t WS_LAG = 270 * MiB;
constexpr size_t WS_MIX = 340 * MiB;
constexpr size_t WS_LR = 380 * MiB;
constexpr size_t WS_DL = 383 * MiB;
constexpr size_t WS_G = 140 * MiB;
constexpr size_t WS_U = 180 * MiB;
constexpr size_t WS_UC = 220 * MiB;
constexpr size_t WS_LAF = 260 * MiB;
constexpr size_t WS_LAB = 300 * MiB;
constexpr size_t WS_BB = 340 * MiB;
constexpr size_t WS_AGG = WS_XN;
constexpr size_t WS_CARRY = WS_XN + 8 * MiB;
constexpr size_t WS_H = 230 * MiB;
constexpr size_t WS_SSQ8 = 220 * MiB;
constexpr size_t WS_XF = 140 * MiB;
constexpr size_t WS_END = 384 * MiB;

constexpr int RING_BYTES = 131072;
constexpr int LDSCTL_OFF = RING_BYTES, MISC_OFF = LDSCTL_OFF + 320;
constexpr int LDS_BYTES = 147456;
constexpr int NWAVES = 8, NTHREADS = 512;

__device__ __forceinline__ unsigned f2bf(float f) { unsigned u = __builtin_bit_cast(unsigned, f); return (u + 0x7fffu + ((u >> 16) & 1u)) >> 16; }
typedef __bf16 bf16x2_t __attribute__((ext_vector_type(2)));
__device__ __forceinline__ unsigned pk2(float lo, float hi) { const f32x2 v = {lo, hi}; return __builtin_bit_cast(unsigned, __builtin_convertvector(v, bf16x2_t)); }
__device__ __forceinline__ float bf2f(unsigned short b) { return __builtin_bit_cast(float, (unsigned)b << 16); }
__device__ __forceinline__ float bflo(unsigned w) { return __builtin_bit_cast(float, w << 16); }
__device__ __forceinline__ float bfhi(unsigned w) { return __builtin_bit_cast(float, w & 0xffff0000u); }
__device__ __forceinline__ float fexp2(float x) { return __builtin_amdgcn_exp2f(x); }
__device__ __forceinline__ float fexp(float x) { return __builtin_amdgcn_exp2f(x * LOG2E); }
__device__ __forceinline__ float frcp(float x) { return __builtin_amdgcn_rcpf(x); }
__device__ __forceinline__ float frsq(float x) { return __builtin_amdgcn_rsqf(x); }
__device__ __forceinline__ float fsqrt(float x) { return __builtin_amdgcn_sqrtf(x); }
__device__ __forceinline__ float flog(float x) { return __builtin_amdgcn_logf(x) * 0.6931471805599453f; }
__device__ __forceinline__ float sigmoidf_(float x) { return frcp(1.0f + fexp(-x)); }
__device__ __forceinline__ float siluf_(float x) { return x * frcp(1.0f + fexp(-x)); }
__device__ __forceinline__ float gelu_tanh(float x) { const float z = 0.7978845608028654f * (x + 0.044715f * x * x * x); const float t = 1.0f - 2.0f * frcp(fexp(2.0f * z) + 1.0f); return 0.5f * x * (1.0f + t); }
__device__ __forceinline__ int crow(int r, int hh) { return (r & 3) + 8 * (r >> 2) + 4 * hh; }
__device__ __forceinline__ int cond_of_row(int row) { return row < MCTX ? 0 : 1 + ((row - MCTX) >> 12); }
#define LDS_WAIT() asm volatile("s_waitcnt lgkmcnt(0)" ::: "memory")
#define VM_WAIT() asm volatile("s_waitcnt vmcnt(0)" ::: "memory")
__device__ __forceinline__ s16x4 tr_read(lptr p) { typedef short v4i16_t __attribute__((ext_vector_type(4))); return __builtin_bit_cast(s16x4, __builtin_amdgcn_ds_read_tr16_b64_v4i16((LAS v4i16_t*)p)); }
__device__ __forceinline__ bf16x8 tr_frag(lptr p) { const s16x4 a = tr_read(p), b = tr_read(p + 512); return (bf16x8){a[0], a[1], a[2], a[3], b[0], b[1], b[2], b[3]}; }
__device__ __forceinline__ float shfl_idx(float v, int src_lane) { return __builtin_bit_cast(float, __builtin_amdgcn_ds_bpermute(src_lane << 2, __builtin_bit_cast(int, v))); }
__device__ __forceinline__ float shfl_x(float v, int lane, int mask) { return shfl_idx(v, lane ^ mask); }
__device__ __forceinline__ float wave_sum(float v, int lane) {
#pragma unroll
    for (int o = 1; o < 64; o <<= 1) v += shfl_x(v, lane, o);
    return v;
}

struct Params {
    const float* in[30];
    float* out; unsigned char* ws;
    int step_lo, step_hi;
};
enum { I_XP = 0, I_XS, I_C, I_CK, I_CV, I_SGLA, I_SLRU, I_CCTX, I_WADA, I_BADA, I_NMIX, I_NFFN, I_WINE, I_SINK, I_WALPHA, I_BALPHA, I_GGAIN, I_WOUTE,
       I_WINO, I_CONVW, I_CONVB, I_WGA, I_BGA, I_WGX, I_BGX, I_LAM, I_WOUTO, I_WF1, I_WF2, I_NFIN };

namespace pg8 {
constexpr int BM = 256, BK = 64, HALF = 128, HTB = HALF * BK * 2, STAGE_BYTES = 8 * HTB, NXCD = 8, WGM = 8;
__device__ __forceinline__ int lds_byte(int r, int c) { const int st = (r >> 4) * 2 + (c >> 5), rr = r & 15, cc = c & 31, ob = rr * 64 + cc * 2; return st * 1024 + (ob ^ (((ob >> 9) & 1) << 5)); }
__device__ __forceinline__ void stage_rc(int b, int& R, int& C) { const int st = b / 1024, sb = b % 1024, swz = sb ^ (((sb >> 9) & 1) << 5); R = (st >> 1) * 16 + swz / 64; C = (st & 1) * 32 + (swz % 64) / 2; }
__device__ __forceinline__ int perm32(int rho) { const int n = rho >> 4, i = rho & 15; return 8 * (i >> 2) + 4 * n + (i & 3); }
struct Unit { int pm, pn; };
struct Gemm { const bf16_t* A; const bf16_t* Bt; int lda, K, nM, nN, a_grp; bool perm; bool aperm; };
struct StaticOrder {
    int nM, nN, nwg, G, c;
    unsigned* queue; LAS unsigned* word;
    int rot;
    unsigned stop_at; int jlo, jhi; bool again;
    unsigned* ready; unsigned need; unsigned* fin;
    __device__ void init(int nM_, int nN_, int G_, int c_) { nM = nM_; nN = nN_; nwg = nM * nN; G = G_; c = c_; rot = 0; ready = nullptr; need = 0; fin = nullptr; queue = nullptr; word = nullptr; stop_at = 0; jlo = 0; jhi = 1 << 30; again = false; }
    __device__ __forceinline__ void a_ready(const Unit& u, int tid) const {
        if (ready == nullptr) return;
        if (tid < 64) { unsigned* p = ready + 16 * u.pm; unsigned sp = 0;
            while ((unsigned)__builtin_amdgcn_readfirstlane(__hip_atomic_load(p, __ATOMIC_RELAXED, __HIP_MEMORY_SCOPE_AGENT)) < need) { __builtin_amdgcn_s_sleep(2); if (++sp > (1u << 22)) break; }
            __builtin_amdgcn_fence(__ATOMIC_ACQUIRE, "agent");
            asm volatile("s_waitcnt vmcnt(0)" ::: "memory"); }
        asm volatile("" ::: "memory"); __builtin_amdgcn_s_barrier(); asm volatile("" ::: "memory");
    }
    __device__ __forceinline__ void unit_of(int j, Unit& u) const { const int x = c & 7, g = j / (5 * nN), jj = j % (5 * nN); u.pn = jj / 5; u.pm = 10 * x + 5 * g + jj % 5; }
    __device__ __forceinline__ bool fetch(int i, Unit& u, int tid) const {
        if (queue == nullptr) { const bool h = next(i, u); if (h) a_ready(u, tid); return h; }
        if (tid < 64) { unsigned j = 0; if (tid == 0) { unsigned* q = queue + 16 * (c & 7);
                if (stop_at != 0 && __hip_atomic_load(q, __ATOMIC_RELAXED, __HIP_MEMORY_SCOPE_AGENT) >= stop_at) j = 0xffffffffu; else j = __hip_atomic_fetch_add(q, 1u, __ATOMIC_RELAXED, __HIP_MEMORY_SCOPE_AGENT); }
            j = (unsigned)__builtin_amdgcn_readfirstlane((int)j);
            if (j < (unsigned)(10 * nN) && ready != nullptr) { Unit t; unit_of((int)j, t); unsigned* p = ready + 16 * t.pm; unsigned sp = 0;
                while ((unsigned)__builtin_amdgcn_readfirstlane(__hip_atomic_load(p, __ATOMIC_RELAXED, __HIP_MEMORY_SCOPE_AGENT)) < need) { __builtin_amdgcn_s_sleep(2); if (++sp > (1u << 22)) break; }
                __builtin_amdgcn_fence(__ATOMIC_ACQUIRE, "agent"); asm volatile("s_waitcnt vmcnt(0)" ::: "memory"); }
            if (tid == 0) *word = j;
            asm volatile("s_waitcnt lgkmcnt(0)" ::: "memory"); }
        asm volatile("" ::: "memory"); __builtin_amdgcn_s_barrier(); asm volatile("" ::: "memory");
        const unsigned j = *(volatile LAS unsigned*)word;
        if (j >= (unsigned)(10 * nN)) return false;
        unit_of((int)j, u); return true;
    }
    __device__ __forceinline__ void done(const Unit& u, int lane) const {
        if (fin == nullptr) return;
        asm volatile("s_waitcnt vmcnt(0)" ::: "memory");
        if (lane == 0) __hip_atomic_fetch_add(fin + 16 * u.pm, 1u, __ATOMIC_RELAXED, __HIP_MEMORY_SCOPE_AGENT);
    }
    __device__ bool next(int i, Unit& u) const {
        if (G == 256 && nM == 80) { const int x = c & 7, idx = ((c >> 3) + rot) & 31; int j = -1, cnt = 0;
            for (int jj = idx; jj < 10 * nN; jj += 32) if (jj >= jlo && jj < jhi) { if (cnt == i) j = jj; ++cnt; }
            if (j < 0) return false;
            const int g = j / (5 * nN), jj = j % (5 * nN); u.pn = jj / 5; u.pm = 10 * x + 5 * g + jj % 5; return true; }
        if (again) return false;
        const long L = (long)i * G + c; if (L >= nwg) return false;
        int wgid = (int)L; { const int q = nwg / NXCD, r = nwg % NXCD, xcd = wgid % NXCD, off = wgid / NXCD; wgid = (xcd < r ? xcd * (q + 1) : r * (q + 1) + (xcd - r) * q) + off; }
        const int nig = WGM * nN, gid = wgid / nig, fm = gid * WGM, gsz = (nM - fm) < WGM ? (nM - fm) : WGM;
        u.pm = fm + ((wgid % nig) % gsz); u.pn = (wgid % nig) / gsz; return true;
    }
};

template <class Epi>
__device__ __forceinline__ void gemm_phase(lptr lds, const int tid, const float zf, const Gemm g, const StaticOrder& S, const Epi& E) {
    const int wid = __builtin_amdgcn_readfirstlane(tid >> 6), lane = tid & 63, wr = wid >> 2, wc = wid & 3, fr = lane & 15, fq = lane >> 4;
    const int K = g.K, nt = K / BK, lda = g.lda;
    unsigned voffA[2], voffB[2];
#pragma unroll
    for (int i = 0; i < 2; ++i) { int R, C; stage_rc(tid * 16 + i * 8192, R, C); const int Rb = g.perm ? ((R & ~31) + perm32(R & 31)) : R;
        const int Ra = g.aperm ? ((R & ~63) | ((R & 15) << 2) | ((R >> 4) & 3)) : R;
        voffA[i] = (unsigned)(Ra * lda + C) * 2u; voffB[i] = (unsigned)(Rb * K + C) * 2u; }
    const size_t kstep = (size_t)(BK * 2);
    const size_t hsA = (size_t)HALF * lda * 2, hsB = (size_t)HALF * K * 2;
    const unsigned ldsw = (unsigned)wid * 1024u;
    const int aoff = lds_byte(wr * 64 + fr, fq * 8), boff = lds_byte(wc * 32 + fr, fq * 8);
#define PG8_SA(b, h) (((b) * 2 + (h)) * HTB)
#define PG8_SB(b, h) ((4 + (b) * 2 + (h)) * HTB)
#define PG8_STAGE(bufoff, gbase, voff) do { _Pragma("unroll") for (int _i = 0; _i < 2; ++_i) \
        __builtin_amdgcn_global_load_lds((const unsigned*)((const char*)(gbase) + (voff)[_i]), (LAS unsigned*)(lds + (bufoff) + ldsw + _i * 8192), 16, 0, 0); } while (0)
#define PG8_LDA(dst, b, h) do { _Pragma("unroll") for (int m = 0; m < 4; ++m) _Pragma("unroll") for (int k = 0; k < 2; ++k) dst[m][k] = *(const LAS bf16x8*)(lds + PG8_SA(b, h) + aoff + m * 2048 + k * 1024); } while (0)
#define PG8_LDB(dst, b, h) do { _Pragma("unroll") for (int n = 0; n < 2; ++n) _Pragma("unroll") for (int k = 0; k < 2; ++k) dst[n][k] = *(const LAS bf16x8*)(lds + PG8_SB(b, h) + boff + n * 2048 + k * 1024); } while (0)
#define PG8_MMA(ai, bj, At, Bt) do { __builtin_amdgcn_s_setprio(1); _Pragma("unroll") for (int m = 0; m < 4; ++m) _Pragma("unroll") for (int n = 0; n < 2; ++n) _Pragma("unroll") for (int k = 0; k < 2; ++k) \
        acc[ai][bj][m][n] = __builtin_amdgcn_mfma_f32_16x16x32_bf16(Bt[n][k], At[m][k], acc[ai][bj][m][n], 0, 0, 0); __builtin_amdgcn_s_setprio(0); } while (0)
#define PG8_WAIT_V(n) asm volatile("s_waitcnt vmcnt(" #n ")" ::: "memory")
#define PG8_WAIT_L(n) asm volatile("s_waitcnt lgkmcnt(" #n ")" ::: "memory")
#define PG8_BAR __builtin_amdgcn_s_barrier()
#define PG8_SCHED __builtin_amdgcn_sched_barrier(0)
#define PG8_ABASE(u) ((const char*)g.A + ((size_t)(u).pm * BM * lda + (g.a_grp ? (size_t)((u).pn / g.a_grp) * K : 0)) * 2)
#define PG8_BBASE(u) ((const char*)g.Bt + (size_t)(u).pn * BM * K * 2)
    Unit cur, nxt; int ui = 0;
    if (!S.fetch(0, cur, tid)) return;
    f32x4 acc[2][2][4][2];
#pragma unroll
    for (int a = 0; a < 2; ++a)
#pragma unroll
        for (int b = 0; b < 2; ++b)
#pragma unroll
            for (int m = 0; m < 4; ++m)
#pragma unroll
                for (int n = 0; n < 2; ++n) acc[a][b][m][n] = (f32x4){zf, zf, zf, zf};
    bf16x8 At[4][2], B0[2][2], B1[2][2];
    const char* cA = PG8_ABASE(cur); const char* cB = PG8_BBASE(cur);
    PG8_STAGE(PG8_SB(0, 0), cB, voffB); PG8_STAGE(PG8_SB(0, 1), cB + hsB, voffB); PG8_STAGE(PG8_SA(0, 0), cA, voffA); PG8_STAGE(PG8_SA(0, 1), cA + hsA, voffA);
    if (wr == 1) PG8_BAR;
    PG8_WAIT_V(2); PG8_BAR;
    PG8_STAGE(PG8_SB(1, 0), cB + kstep, voffB); PG8_STAGE(PG8_SA(1, 0), cA + kstep, voffA); PG8_STAGE(PG8_SB(1, 1), cB + hsB + kstep, voffB);
    PG8_WAIT_V(6); PG8_BAR;
    for (;;) {
        bool has_next = false; const char* nA = cA; const char* nB = cB;
#pragma unroll 1
        for (int t = 0; t < nt; t += 2) {
            const bool last = (t == nt - 2);
            if (last) { has_next = S.fetch(ui + 1, nxt, tid); if (has_next) { nA = PG8_ABASE(nxt); nB = PG8_BBASE(nxt); } }
            const char* a1 = cA + (size_t)(t + 1) * kstep;
            const char* a2 = last ? nA : cA + (size_t)(t + 2) * kstep; const char* b2 = last ? nB : cB + (size_t)(t + 2) * kstep;
            const char* a3 = a2 + kstep; const char* b3 = b2 + kstep;
            PG8_LDB(B0, 0, 0); PG8_LDB(B1, 0, 1); PG8_SCHED; PG8_LDA(At, 0, 0); PG8_STAGE(PG8_SA(1, 1), a1 + hsA, voffA);
            PG8_WAIT_V(8); PG8_WAIT_L(0); PG8_BAR; PG8_MMA(0, 0, At, B0); PG8_MMA(0, 1, At, B1); PG8_BAR; PG8_SCHED;
            PG8_LDA(At, 0, 1); PG8_STAGE(PG8_SB(0, 0), b2, voffB); PG8_STAGE(PG8_SB(0, 1), b2 + hsB, voffB); PG8_STAGE(PG8_SA(0, 0), a2, voffA);
            PG8_WAIT_V(8); PG8_WAIT_L(0); PG8_BAR; PG8_MMA(1, 0, At, B0); PG8_MMA(1, 1, At, B1); PG8_BAR; PG8_SCHED;
            PG8_LDB(B0, 1, 0); PG8_LDB(B1, 1, 1); PG8_SCHED; PG8_LDA(At, 1, 0); PG8_STAGE(PG8_SA(0, 1), a2 + hsA, voffA);
            PG8_WAIT_V(8); PG8_WAIT_L(0); PG8_BAR; PG8_MMA(0, 0, At, B0); PG8_MMA(0, 1, At, B1); PG8_BAR; PG8_SCHED;
            PG8_LDA(At, 1, 1); PG8_STAGE(PG8_SB(1, 0), b3, voffB); PG8_STAGE(PG8_SB(1, 1), b3 + hsB, voffB); PG8_STAGE(PG8_SA(1, 0), a3, voffA);
            PG8_WAIT_V(8); PG8_WAIT_L(0); PG8_BAR; PG8_MMA(1, 0, At, B0); PG8_MMA(1, 1, At, B1); PG8_BAR; PG8_SCHED;
        }
        if (wr == 0) PG8_BAR;
        { int fr_ = fr, fq_ = fq; asm volatile("" : "+v"(fr_), "+v"(fq_)); E(acc, cur, wr, wc, fr_, fq_); S.done(cur, fq_ * 16 + fr_); }
        if (!has_next) break;
#pragma unroll
        for (int a = 0; a < 2; ++a)
#pragma unroll
            for (int b = 0; b < 2; ++b)
#pragma unroll
                for (int m = 0; m < 4; ++m)
#pragma unroll
                    for (int n = 0; n < 2; ++n) acc[a][b][m][n] = (f32x4){zf, zf, zf, zf};
        cur = nxt; cA = nA; cB = nB; ++ui;
        if (wr == 1) PG8_BAR;
    }
    PG8_WAIT_V(0);
    PG8_BAR;
#undef PG8_SA
#undef PG8_SB
#undef PG8_STAGE
#undef PG8_LDA
#undef PG8_LDB
#undef PG8_MMA
#undef PG8_WAIT_V
#undef PG8_WAIT_L
#undef PG8_BAR
#undef PG8_SCHED
#undef PG8_ABASE
#undef PG8_BBASE
}
}

enum EpiKind { EK_EVEN_IN = 0, EK_ODD_IN, EK_GATES, EK_RES, EK_SWIGLU };
template <int kind> struct Epi {
    int layer, sub; int gidx;
    const Params* p; int oz;
#define EWS(T, off) ((T*)(p->ws + ((size_t)(off) + (size_t)oz)))
#define EIN(i) (p->in[(i) + oz])
#define NORM_FIX_SETUP(NIDX, BOFF, NTOT) float rs_[2][4]; f32x4 bia_[2][2]; { const float* sq_ = p->out + oz + SSQP_OFF + (size_t)(NIDX) * M * 16; \
        _Pragma("unroll") for (int ai = 0; ai < 2; ++ai) _Pragma("unroll") for (int m = 0; m < 4; ++m) { const f32x4 a_ = *(const f32x4*)(sq_ + (size_t)(row0 + ai * 128 + m * 16) * 16 + 4 * fq); \
            float s_ = (a_[0] + a_[1]) + (a_[2] + a_[3]); s_ += shfl_x(s_, fq * 16 + fr, 16); s_ += shfl_x(s_, fq * 16 + fr, 32); rs_[ai][m] = frsq(s_ * (1.0f / D) + EPS); }     \
        const float* bp_ = EWS(const float, WS_BIAS) + (BOFF) + (size_t)cond_of_row(u.pm * 256) * (NTOT) + u.pn * 256 + wc * 32 + 8 * fq; \
        _Pragma("unroll") for (int bj = 0; bj < 2; ++bj) _Pragma("unroll") for (int n = 0; n < 2; ++n) bia_[bj][n] = *(const f32x4*)(bp_ + bj * 128 + 4 * n); }
#define FIXV(ai, bj, m, n) (acc[ai][bj][m][n] * rs_[ai][m] + bia_[bj][n])
    __device__ __forceinline__ void operator()(f32x4 (&acc)[2][2][4][2], const pg8::Unit& u, int wr, int wc, int fr, int fq) const {
        const int row0 = u.pm * 256 + wr * 64 + fr;
        float* const X = p->out + oz;
        if constexpr (kind == EK_RES) {
            const float* mod = EWS(const float, WS_MOD);
            const int ci = cond_of_row(u.pm * 256);
            const float* gate = mod + ((size_t)(layer * 5 + ci) * 6 + gidx) * 1024;
            const int col0 = u.pn * 256 + wc * 32 + 8 * fq;
            const int nn = (gidx == 2) ? 2 * layer + 1 : 2 * layer + 2;
            const bool fin = nn == 8;
            const float* nw = (gidx == 2) ? EIN(I_NFFN) + layer * 1024 : (fin ? EIN(I_NFIN) : EIN(I_NMIX) + (layer + 1) * 1024);
            const float* scv = mod + ((size_t)((gidx == 2 ? layer : (fin ? layer : layer + 1)) * 5 + ci) * 6 + (gidx == 2 ? 4 : 1)) * 1024;
            f32x4 gv[2][2], gp[2][2];
#pragma unroll
            for (int bj = 0; bj < 2; ++bj)
#pragma unroll
                for (int n = 0; n < 2; ++n) { gv[bj][n] = *(const f32x4*)(gate + col0 + bj * 128 + n * 4);
                    gp[bj][n] = *(const f32x4*)(nw + col0 + bj * 128 + n * 4); if (!fin) gp[bj][n] = gp[bj][n] * (1.0f + *(const f32x4*)(scv + col0 + bj * 128 + n * 4)); }
            bf16_t* XN = EWS(bf16_t, WS_XN); float* ssq = (fin ? EWS(float, WS_SSQ8) : p->out + oz + SSQP_OFF + (size_t)nn * M * 16) + u.pn * 4 + wc;
            const int lane_ = fq * 16 + fr;
            const char* Xb = (const char*)X; char* Xo = fin ? (char*)EWS(bf16_t, WS_XF) : (char*)X;
            const unsigned vo = (unsigned)(row0 * D + col0) * 2u, so = (unsigned)(row0 * 16) * 4u;
#define RES_OFF(vo, h8_, mm_, bj_) ((vo) + (unsigned)(((((h8_) >> 1) * 128 + (((h8_) & 1) * 2 + (mm_)) * 16) * D + (bj_) * 128) * 2))
            u32x4 xw[4][2][2];
#pragma unroll
            for (int h8 = 0; h8 < 4; ++h8)
#pragma unroll
                for (int mm = 0; mm < 2; ++mm)
#pragma unroll
                    for (int bj = 0; bj < 2; ++bj) xw[h8][mm][bj] = *(const u32x4*)(Xb + RES_OFF(vo, h8, mm, bj));
#pragma unroll
            for (int ai = 0; ai < 2; ++ai)
#pragma unroll
                for (int bj = 0; bj < 2; ++bj)
#pragma unroll
                    for (int m = 0; m < 4; ++m)
                    { acc[ai][bj][m][0] = acc[ai][bj][m][0] * gv[bj][0]; acc[ai][bj][m][1] = acc[ai][bj][m][1] * gv[bj][1];
                        asm volatile("" : "+v"(acc[ai][bj][m][0]), "+v"(acc[ai][bj][m][1])); }
#pragma unroll
            for (int h8 = 0; h8 < 4; ++h8) { const int ai = h8 >> 1, mb = (h8 & 1) * 2;
                __builtin_amdgcn_sched_barrier(0);
                unsigned vq = vo, sq_o = so; asm volatile("" : "+v"(vq), "+v"(sq_o));
#pragma unroll
                for (int mm = 0; mm < 2; ++mm) { const int m = mb + mm; float sq = 0.f;
#pragma unroll
                    for (int bj = 0; bj < 2; ++bj) { const u32x4 w = xw[h8][mm][bj];
                        const f32x4 x0 = (f32x4){bflo(w.x), bfhi(w.x), bflo(w.y), bfhi(w.y)} + acc[ai][bj][m][0], x1 = (f32x4){bflo(w.z), bfhi(w.z), bflo(w.w), bfhi(w.w)} + acc[ai][bj][m][1];
                        *(u32x4*)(Xo + RES_OFF(vq, h8, mm, bj)) = (u32x4){pk2(x0[0], x0[1]), pk2(x0[2], x0[3]), pk2(x1[0], x1[1]), pk2(x1[2], x1[3])};
                        sq += ((x0[0] * x0[0] + x0[1] * x0[1]) + (x0[2] * x0[2] + x0[3] * x0[3])) + ((x1[0] * x1[0] + x1[1] * x1[1]) + (x1[2] * x1[2] + x1[3] * x1[3]));
                        if (!fin) { const f32x4 y0 = x0 * gp[bj][0], y1 = x1 * gp[bj][1]; const u32x4 wv = (u32x4){pk2(y0[0], y0[1]), pk2(y0[2], y0[3]), pk2(y1[0], y1[1]), pk2(y1[2], y1[3])};
                            asm volatile("global_store_dwordx4 %0, %1, %2 sc1\n\ts_nop 1" :: "v"(RES_OFF(vq, h8, mm, bj)), "v"(wv), "s"(XN) : "memory"); } }
                    sq += shfl_x(sq, lane_, 16); sq += shfl_x(sq, lane_, 32);
                    if (fq == 0) __hip_atomic_store((float*)((char*)ssq + (sq_o + (unsigned)((ai * 128 + m * 16) * 64))), sq, __ATOMIC_RELAXED, __HIP_MEMORY_SCOPE_AGENT); }
            }
#undef RES_OFF
        } else if constexpr (kind == EK_SWIGLU) {
            bf16_t* H = EWS(bf16_t, WS_H); const int col0 = u.pn * 128 + wc * 32 + 8 * fq;
            NORM_FIX_SETUP(2 * layer + 1, BIAS_F + (size_t)layer * 5 * 5632, 5632)
#pragma unroll
            for (int ai = 0; ai < 2; ++ai)
#pragma unroll
                for (int m = 0; m < 4; ++m) { const f32x4 g0 = FIXV(ai, 0, m, 0), g1 = FIXV(ai, 0, m, 1), u0 = FIXV(ai, 1, m, 0), u1 = FIXV(ai, 1, m, 1);
#define SWG(g_, u_) ((g_) * (u_) * frcp(1.0f + fexp2(g_)))
                    u32x4 w; w.x = pk2(SWG(g0[0], u0[0]), SWG(g0[1], u0[1])); w.y = pk2(SWG(g0[2], u0[2]), SWG(g0[3], u0[3]));
                    w.z = pk2(SWG(g1[0], u1[0]), SWG(g1[1], u1[1])); w.w = pk2(SWG(g1[2], u1[2]), SWG(g1[3], u1[3]));
#undef SWG
                    bf16_t* hp = H + (size_t)(row0 + ai * 128 + m * 16) * DFF + col0;
                    asm volatile("global_store_dwordx4 %0, %1, off sc1\n\ts_nop 1" :: "v"(hp), "v"(w) : "memory"); }
        } else if constexpr (kind == EK_ODD_IN) {
            const bool isg = u.pn < 4; bf16_t* O = isg ? EWS(bf16_t, WS_G) : EWS(bf16_t, WS_U); const int colt = (isg ? u.pn : u.pn - 4) * 256 + wc * 32 + 8 * fq;
            NORM_FIX_SETUP(2 * layer, BIAS_O + (size_t)sub * 5 * 2048, 2048)
#pragma unroll
            for (int ai = 0; ai < 2; ++ai)
#pragma unroll
                for (int m = 0; m < 4; ++m) { bf16_t* rowp = O + (size_t)(row0 + ai * 128 + m * 16) * D + colt;
#pragma unroll
                    for (int bj = 0; bj < 2; ++bj) { f32x4 v0 = FIXV(ai, bj, m, 0), v1 = FIXV(ai, bj, m, 1);
                        if (isg) {
#pragma unroll
                            for (int j = 0; j < 4; ++j) { v0[j] = gelu_tanh(v0[j]); v1[j] = gelu_tanh(v1[j]); } }
                        u32x4 w; w.x = pk2(v0[0], v0[1]); w.y = pk2(v0[2], v0[3]); w.z = pk2(v1[0], v1[1]); w.w = pk2(v1[2], v1[3]);
                        *(u32x4*)(rowp + bj * 128) = w; } }
        } else if constexpr (kind == EK_GATES) {
            const int blk = u.pn >> 2, t = u.pn & 3, dir = t >> 1, half = t & 1;
            const int ch0 = blk * 256 + half * 128 + wc * 32 + 8 * fq;
            const size_t pofs = (size_t)(sub * 2 + dir) * 1024 + ch0;
            bf16_t* AC = dir ? EWS(bf16_t, WS_LAB) : EWS(bf16_t, WS_LAF); bf16_t* HL = dir ? EWS(bf16_t, WS_BB) : EWS(bf16_t, WS_U);
            const bf16_t* uc = EWS(const bf16_t, WS_UC); const float* ba = EIN(I_BGA); const float* bx = EIN(I_BGX); const float* lam = EIN(I_LAM); float* agg = EWS(float, WS_AGG);
#define SCQ(SHS, h, a) "v_fmac_f32_dpp %" #h ", %" #h ", %" #a " " SHS " row_mask:0xf bank_mask:0xf\n\tv_mul_f32_dpp %" #a ", %" #a ", %" #a " " SHS " row_mask:0xf bank_mask:0xf\n\t"
#define SCS(SHS) SCQ(SHS, 0, 4) SCQ(SHS, 1, 5) SCQ(SHS, 2, 6) SCQ(SHS, 3, 7)
#define SCAN_TOT(SH) asm volatile("s_nop 1\n\t" SCS(SH ":1") SCS(SH ":2") SCS(SH ":4") SCS(SH ":8") : "+v"(Ht[0]), "+v"(Ht[1]), "+v"(Ht[2]), "+v"(Ht[3]), "+v"(At[0]), "+v"(At[1]), "+v"(At[2]), "+v"(At[3]));
#define APQ(SHS, h, a, ht, at) "v_fmac_f32_dpp %" #h ", %" #ht ", %" #a " " SHS ":1 row_mask:0xf bank_mask:0xf\n\tv_mul_f32_dpp %" #a ", %" #at ", %" #a " " SHS ":1 row_mask:0xf bank_mask:0xf\n\t"
#define APPLY2(SH, m0, m1) asm volatile("s_nop 1\n\t" APQ(SH, 0, 8, 16, 20) APQ(SH, 1, 9, 17, 21) APQ(SH, 2, 10, 18, 22) APQ(SH, 3, 11, 19, 23) APQ(SH, 4, 12, 16, 20) APQ(SH, 5, 13, 17, 21) APQ(SH, 6, 14, 18, 22) APQ(SH, 7, 15, 19, 23) \
                : "+v"(H[m0][0]), "+v"(H[m0][1]), "+v"(H[m0][2]), "+v"(H[m0][3]), "+v"(H[m1][0]), "+v"(H[m1][1]), "+v"(H[m1][2]), "+v"(H[m1][3]), \
                  "+v"(A[m0][0]), "+v"(A[m0][1]), "+v"(A[m0][2]), "+v"(A[m0][3]), "+v"(A[m1][0]), "+v"(A[m1][1]), "+v"(A[m1][2]), "+v"(A[m1][3]) \
                : "v"(Ht[0]), "v"(Ht[1]), "v"(Ht[2]), "v"(Ht[3]), "v"(At[0]), "v"(At[1]), "v"(At[2]), "v"(At[3]));
            float ba_[8], bx_[8], c8_[8];
#pragma unroll
            for (int q = 0; q < 8; ++q) { ba_[q] = -LOG2E * ba[pofs + q]; bx_[q] = -LOG2E * bx[pofs + q];     c8_[q] = -8.0f * LOG2E * flog(1.0f + fexp(-lam[pofs + q])); }
            const int rowb = u.pm * 256 + wr * 64 + 4 * fr;
#pragma unroll
            for (int ai = 0; ai < 2; ++ai) {
                u32x4 ucw[4];
#pragma unroll
                for (int m = 0; m < 4; ++m) ucw[m] = *(const u32x4*)(uc + (size_t)(rowb + ai * 128 + m) * D + ch0);
                u32x2 pa[4], ph[4];
#pragma unroll
                for (int n = 0; n < 2; ++n) {
                    float A[4][4], H[4][4], At[4], Ht[4];
#pragma unroll
                    for (int m = 0; m < 4; ++m)
#pragma unroll
                        for (int j = 0; j < 4; ++j) { const int q = 4 * n + j; const unsigned uw = ucw[m][q >> 1]; const float ucv = (q & 1) ? bfhi(uw) : bflo(uw);
                            const float r = frcp(1.0f + fexp2(acc[ai][0][m][n][j] + ba_[q])), ig = frcp(1.0f + fexp2(acc[ai][1][m][n][j] + bx_[q]));
                            const float av = fexp2(c8_[q] * r); A[m][j] = av; H[m][j] = fsqrt(__builtin_fabsf(1.0f - av * av)) * ig * ucv; }
                    if (dir == 0) {
#pragma unroll
                        for (int m = 1; m < 4; ++m)
#pragma unroll
                            for (int j = 0; j < 4; ++j) { H[m][j] = A[m][j] * H[m - 1][j] + H[m][j]; A[m][j] *= A[m - 1][j]; }
#pragma unroll
                        for (int j = 0; j < 4; ++j) { At[j] = A[3][j]; Ht[j] = H[3][j]; }
                        SCAN_TOT("row_shr") APPLY2("row_shr", 0, 1) APPLY2("row_shr", 2, 3)
                    } else {
#pragma unroll
                        for (int m = 2; m >= 0; --m)
#pragma unroll
                            for (int j = 0; j < 4; ++j) { H[m][j] = A[m][j] * H[m + 1][j] + H[m][j]; A[m][j] *= A[m + 1][j]; }
#pragma unroll
                        for (int j = 0; j < 4; ++j) { At[j] = A[0][j]; Ht[j] = H[0][j]; }
                        SCAN_TOT("row_shl") APPLY2("row_shl", 0, 1) APPLY2("row_shl", 2, 3)
                    }
#pragma unroll
                    for (int m = 0; m < 4; ++m) { const u32x2 wa = (u32x2){pk2(A[m][0], A[m][1]), pk2(A[m][2], A[m][3])}, wh = (u32x2){pk2(H[m][0], H[m][1]), pk2(H[m][2], H[m][3])};
                        if (n == 0) { pa[m] = wa; ph[m] = wh; }
                        else { const size_t ro = (size_t)(rowb + ai * 128 + m) * D + ch0; *(u32x4*)(AC + ro) = (u32x4){pa[m].x, pa[m].y, wa.x, wa.y}; *(u32x4*)(HL + ro) = (u32x4){ph[m].x, ph[m].y, wh.x, wh.y}; } }
                    if (fr == (dir == 0 ? 15 : 0)) { float* ag = agg + ((size_t)((u.pm * 4 + ai * 2 + wr) * 2 + dir) * 1024 + ch0 + 4 * n) * 2;
                        *(f32x4*)ag = (f32x4){At[0], Ht[0], At[1], Ht[1]}; *(f32x4*)(ag + 4) = (f32x4){At[2], Ht[2], At[3], Ht[3]}; }
                }
            }
#undef APPLY2
#undef APQ
#undef SCAN_TOT
#undef SCS
#undef SCQ
        } else {
            bf16_t* ZE = EWS(bf16_t, WS_ZE); const int pn = u.pn; const bool lat = u.pm >= 16; float* lr = EWS(float, WS_LR); const float* rope = EWS(const float, WS_ROPE);
            NORM_FIX_SETUP(2 * layer, BIAS_E + (size_t)sub * 5 * 2560, 2560)
            if (pn == 9) {
                if (wc == 0) {
#pragma unroll
                    for (int ai = 0; ai < 2; ++ai)
#pragma unroll
                        for (int m = 0; m < 4; ++m) { float* p = lr + (size_t)(row0 + ai * 128 + m * 16) * 32 + 8 * fq; *(f32x4*)p = FIXV(ai, 0, m, 0); *(f32x4*)(p + 4) = FIXV(ai, 0, m, 1); }
                }
            } else if (pn <= 2) {
                const int half = wc & 1;
#pragma unroll
                for (int ai = 0; ai < 2; ++ai)
#pragma unroll
                    for (int m = 0; m < 4; ++m) { const int row = row0 + ai * 128 + m * 16;
                        const int tpos = (row - MCTX) & 4095; const int pos = half ? (tpos & 63) : (tpos >> 6);
                        f32x4 cs[4];
                        if (lat) {
#pragma unroll
                            for (int q = 0; q < 4; ++q) cs[q] = *(const f32x4*)(rope + (size_t)(pos * 16 + 8 * (fq & 1)) * 2 + q * 4);
                        }
#pragma unroll
                        for (int bj = 0; bj < 2; ++bj) { f32x4 v0 = FIXV(ai, bj, m, 0), v1 = FIXV(ai, bj, m, 1);
                            const bool isv = (pn == 2 && bj == 1), isk = (pn == 2 && bj == 0);
                            if (pn == 2 && !lat) {
                                const int b = row >> 8, tt = row & 255; const int kc = wc * 32 + 8 * fq;
                                float* dst = X + (isv ? OUT_CV : OUT_CK) + ((size_t)(b * 2 + sub) * 256 + tt) * 128 + kc;
                                *(f32x4*)dst = v0; *(f32x4*)(dst + 4) = v1;
                            }
                            if (lat && !isv) {
                                float x[8] = {v0[0], v0[1], v0[2], v0[3], v1[0], v1[1], v1[2], v1[3]}; float o[8];
#pragma unroll
                                for (int q = 0; q < 8; ++q) { const float pr = shfl_x(x[q], fq * 16 + fr, 32); const float c = cs[q >> 1][(q & 1) * 2], s = cs[q >> 1][(q & 1) * 2 + 1];
                                    o[q] = x[q] * c + (fq < 2 ? -pr : pr) * s; }
                                v0 = (f32x4){o[0], o[1], o[2], o[3]}; v1 = (f32x4){o[4], o[5], o[6], o[7]};
                            }
                            if (!isk && !isv) { v0 *= QSCALE; v1 *= QSCALE; }
                            u32x4 w; w.x = pk2(v0[0], v0[1]); w.y = pk2(v0[2], v0[3]); w.z = pk2(v1[0], v1[1]); w.w = pk2(v1[2], v1[3]);
                            *(u32x4*)(ZE + (size_t)row * ZW + pn * 256 + bj * 128 + wc * 32 + 8 * fq) = w; } }
            } else {
                const float sc = (pn == 3) ? 0.125f : 1.0f; const bool act = pn >= 7;
#pragma unroll
                for (int ai = 0; ai < 2; ++ai)
#pragma unroll
                    for (int m = 0; m < 4; ++m) { bf16_t* rowp = ZE + (size_t)(row0 + ai * 128 + m * 16) * ZW + pn * 256 + wc * 32 + 8 * fq;
#pragma unroll
                        for (int bj = 0; bj < 2; ++bj) { f32x4 v0 = FIXV(ai, bj, m, 0) * sc, v1 = FIXV(ai, bj, m, 1) * sc;
                            if (act) {
#pragma unroll
                                for (int j = 0; j < 4; ++j) { v0[j] = siluf_(v0[j]); v1[j] = siluf_(v1[j]); } }
                            u32x4 w; w.x = pk2(v0[0], v0[1]); w.y = pk2(v0[2], v0[3]); w.z = pk2(v1[0], v1[1]); w.w = pk2(v1[2], v1[3]);
                            *(u32x4*)(rowp + bj * 128) = w; } }
            }
        }
    }
#undef EWS
#undef EIN
#undef NORM_FIX_SETUP
#undef FIXV
};

#define XB_TMO      128
#define XB_XCNT(j)  (256  + 64 * (j))
#define XB_XSUB(j)  (1280 + 64 * (j))
#define XB_XGEN(j)  (2304 + 64 * (j))
#define XB_TOP      3328
#define XB_TOPGEN   3392
#define XCD_BAR_WORDS 3456
#define XB_SPIN_CAP (1u << 18)
__device__ __forceinline__ unsigned xb_ld(unsigned* p)              { return __hip_atomic_load(p, __ATOMIC_RELAXED, __HIP_MEMORY_SCOPE_AGENT); }
__device__ __forceinline__ unsigned xb_add(unsigned* p, unsigned v) { return __hip_atomic_fetch_add(p, v, __ATOMIC_RELAXED, __HIP_MEMORY_SCOPE_AGENT); }
__device__ __forceinline__ unsigned xb_xcc_id() { return (unsigned)__builtin_amdgcn_s_getreg((3 << 11) | 20) & 0xFu; }
#define XB_SPIN(cond, bar) do { unsigned _sp = 0; while (cond) { __builtin_amdgcn_s_sleep(1); \
    if ((++_sp & 255u) == 0u) { if (xb_ld(&(bar)[XB_TMO])) break; if (_sp > XB_SPIN_CAP) { atomicAdd(&(bar)[XB_TMO], 1u); break; } } } } while (0)
struct XcdBarrier { unsigned* bar; unsigned x; volatile LAS unsigned* st; };
__device__ __forceinline__ XcdBarrier xcd_barrier_post(unsigned* bar, volatile LAS unsigned* st) {
    XcdBarrier b; b.bar = bar; b.x = xb_xcc_id(); b.st = st;
    if (threadIdx.x == 0) (void)xb_add(&bar[XB_XCNT(b.x)], 1u);
    return b;
}
__device__ __forceinline__ void xcd_barrier_complete(unsigned* bar, unsigned x, unsigned& nloc, unsigned& nx) {
    const unsigned G = gridDim.x * gridDim.y * gridDim.z;
    unsigned sum, cnt, mine, sp = 0u;
    for (;;) {
        sum = 0u; cnt = 0u; mine = 0u;
#pragma unroll
        for (unsigned j = 0; j < 16; ++j) { const unsigned c = xb_ld(&bar[XB_XCNT(j)]); sum += c; cnt += (c > 0u) ? 1u : 0u; mine = (j == x) ? c : mine; }
        if (sum == G) break;
        __builtin_amdgcn_s_sleep(1);
        if ((++sp & 255u) == 0u) { if (xb_ld(&bar[XB_TMO])) break; if (sp > XB_SPIN_CAP) { atomicAdd(&bar[XB_TMO], 1u); break; } }
    }
    nloc = mine > 0u ? mine : 1u; nx = cnt > 0u ? cnt : 1u;
}
__device__ __forceinline__ void xcd_barrier(const XcdBarrier& b, const int tid) {
    asm volatile("s_waitcnt vmcnt(0)" ::: "memory");
    __syncthreads();
    if (tid == 0) {
        unsigned* bar = b.bar;
        __builtin_amdgcn_s_waitcnt(0);
        unsigned nloc = b.st[0], nx = b.st[1];
        if (nloc == 0u) { xcd_barrier_complete(bar, b.x, nloc, nx); b.st[0] = nloc; b.st[1] = nx; }
        const unsigned old = xb_add(&bar[XB_XSUB(b.x)], 1u);
        const unsigned gen = old / nloc;
        if (old + 1u == (gen + 1u) * nloc) {
            __builtin_amdgcn_fence(__ATOMIC_RELEASE, "agent");
            asm volatile("s_waitcnt vmcnt(0)" ::: "memory");
            const unsigned og = xb_add(&bar[XB_TOP], 1u);
            const unsigned tg = og / nx;
            if (og + 1u == (tg + 1u) * nx) xb_add(&bar[XB_TOPGEN], 1u);
            else XB_SPIN(xb_ld(&bar[XB_TOPGEN]) == tg, bar);
            __builtin_amdgcn_fence(__ATOMIC_ACQUIRE, "agent");
            xb_add(&bar[XB_XGEN(b.x)], 1u);
            asm volatile("s_waitcnt vmcnt(0)" ::: "memory");
        } else {
            XB_SPIN(xb_ld(&bar[XB_XGEN(b.x)]) == gen, bar);
            __builtin_amdgcn_fence(__ATOMIC_ACQUIRE, "agent");
            asm volatile("s_waitcnt vmcnt(0)" ::: "memory");
        }
    }
    __syncthreads();
}

struct Frame {
    lptr lds; int tid, lane, wave, vcu, G;
    const Params* p; float* out; int oz, bid;
};
#define FIN(i) (F.p->in[(i) + F.oz])
#define WSP(T, off) ((T*)(F.p->ws + ((size_t)(off) + (size_t)F.oz)))

__device__ __forceinline__ void transpose_block(const float* src, int ldw, bf16_t* dst, int ldt, LAS float* scr, int lane, float scale) {
    { f32x4 tv[8];
      const int rr = lane >> 3, n4 = (lane & 7) * 4;
#pragma unroll
      for (int i = 0; i < 8; ++i) tv[i] = *(const f32x4*)(src + (size_t)(8 * i + rr) * ldw + n4);
#pragma unroll
      for (int i = 0; i < 8; ++i) { LAS float* d = scr + (8 * i + rr) * 33 + n4; d[0] = tv[i][0] * scale; d[1] = tv[i][1] * scale; d[2] = tv[i][2] * scale; d[3] = tv[i][3] * scale; } }
    LDS_WAIT(); asm volatile("" ::: "memory");
    const int c = lane & 7;
#pragma unroll
    for (int j = 0; j < 4; ++j) { const int n = (lane >> 3) + 8 * j; const LAS float* s = scr + (8 * c) * 33 + n;
        u32x4 o; o.x = pk2(s[0 * 33], s[1 * 33]); o.y = pk2(s[2 * 33], s[3 * 33]); o.z = pk2(s[4 * 33], s[5 * 33]); o.w = pk2(s[6 * 33], s[7 * 33]);
        *(u32x4*)(dst + (size_t)n * ldt + 8 * c) = o; }
    LDS_WAIT(); asm volatile("" ::: "memory");
}
constexpr int IT_WINE = 16 * 73, IT_SQ = 512, IT_WINO = 1024, IT_GATES = 512, IT_F1 = 16 * 176, IT_F2 = 44 * 32;
constexpr int IT_E = IT_WINE + IT_SQ, IT_O = IT_WINO + IT_GATES + IT_SQ, IT_L = IT_F1 + IT_F2;
constexpr int IT_TOTAL = 2 * IT_E + 2 * IT_O + 4 * IT_L;

__device__ __forceinline__ void convert_item(Frame& F, int it, LAS float* scr) {
    const float* src; int ldw; bf16_t* dst; int ldt; float scale = 1.0f;
    if (it < 2 * IT_E) {
        const int e = it / IT_E; int r = it % IT_E;
        if (r < IT_WINE) { const int kb = r / 73, nb = r % 73;
            src = FIN(I_WINE) + (size_t)e * D * PE + (size_t)(64 * kb) * PE + 32 * nb; ldw = PE; dst = WSP(bf16_t, WS_WINE) + (size_t)e * PEP * D + (size_t)(32 * nb) * D + 64 * kb; ldt = D;
        } else { r -= IT_WINE; const int kb = r / 32, nb = r % 32;
            src = FIN(I_WOUTE) + (size_t)e * D * D + (size_t)(64 * kb) * D + 32 * nb; ldw = D; dst = WSP(bf16_t, WS_WOUTE) + (size_t)e * D * D + (size_t)(32 * nb) * D + 64 * kb; ldt = D; }
    } else if (it < 2 * IT_E + 2 * IT_O) {
        const int i2 = it - 2 * IT_E; const int o = i2 / IT_O; int r = i2 % IT_O;
        if (r < IT_WINO) { const int kb = r / 64, nb = r % 64;
            src = FIN(I_WINO) + (size_t)o * D * 2048 + (size_t)(64 * kb) * 2048 + 32 * nb; ldw = 2048; dst = WSP(bf16_t, WS_WINO) + (size_t)o * 2048 * D + (size_t)(32 * nb) * D + 64 * kb; ldt = D;
        } else if (r < IT_WINO + IT_GATES) { r -= IT_WINO;
            const int mat = r >> 5, q = r & 31, kb = q >> 3, nb = q & 7; const int isx = mat >> 3, dir = (mat >> 2) & 1, blk = mat & 3;
            src = FIN(isx ? I_WGX : I_WGA) + ((size_t)((o * 2 + dir) * 4 + blk)) * 65536 + (size_t)(64 * kb) * 256 + 32 * nb; ldw = 256;
            const int d0 = 32 * nb, half = d0 >> 7; const int drow = blk * 1024 + (dir * 2 + half) * 256 + isx * 128 + (d0 & 127);
            dst = WSP(bf16_t, WS_WG) + (size_t)o * 4096 * 256 + (size_t)drow * 256 + 64 * kb; ldt = 256; scale = -LOG2E;
        } else { r -= IT_WINO + IT_GATES; const int kb = r / 32, nb = r % 32;
            src = FIN(I_WOUTO) + (size_t)o * D * D + (size_t)(64 * kb) * D + 32 * nb; ldw = D; dst = WSP(bf16_t, WS_WOUTO) + (size_t)o * D * D + (size_t)(32 * nb) * D + 64 * kb; ldt = D; }
    } else {
        const int i3 = it - 2 * IT_E - 2 * IT_O; const int l = i3 / IT_L; int r = i3 % IT_L;
        if (r < IT_F1) { const int kb = r / 176, nb = r % 176; const int n0 = 32 * nb; const int isu = n0 >= DFF; const int c = n0 - isu * DFF; const int drow = (c >> 7) * 256 + isu * 128 + (c & 127);
            src = FIN(I_WF1) + (size_t)l * D * 5632 + (size_t)(64 * kb) * 5632 + n0; ldw = 5632; dst = WSP(bf16_t, WS_WF1) + (size_t)l * 5632 * D + (size_t)drow * D + 64 * kb; ldt = D; scale = isu ? -0.6931471805599453f : -LOG2E;
        } else { r -= IT_F1; const int kb = r / 32, nb = r % 32;
            src = FIN(I_WF2) + (size_t)l * DFF * D + (size_t)(64 * kb) * D + 32 * nb; ldw = D; dst = WSP(bf16_t, WS_WF2) + (size_t)l * D * DFF + (size_t)(32 * nb) * DFF + 64 * kb; ldt = DFF; }
    }
    transpose_block(src, ldw, dst, ldt, scr, F.lane, scale);
}

__device__ __forceinline__ void phase_prologue(Frame& F) {
    const int tid = F.tid, lane = F.lane, wave = F.wave;
    const int gt = F.vcu * NTHREADS + tid, NGT = F.G * NTHREADS;
    {
        LAS float* sil = (LAS float*)F.lds;
        LAS float* red = (LAS float*)(F.lds + 20480);
        for (int i = tid; i < 5 * 1024; i += NTHREADS) { const int ci = i >> 10, k = i & 1023; const float v = ci == 0 ? FIN(I_CCTX)[k] : FIN(I_C)[(ci - 1) * 1024 + k]; sil[i] = siluf_(v); }
        __syncthreads();
        for (int item = F.vcu; item < 4 * 48; item += F.G) {
            const int l = item / 48, n0 = (item % 48) * 128;
            const float* wp = FIN(I_WADA) + ((size_t)l * 1024 + wave * 128) * 6144 + n0 + 2 * lane;
            float a0[5] = {0.f, 0.f, 0.f, 0.f, 0.f}, a1[5] = {0.f, 0.f, 0.f, 0.f, 0.f};
#pragma unroll 8
            for (int kk = 0; kk < 128; ++kk) { const f32x2 w = *(const f32x2*)(wp + (size_t)kk * 6144);
#pragma unroll
                for (int ci = 0; ci < 5; ++ci) { const float s = sil[ci * 1024 + wave * 128 + kk]; a0[ci] += s * w.x; a1[ci] += s * w.y; } }
#pragma unroll
            for (int ci = 0; ci < 5; ++ci) { red[(wave * 5 + ci) * 128 + 2 * lane] = a0[ci]; red[(wave * 5 + ci) * 128 + 2 * lane + 1] = a1[ci]; }
            __syncthreads();
            for (int i = tid; i < 640; i += NTHREADS) { const int ci = i >> 7, n = i & 127; float s = FIN(I_BADA)[l * 6144 + n0 + n];
#pragma unroll
                for (int w = 0; w < 8; ++w) s += red[(w * 5 + ci) * 128 + n];
                WSP(float, WS_MOD)[(size_t)(l * 5 + ci) * 6144 + n0 + n] = s; }
            __syncthreads();
        }
    }
    for (int i = gt; i < 1024; i += NGT) { const int pos = i >> 4, fi = i & 15; const float inv = fexp2(-(float)fi * (13.287712379549449f / 16.0f)); const float a = (float)pos * inv;
        WSP(float, WS_ROPE)[2 * i] = __cosf(a); WSP(float, WS_ROPE)[2 * i + 1] = __sinf(a); }
    for (int i = gt; i < 4 * 2 * 256 * 128 / 4; i += NGT) { const f32x4 k = ((const f32x4*)FIN(I_CK))[i], v = ((const f32x4*)FIN(I_CV))[i];
        u32x2 a; a.x = pk2(k[0], k[1]); a.y = pk2(k[2], k[3]); ((u32x2*)WSP(bf16_t, WS_CK))[i] = a; a.x = pk2(v[0], v[1]); a.y = pk2(v[2], v[3]); ((u32x2*)WSP(bf16_t, WS_CV))[i] = a; }
    for (int i = gt; i < 2 * (PEP - PE) * D / 8; i += NGT) { const int e = i / ((PEP - PE) * D / 8), r = i % ((PEP - PE) * D / 8);
        ((u32x4*)(WSP(bf16_t, WS_WINE) + (size_t)e * PEP * D + (size_t)PE * D))[r] = (u32x4){0u, 0u, 0u, 0u}; }
    {
        LAS float* scr = (LAS float*)(F.lds + 40960 + wave * 8704);
        const int gw = F.vcu * NWAVES + wave, NGW = F.G * NWAVES;
        for (int it = gw; it < IT_TOTAL; it += NGW) convert_item(F, it, scr);
    }
}

__device__ __forceinline__ void bias_rows(Frame& F, int mi, int n0, int cnt, int stride) {
    const int lane = F.lane; const float* mod = WSP(float, WS_MOD); float* bias = WSP(float, WS_BIAS);
    const int l = mi < 2 ? 2 * mi : mi < 4 ? 2 * (mi - 2) + 1 : mi - 4; const int shj = mi < 4 ? 0 : 3;
    const int N = mi < 2 ? 2560 : mi < 4 ? 2048 : 5632;
    const bf16_t* W = mi < 2 ? WSP(bf16_t, WS_WINE) + (size_t)mi * PEP * D : mi < 4 ? WSP(bf16_t, WS_WINO) + (size_t)(mi - 2) * 2048 * D : WSP(bf16_t, WS_WF1) + (size_t)(mi - 4) * 5632 * D;
    float* bo = bias + (mi < 2 ? BIAS_E + (size_t)mi * 5 * 2560 : mi < 4 ? BIAS_O + (size_t)(mi - 2) * 5 * 2048 : BIAS_F + (size_t)(mi - 4) * 5 * 5632);
    f32x4 sh[5][4];
#pragma unroll
    for (int ci = 0; ci < 5; ++ci)
#pragma unroll
        for (int q = 0; q < 4; ++q) sh[ci][q] = *(const f32x4*)(mod + ((size_t)(l * 5 + ci) * 6 + shj) * 1024 + 16 * lane + 4 * q);
    u32x4 wq0[8], wq1[8];
    const bool chunk = (cnt == 8 && stride == 1);
    if (chunk) {
#pragma unroll
        for (int i = 0; i < 8; ++i) { wq0[i] = *(const u32x4*)(W + (size_t)(n0 + i) * D + 16 * lane); wq1[i] = *(const u32x4*)(W + (size_t)(n0 + i) * D + 16 * lane + 8); } }
    for (int i0 = 0; i0 < cnt; i0 += 8)
#pragma unroll
    for (int i = 0; i < 8; ++i) { if (i0 + i >= cnt) break; const int n = n0 + (i0 + i) * stride;
        u32x4 w0, w1; if (chunk) { w0 = wq0[i]; w1 = wq1[i]; } else { w0 = *(const u32x4*)(W + (size_t)n * D + 16 * lane); w1 = *(const u32x4*)(W + (size_t)n * D + 16 * lane + 8); }
        const float wf[16] = {bflo(w0.x), bfhi(w0.x), bflo(w0.y), bfhi(w0.y), bflo(w0.z), bfhi(w0.z), bflo(w0.w), bfhi(w0.w), bflo(w1.x), bfhi(w1.x), bflo(w1.y), bfhi(w1.y), bflo(w1.z), bfhi(w1.z), bflo(w1.w), bfhi(w1.w)};
        float r[5];
#pragma unroll
        for (int ci = 0; ci < 5; ++ci) { float a = 0.f;
#pragma unroll
            for (int q = 0; q < 16; ++q) a += sh[ci][q >> 2][q & 3] * wf[q];
            r[ci] = wave_sum(a, lane); }
        if (lane < 5) bo[(size_t)lane * N + n] = lane == 0 ? r[0] : lane == 1 ? r[1] : lane == 2 ? r[2] : lane == 3 ? r[3] : r[4];
    }
}
__device__ __forceinline__ void phase_bias_rest(Frame& F) {
    unsigned* qc = WSP(unsigned, WS_CTL) + CW_BIAS + 16 * (F.bid & 7);
    for (;;) { unsigned j = 0; if (F.lane == 0) j = __hip_atomic_fetch_add(qc, 1u, __ATOMIC_RELAXED, __HIP_MEMORY_SCOPE_AGENT); j = (unsigned)__builtin_amdgcn_readfirstlane((int)j);
        if (j >= 456u) break;
        int row = ((int)j * 8 + (F.bid & 7)) * 8, mi;
        if (row < 2560) mi = 1; else if (row < 4608) { mi = 2; row -= 2560; } else if (row < 6656) { mi = 3; row -= 4608; } else { row -= 6656; mi = 4 + row / 5632; row = row % 5632; }
        bias_rows(F, mi, row, 8, 1); }
}
__device__ __forceinline__ void phase_pre(Frame& F) {
    const int lane = F.lane; const int gw = F.vcu * NWAVES + F.wave, NGW = F.G * NWAVES;
    const float* mod = WSP(float, WS_MOD);
    for (int mi = 0; mi < (F.p->step_hi - F.p->step_lo > 1 ? 1 : 8); ++mi) { const int N = mi < 2 ? 2560 : mi < 4 ? 2048 : 5632; if (gw < N) bias_rows(F, mi, gw, (N - gw + NGW - 1) / NGW, NGW); }
    {
        const float* gvec = FIN(I_NMIX); bf16_t* XN = WSP(bf16_t, WS_XN); float* ssq = F.out + SSQP_OFF; bf16_t* Xb = (bf16_t*)F.out;
        f32x4 gg[4]; int cur_ci = -1;
        f32x4 vn[4];
#define PRE_XIN(row_) ((row_) < MCTX ? FIN(I_XP) + (size_t)(row_) * D : FIN(I_XS) + (size_t)((row_) - MCTX) * D)
        { const float* x0 = PRE_XIN(gw * 10);
#pragma unroll
          for (int j = 0; j < 4; ++j) vn[j] = *(const f32x4*)(x0 + 4 * lane + 256 * j); }
        for (int r = 0; r < 10; ++r) {
            const int row = gw * 10 + r; const int ci = cond_of_row(row);
            if (ci != cur_ci) { cur_ci = ci;
#pragma unroll
                for (int j = 0; j < 4; ++j) { const int col = 4 * lane + 256 * j; gg[j] = *(const f32x4*)(gvec + col) * (1.0f + *(const f32x4*)(mod + ((size_t)ci * 6 + 1) * 1024 + col)); } }
            f32x4 v[4]; float s = 0.f;
#pragma unroll
            for (int j = 0; j < 4; ++j) v[j] = vn[j];
            { const int rn = r + 1 < 10 ? row + 1 : row; const float* xn = PRE_XIN(rn);
#pragma unroll
              for (int j = 0; j < 4; ++j) vn[j] = *(const f32x4*)(xn + 4 * lane + 256 * j); }
#pragma unroll
            for (int j = 0; j < 4; ++j) s += (v[j].x * v[j].x + v[j].y * v[j].y) + (v[j].z * v[j].z + v[j].w * v[j].w);
            s = wave_sum(s, lane);
            if (lane < 16) ssq[(size_t)row * 16 + lane] = lane == 0 ? s : 0.f;
#pragma unroll
            for (int j = 0; j < 4; ++j) { const f32x4 y = v[j] * gg[j]; *(u32x2*)(XN + (size_t)row * D + 4 * lane + 256 * j) = (u32x2){pk2(y[0], y[1]), pk2(y[2], y[3])};
                *(u32x2*)(Xb + (size_t)row * D + 4 * lane + 256 * j) = (u32x2){pk2(v[j][0], v[j][1]), pk2(v[j][2], v[j][3])}; }
        }
#undef PRE_XIN
    }
}
__device__ __forceinline__ void phase_final(Frame& F) {
    const int lane = F.lane; const int gw = F.vcu * NWAVES + F.wave;
    const float* gvec = FIN(I_NFIN); const float* ssq = WSP(float, WS_SSQ8); const bf16_t* XF = WSP(bf16_t, WS_XF);
    f32x4 gg[4];
#pragma unroll
    for (int j = 0; j < 4; ++j) gg[j] = *(const f32x4*)(gvec + 4 * lane + 256 * j);
    float rs[10];
#pragma unroll
    for (int r = 0; r < 10; ++r) { const int row = gw * 10 + r; const f32x4* q_ = (const f32x4*)(ssq + (size_t)row * 16); const f32x4 a_ = q_[0], b_ = q_[1], c_ = q_[2], d_ = q_[3];
        rs[r] = frsq(((((a_[0] + a_[1]) + (a_[2] + a_[3])) + ((b_[0] + b_[1]) + (b_[2] + b_[3]))) + (((c_[0] + c_[1]) + (c_[2] + c_[3])) + ((d_[0] + d_[1]) + (d_[2] + d_[3])))) * (1.0f / D) + EPS); }
#pragma unroll
    for (int r = 0; r < 10; ++r) { const int row = gw * 10 + r; float* yr = F.out + (size_t)row * D; const bf16_t* xr = XF + (size_t)row * D;
#pragma unroll
        for (int j = 0; j < 4; ++j) { const u32x2 w = *(const u32x2*)(xr + 4 * lane + 256 * j); const f32x4 x = {bflo(w.x), bfhi(w.x), bflo(w.y), bfhi(w.y)}; *(f32x4*)(yr + 4 * lane + 256 * j) = x * rs[r] * gg[j]; } }
}

__device__ __forceinline__ void attn_unit(Frame& F, int e, int kind, int b, int kvh, int qb, int hp) {
    const int lane = F.lane, w = F.wave, r32 = lane & 31, hh = lane >> 5;
    const bf16_t* ZE = WSP(bf16_t, WS_ZE);
    const int head = kvh * 4 + hp * 2 + (w >> 2);
    const int seqbase = kind == 0 ? MCTX + b * TLAT : b * TCTX;
    const int qloc = qb * 128 + (w & 3) * 32 + r32;
    const int iloc = (w & 3) * 32 + r32;
    bf16x8 qr[4];
#pragma unroll
    for (int d0 = 0; d0 < 4; ++d0) qr[d0] = *(const bf16x8*)(ZE + (size_t)(seqbase + qloc) * ZW + head * 64 + d0 * 16 + hh * 8);
    const int wt0 = (kind == 0 && qb == 0) ? 2 : 0, wt1 = (kind == 0) ? ((qb == 31) ? 4 : 6) : 0;
    const int NT = 4 + (wt1 - wt0);
    float m_run = FIN(I_SINK)[e * 8 + head] * LOG2E; float l_run = hh == 0 ? 1.0f : 0.0f;
    f32x16 o0 = {}, o1 = {};
    const int kkey = lane, kchunk = w;
    const int vkey = 16 * (w & 3) + (lane >> 2), vdh = w >> 2, vpiece = lane & 3;
    const unsigned kdstw = (unsigned)(kchunk * 1024), vdstw = (unsigned)(24576 + vdh * 4096 + (w & 3) * 1024);
    int mtype = 0, joff = 0;
    auto tile_ptrs = [&](int t, const bf16_t*& kp, const bf16_t*& vp, int& pitch, int& mt, int& jo) {
        if (kind == 0 && t < 4) { const size_t base = ((size_t)(b * 2 + e) * 256 + 64 * t) * 128 + kvh * 64; kp = WSP(bf16_t, WS_CK) + base; vp = WSP(bf16_t, WS_CV) + base; pitch = 128; mt = 0; jo = 0; }
        else if (kind == 0) { const int wt = t - 4 + wt0; const int blk = qb - 1 + (wt >> 1); const size_t row = (size_t)seqbase + blk * 128 + (wt & 1) * 64;
            kp = ZE + row * ZW + 512 + kvh * 64; vp = ZE + row * ZW + 640 + kvh * 64; pitch = ZW; mt = (blk < qb) ? 1 : (blk > qb) ? 2 : 0; jo = (wt & 1) * 64; }
        else { const size_t row = (size_t)seqbase + 64 * t; kp = ZE + row * ZW + 512 + kvh * 64; vp = ZE + row * ZW + 640 + kvh * 64; pitch = ZW; mt = 0; jo = 0; }
    };
#define ATT_ISSUE(t, slot) do { const bf16_t *kp_, *vp_; int pitch_, mt_, jo_; tile_ptrs((t), kp_, vp_, pitch_, mt_, jo_); \
        __builtin_amdgcn_global_load_lds((const unsigned*)(kp_ + (size_t)kkey * pitch_ + kchunk * 8), (LAS unsigned*)(F.lds + (slot) * 8192 + kdstw), 16, 0, 0); \
        __builtin_amdgcn_global_load_lds((const unsigned*)(vp_ + (size_t)vkey * pitch_ + vdh * 32 + vpiece * 8), (LAS unsigned*)(F.lds + (slot) * 8192 + vdstw), 16, 0, 0); } while (0)
    ATT_ISSUE(0, 0); if (NT > 1) ATT_ISSUE(1, 1);
    int slot = 0;
    for (int t = 0; t < NT; ++t) {
        if (t + 1 < NT) asm volatile("s_waitcnt vmcnt(2)" ::: "memory"); else asm volatile("s_waitcnt vmcnt(0)" ::: "memory");
        asm volatile("s_waitcnt lgkmcnt(0)" ::: "memory"); __builtin_amdgcn_s_barrier(); asm volatile("" ::: "memory");
        if (t + 2 < NT) { const int s2 = slot >= 1 ? slot - 1 : 2; ATT_ISSUE(t + 2, s2); }
        { const bf16_t *kp_, *vp_; int pitch_; tile_ptrs(t, kp_, vp_, pitch_, mtype, joff); }
        const int buf = slot;
        const lptr kb = F.lds + buf * 8192 + hh * 1024 + r32 * 16;
        f32x16 p0 = {}, p1 = {};
#pragma unroll
        for (int d0 = 0; d0 < 4; ++d0) { const bf16x8 k0 = *(const LAS bf16x8*)(kb + d0 * 2048), k1 = *(const LAS bf16x8*)(kb + d0 * 2048 + 512);
            p0 = __builtin_amdgcn_mfma_f32_32x32x16_bf16(k0, qr[d0], p0, 0, 0, 0); p1 = __builtin_amdgcn_mfma_f32_32x32x16_bf16(k1, qr[d0], p1, 0, 0, 0); }
        if (mtype != 0) {
            asm volatile("" ::: "memory");
            const int lo = (mtype == 1) ? iloc : 0, hi = (mtype == 1) ? 255 : iloc; const unsigned span = (unsigned)(hi - lo); const int jb = joff + 4 * hh - lo;
#pragma unroll
            for (int r = 0; r < 16; ++r) { const int c0 = (r & 3) + 8 * (r >> 2);
                if ((unsigned)(jb + c0) > span) p0[r] = -1e30f; if ((unsigned)(jb + c0 + 32) > span) p1[r] = -1e30f; }
        }
        float mx = __builtin_elementwise_maximum(p0[0], p1[0]);
#pragma unroll
        for (int r = 1; r < 16; ++r) mx = __builtin_elementwise_maximum(mx, __builtin_elementwise_maximum(p0[r], p1[r]));
        mx = fmaxf(mx, shfl_x(mx, lane, 32));
        const float m_new = fmaxf(m_run, mx); const float alpha = fexp2(m_run - m_new); m_run = m_new;
        float ps = 0.f;
#pragma unroll
        for (int r = 0; r < 16; ++r) { p0[r] = fexp2(p0[r] - m_new); p1[r] = fexp2(p1[r] - m_new); ps += p0[r] + p1[r]; }
        l_run = l_run * alpha + ps;
#pragma unroll
        for (int r = 0; r < 16; ++r) { o0[r] *= alpha; o1[r] *= alpha; }
        u32x4 pw[4];
#pragma unroll
        for (int s = 0; s < 2; ++s) { pw[s] = (u32x4){pk2(p0[8 * s], p0[8 * s + 1]), pk2(p0[8 * s + 2], p0[8 * s + 3]), pk2(p0[8 * s + 4], p0[8 * s + 5]), pk2(p0[8 * s + 6], p0[8 * s + 7])};
            pw[2 + s] = (u32x4){pk2(p1[8 * s], p1[8 * s + 1]), pk2(p1[8 * s + 2], p1[8 * s + 3]), pk2(p1[8 * s + 4], p1[8 * s + 5]), pk2(p1[8 * s + 6], p1[8 * s + 7])}; }
        const lptr vb = F.lds + 24576 + buf * 8192 + ((lane >> 4) & 1) * 32 + (lane & 3) * 8 + (4 * hh + ((lane & 15) >> 2)) * 64;
#pragma unroll
        for (int s = 0; s < 4; ++s) { const bf16x8 v0 = tr_frag(vb + s * 1024), v1 = tr_frag(vb + 4096 + s * 1024);
            o0 = __builtin_amdgcn_mfma_f32_32x32x16_bf16(v0, __builtin_bit_cast(bf16x8, pw[s]), o0, 0, 0, 0);
            o1 = __builtin_amdgcn_mfma_f32_32x32x16_bf16(v1, __builtin_bit_cast(bf16x8, pw[s]), o1, 0, 0, 0); }
        slot = slot == 2 ? 0 : slot + 1;
    }
#undef ATT_ISSUE
    asm volatile("s_waitcnt lgkmcnt(0)" ::: "memory"); __builtin_amdgcn_s_barrier(); asm volatile("" ::: "memory");
    const float lt = l_run + shfl_x(l_run, lane, 32); const float inv = frcp(lt);
    bf16_t* orow = WSP(bf16_t, WS_MIX) + (size_t)(seqbase + qloc) * D + head * 64;
#pragma unroll
    for (int g = 0; g < 4; ++g) { u32x2 a; a.x = pk2(o0[4 * g] * inv, o0[4 * g + 1] * inv); a.y = pk2(o0[4 * g + 2] * inv, o0[4 * g + 3] * inv); *(u32x2*)(orow + 8 * g + 4 * hh) = a;
        a.x = pk2(o1[4 * g] * inv, o1[4 * g + 1] * inv); a.y = pk2(o1[4 * g + 2] * inv, o1[4 * g + 3] * inv); *(u32x2*)(orow + 32 + 8 * g + 4 * hh) = a; }
}

constexpr int GL_LA = 0;
constexpr int GL_LR = 32768;
constexpr int GL_WA = 40960;
constexpr int GL_BA = 49152;
constexpr int GL_BL = 49664;
constexpr int GL_A = 51200;
constexpr int GL_B = 67584;
constexpr int GL_C = 83968;
__device__ __forceinline__ int timg(int r, int c, int R) { return (c >> 5) * (R * 64) + (r >> 3) * 512 + (r & 7) * 64 + (c & 31) * 2; }

struct GlaPre { f32x4 lr, wa; float ba; u32x4 gk, gq, v0, v1; f32x4 la[2][2]; u32x4 st[4]; };
__device__ __forceinline__ GlaPre gla_load(Frame& F, int e, int gc, int hd, bool with_q) {
    const int tid = F.tid; const int R0 = gc * 64; GlaPre p; const bf16_t* ZE = WSP(bf16_t, WS_ZE);
    if (!with_q) { const int row = tid >> 3, c4 = tid & 7; p.lr = *(const f32x4*)(WSP(float, WS_LR) + (size_t)(R0 + row) * 32 + 4 * c4);
      const int z = tid >> 8, r = (tid >> 4) & 15, k4 = tid & 15; p.wa = *(const f32x4*)(FIN(I_WALPHA) + ((size_t)(e * 2 + z) * 16 + r) * 256 + hd * 64 + 4 * k4);
      p.ba = FIN(I_BALPHA)[(e * 2 + ((tid >> 6) & 1)) * 256 + hd * 64 + (tid & 63)]; }
    else { const int t = tid >> 3, k8 = (tid & 7) * 8; const float* lg = WSP(float, WS_LAG) + (size_t)(gc * 4 + hd) * 8192 + t * 64 + k8;
#pragma unroll
      for (int z = 0; z < 2; ++z) { p.la[z][0] = *(const f32x4*)(lg + z * 4096); p.la[z][1] = *(const f32x4*)(lg + z * 4096 + 4); }
      const bf16_t* KV = WSP(bf16_t, WS_KV) + (size_t)(gc * 4 + hd) * 2 * 8192;
#pragma unroll
      for (int i = 0; i < 4; ++i) { const int idx = tid + 512 * i, z = idx >> 10, rem = idx & 1023, v = rem >> 3, k8 = (rem & 7) * 8; p.st[i] = *(const u32x4*)(KV + (size_t)z * 8192 + v * 64 + k8); } }
    { const int t = tid >> 3, k8 = (tid & 7) * 8; p.gk = *(const u32x4*)(ZE + (size_t)(R0 + t) * ZW + 1024 + hd * 64 + k8);
      p.gq = with_q ? *(const u32x4*)(ZE + (size_t)(R0 + t) * ZW + 768 + hd * 64 + k8) : p.gk; }
    { const int p0 = tid, p1 = tid + 512; p.v0 = *(const u32x4*)(ZE + (size_t)(R0 + (p0 >> 4)) * ZW + 1280 + hd * 128 + (p0 & 15) * 8); p.v1 = *(const u32x4*)(ZE + (size_t)(R0 + (p1 >> 4)) * ZW + 1280 + hd * 128 + (p1 & 15) * 8); }
    return p;
}
__device__ __forceinline__ void gla_bcum(Frame& F, const GlaPre& p) {
    const int tid = F.tid;
    LAS float* LA = (LAS float*)(F.lds + GL_LA); LAS float* LRs = (LAS float*)(F.lds + GL_LR); LAS float* WA = (LAS float*)(F.lds + GL_WA);
    LAS float* BA = (LAS float*)(F.lds + GL_BA); LAS float* BL = (LAS float*)(F.lds + GL_BL);
    { const int row = tid >> 3, c4 = tid & 7; *(LAS f32x4*)(LRs + row * 32 + 4 * c4) = p.lr;
      const int z = tid >> 8, r = (tid >> 4) & 15, k4 = tid & 15; *(LAS f32x4*)(WA + (z * 16 + r) * 64 + 4 * k4) = p.wa;
      if (tid < 128) BA[tid] = p.ba; }
    __syncthreads();
    { const int lane = F.lane, w = F.wave; const int z = w >> 2, kl = lane & 15, seg = lane >> 4, k = (w & 3) * 16 + kl, t0 = seg * 16;
      float wa[16];
#pragma unroll
      for (int r = 0; r < 16; ++r) wa[r] = WA[(z * 16 + r) * 64 + k];
      const float bz = BA[z * 64 + k];
      float la[16];
#pragma unroll
      for (int t4 = 0; t4 < 16; t4 += 4) { f32x4 l[4][4];
#pragma unroll
          for (int a = 0; a < 4; ++a)
#pragma unroll
              for (int r4 = 0; r4 < 4; ++r4) l[a][r4] = *(const LAS f32x4*)(LRs + (t0 + t4 + a) * 32 + z * 16 + 4 * r4);
          LDS_WAIT();
          f32x2 xp[4];
#pragma unroll
          for (int a = 0; a < 4; ++a) xp[a] = (f32x2){bz, 0.f};
#pragma unroll
          for (int r4 = 0; r4 < 4; ++r4)
#pragma unroll
              for (int h2 = 0; h2 < 2; ++h2) { const f32x2 w2 = (f32x2){wa[4 * r4 + 2 * h2], wa[4 * r4 + 2 * h2 + 1]};
#pragma unroll
                  for (int a = 0; a < 4; ++a) { const f32x2 l2 = (f32x2){l[a][r4][2 * h2], l[a][r4][2 * h2 + 1]}; xp[a] = l2 * w2 + xp[a]; } }
#pragma unroll
          for (int a = 0; a < 4; ++a) { const float x = xp[a][0] + xp[a][1]; la[t4 + a] = (fminf(x, 0.f) - flog(1.0f + fexp(-fabsf(x)))) * (1.0f / 16.0f); } }
      float run = 0.f;
      if (z == 0) {
#pragma unroll
          for (int tt = 0; tt < 16; ++tt) { run += la[tt]; la[tt] = run; }
      } else {
#pragma unroll
          for (int tt = 15; tt >= 0; --tt) { run += la[tt]; la[tt] = run; }
      }
      const float s0 = shfl_idx(run, kl), s1 = shfl_idx(run, kl + 16), s2 = shfl_idx(run, kl + 32), s3 = shfl_idx(run, kl + 48);
      float add;
      if (z == 0) add = (seg > 0 ? s0 : 0.f) + (seg > 1 ? s1 : 0.f) + (seg > 2 ? s2 : 0.f);
      else        add = (seg < 3 ? s3 : 0.f) + (seg < 2 ? s2 : 0.f) + (seg < 1 ? s1 : 0.f);
#pragma unroll
      for (int tt = 0; tt < 16; ++tt) LA[(z * 64 + t0 + tt) * 64 + k] = la[tt] + add;
      if (seg == 0) BL[z * 64 + k] = (s0 + s1) + (s2 + s3); }
    __syncthreads();
}
__device__ __forceinline__ void gla_stage_v(Frame& F, const GlaPre& p, int off) {
    { const int q = F.tid, t = q >> 4, v8 = (q & 15) * 8; *(LAS u32x4*)(F.lds + off + timg(t, v8, 64)) = p.v0; }
    { const int q = F.tid + 512, t = q >> 4, v8 = (q & 15) * 8; *(LAS u32x4*)(F.lds + off + timg(t, v8, 64)) = p.v1; }
}
__device__ __forceinline__ void gla_g1_item(Frame& F, int e, int gc, int hd, const GlaPre& pre) {
    const int tid = F.tid, lane = F.lane, w = F.wave;
    gla_stage_v(F, pre, GL_B);
    gla_bcum(F, pre);
    LAS float* LA = (LAS float*)(F.lds + GL_LA); LAS float* BL = (LAS float*)(F.lds + GL_BL);
    { const int t = tid >> 3, k8 = (tid & 7) * 8; const u32x4 gk = pre.gk;
      const float kf[8] = {bflo(gk.x), bfhi(gk.x), bflo(gk.y), bfhi(gk.y), bflo(gk.z), bfhi(gk.z), bflo(gk.w), bfhi(gk.w)};
#pragma unroll
      for (int z = 0; z < 2; ++z) { float ks[8], lav[8];
#pragma unroll
        for (int j = 0; j < 8; ++j) { lav[j] = LA[(z * 64 + t) * 64 + k8 + j]; ks[j] = kf[j] * fexp(BL[z * 64 + k8 + j] - lav[j]); }
        { float* lg = WSP(float, WS_LAG) + (size_t)(gc * 4 + hd) * 8192 + z * 4096 + t * 64 + k8;
          *(f32x4*)lg = (f32x4){lav[0], lav[1], lav[2], lav[3]}; *(f32x4*)(lg + 4) = (f32x4){lav[4], lav[5], lav[6], lav[7]}; }
        *(LAS u32x4*)(F.lds + GL_A + z * 8192 + timg(t, k8, 64)) = (u32x4){pk2(ks[0], ks[1]), pk2(ks[2], ks[3]), pk2(ks[4], ks[5]), pk2(ks[6], ks[7])}; } }
    __syncthreads();
    { const int vb = w & 3, z = w >> 2; const int hh = lane >> 5, q = (lane & 15) >> 2;
      const int lofs = q * 64 + (((lane >> 4) & 1) * 16 + (lane & 3) * 4) * 2;
      f32x16 a0 = {}, a1 = {};
#pragma unroll
      for (int s = 0; s < 4; ++s) { const int rofs = (2 * s + hh) * 512;
        const lptr vp = F.lds + GL_B + vb * 4096 + rofs + lofs; const s16x4 va = tr_read(vp), vb2 = tr_read(vp + 256);
        const bf16x8 vf = (bf16x8){va[0], va[1], va[2], va[3], vb2[0], vb2[1], vb2[2], vb2[3]};
        const lptr kp = F.lds + GL_A + z * 8192 + rofs + lofs; const s16x4 ka = tr_read(kp), kb2 = tr_read(kp + 256), kc = tr_read(kp + 4096), kd = tr_read(kp + 4096 + 256);
        const bf16x8 kf0 = (bf16x8){ka[0], ka[1], ka[2], ka[3], kb2[0], kb2[1], kb2[2], kb2[3]}, kf1 = (bf16x8){kc[0], kc[1], kc[2], kc[3], kd[0], kd[1], kd[2], kd[3]};
        a0 = __builtin_amdgcn_mfma_f32_32x32x16_bf16(vf, kf0, a0, 0, 0, 0); a1 = __builtin_amdgcn_mfma_f32_32x32x16_bf16(vf, kf1, a1, 0, 0, 0); }
      bf16_t* kv = WSP(bf16_t, WS_KV) + ((size_t)(gc * 4 + hd) * 2 + z) * 8192; const bool ev = (lane & 1) == 0; const int kc = lane & 30;
#pragma unroll
      for (int r = 0; r < 16; r += 2) { const int v = 32 * vb + crow(ev ? r : r + 1, hh);
#pragma unroll
        for (int h = 0; h < 2; ++h) { const float xa = h ? a1[r] : a0[r], xb = h ? a1[r + 1] : a0[r + 1]; const float x = ev ? xa : xb, y = ev ? xb : xa;
          const float yp = __builtin_bit_cast(float, __builtin_amdgcn_update_dpp(0, __builtin_bit_cast(int, y), 0xB1, 0xf, 0xf, true));
          *(unsigned*)(kv + v * 64 + 32 * h + kc) = ev ? pk2(x, yp) : pk2(yp, x); } } }
    if (tid < 128) WSP(float, WS_DL)[((size_t)(gc * 4 + hd) * 2 + (tid >> 6)) * 64 + (tid & 63)] = fexp(BL[tid]);
    __syncthreads();
}
__device__ __forceinline__ void phase_g2(Frame& F, int e) {
    const int tid = F.tid; bf16_t* KV = WSP(bf16_t, WS_KV); const float* DL = WSP(float, WS_DL);
    {
        const int v = F.vcu; const int chain = v >> 3, slice = v & 7; const int b = chain >> 3, hd = (chain >> 1) & 3, z = chain & 1;
        const int off = slice * 1024 + tid * 2, k = off & 63, vv = off >> 6;
        const float* s0 = FIN(I_SGLA) + ((size_t)((b * 2 + e) * 2 + z) * 4 + hd) * 8192;
        f32x2 S = (f32x2){s0[(size_t)k * 128 + vv], s0[(size_t)(k + 1) * 128 + vv]};
        unsigned kvA[16], kvB[16]; f32x2 dlA[16], dlB[16];
#define G2_LOAD(KVR, DLR, C8) _Pragma("unroll") for (int i = 0; i < 16; ++i) { const int c = z ? 63 - ((C8) + i) : (C8) + i; const size_t it = (size_t)((64 + b * 64 + c) * 4 + hd) * 2 + z; \
                KVR[i] = *(const unsigned*)(KV + it * 8192 + off); DLR[i] = *(const f32x2*)(DL + it * 64 + k); }
#define G2_FOLD(KVR, DLR, C8) _Pragma("unroll") for (int i = 0; i < 16; ++i) { const int c = z ? 63 - ((C8) + i) : (C8) + i; const size_t it = (size_t)((64 + b * 64 + c) * 4 + hd) * 2 + z; \
                *(unsigned*)(KV + it * 8192 + off) = pk2(S[0], S[1]); S = DLR[i] * S + (f32x2){bflo(KVR[i]), bfhi(KVR[i])}; }
        G2_LOAD(kvA, dlA, 0)
        G2_LOAD(kvB, dlB, 16)
        G2_FOLD(kvA, dlA, 0)
        G2_LOAD(kvA, dlA, 32)
        G2_FOLD(kvB, dlB, 16)
        G2_LOAD(kvB, dlB, 48)
        G2_FOLD(kvA, dlA, 32)
        G2_FOLD(kvB, dlB, 48)
#undef G2_LOAD
#undef G2_FOLD
    }
    for (int item = F.vcu; item < 512; item += F.G) {
        const int chain = item >> 2, slice = item & 3; const int b = chain >> 3, hd = (chain >> 1) & 3, z = chain & 1;
        const int off = slice * 2048 + tid * 4, k = off & 63, vv = off >> 6;
        const float zf = (float)F.oz; f32x4 S = {zf, zf, zf, zf};
        u32x2 kv4[4]; f32x4 dl4[4];
#pragma unroll
        for (int i = 0; i < 4; ++i) { const int c = z ? 3 - i : i; const size_t it = (size_t)((b * 4 + c) * 4 + hd) * 2 + z; kv4[i] = *(const u32x2*)(KV + it * 8192 + off); dl4[i] = *(const f32x4*)(DL + it * 64 + k); }
#pragma unroll
        for (int i = 0; i < 4; ++i) { const int c = z ? 3 - i : i; const size_t it = (size_t)((b * 4 + c) * 4 + hd) * 2 + z; *(u32x2*)(KV + it * 8192 + off) = (u32x2){pk2(S[0], S[1]), pk2(S[2], S[3])}; S = dl4[i] * S + (f32x4){bflo(kv4[i].x), bfhi(kv4[i].x), bflo(kv4[i].y), bfhi(kv4[i].y)}; }
        float* dst = F.out + OUT_GLA + ((size_t)((b * 2 + e) * 2 + z) * 4 + hd) * 8192;
#pragma unroll
        for (int j = 0; j < 4; ++j) dst[(size_t)(k + j) * 128 + vv] = S[j];
    }
}
__device__ __forceinline__ void gla_g3_item(Frame& F, int e, int gc, int hd, const GlaPre& pre) {
    const int tid = F.tid, lane = F.lane, w = F.wave; const int R0 = gc * 64;
    const bf16_t* ZE = WSP(bf16_t, WS_ZE);
    u32x2 grreg[4];
    { const int vb_ = w >> 1, ib_ = w & 1, i_ = 32 * ib_ + (lane & 31), hh_ = lane >> 5;
#pragma unroll
      for (int g = 0; g < 4; ++g) grreg[g] = *(const u32x2*)(ZE + (size_t)(R0 + i_) * ZW + 1792 + hd * 128 + 32 * vb_ + 8 * g + 4 * hh_); }
    gla_stage_v(F, pre, GL_C);
    { const int t = tid >> 3, c = tid & 7;
      const u32x4 gq = pre.gq, gk = pre.gk;
      const float qf[8] = {bflo(gq.x), bfhi(gq.x), bflo(gq.y), bfhi(gq.y), bflo(gq.z), bfhi(gq.z), bflo(gq.w), bfhi(gq.w)};
      const float kf[8] = {bflo(gk.x), bfhi(gk.x), bflo(gk.y), bfhi(gk.y), bflo(gk.z), bfhi(gk.z), bflo(gk.w), bfhi(gk.w)};
      const int so = t * 128 + ((c ^ (t & 7)) * 16);
#pragma unroll
      for (int z = 0; z < 2; ++z) { float qe[8], ke[8];
#pragma unroll
        for (int j = 0; j < 8; ++j) { const float bc = pre.la[z][j >> 2][j & 3]; qe[j] = qf[j] * fexp(bc); ke[j] = kf[j] * fexp(-bc); }
        *(LAS u32x4*)(F.lds + GL_A + z * 8192 + so) = (u32x4){pk2(qe[0], qe[1]), pk2(qe[2], qe[3]), pk2(qe[4], qe[5]), pk2(qe[6], qe[7])};
        *(LAS u32x4*)(F.lds + GL_B + z * 8192 + so) = (u32x4){pk2(ke[0], ke[1]), pk2(ke[2], ke[3]), pk2(ke[4], ke[5]), pk2(ke[6], ke[7])}; } }
    {
#pragma unroll
      for (int i = 0; i < 4; ++i) { const int idx = tid + 512 * i, z = idx >> 10, rem = idx & 1023, v = rem >> 3, k8 = (rem & 7) * 8;
        *(LAS u32x4*)(F.lds + GL_LA + z * 16384 + v * 128 + (((k8 >> 3) ^ (v & 7)) * 16)) = pre.st[i]; } }
    __syncthreads();
    const int vb = w >> 1, ib = w & 1, r32 = lane & 31, hh = lane >> 5;
    f32x16 o = {};
    bf16x8 qf[2][4];
    { const int i = 32 * ib + r32;
#pragma unroll
      for (int z = 0; z < 2; ++z)
#pragma unroll
        for (int s = 0; s < 4; ++s) qf[z][s] = *(const LAS bf16x8*)(F.lds + GL_A + z * 8192 + i * 128 + (((2 * s + hh) ^ (i & 7)) * 16)); }
    { const int v = 32 * vb + r32;
#pragma unroll
      for (int z = 0; z < 2; ++z)
#pragma unroll
        for (int s = 0; s < 4; ++s) { const bf16x8 sf = *(const LAS bf16x8*)(F.lds + GL_LA + z * 16384 + v * 128 + (((2 * s + hh) ^ (v & 7)) * 16));
            o = __builtin_amdgcn_mfma_f32_32x32x16_bf16(sf, qf[z][s], o, 0, 0, 0); } }
    const lptr vbase = F.lds + GL_C + vb * 4096 + ((lane >> 4) & 1) * 32 + (lane & 3) * 8 + (4 * hh + ((lane & 15) >> 2)) * 64;
#pragma unroll
    for (int jb = 0; jb < 2; ++jb) {
        const int j = 32 * jb + r32; f32x16 xf = {}, xb = {};
        const bool do_f = !(jb == 1 && ib == 0), do_b = !(jb == 0 && ib == 1);
#pragma unroll
        for (int s = 0; s < 4; ++s) { const int so = j * 128 + (((2 * s + hh) ^ (j & 7)) * 16);
            if (do_f) { const bf16x8 kf = *(const LAS bf16x8*)(F.lds + GL_B + so); xf = __builtin_amdgcn_mfma_f32_32x32x16_bf16(kf, qf[0][s], xf, 0, 0, 0); }
            if (do_b) { const bf16x8 kb = *(const LAS bf16x8*)(F.lds + GL_B + 8192 + so); xb = __builtin_amdgcn_mfma_f32_32x32x16_bf16(kb, qf[1][s], xb, 0, 0, 0); } }
        float x[16]; const int ii = 32 * ib + r32;
#pragma unroll
        for (int r = 0; r < 16; ++r) { const int jj = 32 * jb + crow(r, hh); x[r] = ((do_f && jj <= ii) ? xf[r] : 0.f) + ((do_b && jj >= ii) ? xb[r] : 0.f); }
#pragma unroll
        for (int s2 = 0; s2 < 2; ++s2) { const u32x4 pw = (u32x4){pk2(x[8 * s2], x[8 * s2 + 1]), pk2(x[8 * s2 + 2], x[8 * s2 + 3]), pk2(x[8 * s2 + 4], x[8 * s2 + 5]), pk2(x[8 * s2 + 6], x[8 * s2 + 7])};
            const bf16x8 vf = tr_frag(vbase + (4 * jb + 2 * s2) * 512);
            o = __builtin_amdgcn_mfma_f32_32x32x16_bf16(vf, __builtin_bit_cast(bf16x8, pw), o, 0, 0, 0); }
    }
    LAS float* SSQ = (LAS float*)(F.lds + GL_LR);
    { float s = 0.f;
#pragma unroll
      for (int r = 0; r < 16; ++r) s += o[r] * o[r];
      s += shfl_x(s, lane, 32);
      if (hh == 0) SSQ[vb * 64 + 32 * ib + r32] = s; }
    __syncthreads();
    { const int i = 32 * ib + r32; const float tot = SSQ[i] + SSQ[64 + i] + SSQ[128 + i] + SSQ[192 + i]; const float rs = frsq(tot * (1.0f / 128.0f) + EPS);
      const float* gain = FIN(I_GGAIN) + e * 512 + hd * 128; const size_t row = (size_t)(R0 + i);
#pragma unroll
      for (int g = 0; g < 4; ++g) { const int v0 = 32 * vb + 8 * g + 4 * hh; const f32x4 gn = *(const f32x4*)(gain + v0);
        const u32x2 gr = grreg[g];
        const float r0 = o[4 * g] * rs * gn[0] * bflo(gr.x), r1 = o[4 * g + 1] * rs * gn[1] * bfhi(gr.x), r2 = o[4 * g + 2] * rs * gn[2] * bflo(gr.y), r3 = o[4 * g + 3] * rs * gn[3] * bfhi(gr.y);
        *(u32x2*)(WSP(bf16_t, WS_MIX) + row * D + 512 + hd * 128 + v0) = (u32x2){pk2(r0, r1), pk2(r2, r3)}; } }
    __syncthreads();
}

__device__ __forceinline__ void phase_attn_g1(Frame& F, int e) {
    const int v = F.vcu;
    for (int i = 0; i < 2; ++i) { const int uid = 2 * v + i; const int hp = uid & 1, qb = (uid >> 1) & 31, kvh = (uid >> 6) & 1, b = uid >> 7; attn_unit(F, e, 0, b, kvh, qb, hp); }
    if (v < 128) { const int hp = v & 1, qb = (v >> 1) & 1, kvh = (v >> 2) & 1, b = v >> 3; attn_unit(F, e, 1, b, kvh, qb, hp); }
    { GlaPre pre = gla_load(F, e, (v * 5) >> 2, (v * 5) & 3, false);
      for (int it = v * 5; it < v * 5 + 5; ++it) { const int nx = it + 1 < v * 5 + 5 ? it + 1 : it; const GlaPre nxt = gla_load(F, e, nx >> 2, nx & 3, false); gla_g1_item(F, e, it >> 2, it & 3, pre); pre = nxt; } }
}
__device__ __forceinline__ void phase_g3(Frame& F, int e) {
    const int v = F.vcu;
    GlaPre pre = gla_load(F, e, (v * 5) >> 2, (v * 5) & 3, true);
    for (int it = v * 5; it < v * 5 + 5; ++it) { const int nx = it + 1 < v * 5 + 5 ? it + 1 : it; const GlaPre nxt = gla_load(F, e, nx >> 2, nx & 3, true); gla_g3_item(F, e, it >> 2, it & 3, pre); pre = nxt; }
}

__device__ __forceinline__ void phase_conv(Frame& F, int o) {
    const bf16_t* U = WSP(bf16_t, WS_U); bf16_t* UC = WSP(bf16_t, WS_UC);
    const int gt = F.vcu * NTHREADS + F.tid, NGT = F.G * NTHREADS;
    constexpr int NIT = 1280 * 128; const int full = (NIT / NGT) * NGT, rem = NIT - full;
    const bool xal = (F.G == 256);
    for (int it_ = gt; it_ < full; it_ += NGT) {
        const int it = xal ? (((160 * (it_ >> 14) + ((it_ & 16383) >> 7)) << 7) | (it_ & 127)) : it_;
        const int cg = it & 127, rg = it >> 7, c0 = cg * 8, r0 = rg * 16;
        const int seqlen = r0 < MCTX ? TCTX : TLAT; const int sb = r0 < MCTX ? (r0 & ~(TCTX - 1)) : MCTX + ((r0 - MCTX) & ~(TLAT - 1)); const int se = sb + seqlen;
        float w[4][8], bias[8];
#pragma unroll
        for (int i = 0; i < 4; ++i)
#pragma unroll
            for (int j = 0; j < 8; ++j) w[i][j] = FIN(I_CONVW)[(size_t)(o * 4 + i) * 1024 + c0 + j];
#pragma unroll
        for (int j = 0; j < 8; ++j) bias[j] = FIN(I_CONVB)[o * 1024 + c0 + j];
        u32x4 raw[19];
#pragma unroll
        for (int r = 0; r < 19; ++r) { const int row = r0 - 2 + r; const int rc = row < sb ? sb : (row >= se ? se - 1 : row); raw[r] = *(const u32x4*)(U + (size_t)rc * D + c0); }
#pragma unroll
        for (int r = 0; r < 19; ++r) { const int row = r0 - 2 + r; if (row < sb || row >= se) raw[r] = (u32x4){0u, 0u, 0u, 0u}; }
#pragma unroll
        for (int r = 0; r < 16; ++r) { float y[8];
#pragma unroll
            for (int j = 0; j < 8; ++j) { const int w2 = j >> 1;
                const float x0 = (j & 1) ? bfhi(raw[r][w2]) : bflo(raw[r][w2]), x1 = (j & 1) ? bfhi(raw[r + 1][w2]) : bflo(raw[r + 1][w2]), x2 = (j & 1) ? bfhi(raw[r + 2][w2]) : bflo(raw[r + 2][w2]), x3 = (j & 1) ? bfhi(raw[r + 3][w2]) : bflo(raw[r + 3][w2]);
                y[j] = bias[j] + w[0][j] * x0 + w[1][j] * x1 + w[2][j] * x2 + w[3][j] * x3; }
            *(u32x4*)(UC + (size_t)(r0 + r) * D + c0) = (u32x4){pk2(y[0], y[1]), pk2(y[2], y[3]), pk2(y[4], y[5]), pk2(y[6], y[7])}; }
    }
    for (int s_ = gt; s_ < rem * 4; s_ += NGT) {
        const int it = xal ? (((160 * (s_ >> 14) + 128 + ((s_ & 4095) >> 7)) << 7) | (s_ & 127)) : full + s_ % rem, q4 = xal ? ((s_ & 16383) >> 12) : s_ / rem;
        const int cg = it & 127, rg = it >> 7, c0 = cg * 8, r0 = rg * 16 + 4 * q4, rs = rg * 16;
        const int seqlen = rs < MCTX ? TCTX : TLAT; const int sb = rs < MCTX ? (rs & ~(TCTX - 1)) : MCTX + ((rs - MCTX) & ~(TLAT - 1)); const int se = sb + seqlen;
        float w[4][8], bias[8];
#pragma unroll
        for (int i = 0; i < 4; ++i)
#pragma unroll
            for (int j = 0; j < 8; ++j) w[i][j] = FIN(I_CONVW)[(size_t)(o * 4 + i) * 1024 + c0 + j];
#pragma unroll
        for (int j = 0; j < 8; ++j) bias[j] = FIN(I_CONVB)[o * 1024 + c0 + j];
        u32x4 raw[7];
#pragma unroll
        for (int r = 0; r < 7; ++r) { const int row = r0 - 2 + r; const int rc = row < sb ? sb : (row >= se ? se - 1 : row); raw[r] = *(const u32x4*)(U + (size_t)rc * D + c0); }
#pragma unroll
        for (int r = 0; r < 7; ++r) { const int row = r0 - 2 + r; if (row < sb || row >= se) raw[r] = (u32x4){0u, 0u, 0u, 0u}; }
#pragma unroll
        for (int r = 0; r < 4; ++r) { float y[8];
#pragma unroll
            for (int j = 0; j < 8; ++j) { const int w2 = j >> 1;
                const float x0 = (j & 1) ? bfhi(raw[r][w2]) : bflo(raw[r][w2]), x1 = (j & 1) ? bfhi(raw[r + 1][w2]) : bflo(raw[r + 1][w2]), x2 = (j & 1) ? bfhi(raw[r + 2][w2]) : bflo(raw[r + 2][w2]), x3 = (j & 1) ? bfhi(raw[r + 3][w2]) : bflo(raw[r + 3][w2]);
                y[j] = bias[j] + w[0][j] * x0 + w[1][j] * x1 + w[2][j] * x2 + w[3][j] * x3; }
            *(u32x4*)(UC + (size_t)(r0 + r) * D + c0) = (u32x4){pk2(y[0], y[1]), pk2(y[2], y[3]), pk2(y[4], y[5]), pk2(y[6], y[7])}; }
    }
}
__device__ __forceinline__ void phase_carry(Frame& F, int o) {
    const float* AGG = WSP(float, WS_AGG); float* CAR = WSP(float, WS_CARRY);
    const int gt = F.vcu * NTHREADS + F.tid, NGT = F.G * NTHREADS;
    for (int c = gt; c < 8192 + 32768; c += NGT) {
        if (c < 8192) { const int b = c >> 11, z = (c >> 10) & 1, ch = c & 1023; const int base = 64 + b * 64;
            float h = FIN(I_SLRU)[(size_t)((b * 2 + o) * 2 + z) * 1024 + ch];
            for (int i8 = 0; i8 < 64; i8 += 32) { f32x2 a[32];
#pragma unroll
                for (int i = 0; i < 32; ++i) { const int ck = base + (z ? 63 - (i8 + i) : i8 + i); a[i] = *(const f32x2*)(AGG + ((size_t)(ck * 2 + z) * 1024 + ch) * 2); }
#pragma unroll
                for (int i = 0; i < 32; ++i) { const int ck = base + (z ? 63 - (i8 + i) : i8 + i); CAR[(size_t)(ck * 2 + z) * 1024 + ch] = h; h = a[i].x * h + a[i].y; } }
        } else { const int cc = c - 8192; const int b = cc >> 11, z = (cc >> 10) & 1, ch = cc & 1023; const int base = b * 4; float h = 0.f;
#pragma unroll
            for (int i = 0; i < 4; ++i) { const int ck = base + (z ? 3 - i : i); const f32x2 a = *(const f32x2*)(AGG + ((size_t)(ck * 2 + z) * 1024 + ch) * 2); CAR[(size_t)(ck * 2 + z) * 1024 + ch] = h; h = a.x * h + a.y; }
            F.out[OUT_LRU + (size_t)((b * 2 + o) * 2 + z) * 1024 + ch] = h; }
    }
}
__device__ __forceinline__ void phase_lru_out(Frame& F) {
    const bf16_t* ACF = WSP(bf16_t, WS_LAF); const bf16_t* ACB = WSP(bf16_t, WS_LAB); const bf16_t* HLF = WSP(bf16_t, WS_U); const bf16_t* HLB = WSP(bf16_t, WS_BB);
    const bf16_t* Gg = WSP(bf16_t, WS_G); bf16_t* YG = WSP(bf16_t, WS_BB); const float* CAR = WSP(float, WS_CARRY);
    const int gt = F.vcu * NTHREADS + F.tid, NGT = F.G * NTHREADS;
    constexpr int NIT = 1280 * 128; const int full = (NIT / NGT) * NGT, rem = NIT - full;
    for (int s_ = gt; s_ < full + rem * 4; s_ += (s_ < full ? NGT : NGT)) {
        int it, rbeg, nrow;
        const bool xal = (F.G == 256);
        if (s_ < full) { it = xal ? (((160 * (s_ >> 14) + ((s_ & 16383) >> 7)) << 7) | (s_ & 127)) : s_; rbeg = 0; nrow = 16; }
        else { const int t_ = s_ - full; const int q = xal ? ((t_ & 16383) >> 12) : t_ / rem; it = xal ? (((160 * (t_ >> 14) + 128 + ((t_ & 4095) >> 7)) << 7) | (t_ & 127)) : full + t_ % rem; rbeg = 4 * q; nrow = 4; }
        const int cg = it & 127, rg = it >> 7, c0 = cg * 8, r0 = rg * 16, ck = r0 >> 6;
        float cf[8], cb[8];
        { const f32x4 a0 = *(const f32x4*)(CAR + (size_t)(ck * 2) * 1024 + c0), a1 = *(const f32x4*)(CAR + (size_t)(ck * 2) * 1024 + c0 + 4), b0 = *(const f32x4*)(CAR + (size_t)(ck * 2 + 1) * 1024 + c0), b1 = *(const f32x4*)(CAR + (size_t)(ck * 2 + 1) * 1024 + c0 + 4);
#pragma unroll
          for (int j = 0; j < 4; ++j) { cf[j] = a0[j]; cf[4 + j] = a1[j]; cb[j] = b0[j]; cb[4 + j] = b1[j]; } }
        for (int rr = rbeg; rr < rbeg + nrow; rr += 4) {
#pragma unroll
        for (int r4 = 0; r4 < 4; ++r4) { const size_t ix = (size_t)(r0 + rr + r4) * D + c0;
            const u32x4 af = *(const u32x4*)(ACF + ix), ab = *(const u32x4*)(ACB + ix), hf = *(const u32x4*)(HLF + ix), hb = *(const u32x4*)(HLB + ix), gg = *(const u32x4*)(Gg + ix);
            float y[8];
#pragma unroll
            for (int w2 = 0; w2 < 4; ++w2) { y[2 * w2] = bflo(gg[w2]) * ((bflo(hf[w2]) + bflo(af[w2]) * cf[2 * w2]) + (bflo(hb[w2]) + bflo(ab[w2]) * cb[2 * w2]));
                y[2 * w2 + 1] = bfhi(gg[w2]) * ((bfhi(hf[w2]) + bfhi(af[w2]) * cf[2 * w2 + 1]) + (bfhi(hb[w2]) + bfhi(ab[w2]) * cb[2 * w2 + 1])); }
            *(u32x4*)(YG + ix) = (u32x4){pk2(y[0], y[1]), pk2(y[2], y[3]), pk2(y[4], y[5]), pk2(y[6], y[7])}; } }
    }
}

constexpr int NSTEPS = 42;
template <int KIND>
__device__ __forceinline__ void run_gemm(Frame& F, int l, int sub, int gidx, const bf16_t* A, int lda, int K, int a_grp, const bf16_t* Bt, int nN, bool perm, int dep, int depneed, int pub, int rot, int qidx, unsigned stop_at = 0, int jlo = 0, int jhi = 1 << 30, bool again = false) {
    pg8::Gemm g; g.A = A; g.Bt = Bt; g.lda = lda; g.K = K; g.nM = M / 256; g.nN = nN; g.a_grp = a_grp; g.perm = perm; g.aperm = (KIND == EK_GATES);
    Epi<KIND> E; E.layer = l; E.sub = sub; E.gidx = gidx; E.p = F.p; E.oz = F.oz;
    pg8::StaticOrder S; S.init(g.nM, g.nN, F.G, F.bid); S.rot = rot;
    S.stop_at = stop_at; S.jlo = jlo; S.jhi = jhi; S.again = again;
    unsigned* cw = WSP(unsigned, WS_CTL) + CW_CNT;
    if (dep >= 0) { S.ready = cw + (size_t)dep * 80 * 16; S.need = (unsigned)depneed * 8u; }
    if (pub >= 0) S.fin = cw + (size_t)pub * 80 * 16;
    if (qidx >= 0 && F.G == 256) { S.queue = WSP(unsigned, WS_CTL) + CW_Q + (size_t)qidx * 8 * 16; S.word = (LAS unsigned*)(F.lds + MISC_OFF + 64); }
    pg8::gemm_phase<Epi<KIND>>(F.lds, F.tid, (float)F.oz, g, S, E);
}
__global__ void __launch_bounds__(NTHREADS, 2) mk_fwd(Params P) {
    extern __shared__ __attribute__((aligned(16))) unsigned char lds_raw[];
    const lptr lds0 = (lptr)lds_raw;
    volatile LAS unsigned* MISC = (volatile LAS unsigned*)(lds0 + MISC_OFF);
    static_assert((LDS_BYTES - LDSCTL_OFF) == 8 * NTHREADS * 4, "LDS control region");
#pragma unroll
    for (int u = 0; u < 8; ++u) ((LAS unsigned*)(lds0 + LDSCTL_OFF))[u * NTHREADS + threadIdx.x] = 0u;
    __syncthreads();
    unsigned* ctl = (unsigned*)(P.ws + WS_CTL);
    XcdBarrier bar; bar.bar = ctl + 1024; bar.x = 0; bar.st = nullptr;
    const int lo = P.step_lo, hi = P.step_hi;
    const bool multi = (hi - lo) > 1;
    if (multi) bar = xcd_barrier_post(ctl + 1024, MISC + 8);
    volatile LAS unsigned long long* TS = (volatile LAS unsigned long long*)(lds0 + LDSCTL_OFF + 1024);
    if (PROBE_K1 >= 0 && blockIdx.x == 0 && threadIdx.x == 0) TS[0] = __builtin_amdgcn_s_memrealtime();
#define STEP_BEGIN(s) if (lo <= (s) && (s) < hi) { Frame F; F.lds = lds0; F.p = &P; \
        { int tid = threadIdx.x; asm volatile("" : "+v"(tid)); F.tid = tid; F.lane = tid & 63; F.wave = __builtin_amdgcn_readfirstlane(tid >> 6); } \
        { int G = gridDim.x, bx = blockIdx.x, oz = 0; asm volatile("" : "+s"(G), "+s"(bx), "+s"(oz)); F.G = G; F.bid = bx; F.vcu = (G % 8 == 0) ? (bx % 8) * (G / 8) + bx / 8 : bx; F.oz = oz; F.out = P.out + oz; }
#define STAMP() do { if (PROBE_K1 >= 0 && blockIdx.x == 0 && threadIdx.x == 0) { const int o_ = (int)TS[63]; if (o_ < 62) TS[o_ + 1] = __builtin_amdgcn_s_memrealtime(); TS[63] = (unsigned long long)(o_ + 1); } } while (0)
#define STEP_END(s) if (multi && (s) + 1 < hi) { XcdBarrier bb = bar; asm volatile("" : "+s"(bb.bar), "+s"(bb.x)); xcd_barrier(bb, F.tid); } else __syncthreads(); STAMP(); }

#define STEP_LINK(s) __syncthreads(); STAMP(); }
#define STEP_END_IF(c, s) if ((c) && multi && (s) + 1 < hi) { XcdBarrier bb = bar; asm volatile("" : "+s"(bb.bar), "+s"(bb.x)); xcd_barrier(bb, F.tid); } else __syncthreads(); STAMP(); }
    STEP_BEGIN(0) phase_prologue(F); STEP_END(0)
    for (int l = 0; l < DEPTH; ++l) {
        const int s0 = 1 + 10 * l; const bool even = (l & 1) == 0; const int sub = l >> 1;
        const int dep_in = l > 0 ? (l - 1) * 3 + 2 : -1;
        if (l == 0) { STEP_BEGIN(1) phase_pre(F); STEP_END(1) }
        if (even) {
            STEP_BEGIN(s0 + 1) run_gemm<EK_EVEN_IN>(F, l, sub, 0, WSP(bf16_t, WS_XN), D, D, 0, WSP(bf16_t, WS_WINE) + (size_t)sub * PEP * D, 10, true, dep_in, 4, -1, 0, l * 4 + 3); if (l == 0 && multi) phase_bias_rest(F); STEP_END(s0 + 1)
            STEP_BEGIN(s0 + 2) phase_attn_g1(F, sub); STEP_END(s0 + 2)
            STEP_BEGIN(s0 + 3) phase_g2(F, sub); STEP_END(s0 + 3)
            STEP_BEGIN(s0 + 4) phase_g3(F, sub); STEP_END(s0 + 4)
            STEP_BEGIN(s0 + 6) run_gemm<EK_RES>(F, l, sub, 2, WSP(bf16_t, WS_MIX), D, D, 0, WSP(bf16_t, WS_WOUTE) + (size_t)sub * D * D, 4, true, -1, 0, l * 3 + 0, 0, -1); STEP_LINK(s0 + 6)
        } else {
            STEP_BEGIN(s0 + 1) run_gemm<EK_ODD_IN>(F, l, sub, 0, WSP(bf16_t, WS_XN), D, D, 0, WSP(bf16_t, WS_WINO) + (size_t)sub * 2048 * D, 8, true, dep_in, 4, -1, 0, l * 4 + 3); STEP_END(s0 + 1)
            STEP_BEGIN(s0 + 2) phase_conv(F, sub); STEP_END(s0 + 2)
            STEP_BEGIN(s0 + 3) run_gemm<EK_GATES>(F, l, sub, 0, WSP(bf16_t, WS_UC), D, 256, 4, WSP(bf16_t, WS_WG) + (size_t)sub * 4096 * 256, 16, true, -1, 0, -1, 0, -1); STEP_END(s0 + 3)
            STEP_BEGIN(s0 + 4) phase_carry(F, sub); STEP_END(s0 + 4)
            STEP_BEGIN(s0 + 5) phase_lru_out(F); STEP_END(s0 + 5)
            STEP_BEGIN(s0 + 6) run_gemm<EK_RES>(F, l, sub, 2, WSP(bf16_t, WS_BB), D, D, 0, WSP(bf16_t, WS_WOUTO) + (size_t)sub * D * D, 4, true, -1, 0, l * 3 + 0, 0, -1); STEP_LINK(s0 + 6)
        }
        for (int ph = 0; ph < 2; ++ph) {
            const int f2s = (l + 1 < DEPTH) ? 20 : 8; const bool own0 = (((int)blockIdx.x >> 3) & 31) < f2s;
            STEP_BEGIN(s0 + 8) run_gemm<EK_SWIGLU>(F, l, sub, 0, WSP(bf16_t, WS_XN), D, D, 0, WSP(bf16_t, WS_WF1) + (size_t)l * 5632 * D, 22, true, l * 3 + 0, 4, l * 3 + 1, 0, l * 4 + 1, (ph == 0 && own0) ? F2_T0 : 0u, 0, 1 << 30, ph != 0); STEP_LINK(s0 + 8)
            STEP_BEGIN(s0 + 9) run_gemm<EK_RES>(F, l, sub, 5, WSP(bf16_t, WS_H), DFF, DFF, 0, WSP(bf16_t, WS_WF2) + (size_t)l * D * DFF, 4, true, l * 3 + 1, 22, (l + 1 < DEPTH) ? l * 3 + 2 : -1, 0, -1, 0u, ph ? f2s : 0, ph ? 40 : f2s, ph != 0);
            STEP_END_IF(ph == 1 && l + 1 == DEPTH, s0 + 9)
        }
    }
    STEP_BEGIN(41) phase_final(F); STEP_END(41)
#undef STEP_LINK
#undef STEP_END_IF
    if (PROBE_K1 >= 0 && blockIdx.x == 0 && threadIdx.x == 0) {
        unsigned long long q1 = (TS[PROBE_K1 + 1] - TS[PROBE_K1]) / 800ull; if (q1 > 63) q1 = 63;
        unsigned long long q2 = PROBE_K2 >= 0 ? (TS[PROBE_K2 + 1] - TS[PROBE_K2]) / 800ull : 0ull; if (q2 > 63) q2 = 63;
        const unsigned long long wait = (64ull * q1 + 4096ull * q2) * 100ull, t0 = __builtin_amdgcn_s_memrealtime();
        while (__builtin_amdgcn_s_memrealtime() - t0 < wait) __builtin_amdgcn_s_sleep(32);
    }
#undef STEP_BEGIN
#undef STEP_END
}

extern "C" void kernel_launch(void* const* d_in, const int* in_sizes, int n_in, void* d_out, int out_size, void* d_ws, size_t ws_size, hipStream_t stream) {
    static int grid = 0;
    if (grid == 0) {
        if (n_in != 30 || (size_t)out_size != OUT_END || ws_size < WS_END) { fprintf(stderr, "kernel_launch: unexpected shapes: n_in %d out %d ws %zu (need %zu)\n", n_in, out_size, ws_size, (size_t)WS_END); grid = -1; return; }
        int dev = 0, cus = 0;
        if (hipGetDevice(&dev) != hipSuccess || hipDeviceGetAttribute(&cus, hipDeviceAttributeMultiprocessorCount, dev) != hipSuccess) { grid = -1; return; }
        if (hipFuncSetAttribute((const void*)mk_fwd, hipFuncAttributeMaxDynamicSharedMemorySize, LDS_BYTES) != hipSuccess) { fprintf(stderr, "kernel_launch: hipFuncSetAttribute failed\n"); grid = -1; return; }
        (void)hipGetLastError();
        grid = cus;
        if (grid != 256) fprintf(stderr, "kernel_launch: %d CUs (built for 256)\n", grid);
    }
    if (grid < 0) return;
    (void)hipMemsetAsync((char*)d_ws + WS_CTL, 0, CTL_ZERO_BYTES, stream);
    Params p{};
    for (int i = 0; i < 30; ++i) p.in[i] = (const float*)d_in[i];
    p.out = (float*)d_out; p.ws = (unsigned char*)d_ws;
#if MK_MULTI
    for (int s = 0; s < NSTEPS; ++s) {
        if (s >= 1 && s <= 40) { const int l = (s - 1) / 10, j = (s - 1) % 10; if (((l & 1) == 0 && j == 5) || j == 7 || (j == 0 && l > 0)) continue; }
        p.step_lo = s; p.step_hi = s + 1;
        hipLaunchKernelGGL(mk_fwd, dim3(grid), dim3(NTHREADS), LDS_BYTES, stream, p);
    }
#else
    p.step_lo = 0; p.step_hi = NSTEPS;
    hipLaunchKernelGGL(mk_fwd, dim3(grid), dim3(NTHREADS), LDS_BYTES, stream, p);
#endif
}
```
